# Optimizing an MI355X kernel written in HIP

```python
import math
import jax
import jax.numpy as jnp
from jax import lax
import numpy as np

D_MODEL = 1024
BATCH = 8
SEQ = 2048
DEPTH = 1

CHUNK = 64
Q_BLOCK = 128
GDN_HEADS = D_MODEL // 256
GDN_DK = 128
GDN_DV = 128
GDN_WIDTH = GDN_HEADS * GDN_DV
FOX_HEADS = D_MODEL // 128
FOX_DH = 64
FOX_WIDTH = FOX_HEADS * FOX_DH
CONV_W = 4
D_FF = 4 * D_MODEL
D_PLE = 256
LN_EPS = 1e-5
NORM_EPS = 1e-6
ALPHA = (2.0 * DEPTH) ** 0.25
BETA_INIT = (8.0 * DEPTH) ** -0.25

GDN_QK = GDN_HEADS * GDN_DK
GDN_QKV = 2 * GDN_QK + GDN_WIDTH
OFF_Z = GDN_QKV
OFF_BETA = OFF_Z + GDN_WIDTH
OFF_A = OFF_BETA + GDN_HEADS
OFF_FOX = OFF_A + GDN_HEADS
OFF_F = OFF_FOX + 3 * FOX_WIDTH
D_IN = OFF_F + FOX_HEADS

kernel_name = 'hybrid_gdn_fox_deepnorm_block'


def _layer_norm(x, g, b):
    xf = x.astype(jnp.float32)
    mu = jnp.mean(xf, -1, keepdims=True)
    var = jnp.mean(jnp.square(xf - mu), -1, keepdims=True)
    return ((xf - mu) * lax.rsqrt(var + LN_EPS) * g.astype(jnp.float32) + b.astype(jnp.float32)).astype(x.dtype)


def _rms_norm(x, g):
    xf = x.astype(jnp.float32)
    return (xf * lax.rsqrt(jnp.mean(xf * xf, -1, keepdims=True) + NORM_EPS) * g.astype(jnp.float32)).astype(x.dtype)


def _l2norm(x):
    xf = x.astype(jnp.float32)
    return xf * lax.rsqrt(jnp.sum(xf * xf, -1, keepdims=True) + NORM_EPS)


def _causal_conv(x, w):
    c = x.shape[-1]
    return lax.conv_general_dilated(x, w[:, None, :], window_strides=(1,), padding=[(CONV_W - 1, 0)],
                                    dimension_numbers=('NWC', 'WIO', 'NWC'), feature_group_count=c)


def _gated_delta_rule(q, k, v, beta, log_g):
    B, T, H, dk = q.shape
    dv = v.shape[-1]
    n = T // CHUNK
    f32 = jnp.float32

    def to_chunks(a):
        a = a.reshape((B, n, CHUNK) + a.shape[2:])
        return jnp.moveaxis(a, 3, 1)

    q = to_chunks(q.astype(f32)) * (dk ** -0.5)
    k = to_chunks(k.astype(f32))
    v = to_chunks(v.astype(f32))
    beta = to_chunks(beta)
    gam = jnp.cumsum(to_chunks(log_g), axis=-1)
    idx = jnp.arange(CHUNK)
    causal = idx[:, None] >= idx[None, :]
    strict = idx[:, None] > idx[None, :]
    decay = jnp.exp(jnp.where(causal, gam[..., :, None] - gam[..., None, :], -jnp.inf))

    kk = jnp.einsum('bhnid,bhnjd->bhnij', k, k)
    a_mat = jnp.where(strict, kk * beta[..., :, None] * decay, 0.0) + jnp.eye(CHUNK, dtype=f32)
    rhs = jnp.concatenate([v * beta[..., None], k * (beta * jnp.exp(gam))[..., None]], axis=-1)
    sol = lax.linalg.triangular_solve(a_mat, rhs, left_side=True, lower=True, unit_diagonal=True)
    u, w = sol[..., :dv], sol[..., dv:]

    qk_intra = jnp.where(causal, jnp.einsum('bhnid,bhnjd->bhnij', q, k) * decay, 0.0)
    q_dec = q * jnp.exp(gam)[..., None]
    k_dec = k * jnp.exp(gam[..., -1:] - gam)[..., None]
    g_last = jnp.exp(gam[..., -1])

    xs = tuple(jnp.moveaxis(a, 2, 0) for a in (q_dec, k_dec, u, w, qk_intra, g_last))

    def step(S, inp):
        qd, kd, u_c, w_c, a_c, gl = inp
        v_new = u_c - jnp.einsum('bhck,bhkv->bhcv', w_c, S)
        o = jnp.einsum('bhck,bhkv->bhcv', qd, S) + jnp.einsum('bhij,bhjv->bhiv', a_c, v_new)
        S = S * gl[..., None, None] + jnp.einsum('bhck,bhcv->bhkv', kd, v_new)
        return S, o

    s0 = jnp.zeros((B, H, dk, dv), f32)
    _, o = lax.scan(step, s0, xs)
    o = jnp.moveaxis(o, 0, 2)
    return jnp.moveaxis(o, 1, 3).reshape(B, T, H, dv)


def _forgetting_attention(q, k, v, log_f):
    B, T, H, d = q.shape
    nb = T // Q_BLOCK
    scale = d ** -0.5
    c_all = jnp.transpose(jnp.cumsum(log_f, axis=1), (0, 2, 1))
    qb = jnp.moveaxis(q.reshape(B, nb, Q_BLOCK, H, d), 1, 0)
    cb = jnp.moveaxis(c_all.reshape(B, H, nb, Q_BLOCK), 2, 0)
    k_pos = jnp.arange(T)

    def block(args):
        i, q_i, c_i = args
        s = jnp.einsum('bqhd,bkhd->bhqk', q_i, k).astype(jnp.float32) * scale
        s = s + c_i[..., :, None] - c_all[..., None, :]
        q_pos = i * Q_BLOCK + jnp.arange(Q_BLOCK)
        s = jnp.where(k_pos[None, :] <= q_pos[:, None], s, -jnp.inf)
        attn = jax.nn.softmax(s, axis=-1)
        return jnp.einsum('bhqk,bkhd->bqhd', attn.astype(v.dtype), v)

    out = lax.map(block, (jnp.arange(nb), qb, cb))
    return jnp.moveaxis(out, 0, 1).reshape(B, T, H, d)


def setup_inputs(seed: int = 0) -> dict:
    key = jax.random.key(seed)
    ks = jax.random.split(key, 24)
    f32 = jnp.float32

    def nrm(k, shape, s):
        return jax.random.normal(k, shape, f32) * s

    x = nrm(ks[0], (BATCH, SEQ, D_MODEL), 1.0)
    p = nrm(ks[1], (DEPTH, BATCH, SEQ, D_PLE), 1.0)
    ln_in_g = 1.0 + nrm(ks[2], (D_MODEL,), 0.02)
    ln_in_b = nrm(ks[3], (D_MODEL,), 0.02)
    w_in = nrm(ks[4], (DEPTH, D_MODEL, D_IN), D_MODEL ** -0.5)
    conv_w = nrm(ks[5], (DEPTH, CONV_W, GDN_QKV), CONV_W ** -0.5)
    a_log = jnp.log(jax.random.uniform(ks[6], (DEPTH, GDN_HEADS), f32, 1.0, 16.0))
    dt = jnp.exp(jax.random.uniform(ks[7], (DEPTH, GDN_HEADS), f32, math.log(1e-3), math.log(1e-1)))
    dt_bias = dt + jnp.log(-jnp.expm1(-dt))
    gdn_norm_g = 1.0 + nrm(ks[8], (DEPTH, GDN_DV), 0.02)
    b_f = jnp.linspace(1.0, 5.0, FOX_HEADS, dtype=f32)[None, :] + nrm(ks[9], (DEPTH, FOX_HEADS), 0.1)
    fox_norm_g = 1.0 + nrm(ks[10], (DEPTH, FOX_DH), 0.02)
    w_out = nrm(ks[11], (DEPTH, D_MODEL, D_MODEL), BETA_INIT * D_MODEL ** -0.5)
    ln1_g = 1.0 + nrm(ks[12], (DEPTH, D_MODEL), 0.02)
    ln1_b = nrm(ks[13], (DEPTH, D_MODEL), 0.02)
    w_up = nrm(ks[14], (DEPTH, D_MODEL, D_FF), D_MODEL ** -0.5)
    w_down = nrm(ks[15], (DEPTH, D_FF, D_MODEL), BETA_INIT * D_FF ** -0.5)
    w_ple = nrm(ks[16], (DEPTH, D_PLE, D_MODEL), BETA_INIT * D_PLE ** -0.5)
    w_ple_gate = nrm(ks[17], (DEPTH, D_MODEL, D_MODEL), D_MODEL ** -0.5)
    b_ple_gate = nrm(ks[18], (DEPTH, D_MODEL), 0.02)
    ln2_g = 1.0 + nrm(ks[19], (DEPTH, D_MODEL), 0.02)
    ln2_b = nrm(ks[20], (DEPTH, D_MODEL), 0.02)
    return {'x': x, 'p': p, 'ln_in_g': ln_in_g, 'ln_in_b': ln_in_b, 'w_in': w_in, 'conv_w': conv_w,
            'a_log': a_log, 'dt_bias': dt_bias, 'gdn_norm_g': gdn_norm_g, 'b_f': b_f,
            'fox_norm_g': fox_norm_g, 'w_out': w_out, 'ln1_g': ln1_g, 'ln1_b': ln1_b, 'w_up': w_up,
            'w_down': w_down, 'w_ple': w_ple, 'w_ple_gate': w_ple_gate, 'b_ple_gate': b_ple_gate,
            'ln2_g': ln2_g, 'ln2_b': ln2_b}


def reference(x, p, ln_in_g, ln_in_b, w_in, conv_w, a_log, dt_bias, gdn_norm_g, b_f, fox_norm_g,
              w_out, ln1_g, ln1_b, w_up, w_down, w_ple, w_ple_gate, b_ple_gate, ln2_g, ln2_b):
    B, T, _ = x.shape
    f32 = jnp.float32
    h = _layer_norm(x, ln_in_g, ln_in_b)
    for i in range(DEPTH):
        proj = h @ w_in[i]

        qkv = jax.nn.silu(_causal_conv(proj[..., :GDN_QKV], conv_w[i]))
        gq = _l2norm(qkv[..., :GDN_QK].reshape(B, T, GDN_HEADS, GDN_DK))
        gk = _l2norm(qkv[..., GDN_QK:2 * GDN_QK].reshape(B, T, GDN_HEADS, GDN_DK))
        gv = qkv[..., 2 * GDN_QK:].reshape(B, T, GDN_HEADS, GDN_DV)
        z = proj[..., OFF_Z:OFF_BETA].reshape(B, T, GDN_HEADS, GDN_DV)
        beta = jax.nn.sigmoid(proj[..., OFF_BETA:OFF_A].astype(f32))
        log_g = -jnp.exp(a_log[i].astype(f32)) * jax.nn.softplus(proj[..., OFF_A:OFF_FOX].astype(f32) + dt_bias[i].astype(f32))
        o_gdn = _gated_delta_rule(gq, gk, gv, beta, log_g).astype(x.dtype)
        o_gdn = (_rms_norm(o_gdn, gdn_norm_g[i]) * jax.nn.silu(z)).reshape(B, T, GDN_WIDTH)

        fqkv = proj[..., OFF_FOX:OFF_F].reshape(B, T, 3, FOX_HEADS, FOX_DH)
        log_f = jax.nn.log_sigmoid(proj[..., OFF_F:].astype(f32) + b_f[i].astype(f32))
        o_fox = _forgetting_attention(fqkv[:, :, 0], fqkv[:, :, 1], fqkv[:, :, 2], log_f)
        o_fox = _rms_norm(o_fox, fox_norm_g[i]).reshape(B, T, FOX_WIDTH)

        mix = jnp.concatenate([o_gdn, o_fox], axis=-1) @ w_out[i]
        h = _layer_norm(ALPHA * h + mix, ln1_g[i], ln1_b[i])

        ff = jnp.square(jax.nn.relu(h @ w_up[i])) @ w_down[i]
        ple = (p[i] @ w_ple[i]) * jax.nn.sigmoid(h @ w_ple_gate[i] + b_ple_gate[i])
        h = _layer_norm(ALPHA * h + ff + ple, ln2_g[i], ln2_b[i])
    return h
```

```cpp
#include <hip/hip_runtime.h>
#include <hip/hip_cooperative_groups.h>
#include <cstdio>
namespace cg = cooperative_groups;

typedef unsigned short bf16_t;
typedef short bf16x8 __attribute__((ext_vector_type(8)));
typedef short s16x4 __attribute__((ext_vector_type(4)));
typedef float f32x16 __attribute__((ext_vector_type(16)));
typedef float f32x4 __attribute__((ext_vector_type(4)));
typedef unsigned u32x4 __attribute__((ext_vector_type(4)));
typedef unsigned u32x2 __attribute__((ext_vector_type(2)));
typedef float f32x2v __attribute__((ext_vector_type(2)));

#define DI __device__ __forceinline__
#define MFMA32(a, b, c) __builtin_amdgcn_mfma_f32_32x32x16_bf16((a), (b), (c), 0, 0, 0)

constexpr int M_TOK = 16384, DM = 1024, TSEQ = 2048;
constexpr int NPROJ = 3840;
constexpr size_t MBy = 1u << 20;
constexpr size_t OFF_WIN = 0, OFF_WOUT = 8 * MBy, OFF_WUP = 10 * MBy, OFF_WDOWN = 18 * MBy, OFF_WG = 26 * MBy, OFF_WPLE = 28 * MBy;
constexpr size_t OFF_STATS = 28 * MBy + 512 * 1024, OFF_GLAST = 28 * MBy + 640 * 1024, OFF_BAR = 29 * MBy + 512 * 1024, OFF_CTR = OFF_BAR + 14336, OFF_CF = 28 * MBy + 768 * 1024;
constexpr size_t OFF_XBUF = 31 * MBy, OFF_PCNT = OFF_BAR + 14848;
constexpr size_t OFF_GATES = 30 * MBy, OFF_GQKV = 32 * MBy, OFF_Z = 80 * MBy, OFF_FQK = 96 * MBy, OFF_VT = 128 * MBy, OFF_HB = 144 * MBy;
constexpr size_t OFF_U = 144 * MBy, OFF_W = 160 * MBy, OFF_QD = 176 * MBy, OFF_KDT = 192 * MBy, OFF_QK = 208 * MBy;
constexpr size_t OFF_OG = 32 * MBy, OFF_MIX = 216 * MBy;
constexpr size_t OFF_H1B = 32 * MBy, OFF_PB = 248 * MBy, OFF_FFB = 72 * MBy, OFF_PG = 200 * MBy;
constexpr float ALPHA = 1.189207115002721f;
constexpr int TEAM_LDS = 76800, LDS_MISC = 153600, LDS_BYTES = 153600 + 256;
#ifndef REP_MASK
#define REP_MASK 0
#endif
#define NREP(k) (1 + ((REP_MASK >> (k)) & 1))

struct Params { const float* in[21]; float* out; unsigned char* ws; };

DI float bf2f(unsigned b) { return __uint_as_float(b << 16); }
typedef float f32x2_t __attribute__((ext_vector_type(2))); typedef __bf16 bf16x2_t __attribute__((ext_vector_type(2)));
DI unsigned pack2(float lo, float hi) { f32x2_t v = {lo, hi}; bf16x2_t b = __builtin_convertvector(v, bf16x2_t); return __builtin_bit_cast(unsigned, b); }
DI unsigned f2bf(float x) { return pack2(x, 0.f) & 0xffffu; }
DI float bflo(unsigned w) { return __uint_as_float(w << 16); }
DI float bfhi(unsigned w) { return __uint_as_float(w & 0xffff0000u); }
DI int crow(int e, int h) { return (e & 3) + 8 * (e >> 2) + 4 * h; }
DI float shx(float v, int mask, int lane) { return __int_as_float(__builtin_amdgcn_ds_bpermute((lane ^ mask) << 2, __float_as_int(v))); }
DI float shup(float v, int o, int lane) { return __int_as_float(__builtin_amdgcn_ds_bpermute(((lane - o) & 63) << 2, __float_as_int(v))); }
DI float shlane(float v, int src) { return __int_as_float(__builtin_amdgcn_readlane(__float_as_int(v), src)); }
DI float wave_sum(float v, int lane) { for (int o = 32; o > 0; o >>= 1) v += shx(v, o, lane); return v; }
DI float siluf(float x) { return x * __builtin_amdgcn_rcpf(1.f + __expf(-x)); }
DI float sigmoidf_(float x) { return __builtin_amdgcn_rcpf(1.f + __expf(-x)); }
DI int fresh_tid(int wid_s) { int l; asm volatile("v_mbcnt_lo_u32_b32 %0, -1, 0\n\tv_mbcnt_hi_u32_b32 %0, -1, %0" : "=v"(l)); return wid_s * 64 + l; }
#define PHASE_IDS const int tid = fresh_tid(wid_s), lane = tid & 63, wave8 = tid >> 6, team = tid >> 8, tt = tid & 255, tw = tt >> 6; unsigned char* smem = lds + team * TEAM_LDS; (void)lane; (void)wave8; (void)tt; (void)tw; (void)smem;

DI void ln_row(const float* src, const float* __restrict__ g, const float* __restrict__ b, float* dstf, bf16_t* dstb, float* stats, int lane) {
    f32x4 v[4];
#pragma unroll
    for (int i = 0; i < 4; ++i) v[i] = *(const f32x4*)(src + i * 256 + lane * 4);
    float s = 0.f;
#pragma unroll
    for (int i = 0; i < 4; ++i) s += (v[i][0] + v[i][1]) + (v[i][2] + v[i][3]);
    s = wave_sum(s, lane);
    const float mu = s * (1.f / 1024.f);
    float q = 0.f;
#pragma unroll
    for (int i = 0; i < 4; ++i) { f32x4 d = v[i] - mu; q += (d[0] * d[0] + d[1] * d[1]) + (d[2] * d[2] + d[3] * d[3]); }
    q = wave_sum(q, lane);
    const float rstd = rsqrtf(q * (1.f / 1024.f) + 1e-5f);
    f32x4 gv[4], bv[4];
#pragma unroll
    for (int i = 0; i < 4; ++i) { gv[i] = *(const f32x4*)(g + i * 256 + lane * 4); bv[i] = *(const f32x4*)(b + i * 256 + lane * 4); }
#pragma unroll
    for (int i = 0; i < 4; ++i) {
        const f32x4 gg = gv[i], bb = bv[i];
        const f32x4 o = (v[i] - mu) * rstd * gg + bb;
        if (dstf) *(f32x4*)(dstf + i * 256 + lane * 4) = o;
        if (dstb) { u32x2 w; w.x = pack2(o[0], o[1]); w.y = pack2(o[2], o[3]); *(u32x2*)(dstb + i * 256 + lane * 4) = w; }
    }
    if (stats && lane == 0) { stats[0] = mu; stats[1] = rstd; }
}

DI void transpose_tile(const float* __restrict__ W, int K, int N, bf16_t* __restrict__ Wt, int kt, int nt, int mode, float* tile, int tt) {
    const int tid = tt;
    const int k0 = kt * 64, n0 = nt * 64;
    {
        const int c = tid & 63, n = n0 + c;
        int sc = n;
        if (mode == 1) { sc = (n < 2048) ? n : (n < 3584) ? n + 8 : (n < 3592) ? 2048 + (n - 3584) : (n < 3600) ? n : -1; }
        const int scc = sc >= 0 ? sc : 0;
        const float mk = sc >= 0 ? 1.f : 0.f;
        float wv[16];
#pragma unroll
        for (int i = 0; i < 16; ++i) wv[i] = W[(size_t)(k0 + (tid >> 6) + 4 * i) * N + scc];
#pragma unroll
        for (int i = 0; i < 16; ++i) tile[((tid >> 6) + 4 * i) * 65 + c] = wv[i] * mk;
    }
    __syncthreads();
    {
        const int n = tid >> 2, ks = (tid & 3) * 16;
        u32x4 o0, o1;
        o0.x = pack2(tile[(ks + 0) * 65 + n], tile[(ks + 1) * 65 + n]); o0.y = pack2(tile[(ks + 2) * 65 + n], tile[(ks + 3) * 65 + n]);
        o0.z = pack2(tile[(ks + 4) * 65 + n], tile[(ks + 5) * 65 + n]); o0.w = pack2(tile[(ks + 6) * 65 + n], tile[(ks + 7) * 65 + n]);
        o1.x = pack2(tile[(ks + 8) * 65 + n], tile[(ks + 9) * 65 + n]); o1.y = pack2(tile[(ks + 10) * 65 + n], tile[(ks + 11) * 65 + n]);
        o1.z = pack2(tile[(ks + 12) * 65 + n], tile[(ks + 13) * 65 + n]); o1.w = pack2(tile[(ks + 14) * 65 + n], tile[(ks + 15) * 65 + n]);
        bf16_t* dst = Wt + (size_t)(n0 + n) * K + k0 + ks;
        *(u32x4*)dst = o0; *(u32x4*)(dst + 8) = o1;
    }
    __syncthreads();
}

namespace pg8 {
#define PG8_LAS __attribute__((address_space(3)))
typedef PG8_LAS unsigned char* PG8_LAS_T;
typedef unsigned short bf16_t;
typedef short bf16x8 __attribute__((ext_vector_type(8)));
typedef float f32x4 __attribute__((ext_vector_type(4)));
typedef unsigned u32x4 __attribute__((ext_vector_type(4)));
constexpr int BM = 256, BK = 64, HALF = 128, HTB = HALF * BK * 2  , STAGE_BYTES = 8 * HTB, NXCD = 8, WGM = 8;

__host__ __device__ __forceinline__ int lds_byte(int r, int c) { const int st = (r >> 4) * 2 + (c >> 5), rr = r & 15, cc = c & 31, ob = rr * 64 + cc * 2; return st * 1024 + (ob ^ (((ob >> 9) & 1) << 5)); }
__host__ __device__ __forceinline__ void stage_rc(int b, int& R, int& C) { const int st = b / 1024, sb = b % 1024, swz = sb ^ (((sb >> 9) & 1) << 5); R = (st >> 1) * 16 + swz / 64; C = (st & 1) * 32 + (swz % 64) / 2; }
__host__ __device__ __forceinline__ int perm32(int rho) { const int n = rho >> 4, i = rho & 15; return 8 * (i >> 2) + 4 * n + (i & 3); }

struct Unit { int pm, pn; };
struct Gemm { const bf16_t* A; const bf16_t* Bt; int M, N, K; };

struct StaticOrder {
    int nM, nN, nwg, G, c;
    __host__ __device__ void init(int M, int N, int G_, int c_) { nM = M / BM; nN = N / BM; nwg = nM * nN; G = G_; c = c_; }
    __host__ __device__ bool next(int i, Unit& u) const {
        const long L = (long)i * G + c; if (L >= nwg) return false;
        int wgid = (int)L; { const int q = nwg / NXCD, r = nwg % NXCD, xcd = wgid % NXCD, off = wgid / NXCD; wgid = (xcd < r ? xcd * (q + 1) : r * (q + 1) + (xcd - r) * q) + off; }
        const int nig = WGM * nN, gid = wgid / nig, fm = gid * WGM, gsz = (nM - fm) < WGM ? (nM - fm) : WGM;
        u.pm = fm + ((wgid % nig) % gsz); u.pn = (wgid % nig) / gsz; return true;
    }
    __device__ __forceinline__ void a_ready(const Unit&) const {}
    __device__ __forceinline__ void done(const Unit&) const {}
};
template <class Epi, class Sched, bool ALIGN_EPI = false, bool SP2 = false>
__device__ __forceinline__ void gemm_phase(PG8_LAS unsigned char* lds, const Gemm g, const Sched& S, const Epi& E, const int wid_s) {
    const int tid = fresh_tid(wid_s), wid = wid_s, lane = tid & 63, wr = wid >> 2, wc = wid & 3, fr = lane & 15, fq = lane >> 4;
    const int K = g.K, nt = K / BK;
    unsigned voffA[2], voffB[2];
#pragma unroll
    for (int i = 0; i < 2; ++i) { int R, C; stage_rc(tid * 16 + i * 8192, R, C); const int Rb = Epi::PERM ? ((R & ~31) + perm32(R & 31)) : R;
        voffA[i] = (unsigned)(R * K + C) * 2u; voffB[i] = (unsigned)(Rb * K + C) * 2u; }
    const size_t kstep = (size_t)(BK * 2);
    const size_t hstep = (size_t)HALF * K * 2;
    const size_t tstep = 2 * hstep;
    const unsigned ldsw = (unsigned)wid * 1024u;
    const int aoff = lds_byte(wr * 64 + fr, fq * 8), boff = lds_byte(wc * 32 + fr, fq * 8);
#define PG8_SA(b, h) (((b) * 2 + (h)) * HTB)
#define PG8_SB(b, h) ((4 + (b) * 2 + (h)) * HTB)
#define PG8_STAGE(bufoff, gbase, voff) do { _Pragma("unroll") for (int _i = 0; _i < 2; ++_i) \
        __builtin_amdgcn_global_load_lds((const unsigned*)((const char*)(gbase) + (voff)[_i]), (PG8_LAS unsigned*)(lds + (bufoff) + ldsw + _i * 8192), 16, 0, 0); } while (0)
#define PG8_LDA(dst, b, h) do { _Pragma("unroll") for (int m = 0; m < 4; ++m) _Pragma("unroll") for (int k = 0; k < 2; ++k) dst[m][k] = *(const PG8_LAS bf16x8*)(lds + PG8_SA(b, h) + aoff + m * 2048 + k * 1024); } while (0)
#define PG8_LDB(dst, b, h) do { _Pragma("unroll") for (int n = 0; n < 2; ++n) _Pragma("unroll") for (int k = 0; k < 2; ++k) dst[n][k] = *(const PG8_LAS bf16x8*)(lds + PG8_SB(b, h) + boff + n * 2048 + k * 1024); } while (0)
#define PG8_MMA(ai, bj, At, Bt) do { __builtin_amdgcn_s_setprio(1); _Pragma("unroll") for (int m = 0; m < 4; ++m) _Pragma("unroll") for (int n = 0; n < 2; ++n) _Pragma("unroll") for (int k = 0; k < 2; ++k) \
        acc[ai][bj][m][n] = __builtin_amdgcn_mfma_f32_16x16x32_bf16(Bt[n][k], At[m][k], acc[ai][bj][m][n], 0, 0, 0); __builtin_amdgcn_s_setprio(0); } while (0)
#define PG8_WAIT_V(n) asm volatile("s_waitcnt vmcnt(" #n ")" ::: "memory")
#define PG8_WAIT_L(n) asm volatile("s_waitcnt lgkmcnt(" #n ")" ::: "memory")
#define PG8_BAR __builtin_amdgcn_s_barrier()
#define PG8_SCHED __builtin_amdgcn_sched_barrier(0)
    Unit cur, nxt; int ui = 0;
    if (!S.next(0, cur)) return;
    f32x4 acc[2][2][4][2];
#pragma unroll
    for (int a = 0; a < 2; ++a)
#pragma unroll
        for (int b = 0; b < 2; ++b)
#pragma unroll
            for (int m = 0; m < 4; ++m)
#pragma unroll
                for (int n = 0; n < 2; ++n) acc[a][b][m][n] = (f32x4){0.f, 0.f, 0.f, 0.f};
    bf16x8 At[4][2], B0[2][2], B1[2][2];
    const char* cA = (const char*)g.A + (size_t)cur.pm * tstep; const char* cB = (const char*)g.Bt + (size_t)cur.pn * tstep;
    S.a_ready(cur);
    if constexpr (SP2) {
        PG8_STAGE(PG8_SB(0, 0), cB, voffB); PG8_STAGE(PG8_SB(0, 1), cB + hstep, voffB); PG8_STAGE(PG8_SA(0, 0), cA, voffA); PG8_STAGE(PG8_SA(0, 1), cA + hstep, voffA);
        if (wr == 1) PG8_BAR;
        PG8_WAIT_V(2); PG8_BAR;
        PG8_STAGE(PG8_SB(1, 0), cB + kstep, voffB); PG8_STAGE(PG8_SA(1, 0), cA + kstep, voffA); PG8_STAGE(PG8_SB(1, 1), cB + hstep + kstep, voffB);
        PG8_WAIT_V(6); PG8_BAR;
    } else {
        PG8_STAGE(PG8_SB(0, 0), cB, voffB); PG8_STAGE(PG8_SA(0, 0), cA, voffA); PG8_STAGE(PG8_SB(0, 1), cB + hstep, voffB); PG8_STAGE(PG8_SA(0, 1), cA + hstep, voffA);
        if (wr == 1) PG8_BAR;
        PG8_WAIT_V(4); PG8_BAR;
        PG8_STAGE(PG8_SB(1, 0), cB + kstep, voffB); PG8_STAGE(PG8_SA(1, 0), cA + kstep, voffA); PG8_STAGE(PG8_SB(1, 1), cB + hstep + kstep, voffB);
        PG8_WAIT_V(6); PG8_BAR;
    }
    for (;;) {
        const bool has_next = S.next(ui + 1, nxt);
        const char* nA = has_next ? (const char*)g.A + (size_t)nxt.pm * tstep : cA; const char* nB = has_next ? (const char*)g.Bt + (size_t)nxt.pn * tstep : cB;
        for (int t = 0; t < nt; t += 2) {
            const bool last = (t == nt - 2);
            const char* a1 = cA + (size_t)(t + 1) * kstep;
            const char* a2 = last ? nA : cA + (size_t)(t + 2) * kstep; const char* b2 = last ? nB : cB + (size_t)(t + 2) * kstep;
            const char* a3 = a2 + kstep; const char* b3 = b2 + kstep;
            if (last && has_next) S.a_ready(nxt);
            if constexpr (SP2) {
            PG8_LDB(B0, 0, 0); PG8_LDB(B1, 0, 1); PG8_SCHED; PG8_LDA(At, 0, 0); PG8_STAGE(PG8_SA(1, 1), a1 + hstep, voffA);
            PG8_WAIT_V(8); PG8_WAIT_L(0); PG8_BAR; PG8_MMA(0, 0, At, B0); PG8_MMA(0, 1, At, B1); PG8_BAR; PG8_SCHED;
            PG8_LDA(At, 0, 1); PG8_STAGE(PG8_SB(0, 0), b2, voffB); PG8_STAGE(PG8_SB(0, 1), b2 + hstep, voffB); PG8_STAGE(PG8_SA(0, 0), a2, voffA);
            PG8_WAIT_V(8); PG8_WAIT_L(0); PG8_BAR; PG8_MMA(1, 0, At, B0); PG8_MMA(1, 1, At, B1); PG8_BAR; PG8_SCHED;
            PG8_LDB(B0, 1, 0); PG8_LDB(B1, 1, 1); PG8_SCHED; PG8_LDA(At, 1, 0); PG8_STAGE(PG8_SA(0, 1), a2 + hstep, voffA);
            PG8_WAIT_V(8); PG8_WAIT_L(0); PG8_BAR; PG8_MMA(0, 0, At, B0); PG8_MMA(0, 1, At, B1); PG8_BAR; PG8_SCHED;
            PG8_LDA(At, 1, 1); PG8_STAGE(PG8_SB(1, 0), b3, voffB); PG8_STAGE(PG8_SB(1, 1), b3 + hstep, voffB); PG8_STAGE(PG8_SA(1, 0), a3, voffA);
            PG8_WAIT_V(8); PG8_WAIT_L(0); PG8_BAR; PG8_MMA(1, 0, At, B0); PG8_MMA(1, 1, At, B1); PG8_BAR; PG8_SCHED;
            } else {
            PG8_LDB(B0, 0, 0); PG8_SCHED; PG8_LDA(At, 0, 0); PG8_STAGE(PG8_SA(1, 1), a1 + hstep, voffA);
            PG8_WAIT_L(8); PG8_BAR; PG8_WAIT_L(0); PG8_MMA(0, 0, At, B0); PG8_BAR; PG8_SCHED;
            PG8_LDB(B1, 0, 1); PG8_STAGE(PG8_SB(0, 0), b2, voffB);
            PG8_BAR; PG8_WAIT_L(0); PG8_MMA(0, 1, At, B1); PG8_BAR;
            PG8_LDA(At, 0, 1); PG8_STAGE(PG8_SA(0, 0), a2, voffA);
            PG8_BAR; PG8_WAIT_L(0); PG8_MMA(1, 0, At, B0); PG8_BAR; PG8_SCHED;
            PG8_STAGE(PG8_SB(0, 1), b2 + hstep, voffB);
            PG8_WAIT_V(6); PG8_BAR; PG8_MMA(1, 1, At, B1); PG8_BAR;
            PG8_LDB(B0, 1, 0); PG8_SCHED; PG8_LDA(At, 1, 0); PG8_STAGE(PG8_SA(0, 1), a2 + hstep, voffA);
            PG8_WAIT_L(8); PG8_BAR; PG8_WAIT_L(0); PG8_MMA(0, 0, At, B0); PG8_BAR; PG8_SCHED;
            PG8_LDB(B1, 1, 1); PG8_STAGE(PG8_SB(1, 0), b3, voffB);
            PG8_BAR; PG8_WAIT_L(0); PG8_MMA(0, 1, At, B1); PG8_BAR;
            PG8_LDA(At, 1, 1); PG8_STAGE(PG8_SA(1, 0), a3, voffA);
            PG8_BAR; PG8_WAIT_L(0); PG8_MMA(1, 0, At, B0); PG8_BAR; PG8_SCHED;
            PG8_STAGE(PG8_SB(1, 1), b3 + hstep, voffB);
            PG8_WAIT_V(6); PG8_BAR; PG8_MMA(1, 1, At, B1); PG8_BAR;
            }
        }
        if constexpr (ALIGN_EPI) { if (wr == 0) PG8_BAR; }
        if constexpr (!Epi::AFTER_DRAIN) { E(acc, cur, wr, wc, fr, fq); S.done(cur); }
        if (!has_next) break;
#pragma unroll
        for (int a = 0; a < 2; ++a)
#pragma unroll
            for (int b = 0; b < 2; ++b)
#pragma unroll
                for (int m = 0; m < 4; ++m)
#pragma unroll
                    for (int n = 0; n < 2; ++n) acc[a][b][m][n] = (f32x4){0.f, 0.f, 0.f, 0.f};
        cur = nxt; cA = nA; cB = nB; ++ui;
        if constexpr (ALIGN_EPI) { if (wr == 1) PG8_BAR; }
    }
    PG8_WAIT_V(0);
    if constexpr (!ALIGN_EPI) { if (wr == 0) PG8_BAR; }
    PG8_BAR;
    if constexpr (Epi::AFTER_DRAIN) { E.fused(acc, cur, wr, wc, fr, fq, lds, wid, lane); S.done(cur); }
#undef PG8_SA
#undef PG8_SB
#undef PG8_STAGE
#undef PG8_LDA
#undef PG8_LDB
#undef PG8_MMA
#undef PG8_WAIT_V
#undef PG8_WAIT_L
#undef PG8_BAR
#undef PG8_SCHED
}
}

template <class F> DI void epi_rows(const pg8::f32x4 (&acc)[2][2][4][2], const pg8::Unit& u, int wr, int wc, int fr, int fq, F f) {
#pragma unroll
    for (int ai = 0; ai < 2; ++ai)
#pragma unroll
        for (int m = 0; m < 4; ++m) {
            const int row = u.pm * 256 + ai * 128 + wr * 64 + m * 16 + fr;
#pragma unroll
            for (int bj = 0; bj < 2; ++bj) f(row, u.pn * 256 + bj * 128 + wc * 32 + 8 * fq, acc[ai][bj][m][0], acc[ai][bj][m][1]);
        }
}
DI u32x4 pack8(const f32x4& a, const f32x4& b) { u32x4 w; w.x = pack2(a[0], a[1]); w.y = pack2(a[2], a[3]); w.z = pack2(b[0], b[1]); w.w = pack2(b[2], b[3]); return w; }
struct EpiProj {
    static constexpr bool PERM = true, AFTER_DRAIN = false;
    unsigned char* ws;
    DI void operator()(const pg8::f32x4 (&acc)[2][2][4][2], const pg8::Unit& u, int wr, int wc, int fr, int fq) const {
        const int pn = u.pn;
        if (pn < 12) {
            bf16_t* dst; int ld, cofs;
            if (pn < 6) { dst = (bf16_t*)(ws + OFF_GQKV); ld = 1536; cofs = 0; }
            else if (pn < 8) { dst = (bf16_t*)(ws + OFF_Z); ld = 512; cofs = 1536; }
            else { dst = (bf16_t*)(ws + OFF_FQK); ld = 1024; cofs = 2048; }
            epi_rows(acc, u, wr, wc, fr, fq, [&](int row, int col, const f32x4& a, const f32x4& b) { *(u32x4*)(dst + (size_t)row * ld + (col - cofs)) = pack8(a, b); });
        } else if (pn < 14) {
            bf16_t* vT = (bf16_t*)(ws + OFF_VT);
            epi_rows(acc, u, wr, wc, fr, fq, [&](int row, int col, const f32x4& a, const f32x4& b) {
                const int c = col - 3072, hh = c >> 6, d0 = c & 63, bb = row >> 11, t = row & 2047;
                bf16_t* p = vT + ((size_t)(bb * 8 + hh) * 64 + d0) * TSEQ + t;
#pragma unroll
                for (int e = 0; e < 4; ++e) { p[(size_t)e * TSEQ] = (bf16_t)f2bf(a[e]); p[(size_t)(e + 4) * TSEQ] = (bf16_t)f2bf(b[e]); }
            });
        } else {
            float* gates = (float*)(ws + OFF_GATES);
            epi_rows(acc, u, wr, wc, fr, fq, [&](int row, int col, const f32x4& a, const f32x4& b) {
                const int c = col - 3584;
                if (c < 16) { *(f32x4*)(gates + (size_t)row * 16 + c) = a; *(f32x4*)(gates + (size_t)row * 16 + c + 4) = b; }
            });
        }
    }
};
struct EpiOutProj {
    static constexpr bool PERM = true, AFTER_DRAIN = false;
    const float* x; const float* g; const float* b; const float* stats; float* out;
    DI void operator()(const pg8::f32x4 (&acc)[2][2][4][2], const pg8::Unit& u, int wr, int wc, int fr, int fq) const {
        epi_rows(acc, u, wr, wc, fr, fq, [&](int row, int col, const f32x4& a0, const f32x4& a1) {
            const float mu = stats[row * 2], rs = stats[row * 2 + 1];
            const size_t idx = (size_t)row * DM + col;
            const f32x4 x0 = *(const f32x4*)(x + idx), x1 = *(const f32x4*)(x + idx + 4);
            const f32x4 g0 = *(const f32x4*)(g + col), g1 = *(const f32x4*)(g + col + 4), b0 = *(const f32x4*)(b + col), b1 = *(const f32x4*)(b + col + 4);
            *(f32x4*)(out + idx) = ((x0 - mu) * rs * g0 + b0) * ALPHA + a0;
            *(f32x4*)(out + idx + 4) = ((x1 - mu) * rs * g1 + b1) * ALPHA + a1;
        });
    }
};
struct EpiUp {
    static constexpr bool PERM = true, AFTER_DRAIN = false;
    bf16_t* ffb;
    DI void operator()(const pg8::f32x4 (&acc)[2][2][4][2], const pg8::Unit& u, int wr, int wc, int fr, int fq) const {
        epi_rows(acc, u, wr, wc, fr, fq, [&](int row, int col, const f32x4& a, const f32x4& b) {
            f32x4 ra, rb;
#pragma unroll
            for (int e = 0; e < 4; ++e) { const float va = fmaxf(a[e], 0.f), vb = fmaxf(b[e], 0.f); ra[e] = va * va; rb[e] = vb * vb; }
            *(u32x4*)(ffb + (size_t)row * 4096 + col) = pack8(ra, rb);
        });
    }
};
struct EpiGate {
    static constexpr bool PERM = true, AFTER_DRAIN = false;
    bf16_t* pg; const float* bias;
    DI void operator()(const pg8::f32x4 (&acc)[2][2][4][2], const pg8::Unit& u, int wr, int wc, int fr, int fq) const {
        f32x4 bv[2][2];
#pragma unroll
        for (int bj = 0; bj < 2; ++bj) { const int c0 = u.pn * 256 + bj * 128 + wc * 32 + 8 * fq; bv[bj][0] = *(const f32x4*)(bias + c0); bv[bj][1] = *(const f32x4*)(bias + c0 + 4); }
        epi_rows(acc, u, wr, wc, fr, fq, [&](int row, int col, const f32x4& a, const f32x4& b) {
            const int bj = (col >> 7) & 1;
            const f32x4 b0 = bv[bj][0], b1 = bv[bj][1];
            f32x4 ra, rb;
#pragma unroll
            for (int e = 0; e < 4; ++e) { ra[e] = sigmoidf_(a[e] + b0[e]); rb[e] = sigmoidf_(b[e] + b1[e]); }
            *(u32x4*)(pg + (size_t)row * DM + col) = pack8(ra, rb);
        });
    }
};
struct EpiPle {
    static constexpr bool PERM = true, AFTER_DRAIN = false;
    bf16_t* pg;
    DI void operator()(const pg8::f32x4 (&acc)[2][2][4][2], const pg8::Unit& u, int wr, int wc, int fr, int fq) const {
        epi_rows(acc, u, wr, wc, fr, fq, [&](int row, int col, const f32x4& a, const f32x4& b) {
            u32x4* p = (u32x4*)(pg + (size_t)row * DM + col);
            const u32x4 w = *p;
            f32x4 ra, rb;
            ra[0] = a[0] * bflo(w.x); ra[1] = a[1] * bfhi(w.x); ra[2] = a[2] * bflo(w.y); ra[3] = a[3] * bfhi(w.y);
            rb[0] = b[0] * bflo(w.z); rb[1] = b[1] * bfhi(w.z); rb[2] = b[2] * bflo(w.w); rb[3] = b[3] * bfhi(w.w);
            *p = pack8(ra, rb);
        });
    }
};
struct EpiDown {
    static constexpr bool PERM = true, AFTER_DRAIN = false;
    const bf16_t* pg; float* out;
    DI void operator()(const pg8::f32x4 (&acc)[2][2][4][2], const pg8::Unit& u, int wr, int wc, int fr, int fq) const {
        epi_rows(acc, u, wr, wc, fr, fq, [&](int row, int col, const f32x4& a, const f32x4& b) {
            const size_t idx = (size_t)row * DM + col;
            const u32x4 w = *(const u32x4*)(pg + idx);
            f32x4 o0 = *(const f32x4*)(out + idx), o1 = *(const f32x4*)(out + idx + 4);
            o0 = o0 * ALPHA + a; o1 = o1 * ALPHA + b;
            o0[0] += bflo(w.x); o0[1] += bfhi(w.x); o0[2] += bflo(w.y); o0[3] += bfhi(w.y);
            o1[0] += bflo(w.z); o1[1] += bfhi(w.z); o1[2] += bflo(w.w); o1[3] += bfhi(w.w);
            *(f32x4*)(out + idx) = o0; *(f32x4*)(out + idx + 4) = o1;
        });
    }
};
DI void lds_read8(unsigned addr, f32x4 (&a)[4][2]) {
    asm volatile(
        "ds_read_b128 %0, %8\n\tds_read_b128 %1, %8 offset:16\n\t"
        "ds_read_b128 %2, %8 offset:256\n\tds_read_b128 %3, %8 offset:272\n\t"
        "ds_read_b128 %4, %8 offset:512\n\tds_read_b128 %5, %8 offset:528\n\t"
        "ds_read_b128 %6, %8 offset:768\n\tds_read_b128 %7, %8 offset:784\n\t"
        "s_waitcnt lgkmcnt(0)"
        : "=&v"(a[0][0]), "=&v"(a[0][1]), "=&v"(a[1][0]), "=&v"(a[1][1]), "=&v"(a[2][0]), "=&v"(a[2][1]), "=&v"(a[3][0]), "=&v"(a[3][1])
        : "v"(addr) : "memory");
}
DI void lds_read8s(unsigned addr, f32x4 (&a)[4][2]) {
    asm volatile(
        "ds_read_b128 %0, %8\n\tds_read_b128 %1, %8 offset:16\n\t"
        "ds_read_b128 %2, %8 offset:128\n\tds_read_b128 %3, %8 offset:144\n\t"
        "ds_read_b128 %4, %8 offset:256\n\tds_read_b128 %5, %8 offset:272\n\t"
        "ds_read_b128 %6, %8 offset:384\n\tds_read_b128 %7, %8 offset:400\n\t"
        "s_waitcnt lgkmcnt(0)"
        : "=&v"(a[0][0]), "=&v"(a[0][1]), "=&v"(a[1][0]), "=&v"(a[1][1]), "=&v"(a[2][0]), "=&v"(a[2][1]), "=&v"(a[3][0]), "=&v"(a[3][1])
        : "v"(addr) : "memory");
}
DI void prep_chunk(const Params& P, int ci, unsigned char* smem, int tt) {
    const int tid = tt, lane = tid & 63, wave = tid >> 6, r = lane & 31, h2 = lane >> 5;
    const int b = ci >> 7, hd = (ci >> 5) & 3, n = ci & 31, t0 = n * 64;
    const size_t rowbase = (size_t)b * TSEQ + t0;
    bf16_t* kbf = (bf16_t*)smem;
    bf16_t* qbf = kbf + 64 * 136;
    bf16_t* vT  = (bf16_t*)smem;
    bf16_t* Tb  = (bf16_t*)(smem + 18432);
    bf16_t* Tg  = (bf16_t*)(smem + 27648);
    bf16_t* kT  = (bf16_t*)(smem + 36864);
    float*  Ad  = (float*)(smem + 55296);
    bf16_t* A10 = (bf16_t*)(smem + 63488);
    bf16_t* DT  = (bf16_t*)(smem + 66048);
    float* sbeta = (float*)(smem + 71168);
    float* sgam = sbeta + 64; float* segam = sgam + 64; float* sdk = segam + 64;
    bf16_t* D1R = (bf16_t*)(smem + 72192);
    const bf16_t* gq = (const bf16_t*)(P.ws + OFF_GQKV);
    const float* gates = (const float*)(P.ws + OFF_GATES);
    const float* cw = P.in[5];
    if (tid < 64) {
        const float* gt = gates + (rowbase + tid) * 16;
        const float be = sigmoidf_(gt[hd]);
        const float a = gt[4 + hd] + P.in[7][hd];
        const float sp = fmaxf(a, 0.f) + log1pf(__expf(-fabsf(a)));
        float lg = -__expf(P.in[6][hd]) * sp;
#pragma unroll
        for (int o = 1; o < 64; o <<= 1) { const float t = shup(lg, o, lane); if (lane >= o) lg += t; }
        const float gl = shlane(lg, 63);
        sbeta[tid] = be; sgam[tid] = lg; segam[tid] = __expf(lg); sdk[tid] = __expf(gl - lg);
    }
    {
        float* wl = Ad;
        for (int idx = tid; idx < 384; idx += 256) {
            const int wh = idx >> 7, rem = idx & 127, j = rem >> 5, c4 = (rem & 31) * 4;
            const int cbw = (wh == 0 ? 512 : wh == 1 ? 0 : 1024) + hd * 128;
            *(f32x4*)(wl + (wh * 4 + j) * 128 + c4) = *(const f32x4*)(cw + j * 1536 + cbw + c4);
        }
    }
    __syncthreads();
    unsigned vkeep[16];
#pragma unroll
    for (int e = 0; e < 16; ++e) vkeep[e] = 0u;
    {
        const int i = tid >> 2, seg = tid & 3;
        const float* wl = Ad;
#pragma unroll 1
        for (int which = 0; which < 3; ++which) {
            const int colbase = (which == 0 ? 512 : which == 1 ? 0 : 1024) + hd * 128 + seg * 32;
            u32x4 xr[4][4];
#pragma unroll
            for (int j = 0; j < 4; ++j) {
                const int t = t0 + i - 3 + j;
                const int tc = t < 0 ? 0 : t;
                const bf16_t* xp = gq + ((size_t)b * TSEQ + tc) * 1536 + colbase;
#pragma unroll
                for (int sub = 0; sub < 4; ++sub) xr[j][sub] = *(const u32x4*)(xp + sub * 8);
            }
            float val[32];
#pragma unroll
            for (int sub = 0; sub < 4; ++sub) {
                float a8[8];
#pragma unroll
                for (int e = 0; e < 8; ++e) a8[e] = 0.f;
#pragma unroll
                for (int j = 0; j < 4; ++j) {
                    const float mk = (t0 + i - 3 + j) < 0 ? 0.f : 1.f;
                    const u32x4 xv = xr[j][sub];
                    f32x4 w0 = *(const f32x4*)(wl + (which * 4 + j) * 128 + seg * 32 + sub * 8), w1 = *(const f32x4*)(wl + (which * 4 + j) * 128 + seg * 32 + sub * 8 + 4);
                    w0 = w0 * mk; w1 = w1 * mk;
                    a8[0] += w0[0] * bflo(xv.x); a8[1] += w0[1] * bfhi(xv.x); a8[2] += w0[2] * bflo(xv.y); a8[3] += w0[3] * bfhi(xv.y);
                    a8[4] += w1[0] * bflo(xv.z); a8[5] += w1[1] * bfhi(xv.z); a8[6] += w1[2] * bflo(xv.w); a8[7] += w1[3] * bfhi(xv.w);
                }
#pragma unroll
                for (int e = 0; e < 8; ++e) val[sub * 8 + e] = siluf(a8[e]);
            }
            float ss = 0.f;
#pragma unroll
            for (int e = 0; e < 32; ++e) ss += val[e] * val[e];
            ss += shx(ss, 1, lane); ss += shx(ss, 2, lane);
            const float sc = (which == 2) ? 1.f : rsqrtf(ss + 1e-6f) * (which == 1 ? 0.08838834764831845f : 1.f);
            unsigned pk[16];
#pragma unroll
            for (int e = 0; e < 16; ++e) pk[e] = pack2(val[2 * e] * sc, val[2 * e + 1] * sc);
            if (which == 2) {
#pragma unroll
                for (int e = 0; e < 16; ++e) vkeep[e] = pk[e];
            } else {
                bf16_t* dst = (which == 0 ? kbf : qbf) + i * 136 + seg * 32;
#pragma unroll
                for (int sub = 0; sub < 4; ++sub) { u32x4 o; o.x = pk[4 * sub]; o.y = pk[4 * sub + 1]; o.z = pk[4 * sub + 2]; o.w = pk[4 * sub + 3]; *(u32x4*)(dst + sub * 8) = o; }
                if (which == 0) {
                    bf16_t* kt = kT + (seg * 32) * 72 + i;
#pragma unroll
                    for (int e = 0; e < 16; ++e) { kt[(2 * e) * 72] = (bf16_t)(pk[e] & 0xffffu); kt[(2 * e + 1) * 72] = (bf16_t)(pk[e] >> 16); }
                }
            }
        }
    }
    __syncthreads();
    {
        const int mi = wave >> 1, ni = wave & 1;
        f32x16 aK, aQ;
#pragma unroll
        for (int e = 0; e < 16; ++e) { aK[e] = 0.f; aQ[e] = 0.f; }
#pragma unroll
        for (int ks = 0; ks < 8; ++ks) {
            const bf16x8 ak = *(const bf16x8*)(kbf + (mi * 32 + r) * 136 + ks * 16 + h2 * 8);
            const bf16x8 bk = *(const bf16x8*)(kbf + (ni * 32 + r) * 136 + ks * 16 + h2 * 8);
            const bf16x8 aq = *(const bf16x8*)(qbf + (mi * 32 + r) * 136 + ks * 16 + h2 * 8);
            aK = MFMA32(ak, bk, aK); aQ = MFMA32(aq, bk, aQ);
        }
        const int j = ni * 32 + r;
        const float gj = sgam[j];
        bf16_t* qkout = (bf16_t*)(P.ws + OFF_QK) + (size_t)ci * 4096;
#pragma unroll
        for (int e = 0; e < 16; ++e) {
            const int il = crow(e, h2), i = mi * 32 + il;
            const float dec = (i >= j) ? __expf(sgam[i] - gj) : 0.f;
            const float aij = (i > j) ? aK[e] * sbeta[i] * dec : 0.f;
            if (mi == ni) Ad[(mi * 32 + il) * 32 + r] = aij;
            else if (mi == 1) A10[il * 40 + r] = (bf16_t)f2bf(aij);
            qkout[(((i >> 5) * 4 + (j >> 4)) * 64 + (i & 31) + 32 * ((j >> 3) & 1)) * 8 + (j & 7)] = (bf16_t)f2bf((i >= j) ? aQ[e] * dec : 0.f);
        }
    }
    {
        const int i = tid >> 2, seg = tid & 3;
        const float eg = segam[i];
        bf16_t* qd = (bf16_t*)(P.ws + OFF_QD) + (size_t)ci * 8192;
#pragma unroll
        for (int sub = 0; sub < 4; ++sub) {
            const u32x4 v = *(const u32x4*)(qbf + i * 136 + seg * 32 + sub * 8);
            u32x4 o;
            o.x = pack2(bflo(v.x) * eg, bfhi(v.x) * eg); o.y = pack2(bflo(v.y) * eg, bfhi(v.y) * eg);
            o.z = pack2(bflo(v.z) * eg, bfhi(v.z) * eg); o.w = pack2(bflo(v.w) * eg, bfhi(v.w) * eg);
            *(u32x4*)(qd + ((((i >> 5) * 8 + seg * 2 + (sub >> 1)) * 64 + (i & 31) + 32 * (sub & 1)) * 8)) = o;
        }
        const int kidx = tid >> 1, cs = (tid & 1) * 32;
        bf16_t* kd = (bf16_t*)(P.ws + OFF_KDT) + (size_t)ci * 8192;
#pragma unroll
        for (int sub = 0; sub < 4; ++sub) {
            const u32x4 v = *(const u32x4*)(kT + kidx * 72 + cs + sub * 8);
            const f32x4 d0 = *(const f32x4*)(sdk + cs + sub * 8), d1 = *(const f32x4*)(sdk + cs + sub * 8 + 4);
            u32x4 o;
            o.x = pack2(bflo(v.x) * d0[0], bfhi(v.x) * d0[1]); o.y = pack2(bflo(v.y) * d0[2], bfhi(v.y) * d0[3]);
            o.z = pack2(bflo(v.z) * d1[0], bfhi(v.z) * d1[1]); o.w = pack2(bflo(v.w) * d1[2], bfhi(v.w) * d1[3]);
            *(u32x4*)(kd + ((((kidx >> 5) * 4 + ((cs + sub * 8) >> 4)) * 64 + (kidx & 31) + 32 * (sub & 1)) * 8)) = o;
        }
        if (tid == 0) ((float*)(P.ws + OFF_GLAST))[ci] = segam[63];
    }
    __syncthreads();
    {
        const int i = tid >> 2, seg = tid & 3;
        bf16_t* vt = vT + (seg * 32) * 72 + i;
#pragma unroll
        for (int e = 0; e < 16; ++e) { vt[(2 * e) * 72] = (bf16_t)(vkeep[e] & 0xffffu); vt[(2 * e + 1) * 72] = (bf16_t)(vkeep[e] >> 16); }
        if (tid >= 64) {
            for (int idx = tid - 64; idx < 1024; idx += 192) { const int rr = idx >> 5, cc = 32 + (idx & 31); Tb[rr * 72 + cc] = 0; Tg[rr * 72 + cc] = 0; }
        } else {
            const int blk = tid >> 5, c = tid & 31;
            float x[32];
#pragma unroll
            for (int e = 0; e < 32; ++e) x[e] = (e == c) ? 1.f : 0.f;
            const unsigned ad_lds = (unsigned)(size_t)(Ad + blk * 1024);
#pragma unroll
            for (int ib = 0; ib < 8; ++ib) {
                const int i0 = ib * 4;
                float s0 = x[i0], s1 = x[i0 + 1], s2 = x[i0 + 2], s3 = x[i0 + 3];
#pragma unroll
                for (int mb = 0; mb <= ib; mb += 2) {
                    f32x4 a[4][2];
                    lds_read8s(ad_lds + (unsigned)((i0 * 32 + mb * 4) * 4), a);
#pragma unroll
                    for (int cb = 0; cb < 2; ++cb) {
                        const int m4 = mb + cb;
                        if (m4 < ib) {
#pragma unroll
                            for (int e = 0; e < 4; ++e) {
                                const float xx = x[m4 * 4 + e];
                                s0 -= a[0][cb][e] * xx; s1 -= a[1][cb][e] * xx; s2 -= a[2][cb][e] * xx; s3 -= a[3][cb][e] * xx;
                            }
                        } else if (m4 == ib) {
                            s1 -= a[1][cb][0] * s0;
                            s2 -= a[2][cb][0] * s0; s2 -= a[2][cb][1] * s1;
                            s3 -= a[3][cb][0] * s0; s3 -= a[3][cb][1] * s1; s3 -= a[3][cb][2] * s2;
                        }
                    }
                    __builtin_amdgcn_sched_barrier(0);
                }
                x[i0] = s0; x[i0 + 1] = s1; x[i0 + 2] = s2; x[i0 + 3] = s3;
            }
            bf16_t* dt = DT + (blk * 32 + c) * 40;
#pragma unroll
            for (int q4 = 0; q4 < 4; ++q4) {
                u32x4 o; o.x = pack2(x[8 * q4], x[8 * q4 + 1]); o.y = pack2(x[8 * q4 + 2], x[8 * q4 + 3]); o.z = pack2(x[8 * q4 + 4], x[8 * q4 + 5]); o.w = pack2(x[8 * q4 + 6], x[8 * q4 + 7]);
                *(u32x4*)(dt + q4 * 8) = o;
            }
            const int cg = blk * 32 + c;
            const float bc = sbeta[cg], bg = bc * segam[cg];
#pragma unroll
            for (int rr = 0; rr < 32; ++rr) {
                if (blk == 1) D1R[rr * 40 + c] = (bf16_t)f2bf(x[rr]);
                Tb[(blk * 32 + rr) * 72 + cg] = (bf16_t)f2bf(x[rr] * bc);
                Tg[(blk * 32 + rr) * 72 + cg] = (bf16_t)f2bf(x[rr] * bg);
            }
        }
    }
    __syncthreads();
    if (wave == 0) {
        f32x16 Pm, Qm;
#pragma unroll
        for (int e = 0; e < 16; ++e) { Pm[e] = 0.f; Qm[e] = 0.f; }
#pragma unroll
        for (int ks = 0; ks < 2; ++ks) {
            const bf16x8 a = *(const bf16x8*)(A10 + r * 40 + ks * 16 + h2 * 8);
            const bf16x8 bb = *(const bf16x8*)(DT + r * 40 + ks * 16 + h2 * 8);
            Pm = MFMA32(a, bb, Pm);
        }
#pragma unroll
        for (int sq = 0; sq < 2; ++sq) {
            u32x4 pw;
            pw.x = pack2(Pm[8 * sq + 0], Pm[8 * sq + 1]); pw.y = pack2(Pm[8 * sq + 2], Pm[8 * sq + 3]);
            pw.z = pack2(Pm[8 * sq + 4], Pm[8 * sq + 5]); pw.w = pack2(Pm[8 * sq + 6], Pm[8 * sq + 7]);
            const bf16_t* dp = D1R + r * 40 + 16 * sq + 4 * h2;
            const u32x2 lo = *(const u32x2*)dp, hi = *(const u32x2*)(dp + 8);
            u32x4 aw; aw.x = lo.x; aw.y = lo.y; aw.z = hi.x; aw.w = hi.y;
            Qm = MFMA32(__builtin_bit_cast(bf16x8, aw), __builtin_bit_cast(bf16x8, pw), Qm);
        }
        const float bc = sbeta[r], bg = bc * segam[r];
#pragma unroll
        for (int e = 0; e < 16; ++e) {
            const int il = crow(e, h2);
            Tb[(32 + il) * 72 + r] = (bf16_t)f2bf(-Qm[e] * bc);
            Tg[(32 + il) * 72 + r] = (bf16_t)f2bf(-Qm[e] * bg);
        }
    }
    __syncthreads();
    {
        const int nt = wave;
        f32x16 aU[2], aW[2];
#pragma unroll
        for (int e = 0; e < 16; ++e) { aU[0][e] = 0.f; aU[1][e] = 0.f; aW[0][e] = 0.f; aW[1][e] = 0.f; }
#pragma unroll
        for (int ks = 0; ks < 4; ++ks) {
            const bf16x8 bv = *(const bf16x8*)(vT + (nt * 32 + r) * 72 + ks * 16 + h2 * 8);
            const bf16x8 bk = *(const bf16x8*)(kT + (nt * 32 + r) * 72 + ks * 16 + h2 * 8);
#pragma unroll
            for (int mt = 0; mt < 2; ++mt) {
                const bf16x8 ab = *(const bf16x8*)(Tb + (mt * 32 + r) * 72 + ks * 16 + h2 * 8);
                const bf16x8 ag = *(const bf16x8*)(Tg + (mt * 32 + r) * 72 + ks * 16 + h2 * 8);
                aU[mt] = MFMA32(ab, bv, aU[mt]); aW[mt] = MFMA32(ag, bk, aW[mt]);
            }
        }
        bf16_t* u = (bf16_t*)(P.ws + OFF_U) + (size_t)ci * 8192;
        bf16_t* w = (bf16_t*)(P.ws + OFF_W) + (size_t)ci * 8192;
#pragma unroll
        for (int mt = 0; mt < 2; ++mt) {
            u32x4 o0, o1;
            o0.x = pack2(aU[mt][0], aU[mt][1]); o0.y = pack2(aU[mt][2], aU[mt][3]); o0.z = pack2(aU[mt][4], aU[mt][5]); o0.w = pack2(aU[mt][6], aU[mt][7]);
            o1.x = pack2(aU[mt][8], aU[mt][9]); o1.y = pack2(aU[mt][10], aU[mt][11]); o1.z = pack2(aU[mt][12], aU[mt][13]); o1.w = pack2(aU[mt][14], aU[mt][15]);
            bf16_t* d = u + (((nt * 2 + mt) * 64 + lane) * 16);
            *(u32x4*)d = o0; *(u32x4*)(d + 8) = o1;
            bf16_t* wb = w + (((mt * 8 + nt * 2 + (r >> 4)) * 64 + 32 * ((r >> 3) & 1)) * 8) + (r & 7);
#pragma unroll
            for (int e = 0; e < 16; ++e) wb[crow(e, h2) * 8] = (bf16_t)f2bf(aW[mt][e]);
        }
    }
    __syncthreads();
}

DI void fox_cumsum(const Params& P, int bh, unsigned char* smem, int tt) {
    const int tid = tt, lane = tid & 63, wave = tid >> 6;
    const int b = bh >> 3, hh = bh & 7;
    float* wsum = (float*)smem;
    const float* gates = (const float*)(P.ws + OFF_GATES);
    const float bf = P.in[9][hh];
    float v[8]; float run = 0.f;
#pragma unroll
    for (int e = 0; e < 8; ++e) {
        const float xx = gates[((size_t)b * TSEQ + tid * 8 + e) * 16 + 8 + hh] + bf;
        const float ls = fminf(xx, 0.f) - log1pf(__expf(-fabsf(xx)));
        run += ls; v[e] = run;
    }
    float sc = run;
#pragma unroll
    for (int o = 1; o < 64; o <<= 1) { const float t = shup(sc, o, lane); if (lane >= o) sc += t; }
    if (lane == 63) wsum[wave] = sc;
    __syncthreads();
    float off = sc - run;
    for (int w = 0; w < wave; ++w) off += wsum[w];
    float* cf = (float*)(P.ws + OFF_CF) + (size_t)bh * TSEQ + tid * 8;
#pragma unroll
    for (int e = 0; e < 8; ++e) cf[e] = v[e] + off;
    __syncthreads();
}

DI void gdn_scan(const Params& P, int item, unsigned char* smem, int tt) {
    const int tid = tt, lane = tid & 63, wave = tid >> 6, r = lane & 31, h2 = lane >> 5;
    const int bh = item >> 2, vs = item & 3, b = bh >> 2, hd = bh & 3;
    const int cb = bh * 32;
    bf16_t* SbT = (bf16_t*)smem;
    bf16_t* VnT = SbT + 32 * 136;
    const bool w01 = wave < 2;
    const int mt = wave & 1;
    const bf16_t* Ubase = (const bf16_t*)(P.ws + OFF_U);
    const bf16_t* Abase = (const bf16_t*)(P.ws + (w01 ? OFF_W : OFF_QD));
    const bf16_t* Kbase = (const bf16_t*)(P.ws + OFF_KDT);
    const bf16_t* QKbase = (const bf16_t*)(P.ws + OFF_QK);
    const float* glast = (const float*)(P.ws + OFF_GLAST);
    bf16_t* og = (bf16_t*)(P.ws + OFF_OG);
    f32x16 S;
#pragma unroll
    for (int e = 0; e < 16; ++e) S[e] = 0.f;
    for (int i = tid; i < 32 * 136 / 2; i += 256) ((unsigned*)SbT)[i] = 0u;
#define SCAN_LOAD_A(AF, ci_) do { const bf16_t* ap_ = Abase + (size_t)(ci_) * 8192 + (mt * 8 * 64 + lane) * 8; \
        _Pragma("unroll") for (int ks = 0; ks < 8; ++ks) AF[ks] = *(const bf16x8*)(ap_ + ks * 512); } while (0)
#define SCAN_LOAD_K(ci_) do { const bf16_t* kp_ = Kbase + (size_t)(ci_) * 8192 + (wave * 4 * 64 + lane) * 8; \
        _Pragma("unroll") for (int ks = 0; ks < 4; ++ks) Kf[ks] = *(const bf16x8*)(kp_ + ks * 512); } while (0)
#define SCAN_LOAD_X(ci_) do { if (w01) { const bf16_t* up_ = Ubase + (size_t)(ci_) * 8192 + ((vs * 2 + mt) * 64 + lane) * 16; \
            Xa = *(const u32x4*)up_; Xb = *(const u32x4*)(up_ + 8); } \
        else { const bf16_t* qp_ = QKbase + (size_t)(ci_) * 4096 + (mt * 4 * 64 + lane) * 8; \
            Xa = *(const u32x4*)qp_; Xb = *(const u32x4*)(qp_ + 512); Xc = *(const u32x4*)(qp_ + 1024); Xd = *(const u32x4*)(qp_ + 1536); } } while (0)
#define SCAN_STEP(AF, n_) do { \
        const int cn1 = cb + ((n_) + 1 < 32 ? (n_) + 1 : 31); const int cn2 = cb + ((n_) + 2 < 32 ? (n_) + 2 : 31); \
        const float gl = shlane(glreg, (n_)); \
        f32x16 acc1; \
        bf16x8 sf[8]; \
        _Pragma("unroll") for (int ks = 0; ks < 8; ++ks) sf[ks] = *(const bf16x8*)(SbT + r * 136 + ks * 16 + h2 * 8); \
        _Pragma("unroll") for (int e = 0; e < 16; ++e) acc1[e] = 0.f; \
        __builtin_amdgcn_sched_barrier(0); \
        _Pragma("unroll") for (int ks = 0; ks < 8; ++ks) acc1 = MFMA32(AF[ks], sf[ks], acc1); \
        __builtin_amdgcn_sched_barrier(0); \
        SCAN_LOAD_A(AF, cn2); \
        if (w01) { \
            u32x2 ov; \
            ov.x = pack2(bflo(Xa.x) - acc1[0], bfhi(Xa.x) - acc1[1]); ov.y = pack2(bflo(Xa.y) - acc1[2], bfhi(Xa.y) - acc1[3]); *(u32x2*)(VnT + r * 72 + mt * 32 + 0 + 4 * h2) = ov; \
            ov.x = pack2(bflo(Xa.z) - acc1[4], bfhi(Xa.z) - acc1[5]); ov.y = pack2(bflo(Xa.w) - acc1[6], bfhi(Xa.w) - acc1[7]); *(u32x2*)(VnT + r * 72 + mt * 32 + 8 + 4 * h2) = ov; \
            ov.x = pack2(bflo(Xb.x) - acc1[8], bfhi(Xb.x) - acc1[9]); ov.y = pack2(bflo(Xb.y) - acc1[10], bfhi(Xb.y) - acc1[11]); *(u32x2*)(VnT + r * 72 + mt * 32 + 16 + 4 * h2) = ov; \
            ov.x = pack2(bflo(Xb.z) - acc1[12], bfhi(Xb.z) - acc1[13]); ov.y = pack2(bflo(Xb.w) - acc1[14], bfhi(Xb.w) - acc1[15]); *(u32x2*)(VnT + r * 72 + mt * 32 + 24 + 4 * h2) = ov; \
        } \
        __syncthreads(); \
        bf16x8 Vf[4]; \
        _Pragma("unroll") for (int ks = 0; ks < 4; ++ks) Vf[ks] = *(const bf16x8*)(VnT + r * 72 + ks * 16 + h2 * 8); \
        _Pragma("unroll") for (int e = 0; e < 16; ++e) S[e] *= gl; \
        __builtin_amdgcn_sched_barrier(0); \
        _Pragma("unroll") for (int ks = 0; ks < 4; ++ks) S = MFMA32(Kf[ks], Vf[ks], S); \
        if (!w01) { \
            acc1 = MFMA32(__builtin_bit_cast(bf16x8, Xa), Vf[0], acc1); acc1 = MFMA32(__builtin_bit_cast(bf16x8, Xb), Vf[1], acc1); \
            acc1 = MFMA32(__builtin_bit_cast(bf16x8, Xc), Vf[2], acc1); acc1 = MFMA32(__builtin_bit_cast(bf16x8, Xd), Vf[3], acc1); \
        } \
        __builtin_amdgcn_sched_barrier(0); \
        SCAN_LOAD_K(cn1); \
        SCAN_LOAD_X(cn1); \
        _Pragma("unroll") for (int g = 0; g < 4; ++g) { u32x2 ov; ov.x = pack2(S[4 * g + 0], S[4 * g + 1]); ov.y = pack2(S[4 * g + 2], S[4 * g + 3]); \
            *(u32x2*)(SbT + r * 136 + wave * 32 + 8 * g + 4 * h2) = ov; } \
        if (!w01) { \
            bf16_t* op = og + ((size_t)b * TSEQ + (n_) * 64 + mt * 32) * 512 + hd * 128 + vs * 32 + r; \
            _Pragma("unroll") for (int e = 0; e < 16; ++e) op[(size_t)crow(e, h2) * 512] = (bf16_t)f2bf(acc1[e]); \
        } \
        __syncthreads(); \
    } while (0)
    const float glreg = glast[cb + (lane & 31)];
    bf16x8 Af0[8], Af1[8], Kf[4];
    u32x4 Xa, Xb, Xc, Xd;
    Xc = Xd = (u32x4){0u, 0u, 0u, 0u};
    SCAN_LOAD_A(Af0, cb); SCAN_LOAD_K(cb); SCAN_LOAD_X(cb);
    SCAN_LOAD_A(Af1, cb + 1);
    __syncthreads();
#pragma unroll 1
    for (int n = 0; n < 32; n += 2) {
        SCAN_STEP(Af0, n);
        SCAN_STEP(Af1, n + 1);
    }
#undef SCAN_LOAD_A
#undef SCAN_LOAD_K
#undef SCAN_LOAD_X
#undef SCAN_STEP
}

DI void fox_attn(const Params& P, int bh, int qb, unsigned char* smem, int tt) {
    const int tid = tt, lane = tid & 63, wave = tid >> 6, r = lane & 31, h2 = lane >> 5;
    const int b = bh >> 3, hh = bh & 7;
    constexpr int BUFB = 2 * 64 * 72 * 2 + 256;
    constexpr float L2E = 1.4426950408889634f;
    const bf16_t* fqk = (const bf16_t*)(P.ws + OFF_FQK);
    const bf16_t* vT = (const bf16_t*)(P.ws + OFF_VT) + (size_t)bh * 64 * TSEQ;
    const float* cf = (const float*)(P.ws + OFF_CF) + (size_t)bh * TSEQ;
    const int q = qb * 128 + wave * 32 + r;
    bf16x8 Qf[4];
    {
        const bf16_t* qp = fqk + ((size_t)b * TSEQ + q) * 1024 + hh * 64 + h2 * 8;
#pragma unroll
        for (int ks = 0; ks < 4; ++ks) Qf[ks] = *(const bf16x8*)(qp + ks * 16);
    }
    const float cq = cf[q] * L2E;
    float m = -1e30f, l = 0.f;
    f32x16 O[2];
#pragma unroll
    for (int e = 0; e < 16; ++e) { O[0][e] = 0.f; O[1][e] = 0.f; }
    const int ntiles = 2 * qb + 2;
    const int srow = tid >> 3, scol = (tid & 7) * 8;
    const bf16_t* kg = fqk + ((size_t)b * TSEQ + srow) * 1024 + 512 + hh * 64 + scol;
    const bf16_t* vg = vT + (size_t)srow * TSEQ + scol;
    u32x4 rk0, rk1, rv0, rv1; float rc = 0.f;
    rk0 = *(const u32x4*)kg; rk1 = *(const u32x4*)(kg + 32 * 1024);
    rv0 = *(const u32x4*)vg; rv1 = *(const u32x4*)(vg + 32 * TSEQ);
    if (tid < 64) rc = cf[tid] * L2E;
    {
        bf16_t* Ks = (bf16_t*)smem; bf16_t* VTs = Ks + 64 * 72; float* cks = (float*)(smem + 2 * 64 * 72 * 2);
        *(u32x4*)(Ks + srow * 72 + scol) = rk0; *(u32x4*)(Ks + (srow + 32) * 72 + scol) = rk1;
        *(u32x4*)(VTs + srow * 72 + scol) = rv0; *(u32x4*)(VTs + (srow + 32) * 72 + scol) = rv1;
        if (tid < 64) cks[tid] = rc;
    }
    __syncthreads();
#pragma unroll 1
    for (int kt = 0; kt < ntiles; ++kt) {
        const unsigned char* bufc = smem + (kt & 1) * BUFB;
        const bf16_t* Ks = (const bf16_t*)bufc; const bf16_t* VTs = Ks + 64 * 72; const float* cks = (const float*)(bufc + 2 * 64 * 72 * 2);
        const bool more = kt + 1 < ntiles;
        if (more) {
            const bf16_t* kg2 = kg + (size_t)(kt + 1) * 64 * 1024; const bf16_t* vg2 = vg + (kt + 1) * 64;
            rk0 = *(const u32x4*)kg2; rk1 = *(const u32x4*)(kg2 + 32 * 1024);
            rv0 = *(const u32x4*)vg2; rv1 = *(const u32x4*)(vg2 + 32 * TSEQ);
            if (tid < 64) rc = cf[(kt + 1) * 64 + tid] * L2E;
        }
        f32x16 sacc[2];
        f32x4 ckv[2][4];
        {
            bf16x8 kf[2][4];
#pragma unroll
            for (int mt = 0; mt < 2; ++mt)
#pragma unroll
                for (int ks = 0; ks < 4; ++ks) kf[mt][ks] = *(const bf16x8*)(Ks + (mt * 32 + r) * 72 + ks * 16 + h2 * 8);
#pragma unroll
            for (int mt = 0; mt < 2; ++mt)
#pragma unroll
                for (int g = 0; g < 4; ++g) ckv[mt][g] = *(const f32x4*)(cks + mt * 32 + 8 * g + 4 * h2);
#pragma unroll
            for (int e = 0; e < 16; ++e) { sacc[0][e] = 0.f; sacc[1][e] = 0.f; }
            __builtin_amdgcn_sched_barrier(0);
#pragma unroll
            for (int ks = 0; ks < 4; ++ks) { sacc[0] = MFMA32(kf[0][ks], Qf[ks], sacc[0]); sacc[1] = MFMA32(kf[1][ks], Qf[ks], sacc[1]); }
        }
        const bool diag = kt >= ntiles - 2;
        float mx = -1e30f;
        {
            const f32x2v csc = {0.125f * L2E, 0.125f * L2E};
#pragma unroll
            for (int mt = 0; mt < 2; ++mt)
#pragma unroll
                for (int g = 0; g < 4; ++g) {
                    const f32x4 ck4 = ckv[mt][g];
                    const f32x2v c01 = {ck4[0], ck4[1]}, c23 = {ck4[2], ck4[3]};
                    const f32x2v a01 = {sacc[mt][4 * g], sacc[mt][4 * g + 1]}, a23 = {sacc[mt][4 * g + 2], sacc[mt][4 * g + 3]};
                    const f32x2v s01 = a01 * csc - c01, s23 = a23 * csc - c23;
                    sacc[mt][4 * g] = s01.x; sacc[mt][4 * g + 1] = s01.y; sacc[mt][4 * g + 2] = s23.x; sacc[mt][4 * g + 3] = s23.y;
                    mx = fmaxf(fmaxf(mx, s01.x), s01.y); mx = fmaxf(fmaxf(mx, s23.x), s23.y);
                }
        }
        if (diag) {
            mx = -1e30f;
            const int qrel = q - kt * 64 - 4 * h2;
#pragma unroll
            for (int mt = 0; mt < 2; ++mt)
#pragma unroll
                for (int e = 0; e < 16; ++e) {
                    const int krel = mt * 32 + (e & 3) + 8 * (e >> 2);
                    const float sv = (krel > qrel) ? -1e30f : sacc[mt][e];
                    sacc[mt][e] = sv;
                    mx = fmaxf(mx, sv);
                }
        }
        mx = fmaxf(mx, shx(mx, 32, lane));
        const float mn = fmaxf(m, mx + cq);
        const float alpha = __builtin_amdgcn_exp2f(m - mn);
        m = mn;
        {
            const float sh = cq - mn;
            const f32x2v sh2 = {sh, sh}, al2 = {alpha, alpha};
            f32x2v rs2 = {0.f, 0.f};
#pragma unroll
            for (int mt = 0; mt < 2; ++mt)
#pragma unroll
                for (int p2 = 0; p2 < 8; ++p2) {
                    const f32x2v sv = {sacc[mt][2 * p2], sacc[mt][2 * p2 + 1]};
                    const f32x2v t = sv + sh2;
                    f32x2v pp; pp.x = __builtin_amdgcn_exp2f(t.x); pp.y = __builtin_amdgcn_exp2f(t.y);
                    sacc[mt][2 * p2] = pp.x; sacc[mt][2 * p2 + 1] = pp.y;
                    rs2 = rs2 + pp;
                }
            float rs = rs2.x + rs2.y;
            rs += shx(rs, 32, lane);
            l = l * alpha + rs;
#pragma unroll
            for (int dt = 0; dt < 2; ++dt)
#pragma unroll
                for (int p2 = 0; p2 < 8; ++p2) {
                    f32x2v ov = {O[dt][2 * p2], O[dt][2 * p2 + 1]};
                    ov = ov * al2;
                    O[dt][2 * p2] = ov.x; O[dt][2 * p2 + 1] = ov.y;
                }
        }
        {
            u32x4 vw[2][2][2];
#pragma unroll
            for (int mt = 0; mt < 2; ++mt)
#pragma unroll
                for (int s = 0; s < 2; ++s)
#pragma unroll
                    for (int dt = 0; dt < 2; ++dt) {
                        const bf16_t* vp = VTs + (dt * 32 + r) * 72 + mt * 32 + 16 * s + 4 * h2;
                        const u32x2 lo = *(const u32x2*)vp, hi = *(const u32x2*)(vp + 8);
                        vw[mt][s][dt].x = lo.x; vw[mt][s][dt].y = lo.y; vw[mt][s][dt].z = hi.x; vw[mt][s][dt].w = hi.y;
                    }
            u32x4 pw[2][2];
#pragma unroll
            for (int mt = 0; mt < 2; ++mt)
#pragma unroll
                for (int s = 0; s < 2; ++s) {
                    pw[mt][s].x = pack2(sacc[mt][8 * s + 0], sacc[mt][8 * s + 1]); pw[mt][s].y = pack2(sacc[mt][8 * s + 2], sacc[mt][8 * s + 3]);
                    pw[mt][s].z = pack2(sacc[mt][8 * s + 4], sacc[mt][8 * s + 5]); pw[mt][s].w = pack2(sacc[mt][8 * s + 6], sacc[mt][8 * s + 7]);
                }
            __builtin_amdgcn_sched_barrier(0);
#pragma unroll
            for (int mt = 0; mt < 2; ++mt)
#pragma unroll
                for (int s = 0; s < 2; ++s) {
                    const bf16x8 pf = __builtin_bit_cast(bf16x8, pw[mt][s]);
                    O[0] = MFMA32(__builtin_bit_cast(bf16x8, vw[mt][s][0]), pf, O[0]);
                    O[1] = MFMA32(__builtin_bit_cast(bf16x8, vw[mt][s][1]), pf, O[1]);
                }
        }
        if (more) {
            unsigned char* bufn = smem + ((kt + 1) & 1) * BUFB;
            bf16_t* Kn = (bf16_t*)bufn; bf16_t* VTn = Kn + 64 * 72; float* ckn = (float*)(bufn + 2 * 64 * 72 * 2);
            *(u32x4*)(Kn + srow * 72 + scol) = rk0; *(u32x4*)(Kn + (srow + 32) * 72 + scol) = rk1;
            *(u32x4*)(VTn + srow * 72 + scol) = rv0; *(u32x4*)(VTn + (srow + 32) * 72 + scol) = rv1;
            if (tid < 64) ckn[tid] = rc;
        }
        __syncthreads();
    }
    const float inv = 1.f / l;
    float ss = 0.f;
#pragma unroll
    for (int e = 0; e < 16; ++e) { O[0][e] *= inv; O[1][e] *= inv; ss += O[0][e] * O[0][e] + O[1][e] * O[1][e]; }
    ss += shx(ss, 32, lane);
    const float sc = rsqrtf(ss * (1.f / 64.f) + 1e-6f);
    bf16_t* op = (bf16_t*)(P.ws + OFF_MIX) + ((size_t)b * TSEQ + q) * 1024 + 512 + hh * 64;
    const float* fg = P.in[10];
    f32x4 ggv[2][4];
#pragma unroll
    for (int dt = 0; dt < 2; ++dt)
#pragma unroll
        for (int g = 0; g < 4; ++g) ggv[dt][g] = *(const f32x4*)(fg + dt * 32 + 8 * g + 4 * h2);
#pragma unroll
    for (int dt = 0; dt < 2; ++dt)
#pragma unroll
        for (int g = 0; g < 4; ++g) {
            const int d0 = dt * 32 + 8 * g + 4 * h2;
            const f32x4 gg = ggv[dt][g];
            u32x2 o;
            o.x = pack2(O[dt][4 * g + 0] * sc * gg[0], O[dt][4 * g + 1] * sc * gg[1]); o.y = pack2(O[dt][4 * g + 2] * sc * gg[2], O[dt][4 * g + 3] * sc * gg[3]);
            *(u32x2*)(op + d0) = o;
        }
}

#define XB_TMO      128
#define XB_XCNT(j)  (256  + 64 * (j))
#define XB_XSUB(j)  (1280 + 64 * (j))
#define XB_XGEN(j)  (2304 + 64 * (j))
#define XB_TOP      3328
#define XB_TOPGEN   3392
#define XCD_BAR_WORDS 3456
#define XB_SPIN_CAP (1u << 18)
#define LAS __attribute__((address_space(3)))
DI unsigned xb_ld(unsigned* p)              { return __hip_atomic_load(p, __ATOMIC_RELAXED, __HIP_MEMORY_SCOPE_AGENT); }
DI unsigned xb_add(unsigned* p, unsigned v) { return __hip_atomic_fetch_add(p, v, __ATOMIC_RELAXED, __HIP_MEMORY_SCOPE_AGENT); }
DI unsigned xb_xcc_id() { return (unsigned)__builtin_amdgcn_s_getreg((3 << 11) | 20) & 0xFu; }
#define XB_SPIN(cond, bar) do { unsigned _sp = 0; while (cond) { __builtin_amdgcn_s_sleep(1); \
    if ((++_sp & 255u) == 0u) { if (xb_ld(&(bar)[XB_TMO])) break; if (_sp > XB_SPIN_CAP) { atomicAdd(&(bar)[XB_TMO], 1u); break; } } } } while (0)
struct XcdBarrier { unsigned* bar; unsigned x; volatile LAS unsigned* st; };
DI XcdBarrier xcd_barrier_post(unsigned* bar, volatile LAS unsigned* st, int tid0) {
    XcdBarrier b; b.bar = bar; b.x = xb_xcc_id(); b.st = st;
    if (tid0 == 0) (void)xb_add(&bar[XB_XCNT(b.x)], 1u);
    return b;
}
DI void xcd_barrier_complete(unsigned* bar, unsigned x, unsigned& nloc, unsigned& nx) {
    const unsigned G = gridDim.x * gridDim.y * gridDim.z;
    unsigned sum, cnt, mine, sp = 0u;
    for (;;) {
        sum = 0u; cnt = 0u; mine = 0u;
#pragma unroll
        for (unsigned j = 0; j < 16; ++j) { const unsigned c = xb_ld(&bar[XB_XCNT(j)]); sum += c; cnt += (c > 0u) ? 1u : 0u; mine = (j == x) ? c : mine; }
        if (sum == G) break;
        __builtin_amdgcn_s_sleep(1);
        if ((++sp & 255u) == 0u) { if (xb_ld(&bar[XB_TMO])) break; if (sp > XB_SPIN_CAP) { atomicAdd(&bar[XB_TMO], 1u); break; } }
    }
    nloc = mine > 0u ? mine : 1u; nx = cnt > 0u ? cnt : 1u;
}
DI void xcd_barrier(const XcdBarrier& b, const int wid_s) {
    asm volatile("s_waitcnt vmcnt(0)" ::: "memory");
    __syncthreads();
    if (fresh_tid(wid_s) == 0) {
        unsigned* bar = b.bar;
        __builtin_amdgcn_s_waitcnt(0);
        unsigned nloc = b.st[0], nx = b.st[1];
        if (nloc == 0u) { xcd_barrier_complete(bar, b.x, nloc, nx); b.st[0] = nloc; b.st[1] = nx; }
        const unsigned old = xb_add(&bar[XB_XSUB(b.x)], 1u);
        const unsigned gen = old / nloc;
        if (old + 1u == (gen + 1u) * nloc) {
            __builtin_amdgcn_fence(__ATOMIC_RELEASE, "agent");
            asm volatile("s_waitcnt vmcnt(0)" ::: "memory");
            const unsigned og = xb_add(&bar[XB_TOP], 1u);
            const unsigned tg = og / nx;
            if (og + 1u == (tg + 1u) * nx) xb_add(&bar[XB_TOPGEN], 1u);
            else XB_SPIN(xb_ld(&bar[XB_TOPGEN]) == tg, bar);
            __builtin_amdgcn_fence(__ATOMIC_ACQUIRE, "agent");
            xb_add(&bar[XB_XGEN(b.x)], 1u);
            asm volatile("s_waitcnt vmcnt(0)" ::: "memory");
        } else {
            XB_SPIN(xb_ld(&bar[XB_XGEN(b.x)]) == gen, bar);
            __builtin_amdgcn_fence(__ATOMIC_ACQUIRE, "agent");
            asm volatile("s_waitcnt vmcnt(0)" ::: "memory");
        }
    }
    __syncthreads();
}


template <int MODE> struct EpiLnFused {
    static constexpr bool PERM = true, AFTER_DRAIN = true;
    const float* x; const float* g_in; const float* b_in; const float* stats;
    const float* h1; const bf16_t* pg;
    float* xbuf; unsigned* cnt; const float* g; const float* b; float* outf; bf16_t* outb;
    DI void operator()(const pg8::f32x4 (&)[2][2][4][2], const pg8::Unit&, int, int, int, int) const {}
    DI void fused(pg8::f32x4 (&acc)[2][2][4][2], const pg8::Unit& u, int wr, int wc, int fr, int fq, pg8::PG8_LAS_T ldsp, int wid, int lane) const {
        float* P = (float*)(unsigned char*)ldsp;
        float* ST = P + 2048;
        const int tid = wid * 64 + lane;
        f32x4 gi[2][2], bi[2][2];
#pragma unroll
        for (int bj = 0; bj < 2; ++bj) {
            const int col = u.pn * 256 + bj * 128 + wc * 32 + 8 * fq;
            if (MODE == 0) { gi[bj][0] = *(const f32x4*)(g_in + col); gi[bj][1] = *(const f32x4*)(g_in + col + 4); bi[bj][0] = *(const f32x4*)(b_in + col); bi[bj][1] = *(const f32x4*)(b_in + col + 4); }
        }
        f32x2v stv[2] = {{0.f, 0.f}, {0.f, 0.f}};
        f32x4 ld[2][2][2];
        u32x4 lp[2][2];
        auto issue = [&](int idx, int bufi) {
            const int row = u.pm * 256 + (idx >> 2) * 128 + wr * 64 + (idx & 3) * 16 + fr;
            if (MODE == 0) stv[bufi] = *(const f32x2v*)(stats + row * 2);
#pragma unroll
            for (int bj = 0; bj < 2; ++bj) {
                const unsigned ix = (unsigned)(row * DM + u.pn * 256 + bj * 128 + wc * 32 + 8 * fq);
                const float* src = (MODE == 0) ? x : h1;
                ld[bufi][bj][0] = *(const f32x4*)(src + ix); ld[bufi][bj][1] = *(const f32x4*)(src + ix + 4);
                if (MODE == 1) lp[bufi][bj] = *(const u32x4*)(pg + ix);
            }
        };
        issue(0, 0);
#pragma unroll
        for (int idx = 0; idx < 8; ++idx) {
            const int ai = idx >> 2, m = idx & 3, cb_ = idx & 1;
            const int rt = ai * 128 + wr * 64 + m * 16 + fr;
            if (idx + 1 < 8) issue(idx + 1, cb_ ^ 1);
            __builtin_amdgcn_sched_barrier(0);
            float sm = 0.f, sq = 0.f;
            const float mu = stv[cb_].x, rs = stv[cb_].y;
#pragma unroll
            for (int bj = 0; bj < 2; ++bj) {
                f32x4 v0, v1;
                if (MODE == 0) {
                    v0 = ((ld[cb_][bj][0] - mu) * rs * gi[bj][0] + bi[bj][0]) * ALPHA + acc[ai][bj][m][0];
                    v1 = ((ld[cb_][bj][1] - mu) * rs * gi[bj][1] + bi[bj][1]) * ALPHA + acc[ai][bj][m][1];
                } else {
                    const u32x4 w = lp[cb_][bj];
                    v0 = ld[cb_][bj][0] * ALPHA + acc[ai][bj][m][0];
                    v1 = ld[cb_][bj][1] * ALPHA + acc[ai][bj][m][1];
                    v0[0] += bflo(w.x); v0[1] += bfhi(w.x); v0[2] += bflo(w.y); v0[3] += bfhi(w.y);
                    v1[0] += bflo(w.z); v1[1] += bfhi(w.z); v1[2] += bflo(w.w); v1[3] += bfhi(w.w);
                }
                acc[ai][bj][m][0] = v0; acc[ai][bj][m][1] = v1;
#pragma unroll
                for (int e = 0; e < 4; ++e) { sm += v0[e] + v1[e]; sq += v0[e] * v0[e] + v1[e] * v1[e]; }
            }
            sm += shx(sm, 16, lane); sm += shx(sm, 32, lane);
            sq += shx(sq, 16, lane); sq += shx(sq, 32, lane);
            P[(rt * 4 + wc) * 2] = sm; P[(rt * 4 + wc) * 2 + 1] = sq;
        }
        __syncthreads();
        if (tid < 256) {
            const f32x4 a = *(const f32x4*)(P + tid * 8), c = *(const f32x4*)(P + tid * 8 + 4);
            float* slot = xbuf + ((size_t)(u.pm * 256 + tid) * 4 + u.pn) * 2;
            __hip_atomic_store(slot, (a[0] + a[2]) + (c[0] + c[2]), __ATOMIC_RELAXED, __HIP_MEMORY_SCOPE_AGENT);
            __hip_atomic_store(slot + 1, (a[1] + a[3]) + (c[1] + c[3]), __ATOMIC_RELAXED, __HIP_MEMORY_SCOPE_AGENT);
        }
        asm volatile("s_waitcnt vmcnt(0)" ::: "memory");
        __syncthreads();
        if (tid == 0) {
            xb_add(cnt + u.pm, 1u);
            unsigned sp = 0;
            while (xb_ld(cnt + u.pm) < 4u) { __builtin_amdgcn_s_sleep(1); if (++sp > (1u << 22)) break; }
        }
        __syncthreads();
        if (tid < 256) {
            float* slot = xbuf + (size_t)(u.pm * 256 + tid) * 8;
            float pv[8];
#pragma unroll
            for (int e = 0; e < 8; ++e) pv[e] = __hip_atomic_load(slot + e, __ATOMIC_RELAXED, __HIP_MEMORY_SCOPE_AGENT);
            const float sm = (pv[0] + pv[2]) + (pv[4] + pv[6]), sq = (pv[1] + pv[3]) + (pv[5] + pv[7]);
            const float mean = sm * (1.f / 1024.f);
            const float var = fmaxf(sq * (1.f / 1024.f) - mean * mean, 0.f);
            ST[tid * 2] = mean; ST[tid * 2 + 1] = rsqrtf(var + 1e-5f);
        }
        __syncthreads();
        f32x4 go[2][2], bo[2][2];
#pragma unroll
        for (int bj = 0; bj < 2; ++bj) {
            const int col = u.pn * 256 + bj * 128 + wc * 32 + 8 * fq;
            go[bj][0] = *(const f32x4*)(g + col); go[bj][1] = *(const f32x4*)(g + col + 4); bo[bj][0] = *(const f32x4*)(b + col); bo[bj][1] = *(const f32x4*)(b + col + 4);
        }
#pragma unroll
        for (int ai = 0; ai < 2; ++ai)
#pragma unroll
            for (int m = 0; m < 4; ++m) {
                const int rt = ai * 128 + wr * 64 + m * 16 + fr, row = u.pm * 256 + rt;
                const float mean = ST[rt * 2], rstd = ST[rt * 2 + 1];
#pragma unroll
                for (int bj = 0; bj < 2; ++bj) {
                    const int col = u.pn * 256 + bj * 128 + wc * 32 + 8 * fq;
                    const unsigned idx = (unsigned)(row * DM + col);
                    const f32x4 o0 = (acc[ai][bj][m][0] - mean) * rstd * go[bj][0] + bo[bj][0], o1 = (acc[ai][bj][m][1] - mean) * rstd * go[bj][1] + bo[bj][1];
                    if (outf) { *(f32x4*)(outf + idx) = o0; *(f32x4*)(outf + idx + 4) = o1; }
                    if (outb) *(u32x4*)(outb + idx) = pack8(o0, o1);
                }
            }
    }
};

template <class Epi> DI void run_gemm(pg8::PG8_LAS_T lds, const bf16_t* A, const bf16_t* Bt, int N, int K, const Epi& E, const int wid_s) {
    pg8::Gemm g{A, Bt, M_TOK, N, K}; pg8::StaticOrder S; S.init(M_TOK, N, (int)gridDim.x, (int)blockIdx.x);
    pg8::gemm_phase<Epi, pg8::StaticOrder, true, true>(lds, g, S, E, wid_s);
}
__global__ void __launch_bounds__(512, 2) fwd_mega(Params P) {
    cg::grid_group grid = cg::this_grid();
    extern __shared__ __attribute__((aligned(16))) unsigned char lds[];
    pg8::PG8_LAS_T glds = (pg8::PG8_LAS_T)lds;
    volatile LAS unsigned* xb_words = (volatile LAS unsigned*)(glds + LDS_MISC);
    volatile int* s_item = (volatile int*)(lds + LDS_MISC + 16);
    const int nblk = gridDim.x, bid = blockIdx.x;
    unsigned char* ws = P.ws;

    const int wid_s = __builtin_amdgcn_readfirstlane((int)threadIdx.x >> 6);
    if (threadIdx.x < 4) xb_words[threadIdx.x] = 0u;
    __syncthreads();
    const XcdBarrier xbar = xcd_barrier_post((unsigned*)(ws + OFF_BAR), xb_words, (int)threadIdx.x);
    if (P.out == nullptr) grid.sync();

    {
    for (int base = bid * 2; base < 3584 + 4096; base += nblk * 2) {
        PHASE_IDS
        const int it = base + team;
        if (it < 3584) {
            const float* W; int K, N, mode = 0, loc, nnt; bf16_t* Wt;
            if (it < 960) { W = P.in[4]; K = 1024; N = 3600; mode = 1; Wt = (bf16_t*)(ws + OFF_WIN); loc = it; nnt = 60; }
            else if (it < 1216) { W = P.in[11]; K = 1024; N = 1024; Wt = (bf16_t*)(ws + OFF_WOUT); loc = it - 960; nnt = 16; }
            else if (it < 2240) { W = P.in[14]; K = 1024; N = 4096; Wt = (bf16_t*)(ws + OFF_WUP); loc = it - 1216; nnt = 64; }
            else if (it < 3264) { W = P.in[15]; K = 4096; N = 1024; Wt = (bf16_t*)(ws + OFF_WDOWN); loc = it - 2240; nnt = 16; }
            else if (it < 3520) { W = P.in[17]; K = 1024; N = 1024; Wt = (bf16_t*)(ws + OFF_WG); loc = it - 3264; nnt = 16; }
            else { W = P.in[16]; K = 256; N = 1024; Wt = (bf16_t*)(ws + OFF_WPLE); loc = it - 3520; nnt = 16; }
            transpose_tile(W, K, N, Wt, loc / nnt, loc % nnt, mode, (float*)smem, tt);
        } else {
            const int row = (it - 3584) * 4 + tw;
            ln_row(P.in[0] + (size_t)row * DM, P.in[2], P.in[3], nullptr, (bf16_t*)(ws + OFF_HB) + (size_t)row * DM, (float*)(ws + OFF_STATS) + row * 2, lane);
            { const f32x4 pv = *(const f32x4*)(P.in[1] + (size_t)row * 256 + lane * 4); u32x2 w; w.x = pack2(pv[0], pv[1]); w.y = pack2(pv[2], pv[3]);
              *(u32x2*)((bf16_t*)(ws + OFF_PB) + (size_t)row * 256 + lane * 4) = w; }
        }
    }
    }
    xcd_barrier(xbar, wid_s);

    { EpiProj E{ws}; run_gemm(glds, (const bf16_t*)(ws + OFF_HB), (const bf16_t*)(ws + OFF_WIN), NPROJ, DM, E, wid_s); }
    xcd_barrier(xbar, wid_s);

    for (int rep = 0; rep < NREP(2); ++rep)
    {
    for (int base = bid * 2; base < 1024 + 64; base += nblk * 2) {
        PHASE_IDS
        const int it = base + team;
        if (it < 1024) prep_chunk(P, it, smem, tt); else fox_cumsum(P, it - 1024, smem, tt);
    }
    }
    xcd_barrier(xbar, wid_s);

    for (int rep = 0; rep < NREP(3); ++rep)
    {
    for (;;) {
        PHASE_IDS
        __syncthreads();
        if (tid == 0) *s_item = atomicAdd((int*)(ws + OFF_CTR) + rep, 1);
        __syncthreads();
        const int pr = *s_item;
        if (pr >= 64 + 512) break;
        if (pr < 64) gdn_scan(P, pr * 2 + team, smem, tt);
        else { const int fj = pr - 64; fox_attn(P, (fj & 31) * 2 + team, 15 - (fj >> 5), smem, tt); }
    }
    }
    xcd_barrier(xbar, wid_s);

    { PHASE_IDS
    for (int it = bid; it < M_TOK / 8; it += nblk) {
        const int row = it * 8 + wave8;
        bf16_t* mix = (bf16_t*)(ws + OFF_MIX) + (size_t)row * DM;
        {
            const int col = lane * 8;
            const u32x4 ov = *(const u32x4*)((const bf16_t*)(ws + OFF_OG) + (size_t)row * 512 + col);
            const u32x4 zv = *(const u32x4*)((const bf16_t*)(ws + OFF_Z) + (size_t)row * 512 + col);
            float o[8] = {bflo(ov.x), bfhi(ov.x), bflo(ov.y), bfhi(ov.y), bflo(ov.z), bfhi(ov.z), bflo(ov.w), bfhi(ov.w)};
            float z[8] = {bflo(zv.x), bfhi(zv.x), bflo(zv.y), bfhi(zv.y), bflo(zv.z), bfhi(zv.z), bflo(zv.w), bfhi(zv.w)};
            float ss = 0.f;
#pragma unroll
            for (int e = 0; e < 8; ++e) ss += o[e] * o[e];
            ss += shx(ss, 1, lane); ss += shx(ss, 2, lane); ss += shx(ss, 4, lane); ss += shx(ss, 8, lane);
            const float sc = rsqrtf(ss * (1.f / 128.f) + 1e-6f);
            const float* gg = P.in[8] + (col & 127);
            float v[8];
#pragma unroll
            for (int e = 0; e < 8; ++e) v[e] = o[e] * sc * gg[e] * siluf(z[e]);
            u32x4 w; w.x = pack2(v[0], v[1]); w.y = pack2(v[2], v[3]); w.z = pack2(v[4], v[5]); w.w = pack2(v[6], v[7]);
            *(u32x4*)(mix + col) = w;
        }
    }
    }
    xcd_barrier(xbar, wid_s);

    { EpiLnFused<0> E{P.in[0], P.in[2], P.in[3], (const float*)(ws + OFF_STATS), nullptr, nullptr, (float*)(ws + OFF_XBUF), (unsigned*)(ws + OFF_PCNT), P.in[12], P.in[13], P.out, (bf16_t*)(ws + OFF_H1B)};
      run_gemm(glds, (const bf16_t*)(ws + OFF_MIX), (const bf16_t*)(ws + OFF_WOUT), DM, DM, E, wid_s); }
    xcd_barrier(xbar, wid_s);

    { EpiUp E{(bf16_t*)(ws + OFF_FFB)}; run_gemm(glds, (const bf16_t*)(ws + OFF_H1B), (const bf16_t*)(ws + OFF_WUP), 4096, DM, E, wid_s); }
    { EpiGate E{(bf16_t*)(ws + OFF_PG), P.in[18]}; run_gemm(glds, (const bf16_t*)(ws + OFF_H1B), (const bf16_t*)(ws + OFF_WG), DM, DM, E, wid_s); }
    { EpiPle E{(bf16_t*)(ws + OFF_PG)}; run_gemm(glds, (const bf16_t*)(ws + OFF_PB), (const bf16_t*)(ws + OFF_WPLE), DM, 256, E, wid_s); }
    xcd_barrier(xbar, wid_s);

    { EpiLnFused<1> E{nullptr, nullptr, nullptr, nullptr, P.out, (const bf16_t*)(ws + OFF_PG), (float*)(ws + OFF_XBUF) + (size_t)M_TOK * 8, (unsigned*)(ws + OFF_PCNT) + 64, P.in[19], P.in[20], P.out, nullptr};
      run_gemm(glds, (const bf16_t*)(ws + OFF_FFB), (const bf16_t*)(ws + OFF_WDOWN), DM, 4096, E, wid_s); }
}

extern "C" void kernel_launch(void* const* d_in, const int* in_sizes, int n_in, void* d_out, int out_size, void* d_ws, size_t ws_size, hipStream_t stream) {
    static int grid_blocks = 0;
    if (!grid_blocks) {
        int dev = 0, cus = 0, per_cu = 0;
        (void)hipGetDevice(&dev);
        (void)hipDeviceGetAttribute(&cus, hipDeviceAttributeMultiprocessorCount, dev);
        if (hipFuncSetAttribute((const void*)fwd_mega, hipFuncAttributeMaxDynamicSharedMemorySize, LDS_BYTES) != hipSuccess) fprintf(stderr, "kernel_launch: hipFuncSetAttribute failed\n");
        (void)hipOccupancyMaxActiveBlocksPerMultiprocessor(&per_cu, (const void*)fwd_mega, 512, LDS_BYTES);
        if (per_cu < 1) fprintf(stderr, "kernel_launch: occupancy query reports %d blocks per CU\n", per_cu);
        (void)hipGetLastError();
        grid_blocks = cus;
        if (ws_size < 232 * MBy) fprintf(stderr, "kernel_launch: workspace too small (%zu)\n", ws_size);
    }
    Params p{};
    for (int i = 0; i < 21; ++i) p.in[i] = (const float*)d_in[i];
    p.out = (float*)d_out; p.ws = (unsigned char*)d_ws;
    (void)hipMemsetAsync((unsigned char*)d_ws + OFF_BAR, 0, 16384, stream);
    void* args[] = {&p};
    hipError_t e = hipLaunchCooperativeKernel((void*)fwd_mega, dim3(grid_blocks), dim3(512), args, LDS_BYTES, stream);
    if (e != hipSuccess) fprintf(stderr, "cooperative launch failed: %s (grid %d)\n", hipGetErrorString(e), grid_blocks);
}
```

```cpp
#include <hip/hip_runtime.h>
#include <hip/hip_cooperative_groups.h>
#include <cstdio>
namespace cg = cooperative_groups;

typedef unsigned short bf16_t;
typedef short bf16x8 __attribute__((ext_vector_type(8)));
typedef short s16x4 __attribute__((ext_vector_type(4)));
typedef float f32x16 __attribute__((ext_vector_type(16)));
typedef float f32x4 __attribute__((ext_vector_type(4)));
typedef unsigned u32x4 __attribute__((ext_vector_type(4)));
typedef unsigned u32x2 __attribute__((ext_vector_type(2)));
typedef float f32x2v __attribute__((ext_vector_type(2)));

#define DI __device__ __forceinline__
#define MFMA32(a, b, c) __builtin_amdgcn_mfma_f32_32x32x16_bf16((a), (b), (c), 0, 0, 0)

constexpr int M_TOK = 16384, DM = 1024, TSEQ = 2048;
constexpr int NPROJ = 3840;
constexpr size_t MBy = 1u << 20;
constexpr size_t OFF_WIN = 0, OFF_WOUT = 8 * MBy, OFF_WUP = 10 * MBy, OFF_WDOWN = 18 * MBy, OFF_WG = 26 * MBy, OFF_WPLE = 28 * MBy;
constexpr size_t OFF_STATS = 28 * MBy + 512 * 1024, OFF_GLAST = 28 * MBy + 640 * 1024, OFF_BAR = 29 * MBy + 512 * 1024, OFF_CTR = OFF_BAR + 14336, OFF_CF = 28 * MBy + 768 * 1024;
constexpr size_t OFF_XBUF = 31 * MBy, OFF_PCNT = OFF_BAR + 14848;
constexpr size_t OFF_GATES = 30 * MBy, OFF_GQKV = 32 * MBy, OFF_Z = 80 * MBy, OFF_FQK = 96 * MBy, OFF_VT = 128 * MBy, OFF_HB = 144 * MBy;
constexpr size_t OFF_U = 144 * MBy, OFF_W = 160 * MBy, OFF_QD = 176 * MBy, OFF_KDT = 192 * MBy, OFF_QK = 208 * MBy;
constexpr size_t OFF_OG = 32 * MBy, OFF_MIX = 216 * MBy;
constexpr size_t OFF_H1B = 32 * MBy, OFF_PB = 248 * MBy, OFF_FFB = 72 * MBy, OFF_PG = 200 * MBy;
constexpr float ALPHA = 1.189207115002721f;
constexpr int TEAM_LDS = 76800, LDS_MISC = 153600, LDS_BYTES = 153600 + 256;
#ifndef REP_MASK
#define REP_MASK 0
#endif
#define NREP(k) (1 + ((REP_MASK >> (k)) & 1))

struct Params { const float* in[21]; float* out; unsigned char* ws; };

DI float bf2f(unsigned b) { return __uint_as_float(b << 16); }
typedef float f32x2_t __attribute__((ext_vector_type(2))); typedef __bf16 bf16x2_t __attribute__((ext_vector_type(2)));
DI unsigned pack2(float lo, float hi) { f32x2_t v = {lo, hi}; bf16x2_t b = __builtin_convertvector(v, bf16x2_t); return __builtin_bit_cast(unsigned, b); }
DI unsigned f2bf(float x) { return pack2(x, 0.f) & 0xffffu; }
DI float bflo(unsigned w) { return __uint_as_float(w << 16); }
DI float bfhi(unsigned w) { return __uint_as_float(w & 0xffff0000u); }
DI int crow(int e, int h) { return (e & 3) + 8 * (e >> 2) + 4 * h; }
DI float shx(float v, int mask, int lane) { return __int_as_float(__builtin_amdgcn_ds_bpermute((lane ^ mask) << 2, __float_as_int(v))); }
DI float shup(float v, int o, int lane) { return __int_as_float(__builtin_amdgcn_ds_bpermute(((lane - o) & 63) << 2, __float_as_int(v))); }
DI float shlane(float v, int src) { return __int_as_float(__builtin_amdgcn_readlane(__float_as_int(v), src)); }
DI float wave_sum(float v, int lane) { for (int o = 32; o > 0; o >>= 1) v += shx(v, o, lane); return v; }
DI float siluf(float x) { return x * __builtin_amdgcn_rcpf(1.f + __expf(-x)); }
DI float sigmoidf_(float x) { return __builtin_amdgcn_rcpf(1.f + __expf(-x)); }
DI int fresh_tid(int wid_s) { int l; asm volatile("v_mbcnt_lo_u32_b32 %0, -1, 0\n\tv_mbcnt_hi_u32_b32 %0, -1, %0" : "=v"(l)); return wid_s * 64 + l; }
#define PHASE_IDS const int tid = fresh_tid(wid_s), lane = tid & 63, wave8 = tid >> 6, team = tid >> 8, tt = tid & 255, tw = tt >> 6; unsigned char* smem = lds + team * TEAM_LDS; (void)lane; (void)wave8; (void)tt; (void)tw; (void)smem;

DI void ln_row(const float* src, const float* __restrict__ g, const float* __restrict__ b, float* dstf, bf16_t* dstb, float* stats, int lane) {
    f32x4 v[4];
#pragma unroll
    for (int i = 0; i < 4; ++i) v[i] = *(const f32x4*)(src + i * 256 + lane * 4);
    float s = 0.f;
#pragma unroll
    for (int i = 0; i < 4; ++i) s += (v[i][0] + v[i][1]) + (v[i][2] + v[i][3]);
    s = wave_sum(s, lane);
    const float mu = s * (1.f / 1024.f);
    float q = 0.f;
#pragma unroll
    for (int i = 0; i < 4; ++i) { f32x4 d = v[i] - mu; q += (d[0] * d[0] + d[1] * d[1]) + (d[2] * d[2] + d[3] * d[3]); }
    q = wave_sum(q, lane);
    const float rstd = rsqrtf(q * (1.f / 1024.f) + 1e-5f);
    f32x4 gv[4], bv[4];
#pragma unroll
    for (int i = 0; i < 4; ++i) { gv[i] = *(const f32x4*)(g + i * 256 + lane * 4); bv[i] = *(const f32x4*)(b + i * 256 + lane * 4); }
#pragma unroll
    for (int i = 0; i < 4; ++i) {
        const f32x4 gg = gv[i], bb = bv[i];
        const f32x4 o = (v[i] - mu) * rstd * gg + bb;
        if (dstf) *(f32x4*)(dstf + i * 256 + lane * 4) = o;
        if (dstb) { u32x2 w; w.x = pack2(o[0], o[1]); w.y = pack2(o[2], o[3]); *(u32x2*)(dstb + i * 256 + lane * 4) = w; }
    }
    if (stats && lane == 0) { stats[0] = mu; stats[1] = rstd; }
}

DI void transpose_tile(const float* __restrict__ W, int K, int N, bf16_t* __restrict__ Wt, int kt, int nt, int mode, float* tile, int tt) {
    const int tid = tt;
    const int k0 = kt * 64, n0 = nt * 64;
    {
        const int c = tid & 63, n = n0 + c;
        int sc = n;
        if (mode == 1) { sc = (n < 2048) ? n : (n < 3584) ? n + 8 : (n < 3592) ? 2048 + (n - 3584) : (n < 3600) ? n : -1; }
        const int scc = sc >= 0 ? sc : 0;
        const float mk = sc >= 0 ? 1.f : 0.f;
        float wv[16];
#pragma unroll
        for (int i = 0; i < 16; ++i) wv[i] = W[(size_t)(k0 + (tid >> 6) + 4 * i) * N + scc];
#pragma unroll
        for (int i = 0; i < 16; ++i) tile[((tid >> 6) + 4 * i) * 65 + c] = wv[i] * mk;
    }
    __syncthreads();
    {
        const int n = tid >> 2, ks = (tid & 3) * 16;
        u32x4 o0, o1;
        o0.x = pack2(tile[(ks + 0) * 65 + n], tile[(ks + 1) * 65 + n]); o0.y = pack2(tile[(ks + 2) * 65 + n], tile[(ks + 3) * 65 + n]);
        o0.z = pack2(tile[(ks + 4) * 65 + n], tile[(ks + 5) * 65 + n]); o0.w = pack2(tile[(ks + 6) * 65 + n], tile[(ks + 7) * 65 + n]);
        o1.x = pack2(tile[(ks + 8) * 65 + n], tile[(ks + 9) * 65 + n]); o1.y = pack2(tile[(ks + 10) * 65 + n], tile[(ks + 11) * 65 + n]);
        o1.z = pack2(tile[(ks + 12) * 65 + n], tile[(ks + 13) * 65 + n]); o1.w = pack2(tile[(ks + 14) * 65 + n], tile[(ks + 15) * 65 + n]);
        bf16_t* dst = Wt + (size_t)(n0 + n) * K + k0 + ks;
        *(u32x4*)dst = o0; *(u32x4*)(dst + 8) = o1;
    }
    __syncthreads();
}

namespace pg8 {
#define PG8_LAS __attribute__((address_space(3)))
typedef PG8_LAS unsigned char* PG8_LAS_T;
typedef unsigned short bf16_t;
typedef short bf16x8 __attribute__((ext_vector_type(8)));
typedef float f32x4 __attribute__((ext_vector_type(4)));
typedef unsigned u32x4 __attribute__((ext_vector_type(4)));
constexpr int BM = 256, BK = 64, HALF = 128, HTB = HALF * BK * 2  , STAGE_BYTES = 8 * HTB, NXCD = 8, WGM = 8;

__host__ __device__ __forceinline__ int lds_byte(int r, int c) { const int st = (r >> 4) * 2 + (c >> 5), rr = r & 15, cc = c & 31, ob = rr * 64 + cc * 2; return st * 1024 + (ob ^ (((ob >> 9) & 1) << 5)); }
__host__ __device__ __forceinline__ void stage_rc(int b, int& R, int& C) { const int st = b / 1024, sb = b % 1024, swz = sb ^ (((sb >> 9) & 1) << 5); R = (st >> 1) * 16 + swz / 64; C = (st & 1) * 32 + (swz % 64) / 2; }
__host__ __device__ __forceinline__ int perm32(int rho) { const int n = rho >> 4, i = rho & 15; return 8 * (i >> 2) + 4 * n + (i & 3); }

struct Unit { int pm, pn; };
struct Gemm { const bf16_t* A; const bf16_t* Bt; int M, N, K; };

struct StaticOrder {
    int nM, nN, nwg, G, c;
    __host__ __device__ void init(int M, int N, int G_, int c_) { nM = M / BM; nN = N / BM; nwg = nM * nN; G = G_; c = c_; }
    __host__ __device__ bool next(int i, Unit& u) const {
        const long L = (long)i * G + c; if (L >= nwg) return false;
        int wgid = (int)L; { const int q = nwg / NXCD, r = nwg % NXCD, xcd = wgid % NXCD, off = wgid / NXCD; wgid = (xcd < r ? xcd * (q + 1) : r * (q + 1) + (xcd - r) * q) + off; }
        const int nig = WGM * nN, gid = wgid / nig, fm = gid * WGM, gsz = (nM - fm) < WGM ? (nM - fm) : WGM;
        u.pm = fm + ((wgid % nig) % gsz); u.pn = (wgid % nig) / gsz; return true;
    }
    __device__ __forceinline__ void a_ready(const Unit&) const {}
    __device__ __forceinline__ void done(const Unit&) const {}
};
template <class Epi, class Sched, bool ALIGN_EPI = false, bool SP2 = false>
__device__ __forceinline__ void gemm_phase(PG8_LAS unsigned char* lds, const Gemm g, const Sched& S, const Epi& E, const int wid_s) {
    const int tid = fresh_tid(wid_s), wid = wid_s, lane = tid & 63, wr = wid >> 2, wc = wid & 3, fr = lane & 15, fq = lane >> 4;
    const int K = g.K, nt = K / BK;
    unsigned voffA[2], voffB[2];
#pragma unroll
    for (int i = 0; i < 2; ++i) { int R, C; stage_rc(tid * 16 + i * 8192, R, C); const int Rb = Epi::PERM ? ((R & ~31) + perm32(R & 31)) : R;
        voffA[i] = (unsigned)(R * K + C) * 2u; voffB[i] = (unsigned)(Rb * K + C) * 2u; }
    const size_t kstep = (size_t)(BK * 2);
    const size_t hstep = (size_t)HALF * K * 2;
    const size_t tstep = 2 * hstep;
    const unsigned ldsw = (unsigned)wid * 1024u;
    const int aoff = lds_byte(wr * 64 + fr, fq * 8), boff = lds_byte(wc * 32 + fr, fq * 8);
#define PG8_SA(b, h) (((b) * 2 + (h)) * HTB)
#define PG8_SB(b, h) ((4 + (b) * 2 + (h)) * HTB)
#define PG8_STAGE(bufoff, gbase, voff) do { _Pragma("unroll") for (int _i = 0; _i < 2; ++_i) \
        __builtin_amdgcn_global_load_lds((const unsigned*)((const char*)(gbase) + (voff)[_i]), (PG8_LAS unsigned*)(lds + (bufoff) + ldsw + _i * 8192), 16, 0, 0); } while (0)
#define PG8_LDA(dst, b, h) do { _Pragma("unroll") for (int m = 0; m < 4; ++m) _Pragma("unroll") for (int k = 0; k < 2; ++k) dst[m][k] = *(const PG8_LAS bf16x8*)(lds + PG8_SA(b, h) + aoff + m * 2048 + k * 1024); } while (0)
#define PG8_LDB(dst, b, h) do { _Pragma("unroll") for (int n = 0; n < 2; ++n) _Pragma("unroll") for (int k = 0; k < 2; ++k) dst[n][k] = *(const PG8_LAS bf16x8*)(lds + PG8_SB(b, h) + boff + n * 2048 + k * 1024); } while (0)
#define PG8_MMA(ai, bj, At, Bt) do { __builtin_amdgcn_s_setprio(1); _Pragma("unroll") for (int m = 0; m < 4; ++m) _Pragma("unroll") for (int n = 0; n < 2; ++n) _Pragma("unroll") for (int k = 0; k < 2; ++k) \
        acc[ai][bj][m][n] = __builtin_amdgcn_mfma_f32_16x16x32_bf16(Bt[n][k], At[m][k], acc[ai][bj][m][n], 0, 0, 0); __builtin_amdgcn_s_setprio(0); } while (0)
#define PG8_WAIT_V(n) asm volatile("s_waitcnt vmcnt(" #n ")" ::: "memory")
#define PG8_WAIT_L(n) asm volatile("s_waitcnt lgkmcnt(" #n ")" ::: "memory")
#define PG8_BAR __builtin_amdgcn_s_barrier()
#define PG8_SCHED __builtin_amdgcn_sched_barrier(0)
    Unit cur, nxt; int ui = 0;
    if (!S.next(0, cur)) return;
    f32x4 acc[2][2][4][2];
#pragma unroll
    for (int a = 0; a < 2; ++a)
#pragma unroll
        for (int b = 0; b < 2; ++b)
#pragma unroll
            for (int m = 0; m < 4; ++m)
#pragma unroll
                for (int n = 0; n < 2; ++n) acc[a][b][m][n] = (f32x4){0.f, 0.f, 0.f, 0.f};
    bf16x8 At[4][2], B0[2][2], B1[2][2];
    const char* cA = (const char*)g.A + (size_t)cur.pm * tstep; const char* cB = (const char*)g.Bt + (size_t)cur.pn * tstep;
    S.a_ready(cur);
    if constexpr (SP2) {
        PG8_STAGE(PG8_SB(0, 0), cB, voffB); PG8_STAGE(PG8_SB(0, 1), cB + hstep, voffB); PG8_STAGE(PG8_SA(0, 0), cA, voffA); PG8_STAGE(PG8_SA(0, 1), cA + hstep, voffA);
        if (wr == 1) PG8_BAR;
        PG8_WAIT_V(2); PG8_BAR;
        PG8_STAGE(PG8_SB(1, 0), cB + kstep, voffB); PG8_STAGE(PG8_SA(1, 0), cA + kstep, voffA); PG8_STAGE(PG8_SB(1, 1), cB + hstep + kstep, voffB);
        PG8_WAIT_V(6); PG8_BAR;
    } else {
        PG8_STAGE(PG8_SB(0, 0), cB, voffB); PG8_STAGE(PG8_SA(0, 0), cA, voffA); PG8_STAGE(PG8_SB(0, 1), cB + hstep, voffB); PG8_STAGE(PG8_SA(0, 1), cA + hstep, voffA);
        if (wr == 1) PG8_BAR;
        PG8_WAIT_V(4); PG8_BAR;
        PG8_STAGE(PG8_SB(1, 0), cB + kstep, voffB); PG8_STAGE(PG8_SA(1, 0), cA + kstep, voffA); PG8_STAGE(PG8_SB(1, 1), cB + hstep + kstep, voffB);
        PG8_WAIT_V(6); PG8_BAR;
    }
    for (;;) {
        const bool has_next = S.next(ui + 1, nxt);
        const char* nA = has_next ? (const char*)g.A + (size_t)nxt.pm * tstep : cA; const char* nB = has_next ? (const char*)g.Bt + (size_t)nxt.pn * tstep : cB;
        for (int t = 0; t < nt; t += 2) {
            const bool last = (t == nt - 2);
            const char* a1 = cA + (size_t)(t + 1) * kstep;
            const char* a2 = last ? nA : cA + (size_t)(t + 2) * kstep; const char* b2 = last ? nB : cB + (size_t)(t + 2) * kstep;
            const char* a3 = a2 + kstep; const char* b3 = b2 + kstep;
            if (last && has_next) S.a_ready(nxt);
            if constexpr (SP2) {
            PG8_LDB(B0, 0, 0); PG8_LDB(B1, 0, 1); PG8_SCHED; PG8_LDA(At, 0, 0); PG8_STAGE(PG8_SA(1, 1), a1 + hstep, voffA);
            PG8_WAIT_V(8); PG8_WAIT_L(0); PG8_BAR; PG8_MMA(0, 0, At, B0); PG8_MMA(0, 1, At, B1); PG8_BAR; PG8_SCHED;
            PG8_LDA(At, 0, 1); PG8_STAGE(PG8_SB(0, 0), b2, voffB); PG8_STAGE(PG8_SB(0, 1), b2 + hstep, voffB); PG8_STAGE(PG8_SA(0, 0), a2, voffA);
            PG8_WAIT_V(8); PG8_WAIT_L(0); PG8_BAR; PG8_MMA(1, 0, At, B0); PG8_MMA(1, 1, At, B1); PG8_BAR; PG8_SCHED;
            PG8_LDB(B0, 1, 0); PG8_LDB(B1, 1, 1); PG8_SCHED; PG8_LDA(At, 1, 0); PG8_STAGE(PG8_SA(0, 1), a2 + hstep, voffA);
            PG8_WAIT_V(8); PG8_WAIT_L(0); PG8_BAR; PG8_MMA(0, 0, At, B0); PG8_MMA(0, 1, At, B1); PG8_BAR; PG8_SCHED;
            PG8_LDA(At, 1, 1); PG8_STAGE(PG8_SB(1, 0), b3, voffB); PG8_STAGE(PG8_SB(1, 1), b3 + hstep, voffB); PG8_STAGE(PG8_SA(1, 0), a3, voffA);
            PG8_WAIT_V(8); PG8_WAIT_L(0); PG8_BAR; PG8_MMA(1, 0, At, B0); PG8_MMA(1, 1, At, B1); PG8_BAR; PG8_SCHED;
            } else {
            PG8_LDB(B0, 0, 0); PG8_SCHED; PG8_LDA(At, 0, 0); PG8_STAGE(PG8_SA(1, 1), a1 + hstep, voffA);
            PG8_WAIT_L(8); PG8_BAR; PG8_WAIT_L(0); PG8_MMA(0, 0, At, B0); PG8_BAR; PG8_SCHED;
            PG8_LDB(B1, 0, 1); PG8_STAGE(PG8_SB(0, 0), b2, voffB);
            PG8_BAR; PG8_WAIT_L(0); PG8_MMA(0, 1, At, B1); PG8_BAR;
            PG8_LDA(At, 0, 1); PG8_STAGE(PG8_SA(0, 0), a2, voffA);
            PG8_BAR; PG8_WAIT_L(0); PG8_MMA(1, 0, At, B0); PG8_BAR; PG8_SCHED;
            PG8_STAGE(PG8_SB(0, 1), b2 + hstep, voffB);
            PG8_WAIT_V(6); PG8_BAR; PG8_MMA(1, 1, At, B1); PG8_BAR;
            PG8_LDB(B0, 1, 0); PG8_SCHED; PG8_LDA(At, 1, 0); PG8_STAGE(PG8_SA(0, 1), a2 + hstep, voffA);
            PG8_WAIT_L(8); PG8_BAR; PG8_WAIT_L(0); PG8_MMA(0, 0, At, B0); PG8_BAR; PG8_SCHED;
            PG8_LDB(B1, 1, 1); PG8_STAGE(PG8_SB(1, 0), b3, voffB);
            PG8_BAR; PG8_WAIT_L(0); PG8_MMA(0, 1, At, B1); PG8_BAR;
            PG8_LDA(At, 1, 1); PG8_STAGE(PG8_SA(1, 0), a3, voffA);
            PG8_BAR; PG8_WAIT_L(0); PG8_MMA(1, 0, At, B0); PG8_BAR; PG8_SCHED;
            PG8_STAGE(PG8_SB(1, 1), b3 + hstep, voffB);
            PG8_WAIT_V(6); PG8_BAR; PG8_MMA(1, 1, At, B1); PG8_BAR;
            }
        }
        if constexpr (ALIGN_EPI) { if (wr == 0) PG8_BAR; }
        if constexpr (!Epi::AFTER_DRAIN) { E(acc, cur, wr, wc, fr, fq); S.done(cur); }
        if (!has_next) break;
#pragma unroll
        for (int a = 0; a < 2; ++a)
#pragma unroll
            for (int b = 0; b < 2; ++b)
#pragma unroll
                for (int m = 0; m < 4; ++m)
#pragma unroll
                    for (int n = 0; n < 2; ++n) acc[a][b][m][n] = (f32x4){0.f, 0.f, 0.f, 0.f};
        cur = nxt; cA = nA; cB = nB; ++ui;
        if constexpr (ALIGN_EPI) { if (wr == 1) PG8_BAR; }
    }
    PG8_WAIT_V(0);
    if constexpr (!ALIGN_EPI) { if (wr == 0) PG8_BAR; }
    PG8_BAR;
    if constexpr (Epi::AFTER_DRAIN) { E.fused(acc, cur, wr, wc, fr, fq, lds, wid, lane); S.done(cur); }
#undef PG8_SA
#undef PG8_SB
#undef PG8_STAGE
#undef PG8_LDA
#undef PG8_LDB
#undef PG8_MMA
#undef PG8_WAIT_V
#undef PG8_WAIT_L
#undef PG8_BAR
#undef PG8_SCHED
}
}

template <class F> DI void epi_rows(const pg8::f32x4 (&acc)[2][2][4][2], const pg8::Unit& u, int wr, int wc, int fr, int fq, F f) {
#pragma unroll
    for (int ai = 0; ai < 2; ++ai)
#pragma unroll
        for (int m = 0; m < 4; ++m) {
            const int row = u.pm * 256 + ai * 128 + wr * 64 + m * 16 + fr;
#pragma unroll
            for (int bj = 0; bj < 2; ++bj) f(row, u.pn * 256 + bj * 128 + wc * 32 + 8 * fq, acc[ai][bj][m][0], acc[ai][bj][m][1]);
        }
}
DI u32x4 pack8(const f32x4& a, const f32x4& b) { u32x4 w; w.x = pack2(a[0], a[1]); w.y = pack2(a[2], a[3]); w.z = pack2(b[0], b[1]); w.w = pack2(b[2], b[3]); return w; }
struct EpiProj {
    static constexpr bool PERM = true, AFTER_DRAIN = false;
    unsigned char* ws;
    DI void operator()(const pg8::f32x4 (&acc)[2][2][4][2], const pg8::Unit& u, int wr, int wc, int fr, int fq) const {
        const int pn = u.pn;
        if (pn < 12) {
            bf16_t* dst; int ld, cofs;
            if (pn < 6) { dst = (bf16_t*)(ws + OFF_GQKV); ld = 1536; cofs = 0; }
            else if (pn < 8) { dst = (bf16_t*)(ws + OFF_Z); ld = 512; cofs = 1536; }
            else { dst = (bf16_t*)(ws + OFF_FQK); ld = 1024; cofs = 2048; }
            epi_rows(acc, u, wr, wc, fr, fq, [&](int row, int col, const f32x4& a, const f32x4& b) { *(u32x4*)(dst + (size_t)row * ld + (col - cofs)) = pack8(a, b); });
        } else if (pn < 14) {
            bf16_t* vT = (bf16_t*)(ws + OFF_VT);
            epi_rows(acc, u, wr, wc, fr, fq, [&](int row, int col, const f32x4& a, const f32x4& b) {
                const int c = col - 3072, hh = c >> 6, d0 = c & 63, bb = row >> 11, t = row & 2047;
                bf16_t* p = vT + ((size_t)(bb * 8 + hh) * 64 + d0) * TSEQ + t;
#pragma unroll
                for (int e = 0; e < 4; ++e) { p[(size_t)e * TSEQ] = (bf16_t)f2bf(a[e]); p[(size_t)(e + 4) * TSEQ] = (bf16_t)f2bf(b[e]); }
            });
        } else {
            float* gates = (float*)(ws + OFF_GATES);
            epi_rows(acc, u, wr, wc, fr, fq, [&](int row, int col, const f32x4& a, const f32x4& b) {
                const int c = col - 3584;
                if (c < 16) { *(f32x4*)(gates + (size_t)row * 16 + c) = a; *(f32x4*)(gates + (size_t)row * 16 + c + 4) = b; }
            });
        }
    }
};
struct EpiOutProj {
    static constexpr bool PERM = true, AFTER_DRAIN = false;
    const float* x; const float* g; const float* b; const float* stats; float* out;
    DI void operator()(const pg8::f32x4 (&acc)[2][2][4][2], const pg8::Unit& u, int wr, int wc, int fr, int fq) const {
        epi_rows(acc, u, wr, wc, fr, fq, [&](int row, int col, const f32x4& a0, const f32x4& a1) {
            const float mu = stats[row * 2], rs = stats[row * 2 + 1];
            const size_t idx = (size_t)row * DM + col;
            const f32x4 x0 = *(const f32x4*)(x + idx), x1 = *(const f32x4*)(x + idx + 4);
            const f32x4 g0 = *(const f32x4*)(g + col), g1 = *(const f32x4*)(g + col + 4), b0 = *(const f32x4*)(b + col), b1 = *(const f32x4*)(b + col + 4);
            *(f32x4*)(out + idx) = ((x0 - mu) * rs * g0 + b0) * ALPHA + a0;
            *(f32x4*)(out + idx + 4) = ((x1 - mu) * rs * g1 + b1) * ALPHA + a1;
        });
    }
};
struct EpiUp {
    static constexpr bool PERM = true, AFTER_DRAIN = false;
    bf16_t* ffb;
    DI void operator()(const pg8::f32x4 (&acc)[2][2][4][2], const pg8::Unit& u, int wr, int wc, int fr, int fq) const {
        epi_rows(acc, u, wr, wc, fr, fq, [&](int row, int col, const f32x4& a, const f32x4& b) {
            f32x4 ra, rb;
#pragma unroll
            for (int e = 0; e < 4; ++e) { const float va = fmaxf(a[e], 0.f), vb = fmaxf(b[e], 0.f); ra[e] = va * va; rb[e] = vb * vb; }
            *(u32x4*)(ffb + (size_t)row * 4096 + col) = pack8(ra, rb);
        });
    }
};
struct EpiGate {
    static constexpr bool PERM = true, AFTER_DRAIN = false;
    bf16_t* pg; const float* bias;
    DI void operator()(const pg8::f32x4 (&acc)[2][2][4][2], const pg8::Unit& u, int wr, int wc, int fr, int fq) const {
        f32x4 bv[2][2];
#pragma unroll
        for (int bj = 0; bj < 2; ++bj) { const int c0 = u.pn * 256 + bj * 128 + wc * 32 + 8 * fq; bv[bj][0] = *(const f32x4*)(bias + c0); bv[bj][1] = *(const f32x4*)(bias + c0 + 4); }
        epi_rows(acc, u, wr, wc, fr, fq, [&](int row, int col, const f32x4& a, const f32x4& b) {
            const int bj = (col >> 7) & 1;
            const f32x4 b0 = bv[bj][0], b1 = bv[bj][1];
            f32x4 ra, rb;
#pragma unroll
            for (int e = 0; e < 4; ++e) { ra[e] = sigmoidf_(a[e] + b0[e]); rb[e] = sigmoidf_(b[e] + b1[e]); }
            *(u32x4*)(pg + (size_t)row * DM + col) = pack8(ra, rb);
        });
    }
};
struct EpiPle {
    static constexpr bool PERM = true, AFTER_DRAIN = false;
    bf16_t* pg;
    DI void operator()(const pg8::f32x4 (&acc)[2][2][4][2], const pg8::Unit& u, int wr, int wc, int fr, int fq) const {
        epi_rows(acc, u, wr, wc, fr, fq, [&](int row, int col, const f32x4& a, const f32x4& b) {
            u32x4* p = (u32x4*)(pg + (size_t)row * DM + col);
            const u32x4 w = *p;
            f32x4 ra, rb;
            ra[0] = a[0] * bflo(w.x); ra[1] = a[1] * bfhi(w.x); ra[2] = a[2] * bflo(w.y); ra[3] = a[3] * bfhi(w.y);
            rb[0] = b[0] * bflo(w.z); rb[1] = b[1] * bfhi(w.z); rb[2] = b[2] * bflo(w.w); rb[3] = b[3] * bfhi(w.w);
            *p = pack8(ra, rb);
        });
    }
};
struct EpiDown {
    static constexpr bool PERM = true, AFTER_DRAIN = false;
    const bf16_t* pg; float* out;
    DI void operator()(const pg8::f32x4 (&acc)[2][2][4][2], const pg8::Unit& u, int wr, int wc, int fr, int fq) const {
        epi_rows(acc, u, wr, wc, fr, fq, [&](int row, int col, const f32x4& a, const f32x4& b) {
            const size_t idx = (size_t)row * DM + col;
            const u32x4 w = *(const u32x4*)(pg + idx);
            f32x4 o0 = *(const f32x4*)(out + idx), o1 = *(const f32x4*)(out + idx + 4);
            o0 = o0 * ALPHA + a; o1 = o1 * ALPHA + b;
            o0[0] += bflo(w.x); o0[1] += bfhi(w.x); o0[2] += bflo(w.y); o0[3] += bfhi(w.y);
            o1[0] += bflo(w.z); o1[1] += bfhi(w.z); o1[2] += bflo(w.w); o1[3] += bfhi(w.w);
            *(f32x4*)(out + idx) = o0; *(f32x4*)(out + idx + 4) = o1;
        });
    }
};
DI void lds_read8(unsigned addr, f32x4 (&a)[4][2]) {
    asm volatile(
        "ds_read_b128 %0, %8\n\tds_read_b128 %1, %8 offset:16\n\t"
        "ds_read_b128 %2, %8 offset:256\n\tds_read_b128 %3, %8 offset:272\n\t"
        "ds_read_b128 %4, %8 offset:512\n\tds_read_b128 %5, %8 offset:528\n\t"
        "ds_read_b128 %6, %8 offset:768\n\tds_read_b128 %7, %8 offset:784\n\t"
        "s_waitcnt lgkmcnt(0)"
        : "=&v"(a[0][0]), "=&v"(a[0][1]), "=&v"(a[1][0]), "=&v"(a[1][1]), "=&v"(a[2][0]), "=&v"(a[2][1]), "=&v"(a[3][0]), "=&v"(a[3][1])
        : "v"(addr) : "memory");
}
DI void lds_read8s(unsigned addr, f32x4 (&a)[4][2]) {
    asm volatile(
        "ds_read_b128 %0, %8\n\tds_read_b128 %1, %8 offset:16\n\t"
        "ds_read_b128 %2, %8 offset:128\n\tds_read_b128 %3, %8 offset:144\n\t"
        "ds_read_b128 %4, %8 offset:256\n\tds_read_b128 %5, %8 offset:272\n\t"
        "ds_read_b128 %6, %8 offset:384\n\tds_read_b128 %7, %8 offset:400\n\t"
        "s_waitcnt lgkmcnt(0)"
        : "=&v"(a[0][0]), "=&v"(a[0][1]), "=&v"(a[1][0]), "=&v"(a[1][1]), "=&v"(a[2][0]), "=&v"(a[2][1]), "=&v"(a[3][0]), "=&v"(a[3][1])
        : "v"(addr) : "memory");
}
DI void prep_chunk(const Params& P, int ci, unsigned char* smem, int tt) {
    const int tid = tt, lane = tid & 63, wave = tid >> 6, r = lane & 31, h2 = lane >> 5;
    const int b = ci >> 7, hd = (ci >> 5) & 3, n = ci & 31, t0 = n * 64;
    const size_t rowbase = (size_t)b * TSEQ + t0;
    bf16_t* kbf = (bf16_t*)smem;
    bf16_t* qbf = kbf + 64 * 136;
    bf16_t* vT  = (bf16_t*)smem;
    bf16_t* Tb  = (bf16_t*)(smem + 18432);
    bf16_t* Tg  = (bf16_t*)(smem + 27648);
    bf16_t* kT  = (bf16_t*)(smem + 36864);
    float*  Ad  = (float*)(smem + 55296);
    bf16_t* A10 = (bf16_t*)(smem + 63488);
    bf16_t* DT  = (bf16_t*)(smem + 66048);
    float* sbeta = (float*)(smem + 71168);
    float* sgam = sbeta + 64; float* segam = sgam + 64; float* sdk = segam + 64;
    bf16_t* D1R = (bf16_t*)(smem + 72192);
    const bf16_t* gq = (const bf16_t*)(P.ws + OFF_GQKV);
    const float* gates = (const float*)(P.ws + OFF_GATES);
    const float* cw = P.in[5];
    if (tid < 64) {
        const float* gt = gates + (rowbase + tid) * 16;
        const float be = sigmoidf_(gt[hd]);
        const float a = gt[4 + hd] + P.in[7][hd];
        const float sp = fmaxf(a, 0.f) + log1pf(__expf(-fabsf(a)));
        float lg = -__expf(P.in[6][hd]) * sp;
#pragma unroll
        for (int o = 1; o < 64; o <<= 1) { const float t = shup(lg, o, lane); if (lane >= o) lg += t; }
        const float gl = shlane(lg, 63);
        sbeta[tid] = be; sgam[tid] = lg; segam[tid] = __expf(lg); sdk[tid] = __expf(gl - lg);
    }
    {
        float* wl = Ad;
        for (int idx = tid; idx < 384; idx += 256) {
            const int wh = idx >> 7, rem = idx & 127, j = rem >> 5, c4 = (rem & 31) * 4;
            const int cbw = (wh == 0 ? 512 : wh == 1 ? 0 : 1024) + hd * 128;
            *(f32x4*)(wl + (wh * 4 + j) * 128 + c4) = *(const f32x4*)(cw + j * 1536 + cbw + c4);
        }
    }
    __syncthreads();
    unsigned vkeep[16];
#pragma unroll
    for (int e = 0; e < 16; ++e) vkeep[e] = 0u;
    {
        const int i = tid >> 2, seg = tid & 3;
        const float* wl = Ad;
#pragma unroll 1
        for (int which = 0; which < 3; ++which) {
            const int colbase = (which == 0 ? 512 : which == 1 ? 0 : 1024) + hd * 128 + seg * 32;
            u32x4 xr[4][4];
#pragma unroll
            for (int j = 0; j < 4; ++j) {
                const int t = t0 + i - 3 + j;
                const int tc = t < 0 ? 0 : t;
                const bf16_t* xp = gq + ((size_t)b * TSEQ + tc) * 1536 + colbase;
#pragma unroll
                for (int sub = 0; sub < 4; ++sub) xr[j][sub] = *(const u32x4*)(xp + sub * 8);
            }
            float val[32];
#pragma unroll
            for (int sub = 0; sub < 4; ++sub) {
                float a8[8];
#pragma unroll
                for (int e = 0; e < 8; ++e) a8[e] = 0.f;
#pragma unroll
                for (int j = 0; j < 4; ++j) {
                    const float mk = (t0 + i - 3 + j) < 0 ? 0.f : 1.f;
                    const u32x4 xv = xr[j][sub];
                    f32x4 w0 = *(const f32x4*)(wl + (which * 4 + j) * 128 + seg * 32 + sub * 8), w1 = *(const f32x4*)(wl + (which * 4 + j) * 128 + seg * 32 + sub * 8 + 4);
                    w0 = w0 * mk; w1 = w1 * mk;
                    a8[0] += w0[0] * bflo(xv.x); a8[1] += w0[1] * bfhi(xv.x); a8[2] += w0[2] * bflo(xv.y); a8[3] += w0[3] * bfhi(xv.y);
                    a8[4] += w1[0] * bflo(xv.z); a8[5] += w1[1] * bfhi(xv.z); a8[6] += w1[2] * bflo(xv.w); a8[7] += w1[3] * bfhi(xv.w);
                }
#pragma unroll
                for (int e = 0; e < 8; ++e) val[sub * 8 + e] = siluf(a8[e]);
            }
            float ss = 0.f;
#pragma unroll
            for (int e = 0; e < 32; ++e) ss += val[e] * val[e];
            ss += shx(ss, 1, lane); ss += shx(ss, 2, lane);
            const float sc = (which == 2) ? 1.f : rsqrtf(ss + 1e-6f) * (which == 1 ? 0.08838834764831845f : 1.f);
            unsigned pk[16];
#pragma unroll
            for (int e = 0; e < 16; ++e) pk[e] = pack2(val[2 * e] * sc, val[2 * e + 1] * sc);
            if (which == 2) {
#pragma unroll
                for (int e = 0; e < 16; ++e) vkeep[e] = pk[e];
            } else {
                bf16_t* dst = (which == 0 ? kbf : qbf) + i * 136 + seg * 32;
#pragma unroll
                for (int sub = 0; sub < 4; ++sub) { u32x4 o; o.x = pk[4 * sub]; o.y = pk[4 * sub + 1]; o.z = pk[4 * sub + 2]; o.w = pk[4 * sub + 3]; *(u32x4*)(dst + sub * 8) = o; }
                if (which == 0) {
                    bf16_t* kt = kT + (seg * 32) * 72 + i;
#pragma unroll
                    for (int e = 0; e < 16; ++e) { kt[(2 * e) * 72] = (bf16_t)(pk[e] & 0xffffu); kt[(2 * e + 1) * 72] = (bf16_t)(pk[e] >> 16); }
                }
            }
        }
    }
    __syncthreads();
    {
        const int mi = wave >> 1, ni = wave & 1;
        f32x16 aK, aQ;
#pragma unroll
        for (int e = 0; e < 16; ++e) { aK[e] = 0.f; aQ[e] = 0.f; }
#pragma unroll
        for (int ks = 0; ks < 8; ++ks) {
            const bf16x8 ak = *(const bf16x8*)(kbf + (mi * 32 + r) * 136 + ks * 16 + h2 * 8);
            const bf16x8 bk = *(const bf16x8*)(kbf + (ni * 32 + r) * 136 + ks * 16 + h2 * 8);
            const bf16x8 aq = *(const bf16x8*)(qbf + (mi * 32 + r) * 136 + ks * 16 + h2 * 8);
            aK = MFMA32(ak, bk, aK); aQ = MFMA32(aq, bk, aQ);
        }
        const int j = ni * 32 + r;
        const float gj = sgam[j];
        bf16_t* qkout = (bf16_t*)(P.ws + OFF_QK) + (size_t)ci * 4096;
#pragma unroll
        for (int e = 0; e < 16; ++e) {
            const int il = crow(e, h2), i = mi * 32 + il;
            const float dec = (i >= j) ? __expf(sgam[i] - gj) : 0.f;
            const float aij = (i > j) ? aK[e] * sbeta[i] * dec : 0.f;
            if (mi == ni) Ad[(mi * 32 + il) * 32 + r] = aij;
            else if (mi == 1) A10[il * 40 + r] = (bf16_t)f2bf(aij);
            qkout[(((i >> 5) * 4 + (j >> 4)) * 64 + (i & 31) + 32 * ((j >> 3) & 1)) * 8 + (j & 7)] = (bf16_t)f2bf((i >= j) ? aQ[e] * dec : 0.f);
        }
    }
    {
        const int i = tid >> 2, seg = tid & 3;
        const float eg = segam[i];
        bf16_t* qd = (bf16_t*)(P.ws + OFF_QD) + (size_t)ci * 8192;
#pragma unroll
        for (int sub = 0; sub < 4; ++sub) {
            const u32x4 v = *(const u32x4*)(qbf + i * 136 + seg * 32 + sub * 8);
            u32x4 o;
            o.x = pack2(bflo(v.x) * eg, bfhi(v.x) * eg); o.y = pack2(bflo(v.y) * eg, bfhi(v.y) * eg);
            o.z = pack2(bflo(v.z) * eg, bfhi(v.z) * eg); o.w = pack2(bflo(v.w) * eg, bfhi(v.w) * eg);
            *(u32x4*)(qd + ((((i >> 5) * 8 + seg * 2 + (sub >> 1)) * 64 + (i & 31) + 32 * (sub & 1)) * 8)) = o;
        }
        const int kidx = tid >> 1, cs = (tid & 1) * 32;
        bf16_t* kd = (bf16_t*)(P.ws + OFF_KDT) + (size_t)ci * 8192;
#pragma unroll
        for (int sub = 0; sub < 4; ++sub) {
            const u32x4 v = *(const u32x4*)(kT + kidx * 72 + cs + sub * 8);
            const f32x4 d0 = *(const f32x4*)(sdk + cs + sub * 8), d1 = *(const f32x4*)(sdk + cs + sub * 8 + 4);
            u32x4 o;
            o.x = pack2(bflo(v.x) * d0[0], bfhi(v.x) * d0[1]); o.y = pack2(bflo(v.y) * d0[2], bfhi(v.y) * d0[3]);
            o.z = pack2(bflo(v.z) * d1[0], bfhi(v.z) * d1[1]); o.w = pack2(bflo(v.w) * d1[2], bfhi(v.w) * d1[3]);
            *(u32x4*)(kd + ((((kidx >> 5) * 4 + ((cs + sub * 8) >> 4)) * 64 + (kidx & 31) + 32 * (sub & 1)) * 8)) = o;
        }
        if (tid == 0) ((float*)(P.ws + OFF_GLAST))[ci] = segam[63];
    }
    __syncthreads();
    {
        const int i = tid >> 2, seg = tid & 3;
        bf16_t* vt = vT + (seg * 32) * 72 + i;
#pragma unroll
        for (int e = 0; e < 16; ++e) { vt[(2 * e) * 72] = (bf16_t)(vkeep[e] & 0xffffu); vt[(2 * e + 1) * 72] = (bf16_t)(vkeep[e] >> 16); }
        if (tid >= 64) {
            for (int idx = tid - 64; idx < 1024; idx += 192) { const int rr = idx >> 5, cc = 32 + (idx & 31); Tb[rr * 72 + cc] = 0; Tg[rr * 72 + cc] = 0; }
        } else {
            const int blk = tid >> 5, c = tid & 31;
            float x[32];
#pragma unroll
            for (int e = 0; e < 32; ++e) x[e] = (e == c) ? 1.f : 0.f;
            const unsigned ad_lds = (unsigned)(size_t)(Ad + blk * 1024);
#pragma unroll
            for (int ib = 0; ib < 8; ++ib) {
                const int i0 = ib * 4;
                float s0 = x[i0], s1 = x[i0 + 1], s2 = x[i0 + 2], s3 = x[i0 + 3];
#pragma unroll
                for (int mb = 0; mb <= ib; mb += 2) {
                    f32x4 a[4][2];
                    lds_read8s(ad_lds + (unsigned)((i0 * 32 + mb * 4) * 4), a);
#pragma unroll
                    for (int cb = 0; cb < 2; ++cb) {
                        const int m4 = mb + cb;
                        if (m4 < ib) {
#pragma unroll
                            for (int e = 0; e < 4; ++e) {
                                const float xx = x[m4 * 4 + e];
                                s0 -= a[0][cb][e] * xx; s1 -= a[1][cb][e] * xx; s2 -= a[2][cb][e] * xx; s3 -= a[3][cb][e] * xx;
                            }
                        } else if (m4 == ib) {
                            s1 -= a[1][cb][0] * s0;
                            s2 -= a[2][cb][0] * s0; s2 -= a[2][cb][1] * s1;
                            s3 -= a[3][cb][0] * s0; s3 -= a[3][cb][1] * s1; s3 -= a[3][cb][2] * s2;
                        }
                    }
                    __builtin_amdgcn_sched_barrier(0);
                }
                x[i0] = s0; x[i0 + 1] = s1; x[i0 + 2] = s2; x[i0 + 3] = s3;
            }
            bf16_t* dt = DT + (blk * 32 + c) * 40;
#pragma unroll
            for (int q4 = 0; q4 < 4; ++q4) {
                u32x4 o; o.x = pack2(x[8 * q4], x[8 * q4 + 1]); o.y = pack2(x[8 * q4 + 2], x[8 * q4 + 3]); o.z = pack2(x[8 * q4 + 4], x[8 * q4 + 5]); o.w = pack2(x[8 * q4 + 6], x[8 * q4 + 7]);
                *(u32x4*)(dt + q4 * 8) = o;
            }
            const int cg = blk * 32 + c;
            const float bc = sbeta[cg], bg = bc * segam[cg];
#pragma unroll
            for (int rr = 0; rr < 32; ++rr) {
                if (blk == 1) D1R[rr * 40 + c] = (bf16_t)f2bf(x[rr]);
                Tb[(blk * 32 + rr) * 72 + cg] = (bf16_t)f2bf(x[rr] * bc);
                Tg[(blk * 32 + rr) * 72 + cg] = (bf16_t)f2bf(x[rr] * bg);
            }
        }
    }
    __syncthreads();
    if (wave == 0) {
        f32x16 Pm, Qm;
#pragma unroll
        for (int e = 0; e < 16; ++e) { Pm[e] = 0.f; Qm[e] = 0.f; }
#pragma unroll
        for (int ks = 0; ks < 2; ++ks) {
            const bf16x8 a = *(const bf16x8*)(A10 + r * 40 + ks * 16 + h2 * 8);
            const bf16x8 bb = *(const bf16x8*)(DT + r * 40 + ks * 16 + h2 * 8);
            Pm = MFMA32(a, bb, Pm);
        }
#pragma unroll
        for (int sq = 0; sq < 2; ++sq) {
            u32x4 pw;
            pw.x = pack2(Pm[8 * sq + 0], Pm[8 * sq + 1]); pw.y = pack2(Pm[8 * sq + 2], Pm[8 * sq + 3]);
            pw.z = pack2(Pm[8 * sq + 4], Pm[8 * sq + 5]); pw.w = pack2(Pm[8 * sq + 6], Pm[8 * sq + 7]);
            const bf16_t* dp = D1R + r * 40 + 16 * sq + 4 * h2;
            const u32x2 lo = *(const u32x2*)dp, hi = *(const u32x2*)(dp + 8);
            u32x4 aw; aw.x = lo.x; aw.y = lo.y; aw.z = hi.x; aw.w = hi.y;
            Qm = MFMA32(__builtin_bit_cast(bf16x8, aw), __builtin_bit_cast(bf16x8, pw), Qm);
        }
        const float bc = sbeta[r], bg = bc * segam[r];
#pragma unroll
        for (int e = 0; e < 16; ++e) {
            const int il = crow(e, h2);
            Tb[(32 + il) * 72 + r] = (bf16_t)f2bf(-Qm[e] * bc);
            Tg[(32 + il) * 72 + r] = (bf16_t)f2bf(-Qm[e] * bg);
        }
    }
    __syncthreads();
    {
        const int nt = wave;
        f32x16 aU[2], aW[2];
#pragma unroll
        for (int e = 0; e < 16; ++e) { aU[0][e] = 0.f; aU[1][e] = 0.f; aW[0][e] = 0.f; aW[1][e] = 0.f; }
#pragma unroll
        for (int ks = 0; ks < 4; ++ks) {
            const bf16x8 bv = *(const bf16x8*)(vT + (nt * 32 + r) * 72 + ks * 16 + h2 * 8);
            const bf16x8 bk = *(const bf16x8*)(kT + (nt * 32 + r) * 72 + ks * 16 + h2 * 8);
#pragma unroll
            for (int mt = 0; mt < 2; ++mt) {
                const bf16x8 ab = *(const bf16x8*)(Tb + (mt * 32 + r) * 72 + ks * 16 + h2 * 8);
                const bf16x8 ag = *(const bf16x8*)(Tg + (mt * 32 + r) * 72 + ks * 16 + h2 * 8);
                aU[mt] = MFMA32(ab, bv, aU[mt]); aW[mt] = MFMA32(ag, bk, aW[mt]);
            }
        }
        bf16_t* u = (bf16_t*)(P.ws + OFF_U) + (size_t)ci * 8192;
        bf16_t* w = (bf16_t*)(P.ws + OFF_W) + (size_t)ci * 8192;
#pragma unroll
        for (int mt = 0; mt < 2; ++mt) {
            u32x4 o0, o1;
            o0.x = pack2(aU[mt][0], aU[mt][1]); o0.y = pack2(aU[mt][2], aU[mt][3]); o0.z = pack2(aU[mt][4], aU[mt][5]); o0.w = pack2(aU[mt][6], aU[mt][7]);
            o1.x = pack2(aU[mt][8], aU[mt][9]); o1.y = pack2(aU[mt][10], aU[mt][11]); o1.z = pack2(aU[mt][12], aU[mt][13]); o1.w = pack2(aU[mt][14], aU[mt][15]);
            bf16_t* d = u + (((nt * 2 + mt) * 64 + lane) * 16);
            *(u32x4*)d = o0; *(u32x4*)(d + 8) = o1;
            bf16_t* wb = w + (((mt * 8 + nt * 2 + (r >> 4)) * 64 + 32 * ((r >> 3) & 1)) * 8) + (r & 7);
#pragma unroll
            for (int e = 0; e < 16; ++e) wb[crow(e, h2) * 8] = (bf16_t)f2bf(aW[mt][e]);
        }
    }
    __syncthreads();
}

DI void fox_cumsum(const Params& P, int bh, unsigned char* smem, int tt) {
    const int tid = tt, lane = tid & 63, wave = tid >> 6;
    const int b = bh >> 3, hh = bh & 7;
    float* wsum = (float*)smem;
    const float* gates = (const float*)(P.ws + OFF_GATES);
    const float bf = P.in[9][hh];
    float v[8]; float run = 0.f;
#pragma unroll
    for (int e = 0; e < 8; ++e) {
        const float xx = gates[((size_t)b * TSEQ + tid * 8 + e) * 16 + 8 + hh] + bf;
        const float ls = fminf(xx, 0.f) - log1pf(__expf(-fabsf(xx)));
        run += ls; v[e] = run;
    }
    float sc = run;
#pragma unroll
    for (int o = 1; o < 64; o <<= 1) { const float t = shup(sc, o, lane); if (lane >= o) sc += t; }
    if (lane == 63) wsum[wave] = sc;
    __syncthreads();
    float off = sc - run;
    for (int w = 0; w < wave; ++w) off += wsum[w];
    float* cf = (float*)(P.ws + OFF_CF) + (size_t)bh * TSEQ + tid * 8;
#pragma unroll
    for (int e = 0; e < 8; ++e) cf[e] = v[e] + off;
    __syncthreads();
}

DI void gdn_scan(const Params& P, int item, unsigned char* smem, int tt) {
    const int tid = tt, lane = tid & 63, wave = tid >> 6, r = lane & 31, h2 = lane >> 5;
    const int bh = item >> 2, vs = item & 3, b = bh >> 2, hd = bh & 3;
    const int cb = bh * 32;
    bf16_t* SbT = (bf16_t*)smem;
    bf16_t* VnT = SbT + 32 * 136;
    const bool w01 = wave < 2;
    const int mt = wave & 1;
    const bf16_t* Ubase = (const bf16_t*)(P.ws + OFF_U);
    const bf16_t* Abase = (const bf16_t*)(P.ws + (w01 ? OFF_W : OFF_QD));
    const bf16_t* Kbase = (const bf16_t*)(P.ws + OFF_KDT);
    const bf16_t* QKbase = (const bf16_t*)(P.ws + OFF_QK);
    const float* glast = (const float*)(P.ws + OFF_GLAST);
    bf16_t* og = (bf16_t*)(P.ws + OFF_OG);
    f32x16 S;
#pragma unroll
    for (int e = 0; e < 16; ++e) S[e] = 0.f;
    for (int i = tid; i < 32 * 136 / 2; i += 256) ((unsigned*)SbT)[i] = 0u;
#define SCAN_LOAD_A(AF, ci_) do { const bf16_t* ap_ = Abase + (size_t)(ci_) * 8192 + (mt * 8 * 64 + lane) * 8; \
        _Pragma("unroll") for (int ks = 0; ks < 8; ++ks) AF[ks] = *(const bf16x8*)(ap_ + ks * 512); } while (0)
#define SCAN_LOAD_K(ci_) do { const bf16_t* kp_ = Kbase + (size_t)(ci_) * 8192 + (wave * 4 * 64 + lane) * 8; \
        _Pragma("unroll") for (int ks = 0; ks < 4; ++ks) Kf[ks] = *(const bf16x8*)(kp_ + ks * 512); } while (0)
#define SCAN_LOAD_X(ci_) do { if (w01) { const bf16_t* up_ = Ubase + (size_t)(ci_) * 8192 + ((vs * 2 + mt) * 64 + lane) * 16; \
            Xa = *(const u32x4*)up_; Xb = *(const u32x4*)(up_ + 8); } \
        else { const bf16_t* qp_ = QKbase + (size_t)(ci_) * 4096 + (mt * 4 * 64 + lane) * 8; \
            Xa = *(const u32x4*)qp_; Xb = *(const u32x4*)(qp_ + 512); Xc = *(const u32x4*)(qp_ + 1024); Xd = *(const u32x4*)(qp_ + 1536); } } while (0)
#define SCAN_STEP(AF, n_) do { \
        const int cn1 = cb + ((n_) + 1 < 32 ? (n_) + 1 : 31); const int cn2 = cb + ((n_) + 2 < 32 ? (n_) + 2 : 31); \
        const float gl = shlane(glreg, (n_)); \
        f32x16 acc1; \
        bf16x8 sf[8]; \
        _Pragma("unroll") for (int ks = 0; ks < 8; ++ks) sf[ks] = *(const bf16x8*)(SbT + r * 136 + ks * 16 + h2 * 8); \
        _Pragma("unroll") for (int e = 0; e < 16; ++e) acc1[e] = 0.f; \
        __builtin_amdgcn_sched_barrier(0); \
        _Pragma("unroll") for (int ks = 0; ks < 8; ++ks) acc1 = MFMA32(AF[ks], sf[ks], acc1); \
        __builtin_amdgcn_sched_barrier(0); \
        SCAN_LOAD_A(AF, cn2); \
        if (w01) { \
            u32x2 ov; \
            ov.x = pack2(bflo(Xa.x) - acc1[0], bfhi(Xa.x) - acc1[1]); ov.y = pack2(bflo(Xa.y) - acc1[2], bfhi(Xa.y) - acc1[3]); *(u32x2*)(VnT + r * 72 + mt * 32 + 0 + 4 * h2) = ov; \
            ov.x = pack2(bflo(Xa.z) - acc1[4], bfhi(Xa.z) - acc1[5]); ov.y = pack2(bflo(Xa.w) - acc1[6], bfhi(Xa.w) - acc1[7]); *(u32x2*)(VnT + r * 72 + mt * 32 + 8 + 4 * h2) = ov; \
            ov.x = pack2(bflo(Xb.x) - acc1[8], bfhi(Xb.x) - acc1[9]); ov.y = pack2(bflo(Xb.y) - acc1[10], bfhi(Xb.y) - acc1[11]); *(u32x2*)(VnT + r * 72 + mt * 32 + 16 + 4 * h2) = ov; \
            ov.x = pack2(bflo(Xb.z) - acc1[12], bfhi(Xb.z) - acc1[13]); ov.y = pack2(bflo(Xb.w) - acc1[14], bfhi(Xb.w) - acc1[15]); *(u32x2*)(VnT + r * 72 + mt * 32 + 24 + 4 * h2) = ov; \
        } \
        __syncthreads(); \
        bf16x8 Vf[4]; \
        _Pragma("unroll") for (int ks = 0; ks < 4; ++ks) Vf[ks] = *(const bf16x8*)(VnT + r * 72 + ks * 16 + h2 * 8); \
        _Pragma("unroll") for (int e = 0; e < 16; ++e) S[e] *= gl; \
        __builtin_amdgcn_sched_barrier(0); \
        _Pragma("unroll") for (int ks = 0; ks < 4; ++ks) S = MFMA32(Kf[ks], Vf[ks], S); \
        if (!w01) { \
            acc1 = MFMA32(__builtin_bit_cast(bf16x8, Xa), Vf[0], acc1); acc1 = MFMA32(__builtin_bit_cast(bf16x8, Xb), Vf[1], acc1); \
            acc1 = MFMA32(__builtin_bit_cast(bf16x8, Xc), Vf[2], acc1); acc1 = MFMA32(__builtin_bit_cast(bf16x8, Xd), Vf[3], acc1); \
        } \
        __builtin_amdgcn_sched_barrier(0); \
        SCAN_LOAD_K(cn1); \
        SCAN_LOAD_X(cn1); \
        _Pragma("unroll") for (int g = 0; g < 4; ++g) { u32x2 ov; ov.x = pack2(S[4 * g + 0], S[4 * g + 1]); ov.y = pack2(S[4 * g + 2], S[4 * g + 3]); \
            *(u32x2*)(SbT + r * 136 + wave * 32 + 8 * g + 4 * h2) = ov; } \
        if (!w01) { \
            bf16_t* op = og + ((size_t)b * TSEQ + (n_) * 64 + mt * 32) * 512 + hd * 128 + vs * 32 + r; \
            _Pragma("unroll") for (int e = 0; e < 16; ++e) op[(size_t)crow(e, h2) * 512] = (bf16_t)f2bf(acc1[e]); \
        } \
        __syncthreads(); \
    } while (0)
    const float glreg = glast[cb + (lane & 31)];
    bf16x8 Af0[8], Af1[8], Kf[4];
    u32x4 Xa, Xb, Xc, Xd;
    Xc = Xd = (u32x4){0u, 0u, 0u, 0u};
    SCAN_LOAD_A(Af0, cb); SCAN_LOAD_K(cb); SCAN_LOAD_X(cb);
    SCAN_LOAD_A(Af1, cb + 1);
    __syncthreads();
#pragma unroll 1
    for (int n = 0; n < 32; n += 2) {
        SCAN_STEP(Af0, n);
        SCAN_STEP(Af1, n + 1);
    }
#undef SCAN_LOAD_A
#undef SCAN_LOAD_K
#undef SCAN_LOAD_X
#undef SCAN_STEP
}

DI void fox_attn(const Params& P, int bh, int qb, unsigned char* smem, int tt) {
    const int tid = tt, lane = tid & 63, wave = tid >> 6, r = lane & 31, h2 = lane >> 5;
    const int b = bh >> 3, hh = bh & 7;
    constexpr int BUFB = 2 * 64 * 72 * 2 + 256;
    constexpr float L2E = 1.4426950408889634f;
    const bf16_t* fqk = (const bf16_t*)(P.ws + OFF_FQK);
    const bf16_t* vT = (const bf16_t*)(P.ws + OFF_VT) + (size_t)bh * 64 * TSEQ;
    const float* cf = (const float*)(P.ws + OFF_CF) + (size_t)bh * TSEQ;
    const int q = qb * 128 + wave * 32 + r;
    bf16x8 Qf[4];
    {
        const bf16_t* qp = fqk + ((size_t)b * TSEQ + q) * 1024 + hh * 64 + h2 * 8;
#pragma unroll
        for (int ks = 0; ks < 4; ++ks) Qf[ks] = *(const bf16x8*)(qp + ks * 16);
    }
    const float cq = cf[q] * L2E;
    float m = -1e30f, l = 0.f;
    f32x16 O[2];
#pragma unroll
    for (int e = 0; e < 16; ++e) { O[0][e] = 0.f; O[1][e] = 0.f; }
    const int ntiles = 2 * qb + 2;
    const int srow = tid >> 3, scol = (tid & 7) * 8;
    const bf16_t* kg = fqk + ((size_t)b * TSEQ + srow) * 1024 + 512 + hh * 64 + scol;
    const bf16_t* vg = vT + (size_t)srow * TSEQ + scol;
    u32x4 rk0, rk1, rv0, rv1; float rc = 0.f;
    rk0 = *(const u32x4*)kg; rk1 = *(const u32x4*)(kg + 32 * 1024);
    rv0 = *(const u32x4*)vg; rv1 = *(const u32x4*)(vg + 32 * TSEQ);
    if (tid < 64) rc = cf[tid] * L2E;
    {
        bf16_t* Ks = (bf16_t*)smem; bf16_t* VTs = Ks + 64 * 72; float* cks = (float*)(smem + 2 * 64 * 72 * 2);
        *(u32x4*)(Ks + srow * 72 + scol) = rk0; *(u32x4*)(Ks + (srow + 32) * 72 + scol) = rk1;
        *(u32x4*)(VTs + srow * 72 + scol) = rv0; *(u32x4*)(VTs + (srow + 32) * 72 + scol) = rv1;
        if (tid < 64) cks[tid] = rc;
    }
    __syncthreads();
#pragma unroll 1
    for (int kt = 0; kt < ntiles; ++kt) {
        const unsigned char* bufc = smem + (kt & 1) * BUFB;
        const bf16_t* Ks = (const bf16_t*)bufc; const bf16_t* VTs = Ks + 64 * 72; const float* cks = (const float*)(bufc + 2 * 64 * 72 * 2);
        const bool more = kt + 1 < ntiles;
        if (more) {
            const bf16_t* kg2 = kg + (size_t)(kt + 1) * 64 * 1024; const bf16_t* vg2 = vg + (kt + 1) * 64;
            rk0 = *(const u32x4*)kg2; rk1 = *(const u32x4*)(kg2 + 32 * 1024);
            rv0 = *(const u32x4*)vg2; rv1 = *(const u32x4*)(vg2 + 32 * TSEQ);
            if (tid < 64) rc = cf[(kt + 1) * 64 + tid] * L2E;
        }
        f32x16 sacc[2];
        f32x4 ckv[2][4];
        {
            bf16x8 kf[2][4];
#pragma unroll
            for (int mt = 0; mt < 2; ++mt)
#pragma unroll
                for (int ks = 0; ks < 4; ++ks) kf[mt][ks] = *(const bf16x8*)(Ks + (mt * 32 + r) * 72 + ks * 16 + h2 * 8);
#pragma unroll
            for (int mt = 0; mt < 2; ++mt)
#pragma unroll
                for (int g = 0; g < 4; ++g) ckv[mt][g] = *(const f32x4*)(cks + mt * 32 + 8 * g + 4 * h2);
#pragma unroll
            for (int e = 0; e < 16; ++e) { sacc[0][e] = 0.f; sacc[1][e] = 0.f; }
            __builtin_amdgcn_sched_barrier(0);
#pragma unroll
            for (int ks = 0; ks < 4; ++ks) { sacc[0] = MFMA32(kf[0][ks], Qf[ks], sacc[0]); sacc[1] = MFMA32(kf[1][ks], Qf[ks], sacc[1]); }
        }
        const bool diag = kt >= ntiles - 2;
        float mx = -1e30f;
        {
            const f32x2v csc = {0.125f * L2E, 0.125f * L2E};
#pragma unroll
            for (int mt = 0; mt < 2; ++mt)
#pragma unroll
                for (int g = 0; g < 4; ++g) {
                    const f32x4 ck4 = ckv[mt][g];
                    const f32x2v c01 = {ck4[0], ck4[1]}, c23 = {ck4[2], ck4[3]};
                    const f32x2v a01 = {sacc[mt][4 * g], sacc[mt][4 * g + 1]}, a23 = {sacc[mt][4 * g + 2], sacc[mt][4 * g + 3]};
                    const f32x2v s01 = a01 * csc - c01, s23 = a23 * csc - c23;
                    sacc[mt][4 * g] = s01.x; sacc[mt][4 * g + 1] = s01.y; sacc[mt][4 * g + 2] = s23.x; sacc[mt][4 * g + 3] = s23.y;
                    mx = fmaxf(fmaxf(mx, s01.x), s01.y); mx = fmaxf(fmaxf(mx, s23.x), s23.y);
                }
        }
        if (diag) {
            mx = -1e30f;
            const int qrel = q - kt * 64 - 4 * h2;
#pragma unroll
            for (int mt = 0; mt < 2; ++mt)
#pragma unroll
                for (int e = 0; e < 16; ++e) {
                    const int krel = mt * 32 + (e & 3) + 8 * (e >> 2);
                    const float sv = (krel > qrel) ? -1e30f : sacc[mt][e];
                    sacc[mt][e] = sv;
                    mx = fmaxf(mx, sv);
                }
        }
        mx = fmaxf(mx, shx(mx, 32, lane));
        if (__builtin_amdgcn_ballot_w64(mx + cq - m > 8.f) != 0ull) {
            const float mn = fmaxf(m, mx + cq);
            const float alpha = __builtin_amdgcn_exp2f(m - mn);
            m = mn;
            l *= alpha;
            const f32x2v al2 = {alpha, alpha};
#pragma unroll
            for (int dt = 0; dt < 2; ++dt)
#pragma unroll
                for (int p2 = 0; p2 < 8; ++p2) {
                    f32x2v ov = {O[dt][2 * p2], O[dt][2 * p2 + 1]};
                    ov = ov * al2;
                    O[dt][2 * p2] = ov.x; O[dt][2 * p2 + 1] = ov.y;
                }
        }
        {
            const float sh = cq - m;
            const f32x2v sh2 = {sh, sh};
            f32x2v rs2 = {0.f, 0.f};
#pragma unroll
            for (int mt = 0; mt < 2; ++mt)
#pragma unroll
                for (int p2 = 0; p2 < 8; ++p2) {
                    const f32x2v sv = {sacc[mt][2 * p2], sacc[mt][2 * p2 + 1]};
                    const f32x2v t = sv + sh2;
                    f32x2v pp; pp.x = __builtin_amdgcn_exp2f(t.x); pp.y = __builtin_amdgcn_exp2f(t.y);
                    sacc[mt][2 * p2] = pp.x; sacc[mt][2 * p2 + 1] = pp.y;
                    rs2 = rs2 + pp;
                }
            l += rs2.x + rs2.y;
        }
        {
            u32x4 vw[2][2][2];
#pragma unroll
            for (int mt = 0; mt < 2; ++mt)
#pragma unroll
                for (int s = 0; s < 2; ++s)
#pragma unroll
                    for (int dt = 0; dt < 2; ++dt) {
                        const bf16_t* vp = VTs + (dt * 32 + r) * 72 + mt * 32 + 16 * s + 4 * h2;
                        const u32x2 lo = *(const u32x2*)vp, hi = *(const u32x2*)(vp + 8);
                        vw[mt][s][dt].x = lo.x; vw[mt][s][dt].y = lo.y; vw[mt][s][dt].z = hi.x; vw[mt][s][dt].w = hi.y;
                    }
            u32x4 pw[2][2];
#pragma unroll
            for (int mt = 0; mt < 2; ++mt)
#pragma unroll
                for (int s = 0; s < 2; ++s) {
                    pw[mt][s].x = pack2(sacc[mt][8 * s + 0], sacc[mt][8 * s + 1]); pw[mt][s].y = pack2(sacc[mt][8 * s + 2], sacc[mt][8 * s + 3]);
                    pw[mt][s].z = pack2(sacc[mt][8 * s + 4], sacc[mt][8 * s + 5]); pw[mt][s].w = pack2(sacc[mt][8 * s + 6], sacc[mt][8 * s + 7]);
                }
            __builtin_amdgcn_sched_barrier(0);
#pragma unroll
            for (int mt = 0; mt < 2; ++mt)
#pragma unroll
                for (int s = 0; s < 2; ++s) {
                    const bf16x8 pf = __builtin_bit_cast(bf16x8, pw[mt][s]);
                    O[0] = MFMA32(__builtin_bit_cast(bf16x8, vw[mt][s][0]), pf, O[0]);
                    O[1] = MFMA32(__builtin_bit_cast(bf16x8, vw[mt][s][1]), pf, O[1]);
                }
        }
        if (more) {
            unsigned char* bufn = smem + ((kt + 1) & 1) * BUFB;
            bf16_t* Kn = (bf16_t*)bufn; bf16_t* VTn = Kn + 64 * 72; float* ckn = (float*)(bufn + 2 * 64 * 72 * 2);
            *(u32x4*)(Kn + srow * 72 + scol) = rk0; *(u32x4*)(Kn + (srow + 32) * 72 + scol) = rk1;
            *(u32x4*)(VTn + srow * 72 + scol) = rv0; *(u32x4*)(VTn + (srow + 32) * 72 + scol) = rv1;
            if (tid < 64) ckn[tid] = rc;
        }
        __syncthreads();
    }
    l += shx(l, 32, lane);
    const float inv = 1.f / l;
    float ss = 0.f;
#pragma unroll
    for (int e = 0; e < 16; ++e) { O[0][e] *= inv; O[1][e] *= inv; ss += O[0][e] * O[0][e] + O[1][e] * O[1][e]; }
    ss += shx(ss, 32, lane);
    const float sc = rsqrtf(ss * (1.f / 64.f) + 1e-6f);
    bf16_t* op = (bf16_t*)(P.ws + OFF_MIX) + ((size_t)b * TSEQ + q) * 1024 + 512 + hh * 64;
    const float* fg = P.in[10];
    f32x4 ggv[2][4];
#pragma unroll
    for (int dt = 0; dt < 2; ++dt)
#pragma unroll
        for (int g = 0; g < 4; ++g) ggv[dt][g] = *(const f32x4*)(fg + dt * 32 + 8 * g + 4 * h2);
#pragma unroll
    for (int dt = 0; dt < 2; ++dt)
#pragma unroll
        for (int g = 0; g < 4; ++g) {
            const int d0 = dt * 32 + 8 * g + 4 * h2;
            const f32x4 gg = ggv[dt][g];
            u32x2 o;
            o.x = pack2(O[dt][4 * g + 0] * sc * gg[0], O[dt][4 * g + 1] * sc * gg[1]); o.y = pack2(O[dt][4 * g + 2] * sc * gg[2], O[dt][4 * g + 3] * sc * gg[3]);
            *(u32x2*)(op + d0) = o;
        }
}

#define XB_TMO      128
#define XB_XCNT(j)  (256  + 64 * (j))
#define XB_XSUB(j)  (1280 + 64 * (j))
#define XB_XGEN(j)  (2304 + 64 * (j))
#define XB_TOP      3328
#define XB_TOPGEN   3392
#define XCD_BAR_WORDS 3456
#define XB_SPIN_CAP (1u << 18)
#define LAS __attribute__((address_space(3)))
DI unsigned xb_ld(unsigned* p)              { return __hip_atomic_load(p, __ATOMIC_RELAXED, __HIP_MEMORY_SCOPE_AGENT); }
DI unsigned xb_add(unsigned* p, unsigned v) { return __hip_atomic_fetch_add(p, v, __ATOMIC_RELAXED, __HIP_MEMORY_SCOPE_AGENT); }
DI unsigned xb_xcc_id() { return (unsigned)__builtin_amdgcn_s_getreg((3 << 11) | 20) & 0xFu; }
#define XB_SPIN(cond, bar) do { unsigned _sp = 0; while (cond) { __builtin_amdgcn_s_sleep(1); \
    if ((++_sp & 255u) == 0u) { if (xb_ld(&(bar)[XB_TMO])) break; if (_sp > XB_SPIN_CAP) { atomicAdd(&(bar)[XB_TMO], 1u); break; } } } } while (0)
struct XcdBarrier { unsigned* bar; unsigned x; volatile LAS unsigned* st; };
DI XcdBarrier xcd_barrier_post(unsigned* bar, volatile LAS unsigned* st, int tid0) {
    XcdBarrier b; b.bar = bar; b.x = xb_xcc_id(); b.st = st;
    if (tid0 == 0) (void)xb_add(&bar[XB_XCNT(b.x)], 1u);
    return b;
}
DI void xcd_barrier_complete(unsigned* bar, unsigned x, unsigned& nloc, unsigned& nx) {
    const unsigned G = gridDim.x * gridDim.y * gridDim.z;
    unsigned sum, cnt, mine, sp = 0u;
    for (;;) {
        sum = 0u; cnt = 0u; mine = 0u;
#pragma unroll
        for (unsigned j = 0; j < 16; ++j) { const unsigned c = xb_ld(&bar[XB_XCNT(j)]); sum += c; cnt += (c > 0u) ? 1u : 0u; mine = (j == x) ? c : mine; }
        if (sum == G) break;
        __builtin_amdgcn_s_sleep(1);
        if ((++sp & 255u) == 0u) { if (xb_ld(&bar[XB_TMO])) break; if (sp > XB_SPIN_CAP) { atomicAdd(&bar[XB_TMO], 1u); break; } }
    }
    nloc = mine > 0u ? mine : 1u; nx = cnt > 0u ? cnt : 1u;
}
DI void xcd_barrier(const XcdBarrier& b, const int wid_s) {
    asm volatile("s_waitcnt vmcnt(0)" ::: "memory");
    __syncthreads();
    if (fresh_tid(wid_s) == 0) {
        unsigned* bar = b.bar;
        __builtin_amdgcn_s_waitcnt(0);
        unsigned nloc = b.st[0], nx = b.st[1];
        if (nloc == 0u) { xcd_barrier_complete(bar, b.x, nloc, nx); b.st[0] = nloc; b.st[1] = nx; }
        const unsigned old = xb_add(&bar[XB_XSUB(b.x)], 1u);
        const unsigned gen = old / nloc;
        if (old + 1u == (gen + 1u) * nloc) {
            __builtin_amdgcn_fence(__ATOMIC_RELEASE, "agent");
            asm volatile("s_waitcnt vmcnt(0)" ::: "memory");
            const unsigned og = xb_add(&bar[XB_TOP], 1u);
            const unsigned tg = og / nx;
            if (og + 1u == (tg + 1u) * nx) xb_add(&bar[XB_TOPGEN], 1u);
            else XB_SPIN(xb_ld(&bar[XB_TOPGEN]) == tg, bar);
            __builtin_amdgcn_fence(__ATOMIC_ACQUIRE, "agent");
            xb_add(&bar[XB_XGEN(b.x)], 1u);
            asm volatile("s_waitcnt vmcnt(0)" ::: "memory");
        } else {
            XB_SPIN(xb_ld(&bar[XB_XGEN(b.x)]) == gen, bar);
            __builtin_amdgcn_fence(__ATOMIC_ACQUIRE, "agent");
            asm volatile("s_waitcnt vmcnt(0)" ::: "memory");
        }
    }
    __syncthreads();
}


template <int MODE> struct EpiLnFused {
    static constexpr bool PERM = true, AFTER_DRAIN = true;
    const float* x; const float* g_in; const float* b_in; const float* stats;
    const float* h1; const bf16_t* pg;
    float* xbuf; unsigned* cnt; const float* g; const float* b; float* outf; bf16_t* outb;
    DI void operator()(const pg8::f32x4 (&)[2][2][4][2], const pg8::Unit&, int, int, int, int) const {}
    DI void fused(pg8::f32x4 (&acc)[2][2][4][2], const pg8::Unit& u, int wr, int wc, int fr, int fq, pg8::PG8_LAS_T ldsp, int wid, int lane) const {
        float* P = (float*)(unsigned char*)ldsp;
        float* ST = P + 2048;
        const int tid = wid * 64 + lane;
        f32x4 gi[2][2], bi[2][2];
#pragma unroll
        for (int bj = 0; bj < 2; ++bj) {
            const int col = u.pn * 256 + bj * 128 + wc * 32 + 8 * fq;
            if (MODE == 0) { gi[bj][0] = *(const f32x4*)(g_in + col); gi[bj][1] = *(const f32x4*)(g_in + col + 4); bi[bj][0] = *(const f32x4*)(b_in + col); bi[bj][1] = *(const f32x4*)(b_in + col + 4); }
        }
#pragma unroll
        for (int ai = 0; ai < 2; ++ai)
#pragma unroll
            for (int m = 0; m < 4; ++m) {
                const int rt = ai * 128 + wr * 64 + m * 16 + fr, row = u.pm * 256 + rt;
                float sm = 0.f, sq = 0.f;
                float mu = 0.f, rs = 0.f;
                if (MODE == 0) { mu = stats[row * 2]; rs = stats[row * 2 + 1]; }
#pragma unroll
                for (int bj = 0; bj < 2; ++bj) {
                    const int col = u.pn * 256 + bj * 128 + wc * 32 + 8 * fq;
                    const size_t idx = (size_t)row * DM + col;
                    f32x4 v0, v1;
                    if (MODE == 0) {
                        const f32x4 x0 = *(const f32x4*)(x + idx), x1 = *(const f32x4*)(x + idx + 4);
                        v0 = ((x0 - mu) * rs * gi[bj][0] + bi[bj][0]) * ALPHA + acc[ai][bj][m][0];
                        v1 = ((x1 - mu) * rs * gi[bj][1] + bi[bj][1]) * ALPHA + acc[ai][bj][m][1];
                    } else {
                        const u32x4 w = *(const u32x4*)(pg + idx);
                        v0 = *(const f32x4*)(h1 + idx) * ALPHA + acc[ai][bj][m][0];
                        v1 = *(const f32x4*)(h1 + idx + 4) * ALPHA + acc[ai][bj][m][1];
                        v0[0] += bflo(w.x); v0[1] += bfhi(w.x); v0[2] += bflo(w.y); v0[3] += bfhi(w.y);
                        v1[0] += bflo(w.z); v1[1] += bfhi(w.z); v1[2] += bflo(w.w); v1[3] += bfhi(w.w);
                    }
                    acc[ai][bj][m][0] = v0; acc[ai][bj][m][1] = v1;
#pragma unroll
                    for (int e = 0; e < 4; ++e) { sm += v0[e] + v1[e]; sq += v0[e] * v0[e] + v1[e] * v1[e]; }
                }
                sm += shx(sm, 16, lane); sm += shx(sm, 32, lane);
                sq += shx(sq, 16, lane); sq += shx(sq, 32, lane);
                if (fq == 0) { P[(rt * 4 + wc) * 2] = sm; P[(rt * 4 + wc) * 2 + 1] = sq; }
            }
        __syncthreads();
        if (tid < 256) {
            const f32x4 a = *(const f32x4*)(P + tid * 8), c = *(const f32x4*)(P + tid * 8 + 4);
            float* slot = xbuf + ((size_t)(u.pm * 256 + tid) * 4 + u.pn) * 2;
            __hip_atomic_store(slot, (a[0] + a[2]) + (c[0] + c[2]), __ATOMIC_RELAXED, __HIP_MEMORY_SCOPE_AGENT);
            __hip_atomic_store(slot + 1, (a[1] + a[3]) + (c[1] + c[3]), __ATOMIC_RELAXED, __HIP_MEMORY_SCOPE_AGENT);
        }
        asm volatile("s_waitcnt vmcnt(0)" ::: "memory");
        __syncthreads();
        if (tid == 0) {
            xb_add(cnt + u.pm, 1u);
            unsigned sp = 0;
            while (xb_ld(cnt + u.pm) < 4u) { __builtin_amdgcn_s_sleep(1); if (++sp > (1u << 22)) break; }
        }
        __syncthreads();
        if (tid < 256) {
            float* slot = xbuf + (size_t)(u.pm * 256 + tid) * 8;
            float pv[8];
#pragma unroll
            for (int e = 0; e < 8; ++e) pv[e] = __hip_atomic_load(slot + e, __ATOMIC_RELAXED, __HIP_MEMORY_SCOPE_AGENT);
            const float sm = (pv[0] + pv[2]) + (pv[4] + pv[6]), sq = (pv[1] + pv[3]) + (pv[5] + pv[7]);
            const float mean = sm * (1.f / 1024.f);
            const float var = fmaxf(sq * (1.f / 1024.f) - mean * mean, 0.f);
            ST[tid * 2] = mean; ST[tid * 2 + 1] = rsqrtf(var + 1e-5f);
        }
        __syncthreads();
        f32x4 go[2][2], bo[2][2];
#pragma unroll
        for (int bj = 0; bj < 2; ++bj) {
            const int col = u.pn * 256 + bj * 128 + wc * 32 + 8 * fq;
            go[bj][0] = *(const f32x4*)(g + col); go[bj][1] = *(const f32x4*)(g + col + 4); bo[bj][0] = *(const f32x4*)(b + col); bo[bj][1] = *(const f32x4*)(b + col + 4);
        }
#pragma unroll
        for (int ai = 0; ai < 2; ++ai)
#pragma unroll
            for (int m = 0; m < 4; ++m) {
                const int rt = ai * 128 + wr * 64 + m * 16 + fr, row = u.pm * 256 + rt;
                const float mean = ST[rt * 2], rstd = ST[rt * 2 + 1];
#pragma unroll
                for (int bj = 0; bj < 2; ++bj) {
                    const int col = u.pn * 256 + bj * 128 + wc * 32 + 8 * fq;
                    const size_t idx = (size_t)row * DM + col;
                    const f32x4 o0 = (acc[ai][bj][m][0] - mean) * rstd * go[bj][0] + bo[bj][0], o1 = (acc[ai][bj][m][1] - mean) * rstd * go[bj][1] + bo[bj][1];
                    if (outf) { *(f32x4*)(outf + idx) = o0; *(f32x4*)(outf + idx + 4) = o1; }
                    if (outb) *(u32x4*)(outb + idx) = pack8(o0, o1);
                }
            }
    }
};

template <class Epi> DI void run_gemm(pg8::PG8_LAS_T lds, const bf16_t* A, const bf16_t* Bt, int N, int K, const Epi& E, const int wid_s) {
    pg8::Gemm g{A, Bt, M_TOK, N, K}; pg8::StaticOrder S; S.init(M_TOK, N, (int)gridDim.x, (int)blockIdx.x);
    pg8::gemm_phase<Epi, pg8::StaticOrder, true, true>(lds, g, S, E, wid_s);
}
__global__ void __launch_bounds__(512, 2) fwd_mega(Params P) {
    cg::grid_group grid = cg::this_grid();
    extern __shared__ __attribute__((aligned(16))) unsigned char lds[];
    pg8::PG8_LAS_T glds = (pg8::PG8_LAS_T)lds;
    volatile LAS unsigned* xb_words = (volatile LAS unsigned*)(glds + LDS_MISC);
    volatile int* s_item = (volatile int*)(lds + LDS_MISC + 16);
    const int nblk = gridDim.x, bid = blockIdx.x;
    unsigned char* ws = P.ws;

    const int wid_s = __builtin_amdgcn_readfirstlane((int)threadIdx.x >> 6);
    if (threadIdx.x < 4) xb_words[threadIdx.x] = 0u;
    __syncthreads();
    const XcdBarrier xbar = xcd_barrier_post((unsigned*)(ws + OFF_BAR), xb_words, (int)threadIdx.x);
    if (P.out == nullptr) grid.sync();

    {
    for (int base = bid * 2; base < 3584 + 4096; base += nblk * 2) {
        PHASE_IDS
        const int it = base + team;
        if (it < 3584) {
            const float* W; int K, N, mode = 0, loc, nnt; bf16_t* Wt;
            if (it < 960) { W = P.in[4]; K = 1024; N = 3600; mode = 1; Wt = (bf16_t*)(ws + OFF_WIN); loc = it; nnt = 60; }
            else if (it < 1216) { W = P.in[11]; K = 1024; N = 1024; Wt = (bf16_t*)(ws + OFF_WOUT); loc = it - 960; nnt = 16; }
            else if (it < 2240) { W = P.in[14]; K = 1024; N = 4096; Wt = (bf16_t*)(ws + OFF_WUP); loc = it - 1216; nnt = 64; }
            else if (it < 3264) { W = P.in[15]; K = 4096; N = 1024; Wt = (bf16_t*)(ws + OFF_WDOWN); loc = it - 2240; nnt = 16; }
            else if (it < 3520) { W = P.in[17]; K = 1024; N = 1024; Wt = (bf16_t*)(ws + OFF_WG); loc = it - 3264; nnt = 16; }
            else { W = P.in[16]; K = 256; N = 1024; Wt = (bf16_t*)(ws + OFF_WPLE); loc = it - 3520; nnt = 16; }
            transpose_tile(W, K, N, Wt, loc / nnt, loc % nnt, mode, (float*)smem, tt);
        } else {
            const int row = (it - 3584) * 4 + tw;
            ln_row(P.in[0] + (size_t)row * DM, P.in[2], P.in[3], nullptr, (bf16_t*)(ws + OFF_HB) + (size_t)row * DM, (float*)(ws + OFF_STATS) + row * 2, lane);
            { const f32x4 pv = *(const f32x4*)(P.in[1] + (size_t)row * 256 + lane * 4); u32x2 w; w.x = pack2(pv[0], pv[1]); w.y = pack2(pv[2], pv[3]);
              *(u32x2*)((bf16_t*)(ws + OFF_PB) + (size_t)row * 256 + lane * 4) = w; }
        }
    }
    }
    xcd_barrier(xbar, wid_s);

    { EpiProj E{ws}; run_gemm(glds, (const bf16_t*)(ws + OFF_HB), (const bf16_t*)(ws + OFF_WIN), NPROJ, DM, E, wid_s); }
    xcd_barrier(xbar, wid_s);

    for (int rep = 0; rep < NREP(2); ++rep)
    {
    for (int base = bid * 2; base < 1024 + 64; base += nblk * 2) {
        PHASE_IDS
        const int it = base + team;
        if (it < 1024) prep_chunk(P, it, smem, tt); else fox_cumsum(P, it - 1024, smem, tt);
    }
    }
    xcd_barrier(xbar, wid_s);

    for (int rep = 0; rep < NREP(3); ++rep)
    {
    for (;;) {
        PHASE_IDS
        __syncthreads();
        if (tid == 0) *s_item = atomicAdd((int*)(ws + OFF_CTR) + rep, 1);
        __syncthreads();
        const int pr = *s_item;
        if (pr >= 64 + 512) break;
        if (pr < 64) gdn_scan(P, pr * 2 + team, smem, tt);
        else { const int fj = pr - 64; fox_attn(P, (fj & 31) * 2 + team, 15 - (fj >> 5), smem, tt); }
    }
    }
    xcd_barrier(xbar, wid_s);

    { PHASE_IDS
    for (int it = bid; it < M_TOK / 8; it += nblk) {
        const int row = it * 8 + wave8;
        bf16_t* mix = (bf16_t*)(ws + OFF_MIX) + (size_t)row * DM;
        {
            const int col = lane * 8;
            const u32x4 ov = *(const u32x4*)((const bf16_t*)(ws + OFF_OG) + (size_t)row * 512 + col);
            const u32x4 zv = *(const u32x4*)((const bf16_t*)(ws + OFF_Z) + (size_t)row * 512 + col);
            float o[8] = {bflo(ov.x), bfhi(ov.x), bflo(ov.y), bfhi(ov.y), bflo(ov.z), bfhi(ov.z), bflo(ov.w), bfhi(ov.w)};
            float z[8] = {bflo(zv.x), bfhi(zv.x), bflo(zv.y), bfhi(zv.y), bflo(zv.z), bfhi(zv.z), bflo(zv.w), bfhi(zv.w)};
            float ss = 0.f;
#pragma unroll
            for (int e = 0; e < 8; ++e) ss += o[e] * o[e];
            ss += shx(ss, 1, lane); ss += shx(ss, 2, lane); ss += shx(ss, 4, lane); ss += shx(ss, 8, lane);
            const float sc = rsqrtf(ss * (1.f / 128.f) + 1e-6f);
            const float* gg = P.in[8] + (col & 127);
            float v[8];
#pragma unroll
            for (int e = 0; e < 8; ++e) v[e] = o[e] * sc * gg[e] * siluf(z[e]);
            u32x4 w; w.x = pack2(v[0], v[1]); w.y = pack2(v[2], v[3]); w.z = pack2(v[4], v[5]); w.w = pack2(v[6], v[7]);
            *(u32x4*)(mix + col) = w;
        }
    }
    }
    xcd_barrier(xbar, wid_s);

    { EpiLnFused<0> E{P.in[0], P.in[2], P.in[3], (const float*)(ws + OFF_STATS), nullptr, nullptr, (float*)(ws + OFF_XBUF), (unsigned*)(ws + OFF_PCNT), P.in[12], P.in[13], P.out, (bf16_t*)(ws + OFF_H1B)};
      run_gemm(glds, (const bf16_t*)(ws + OFF_MIX), (const bf16_t*)(ws + OFF_WOUT), DM, DM, E, wid_s); }
    xcd_barrier(xbar, wid_s);

    { EpiUp E{(bf16_t*)(ws + OFF_FFB)}; run_gemm(glds, (const bf16_t*)(ws + OFF_H1B), (const bf16_t*)(ws + OFF_WUP), 4096, DM, E, wid_s); }
    { EpiGate E{(bf16_t*)(ws + OFF_PG), P.in[18]}; run_gemm(glds, (const bf16_t*)(ws + OFF_H1B), (const bf16_t*)(ws + OFF_WG), DM, DM, E, wid_s); }
    { EpiPle E{(bf16_t*)(ws + OFF_PG)}; run_gemm(glds, (const bf16_t*)(ws + OFF_PB), (const bf16_t*)(ws + OFF_WPLE), DM, 256, E, wid_s); }
    xcd_barrier(xbar, wid_s);

    { EpiLnFused<1> E{nullptr, nullptr, nullptr, nullptr, P.out, (const bf16_t*)(ws + OFF_PG), (float*)(ws + OFF_XBUF) + (size_t)M_TOK * 8, (unsigned*)(ws + OFF_PCNT) + 64, P.in[19], P.in[20], P.out, nullptr};
      run_gemm(glds, (const bf16_t*)(ws + OFF_FFB), (const bf16_t*)(ws + OFF_WDOWN), DM, 4096, E, wid_s); }
}

extern "C" void kernel_launch(void* const* d_in, const int* in_sizes, int n_in, void* d_out, int out_size, void* d_ws, size_t ws_size, hipStream_t stream) {
    static int grid_blocks = 0;
    if (!grid_blocks) {
        int dev = 0, cus = 0, per_cu = 0;
        (void)hipGetDevice(&dev);
        (void)hipDeviceGetAttribute(&cus, hipDeviceAttributeMultiprocessorCount, dev);
        if (hipFuncSetAttribute((const void*)fwd_mega, hipFuncAttributeMaxDynamicSharedMemorySize, LDS_BYTES) != hipSuccess) fprintf(stderr, "kernel_launch: hipFuncSetAttribute failed\n");
        (void)hipOccupancyMaxActiveBlocksPerMultiprocessor(&per_cu, (const void*)fwd_mega, 512, LDS_BYTES);
        if (per_cu < 1) fprintf(stderr, "kernel_launch: occupancy query reports %d blocks per CU\n", per_cu);
        (void)hipGetLastError();
        grid_blocks = cus;
        if (ws_size < 232 * MBy) fprintf(stderr, "kernel_launch: workspace too small (%zu)\n", ws_size);
    }
    Params p{};
    for (int i = 0; i < 21; ++i) p.in[i] = (const float*)d_in[i];
    p.out = (float*)d_out; p.ws = (unsigned char*)d_ws;
    (void)hipMemsetAsync((unsigned char*)d_ws + OFF_BAR, 0, 16384, stream);
    void* args[] = {&p};
    hipError_t e = hipLaunchCooperativeKernel((void*)fwd_mega, dim3(grid_blocks), dim3(512), args, LDS_BYTES, stream);
    if (e != hipSuccess) fprintf(stderr, "cooperative launch failed: %s (grid %d)\n", hipGetErrorString(e), grid_blocks);
}
```

```cpp
#include <hip/hip_runtime.h>
#include <hip/hip_cooperative_groups.h>
#include <cstdio>
namespace cg = cooperative_groups;

typedef unsigned short bf16_t;
typedef short bf16x8 __attribute__((ext_vector_type(8)));
typedef short s16x4 __attribute__((ext_vector_type(4)));
typedef float f32x16 __attribute__((ext_vector_type(16)));
typedef float f32x4 __attribute__((ext_vector_type(4)));
typedef unsigned u32x4 __attribute__((ext_vector_type(4)));
typedef unsigned u32x2 __attribute__((ext_vector_type(2)));
typedef float f32x2v __attribute__((ext_vector_type(2)));

#define DI __device__ __forceinline__
#define MFMA32(a, b, c) __builtin_amdgcn_mfma_f32_32x32x16_bf16((a), (b), (c), 0, 0, 0)

constexpr int M_TOK = 16384, DM = 1024, TSEQ = 2048;
constexpr int NPROJ = 3840;
constexpr size_t MBy = 1u << 20;
constexpr size_t OFF_WIN = 0, OFF_WOUT = 8 * MBy, OFF_WUP = 10 * MBy, OFF_WDOWN = 18 * MBy, OFF_WG = 26 * MBy, OFF_WPLE = 28 * MBy;
constexpr size_t OFF_STATS = 28 * MBy + 512 * 1024, OFF_GLAST = 28 * MBy + 640 * 1024, OFF_BAR = 29 * MBy + 512 * 1024, OFF_CTR = OFF_BAR + 14336, OFF_CF = 28 * MBy + 768 * 1024;
constexpr size_t OFF_XBUF = 31 * MBy, OFF_PCNT = OFF_BAR + 14848;
constexpr size_t OFF_GATES = 30 * MBy, OFF_GQKV = 32 * MBy, OFF_Z = 80 * MBy, OFF_FQK = 96 * MBy, OFF_VT = 128 * MBy, OFF_HB = 144 * MBy;
constexpr size_t OFF_U = 144 * MBy, OFF_W = 160 * MBy, OFF_QD = 176 * MBy, OFF_KDT = 192 * MBy, OFF_QK = 208 * MBy;
constexpr size_t OFF_OG = 32 * MBy, OFF_MIX = 216 * MBy;
constexpr size_t OFF_H1B = 32 * MBy, OFF_PB = 248 * MBy, OFF_FFB = 72 * MBy, OFF_PG = 200 * MBy;
constexpr float ALPHA = 1.189207115002721f;
constexpr int TEAM_LDS = 76800, LDS_MISC = 153600, LDS_BYTES = 153600 + 256;
#ifndef REP_MASK
#define REP_MASK 0
#endif
#define NREP(k) (1 + ((REP_MASK >> (k)) & 1))

struct Params { const float* in[21]; float* out; unsigned char* ws; };

DI float bf2f(unsigned b) { return __uint_as_float(b << 16); }
typedef float f32x2_t __attribute__((ext_vector_type(2))); typedef __bf16 bf16x2_t __attribute__((ext_vector_type(2)));
DI unsigned pack2(float lo, float hi) { f32x2_t v = {lo, hi}; bf16x2_t b = __builtin_convertvector(v, bf16x2_t); return __builtin_bit_cast(unsigned, b); }
DI unsigned f2bf(float x) { return pack2(x, 0.f) & 0xffffu; }
DI float bflo(unsigned w) { return __uint_as_float(w << 16); }
DI float bfhi(unsigned w) { return __uint_as_float(w & 0xffff0000u); }
DI int crow(int e, int h) { return (e & 3) + 8 * (e >> 2) + 4 * h; }
DI float shx(float v, int mask, int lane) { return __int_as_float(__builtin_amdgcn_ds_bpermute((lane ^ mask) << 2, __float_as_int(v))); }
DI float shup(float v, int o, int lane) { return __int_as_float(__builtin_amdgcn_ds_bpermute(((lane - o) & 63) << 2, __float_as_int(v))); }
DI float shlane(float v, int src) { return __int_as_float(__builtin_amdgcn_readlane(__float_as_int(v), src)); }
DI float wave_sum(float v, int lane) { for (int o = 32; o > 0; o >>= 1) v += shx(v, o, lane); return v; }
DI float siluf(float x) { return x * __builtin_amdgcn_rcpf(1.f + __expf(-x)); }
DI float sigmoidf_(float x) { return __builtin_amdgcn_rcpf(1.f + __expf(-x)); }
DI int fresh_tid(int wid_s) { int l; asm volatile("v_mbcnt_lo_u32_b32 %0, -1, 0\n\tv_mbcnt_hi_u32_b32 %0, -1, %0" : "=v"(l)); return wid_s * 64 + l; }
#define PHASE_IDS const int tid = fresh_tid(wid_s), lane = tid & 63, wave8 = tid >> 6, team = tid >> 8, tt = tid & 255, tw = tt >> 6; unsigned char* smem = lds + team * TEAM_LDS; (void)lane; (void)wave8; (void)tt; (void)tw; (void)smem;

DI void ln_row(const float* src, const float* __restrict__ g, const float* __restrict__ b, float* dstf, bf16_t* dstb, float* stats, int lane) {
    f32x4 v[4];
#pragma unroll
    for (int i = 0; i < 4; ++i) v[i] = *(const f32x4*)(src + i * 256 + lane * 4);
    float s = 0.f;
#pragma unroll
    for (int i = 0; i < 4; ++i) s += (v[i][0] + v[i][1]) + (v[i][2] + v[i][3]);
    s = wave_sum(s, lane);
    const float mu = s * (1.f / 1024.f);
    float q = 0.f;
#pragma unroll
    for (int i = 0; i < 4; ++i) { f32x4 d = v[i] - mu; q += (d[0] * d[0] + d[1] * d[1]) + (d[2] * d[2] + d[3] * d[3]); }
    q = wave_sum(q, lane);
    const float rstd = rsqrtf(q * (1.f / 1024.f) + 1e-5f);
    f32x4 gv[4], bv[4];
#pragma unroll
    for (int i = 0; i < 4; ++i) { gv[i] = *(const f32x4*)(g + i * 256 + lane * 4); bv[i] = *(const f32x4*)(b + i * 256 + lane * 4); }
#pragma unroll
    for (int i = 0; i < 4; ++i) {
        const f32x4 gg = gv[i], bb = bv[i];
        const f32x4 o = (v[i] - mu) * rstd * gg + bb;
        if (dstf) *(f32x4*)(dstf + i * 256 + lane * 4) = o;
        if (dstb) { u32x2 w; w.x = pack2(o[0], o[1]); w.y = pack2(o[2], o[3]); *(u32x2*)(dstb + i * 256 + lane * 4) = w; }
    }
    if (stats && lane == 0) { stats[0] = mu; stats[1] = rstd; }
}

DI void transpose_tile(const float* __restrict__ W, int K, int N, bf16_t* __restrict__ Wt, int kt, int nt, int mode, float* tile, int tt) {
    const int tid = tt;
    const int k0 = kt * 64, n0 = nt * 64;
    {
        const int c = tid & 63, n = n0 + c;
        int sc = n;
        if (mode == 1) { sc = (n < 2048) ? n : (n < 3584) ? n + 8 : (n < 3592) ? 2048 + (n - 3584) : (n < 3600) ? n : -1; }
        const int scc = sc >= 0 ? sc : 0;
        const float mk = sc >= 0 ? 1.f : 0.f;
        float wv[16];
#pragma unroll
        for (int i = 0; i < 16; ++i) wv[i] = W[(size_t)(k0 + (tid >> 6) + 4 * i) * N + scc];
#pragma unroll
        for (int i = 0; i < 16; ++i) tile[((tid >> 6) + 4 * i) * 65 + c] = wv[i] * mk;
    }
    __syncthreads();
    {
        const int n = tid >> 2, ks = (tid & 3) * 16;
        u32x4 o0, o1;
        o0.x = pack2(tile[(ks + 0) * 65 + n], tile[(ks + 1) * 65 + n]); o0.y = pack2(tile[(ks + 2) * 65 + n], tile[(ks + 3) * 65 + n]);
        o0.z = pack2(tile[(ks + 4) * 65 + n], tile[(ks + 5) * 65 + n]); o0.w = pack2(tile[(ks + 6) * 65 + n], tile[(ks + 7) * 65 + n]);
        o1.x = pack2(tile[(ks + 8) * 65 + n], tile[(ks + 9) * 65 + n]); o1.y = pack2(tile[(ks + 10) * 65 + n], tile[(ks + 11) * 65 + n]);
        o1.z = pack2(tile[(ks + 12) * 65 + n], tile[(ks + 13) * 65 + n]); o1.w = pack2(tile[(ks + 14) * 65 + n], tile[(ks + 15) * 65 + n]);
        bf16_t* dst = Wt + (size_t)(n0 + n) * K + k0 + ks;
        *(u32x4*)dst = o0; *(u32x4*)(dst + 8) = o1;
    }
    __syncthreads();
}

namespace pg8 {
#define PG8_LAS __attribute__((address_space(3)))
typedef PG8_LAS unsigned char* PG8_LAS_T;
typedef unsigned short bf16_t;
typedef short bf16x8 __attribute__((ext_vector_type(8)));
typedef float f32x4 __attribute__((ext_vector_type(4)));
typedef unsigned u32x4 __attribute__((ext_vector_type(4)));
constexpr int BM = 256, BK = 64, HALF = 128, HTB = HALF * BK * 2  , STAGE_BYTES = 8 * HTB, NXCD = 8, WGM = 8;

__host__ __device__ __forceinline__ int lds_byte(int r, int c) { const int st = (r >> 4) * 2 + (c >> 5), rr = r & 15, cc = c & 31, ob = rr * 64 + cc * 2; return st * 1024 + (ob ^ (((ob >> 9) & 1) << 5)); }
__host__ __device__ __forceinline__ void stage_rc(int b, int& R, int& C) { const int st = b / 1024, sb = b % 1024, swz = sb ^ (((sb >> 9) & 1) << 5); R = (st >> 1) * 16 + swz / 64; C = (st & 1) * 32 + (swz % 64) / 2; }
__host__ __device__ __forceinline__ int perm32(int rho) { const int n = rho >> 4, i = rho & 15; return 8 * (i >> 2) + 4 * n + (i & 3); }

struct Unit { int pm, pn; };
struct Gemm { const bf16_t* A; const bf16_t* Bt; int M, N, K; };

struct StaticOrder {
    int nM, nN, nwg, G, c;
    __host__ __device__ void init(int M, int N, int G_, int c_) { nM = M / BM; nN = N / BM; nwg = nM * nN; G = G_; c = c_; }
    __host__ __device__ bool next(int i, Unit& u) const {
        const long L = (long)i * G + c; if (L >= nwg) return false;
        int wgid = (int)L; { const int q = nwg / NXCD, r = nwg % NXCD, xcd = wgid % NXCD, off = wgid / NXCD; wgid = (xcd < r ? xcd * (q + 1) : r * (q + 1) + (xcd - r) * q) + off; }
        const int nig = WGM * nN, gid = wgid / nig, fm = gid * WGM, gsz = (nM - fm) < WGM ? (nM - fm) : WGM;
        u.pm = fm + ((wgid % nig) % gsz); u.pn = (wgid % nig) / gsz; return true;
    }
    __device__ __forceinline__ void a_ready(const Unit&) const {}
    __device__ __forceinline__ void done(const Unit&) const {}
};
template <class Epi, class Sched, bool ALIGN_EPI = false, bool SP2 = false>
__device__ __forceinline__ void gemm_phase(PG8_LAS unsigned char* lds, const Gemm g, const Sched& S, const Epi& E, const int wid_s) {
    const int tid = fresh_tid(wid_s), wid = wid_s, lane = tid & 63, wr = wid >> 2, wc = wid & 3, fr = lane & 15, fq = lane >> 4;
    const int K = g.K, nt = K / BK;
    unsigned voffA[2], voffB[2];
#pragma unroll
    for (int i = 0; i < 2; ++i) { int R, C; stage_rc(tid * 16 + i * 8192, R, C); const int Rb = Epi::PERM ? ((R & ~31) + perm32(R & 31)) : R;
        voffA[i] = (unsigned)(R * K + C) * 2u; voffB[i] = (unsigned)(Rb * K + C) * 2u; }
    const size_t kstep = (size_t)(BK * 2);
    const size_t hstep = (size_t)HALF * K * 2;
    const size_t tstep = 2 * hstep;
    const unsigned ldsw = (unsigned)wid * 1024u;
    const int aoff = lds_byte(wr * 64 + fr, fq * 8), boff = lds_byte(wc * 32 + fr, fq * 8);
#define PG8_SA(b, h) (((b) * 2 + (h)) * HTB)
#define PG8_SB(b, h) ((4 + (b) * 2 + (h)) * HTB)
#define PG8_STAGE(bufoff, gbase, voff) do { _Pragma("unroll") for (int _i = 0; _i < 2; ++_i) \
        __builtin_amdgcn_global_load_lds((const unsigned*)((const char*)(gbase) + (voff)[_i]), (PG8_LAS unsigned*)(lds + (bufoff) + ldsw + _i * 8192), 16, 0, 0); } while (0)
#define PG8_LDA(dst, b, h) do { _Pragma("unroll") for (int m = 0; m < 4; ++m) _Pragma("unroll") for (int k = 0; k < 2; ++k) dst[m][k] = *(const PG8_LAS bf16x8*)(lds + PG8_SA(b, h) + aoff + m * 2048 + k * 1024); } while (0)
#define PG8_LDB(dst, b, h) do { _Pragma("unroll") for (int n = 0; n < 2; ++n) _Pragma("unroll") for (int k = 0; k < 2; ++k) dst[n][k] = *(const PG8_LAS bf16x8*)(lds + PG8_SB(b, h) + boff + n * 2048 + k * 1024); } while (0)
#define PG8_MMA(ai, bj, At, Bt) do { __builtin_amdgcn_s_setprio(1); _Pragma("unroll") for (int m = 0; m < 4; ++m) _Pragma("unroll") for (int n = 0; n < 2; ++n) _Pragma("unroll") for (int k = 0; k < 2; ++k) \
        acc[ai][bj][m][n] = __builtin_amdgcn_mfma_f32_16x16x32_bf16(Bt[n][k], At[m][k], acc[ai][bj][m][n], 0, 0, 0); __builtin_amdgcn_s_setprio(0); } while (0)
#define PG8_WAIT_V(n) asm volatile("s_waitcnt vmcnt(" #n ")" ::: "memory")
#define PG8_WAIT_L(n) asm volatile("s_waitcnt lgkmcnt(" #n ")" ::: "memory")
#define PG8_BAR __builtin_amdgcn_s_barrier()
#define PG8_SCHED __builtin_amdgcn_sched_barrier(0)
    Unit cur, nxt; int ui = 0;
    if (!S.next(0, cur)) return;
    f32x4 acc[2][2][4][2];
#pragma unroll
    for (int a = 0; a < 2; ++a)
#pragma unroll
        for (int b = 0; b < 2; ++b)
#pragma unroll
            for (int m = 0; m < 4; ++m)
#pragma unroll
                for (int n = 0; n < 2; ++n) acc[a][b][m][n] = (f32x4){0.f, 0.f, 0.f, 0.f};
    bf16x8 At[4][2], B0[2][2], B1[2][2];
    const char* cA = (const char*)g.A + (size_t)cur.pm * tstep; const char* cB = (const char*)g.Bt + (size_t)cur.pn * tstep;
    S.a_ready(cur);
    if constexpr (SP2) {
        PG8_STAGE(PG8_SB(0, 0), cB, voffB); PG8_STAGE(PG8_SB(0, 1), cB + hstep, voffB); PG8_STAGE(PG8_SA(0, 0), cA, voffA); PG8_STAGE(PG8_SA(0, 1), cA + hstep, voffA);
        if (wr == 1) PG8_BAR;
        PG8_WAIT_V(2); PG8_BAR;
        PG8_STAGE(PG8_SB(1, 0), cB + kstep, voffB); PG8_STAGE(PG8_SA(1, 0), cA + kstep, voffA); PG8_STAGE(PG8_SB(1, 1), cB + hstep + kstep, voffB);
        PG8_WAIT_V(6); PG8_BAR;
    } else {
        PG8_STAGE(PG8_SB(0, 0), cB, voffB); PG8_STAGE(PG8_SA(0, 0), cA, voffA); PG8_STAGE(PG8_SB(0, 1), cB + hstep, voffB); PG8_STAGE(PG8_SA(0, 1), cA + hstep, voffA);
        if (wr == 1) PG8_BAR;
        PG8_WAIT_V(4); PG8_BAR;
        PG8_STAGE(PG8_SB(1, 0), cB + kstep, voffB); PG8_STAGE(PG8_SA(1, 0), cA + kstep, voffA); PG8_STAGE(PG8_SB(1, 1), cB + hstep + kstep, voffB);
        PG8_WAIT_V(6); PG8_BAR;
    }
    for (;;) {
        const bool has_next = S.next(ui + 1, nxt);
        const char* nA = has_next ? (const char*)g.A + (size_t)nxt.pm * tstep : cA; const char* nB = has_next ? (const char*)g.Bt + (size_t)nxt.pn * tstep : cB;
        for (int t = 0; t < nt; t += 2) {
            const bool last = (t == nt - 2);
            const char* a1 = cA + (size_t)(t + 1) * kstep;
            const char* a2 = last ? nA : cA + (size_t)(t + 2) * kstep; const char* b2 = last ? nB : cB + (size_t)(t + 2) * kstep;
            const char* a3 = a2 + kstep; const char* b3 = b2 + kstep;
            if (last && has_next) S.a_ready(nxt);
            if constexpr (SP2) {
            PG8_LDB(B0, 0, 0); PG8_LDB(B1, 0, 1); PG8_SCHED; PG8_LDA(At, 0, 0); PG8_STAGE(PG8_SA(1, 1), a1 + hstep, voffA);
            PG8_WAIT_V(8); PG8_WAIT_L(0); PG8_BAR; PG8_MMA(0, 0, At, B0); PG8_MMA(0, 1, At, B1); PG8_BAR; PG8_SCHED;
            PG8_LDA(At, 0, 1); PG8_STAGE(PG8_SB(0, 0), b2, voffB); PG8_STAGE(PG8_SB(0, 1), b2 + hstep, voffB); PG8_STAGE(PG8_SA(0, 0), a2, voffA);
            PG8_WAIT_V(8); PG8_WAIT_L(0); PG8_BAR; PG8_MMA(1, 0, At, B0); PG8_MMA(1, 1, At, B1); PG8_BAR; PG8_SCHED;
            PG8_LDB(B0, 1, 0); PG8_LDB(B1, 1, 1); PG8_SCHED; PG8_LDA(At, 1, 0); PG8_STAGE(PG8_SA(0, 1), a2 + hstep, voffA);
            PG8_WAIT_V(8); PG8_WAIT_L(0); PG8_BAR; PG8_MMA(0, 0, At, B0); PG8_MMA(0, 1, At, B1); PG8_BAR; PG8_SCHED;
            PG8_LDA(At, 1, 1); PG8_STAGE(PG8_SB(1, 0), b3, voffB); PG8_STAGE(PG8_SB(1, 1), b3 + hstep, voffB); PG8_STAGE(PG8_SA(1, 0), a3, voffA);
            PG8_WAIT_V(8); PG8_WAIT_L(0); PG8_BAR; PG8_MMA(1, 0, At, B0); PG8_MMA(1, 1, At, B1); PG8_BAR; PG8_SCHED;
            } else {
            PG8_LDB(B0, 0, 0); PG8_SCHED; PG8_LDA(At, 0, 0); PG8_STAGE(PG8_SA(1, 1), a1 + hstep, voffA);
            PG8_WAIT_L(8); PG8_BAR; PG8_WAIT_L(0); PG8_MMA(0, 0, At, B0); PG8_BAR; PG8_SCHED;
            PG8_LDB(B1, 0, 1); PG8_STAGE(PG8_SB(0, 0), b2, voffB);
            PG8_BAR; PG8_WAIT_L(0); PG8_MMA(0, 1, At, B1); PG8_BAR;
            PG8_LDA(At, 0, 1); PG8_STAGE(PG8_SA(0, 0), a2, voffA);
            PG8_BAR; PG8_WAIT_L(0); PG8_MMA(1, 0, At, B0); PG8_BAR; PG8_SCHED;
            PG8_STAGE(PG8_SB(0, 1), b2 + hstep, voffB);
            PG8_WAIT_V(6); PG8_BAR; PG8_MMA(1, 1, At, B1); PG8_BAR;
            PG8_LDB(B0, 1, 0); PG8_SCHED; PG8_LDA(At, 1, 0); PG8_STAGE(PG8_SA(0, 1), a2 + hstep, voffA);
            PG8_WAIT_L(8); PG8_BAR; PG8_WAIT_L(0); PG8_MMA(0, 0, At, B0); PG8_BAR; PG8_SCHED;
            PG8_LDB(B1, 1, 1); PG8_STAGE(PG8_SB(1, 0), b3, voffB);
            PG8_BAR; PG8_WAIT_L(0); PG8_MMA(0, 1, At, B1); PG8_BAR;
            PG8_LDA(At, 1, 1); PG8_STAGE(PG8_SA(1, 0), a3, voffA);
            PG8_BAR; PG8_WAIT_L(0); PG8_MMA(1, 0, At, B0); PG8_BAR; PG8_SCHED;
            PG8_STAGE(PG8_SB(1, 1), b3 + hstep, voffB);
            PG8_WAIT_V(6); PG8_BAR; PG8_MMA(1, 1, At, B1); PG8_BAR;
            }
        }
        if constexpr (ALIGN_EPI) { if (wr == 0) PG8_BAR; }
        if constexpr (!Epi::AFTER_DRAIN) { E(acc, cur, wr, wc, fr, fq); S.done(cur); }
        if (!has_next) break;
#pragma unroll
        for (int a = 0; a < 2; ++a)
#pragma unroll
            for (int b = 0; b < 2; ++b)
#pragma unroll
                for (int m = 0; m < 4; ++m)
#pragma unroll
                    for (int n = 0; n < 2; ++n) acc[a][b][m][n] = (f32x4){0.f, 0.f, 0.f, 0.f};
        cur = nxt; cA = nA; cB = nB; ++ui;
        if constexpr (ALIGN_EPI) { if (wr == 1) PG8_BAR; }
    }
    PG8_WAIT_V(0);
    if constexpr (!ALIGN_EPI) { if (wr == 0) PG8_BAR; }
    PG8_BAR;
    if constexpr (Epi::AFTER_DRAIN) { E.fused(acc, cur, wr, wc, fr, fq, lds, wid, lane); S.done(cur); }
#undef PG8_SA
#undef PG8_SB
#undef PG8_STAGE
#undef PG8_LDA
#undef PG8_LDB
#undef PG8_MMA
#undef PG8_WAIT_V
#undef PG8_WAIT_L
#undef PG8_BAR
#undef PG8_SCHED
}
}

template <class F> DI void epi_rows(const pg8::f32x4 (&acc)[2][2][4][2], const pg8::Unit& u, int wr, int wc, int fr, int fq, F f) {
#pragma unroll
    for (int ai = 0; ai < 2; ++ai)
#pragma unroll
        for (int m = 0; m < 4; ++m) {
            const int row = u.pm * 256 + ai * 128 + wr * 64 + m * 16 + fr;
#pragma unroll
            for (int bj = 0; bj < 2; ++bj) f(row, u.pn * 256 + bj * 128 + wc * 32 + 8 * fq, acc[ai][bj][m][0], acc[ai][bj][m][1]);
        }
}
DI u32x4 pack8(const f32x4& a, const f32x4& b) { u32x4 w; w.x = pack2(a[0], a[1]); w.y = pack2(a[2], a[3]); w.z = pack2(b[0], b[1]); w.w = pack2(b[2], b[3]); return w; }
struct EpiProj {
    static constexpr bool PERM = true, AFTER_DRAIN = false;
    unsigned char* ws;
    DI void operator()(const pg8::f32x4 (&acc)[2][2][4][2], const pg8::Unit& u, int wr, int wc, int fr, int fq) const {
        const int pn = u.pn;
        if (pn < 12) {
            bf16_t* dst; int ld, cofs;
            if (pn < 6) { dst = (bf16_t*)(ws + OFF_GQKV); ld = 1536; cofs = 0; }
            else if (pn < 8) { dst = (bf16_t*)(ws + OFF_Z); ld = 512; cofs = 1536; }
            else { dst = (bf16_t*)(ws + OFF_FQK); ld = 1024; cofs = 2048; }
            epi_rows(acc, u, wr, wc, fr, fq, [&](int row, int col, const f32x4& a, const f32x4& b) { *(u32x4*)(dst + (size_t)row * ld + (col - cofs)) = pack8(a, b); });
        } else if (pn < 14) {
            bf16_t* vT = (bf16_t*)(ws + OFF_VT);
            epi_rows(acc, u, wr, wc, fr, fq, [&](int row, int col, const f32x4& a, const f32x4& b) {
                const int c = col - 3072, hh = c >> 6, d0 = c & 63, bb = row >> 11, t = row & 2047;
                bf16_t* p = vT + ((size_t)(bb * 8 + hh) * 64 + d0) * TSEQ + t;
#pragma unroll
                for (int e = 0; e < 4; ++e) { p[(size_t)e * TSEQ] = (bf16_t)f2bf(a[e]); p[(size_t)(e + 4) * TSEQ] = (bf16_t)f2bf(b[e]); }
            });
        } else {
            float* gates = (float*)(ws + OFF_GATES);
            epi_rows(acc, u, wr, wc, fr, fq, [&](int row, int col, const f32x4& a, const f32x4& b) {
                const int c = col - 3584;
                if (c < 16) { *(f32x4*)(gates + (size_t)row * 16 + c) = a; *(f32x4*)(gates + (size_t)row * 16 + c + 4) = b; }
            });
        }
    }
};
struct EpiOutProj {
    static constexpr bool PERM = true, AFTER_DRAIN = false;
    const float* x; const float* g; const float* b; const float* stats; float* out;
    DI void operator()(const pg8::f32x4 (&acc)[2][2][4][2], const pg8::Unit& u, int wr, int wc, int fr, int fq) const {
        epi_rows(acc, u, wr, wc, fr, fq, [&](int row, int col, const f32x4& a0, const f32x4& a1) {
            const float mu = stats[row * 2], rs = stats[row * 2 + 1];
            const size_t idx = (size_t)row * DM + col;
            const f32x4 x0 = *(const f32x4*)(x + idx), x1 = *(const f32x4*)(x + idx + 4);
            const f32x4 g0 = *(const f32x4*)(g + col), g1 = *(const f32x4*)(g + col + 4), b0 = *(const f32x4*)(b + col), b1 = *(const f32x4*)(b + col + 4);
            *(f32x4*)(out + idx) = ((x0 - mu) * rs * g0 + b0) * ALPHA + a0;
            *(f32x4*)(out + idx + 4) = ((x1 - mu) * rs * g1 + b1) * ALPHA + a1;
        });
    }
};
struct EpiUp {
    static constexpr bool PERM = true, AFTER_DRAIN = false;
    bf16_t* ffb;
    DI void operator()(const pg8::f32x4 (&acc)[2][2][4][2], const pg8::Unit& u, int wr, int wc, int fr, int fq) const {
        epi_rows(acc, u, wr, wc, fr, fq, [&](int row, int col, const f32x4& a, const f32x4& b) {
            f32x4 ra, rb;
#pragma unroll
            for (int e = 0; e < 4; ++e) { const float va = fmaxf(a[e], 0.f), vb = fmaxf(b[e], 0.f); ra[e] = va * va; rb[e] = vb * vb; }
            *(u32x4*)(ffb + (size_t)row * 4096 + col) = pack8(ra, rb);
        });
    }
};
struct EpiGate {
    static constexpr bool PERM = true, AFTER_DRAIN = false;
    bf16_t* pg; const float* bias;
    DI void operator()(const pg8::f32x4 (&acc)[2][2][4][2], const pg8::Unit& u, int wr, int wc, int fr, int fq) const {
        f32x4 bv[2][2];
#pragma unroll
        for (int bj = 0; bj < 2; ++bj) { const int c0 = u.pn * 256 + bj * 128 + wc * 32 + 8 * fq; bv[bj][0] = *(const f32x4*)(bias + c0); bv[bj][1] = *(const f32x4*)(bias + c0 + 4); }
        epi_rows(acc, u, wr, wc, fr, fq, [&](int row, int col, const f32x4& a, const f32x4& b) {
            const int bj = (col >> 7) & 1;
            const f32x4 b0 = bv[bj][0], b1 = bv[bj][1];
            f32x4 ra, rb;
#pragma unroll
            for (int e = 0; e < 4; ++e) { ra[e] = sigmoidf_(a[e] + b0[e]); rb[e] = sigmoidf_(b[e] + b1[e]); }
            *(u32x4*)(pg + (size_t)row * DM + col) = pack8(ra, rb);
        });
    }
};
struct EpiPle {
    static constexpr bool PERM = true, AFTER_DRAIN = false;
    bf16_t* pg;
    DI void operator()(const pg8::f32x4 (&acc)[2][2][4][2], const pg8::Unit& u, int wr, int wc, int fr, int fq) const {
        epi_rows(acc, u, wr, wc, fr, fq, [&](int row, int col, const f32x4& a, const f32x4& b) {
            u32x4* p = (u32x4*)(pg + (size_t)row * DM + col);
            const u32x4 w = *p;
            f32x4 ra, rb;
            ra[0] = a[0] * bflo(w.x); ra[1] = a[1] * bfhi(w.x); ra[2] = a[2] * bflo(w.y); ra[3] = a[3] * bfhi(w.y);
            rb[0] = b[0] * bflo(w.z); rb[1] = b[1] * bfhi(w.z); rb[2] = b[2] * bflo(w.w); rb[3] = b[3] * bfhi(w.w);
            *p = pack8(ra, rb);
        });
    }
};
struct EpiDown {
    static constexpr bool PERM = true, AFTER_DRAIN = false;
    const bf16_t* pg; float* out;
    DI void operator()(const pg8::f32x4 (&acc)[2][2][4][2], const pg8::Unit& u, int wr, int wc, int fr, int fq) const {
        epi_rows(acc, u, wr, wc, fr, fq, [&](int row, int col, const f32x4& a, const f32x4& b) {
            const size_t idx = (size_t)row * DM + col;
            const u32x4 w = *(const u32x4*)(pg + idx);
            f32x4 o0 = *(const f32x4*)(out + idx), o1 = *(const f32x4*)(out + idx + 4);
            o0 = o0 * ALPHA + a; o1 = o1 * ALPHA + b;
            o0[0] += bflo(w.x); o0[1] += bfhi(w.x); o0[2] += bflo(w.y); o0[3] += bfhi(w.y);
            o1[0] += bflo(w.z); o1[1] += bfhi(w.z); o1[2] += bflo(w.w); o1[3] += bfhi(w.w);
            *(f32x4*)(out + idx) = o0; *(f32x4*)(out + idx + 4) = o1;
        });
    }
};
DI void lds_read8(unsigned addr, f32x4 (&a)[4][2]) {
    asm volatile(
        "ds_read_b128 %0, %8\n\tds_read_b128 %1, %8 offset:16\n\t"
        "ds_read_b128 %2, %8 offset:256\n\tds_read_b128 %3, %8 offset:272\n\t"
        "ds_read_b128 %4, %8 offset:512\n\tds_read_b128 %5, %8 offset:528\n\t"
        "ds_read_b128 %6, %8 offset:768\n\tds_read_b128 %7, %8 offset:784\n\t"
        "s_waitcnt lgkmcnt(0)"
        : "=&v"(a[0][0]), "=&v"(a[0][1]), "=&v"(a[1][0]), "=&v"(a[1][1]), "=&v"(a[2][0]), "=&v"(a[2][1]), "=&v"(a[3][0]), "=&v"(a[3][1])
        : "v"(addr) : "memory");
}
DI void lds_read8s(unsigned addr, f32x4 (&a)[4][2]) {
    asm volatile(
        "ds_read_b128 %0, %8\n\tds_read_b128 %1, %8 offset:16\n\t"
        "ds_read_b128 %2, %8 offset:128\n\tds_read_b128 %3, %8 offset:144\n\t"
        "ds_read_b128 %4, %8 offset:256\n\tds_read_b128 %5, %8 offset:272\n\t"
        "ds_read_b128 %6, %8 offset:384\n\tds_read_b128 %7, %8 offset:400\n\t"
        "s_waitcnt lgkmcnt(0)"
        : "=&v"(a[0][0]), "=&v"(a[0][1]), "=&v"(a[1][0]), "=&v"(a[1][1]), "=&v"(a[2][0]), "=&v"(a[2][1]), "=&v"(a[3][0]), "=&v"(a[3][1])
        : "v"(addr) : "memory");
}
DI void prep_chunk(const Params& P, int ci, unsigned char* smem, int tt) {
    const int tid = tt, lane = tid & 63, wave = tid >> 6, r = lane & 31, h2 = lane >> 5;
    const int b = ci >> 7, hd = (ci >> 5) & 3, n = ci & 31, t0 = n * 64;
    const size_t rowbase = (size_t)b * TSEQ + t0;
    bf16_t* kbf = (bf16_t*)smem;
    bf16_t* qbf = kbf + 64 * 136;
    bf16_t* vT  = (bf16_t*)smem;
    bf16_t* Tb  = (bf16_t*)(smem + 18432);
    bf16_t* Tg  = (bf16_t*)(smem + 27648);
    bf16_t* kT  = (bf16_t*)(smem + 36864);
    float*  Ad  = (float*)(smem + 55296);
    bf16_t* A10 = (bf16_t*)(smem + 63488);
    bf16_t* DT  = (bf16_t*)(smem + 66048);
    float* sbeta = (float*)(smem + 71168);
    float* sgam = sbeta + 64; float* segam = sgam + 64; float* sdk = segam + 64;
    bf16_t* D1R = (bf16_t*)(smem + 72192);
    const bf16_t* gq = (const bf16_t*)(P.ws + OFF_GQKV);
    const float* gates = (const float*)(P.ws + OFF_GATES);
    const float* cw = P.in[5];
    if (tid < 64) {
        const float* gt = gates + (rowbase + tid) * 16;
        const float be = sigmoidf_(gt[hd]);
        const float a = gt[4 + hd] + P.in[7][hd];
        const float sp = fmaxf(a, 0.f) + log1pf(__expf(-fabsf(a)));
        float lg = -__expf(P.in[6][hd]) * sp;
#pragma unroll
        for (int o = 1; o < 64; o <<= 1) { const float t = shup(lg, o, lane); if (lane >= o) lg += t; }
        const float gl = shlane(lg, 63);
        sbeta[tid] = be; sgam[tid] = lg; segam[tid] = __expf(lg); sdk[tid] = __expf(gl - lg);
    }
    {
        float* wl = Ad;
        for (int idx = tid; idx < 384; idx += 256) {
            const int wh = idx >> 7, rem = idx & 127, j = rem >> 5, c4 = (rem & 31) * 4;
            const int cbw = (wh == 0 ? 512 : wh == 1 ? 0 : 1024) + hd * 128;
            *(f32x4*)(wl + (wh * 4 + j) * 128 + c4) = *(const f32x4*)(cw + j * 1536 + cbw + c4);
        }
    }
    __syncthreads();
    unsigned vkeep[16];
#pragma unroll
    for (int e = 0; e < 16; ++e) vkeep[e] = 0u;
    {
        const int i = tid >> 2, seg = tid & 3;
        const float* wl = Ad;
#pragma unroll 1
        for (int which = 0; which < 3; ++which) {
            const int colbase = (which == 0 ? 512 : which == 1 ? 0 : 1024) + hd * 128 + seg * 32;
            u32x4 xr[4][4];
#pragma unroll
            for (int j = 0; j < 4; ++j) {
                const int t = t0 + i - 3 + j;
                const int tc = t < 0 ? 0 : t;
                const bf16_t* xp = gq + ((size_t)b * TSEQ + tc) * 1536 + colbase;
#pragma unroll
                for (int sub = 0; sub < 4; ++sub) xr[j][sub] = *(const u32x4*)(xp + sub * 8);
            }
            float val[32];
#pragma unroll
            for (int sub = 0; sub < 4; ++sub) {
                float a8[8];
#pragma unroll
                for (int e = 0; e < 8; ++e) a8[e] = 0.f;
#pragma unroll
                for (int j = 0; j < 4; ++j) {
                    const float mk = (t0 + i - 3 + j) < 0 ? 0.f : 1.f;
                    const u32x4 xv = xr[j][sub];
                    f32x4 w0 = *(const f32x4*)(wl + (which * 4 + j) * 128 + seg * 32 + sub * 8), w1 = *(const f32x4*)(wl + (which * 4 + j) * 128 + seg * 32 + sub * 8 + 4);
                    w0 = w0 * mk; w1 = w1 * mk;
                    a8[0] += w0[0] * bflo(xv.x); a8[1] += w0[1] * bfhi(xv.x); a8[2] += w0[2] * bflo(xv.y); a8[3] += w0[3] * bfhi(xv.y);
                    a8[4] += w1[0] * bflo(xv.z); a8[5] += w1[1] * bfhi(xv.z); a8[6] += w1[2] * bflo(xv.w); a8[7] += w1[3] * bfhi(xv.w);
                }
#pragma unroll
                for (int e = 0; e < 8; ++e) val[sub * 8 + e] = siluf(a8[e]);
            }
            float ss = 0.f;
#pragma unroll
            for (int e = 0; e < 32; ++e) ss += val[e] * val[e];
            ss += shx(ss, 1, lane); ss += shx(ss, 2, lane);
            const float sc = (which == 2) ? 1.f : rsqrtf(ss + 1e-6f) * (which == 1 ? 0.08838834764831845f : 1.f);
            unsigned pk[16];
#pragma unroll
            for (int e = 0; e < 16; ++e) pk[e] = pack2(val[2 * e] * sc, val[2 * e + 1] * sc);
            if (which == 2) {
#pragma unroll
                for (int e = 0; e < 16; ++e) vkeep[e] = pk[e];
            } else {
                bf16_t* dst = (which == 0 ? kbf : qbf) + i * 136 + seg * 32;
#pragma unroll
                for (int sub = 0; sub < 4; ++sub) { u32x4 o; o.x = pk[4 * sub]; o.y = pk[4 * sub + 1]; o.z = pk[4 * sub + 2]; o.w = pk[4 * sub + 3]; *(u32x4*)(dst + sub * 8) = o; }
                if (which == 0) {
                    bf16_t* kt = kT + (seg * 32) * 72 + i;
#pragma unroll
                    for (int e = 0; e < 16; ++e) { kt[(2 * e) * 72] = (bf16_t)(pk[e] & 0xffffu); kt[(2 * e + 1) * 72] = (bf16_t)(pk[e] >> 16); }
                }
            }
        }
    }
    __syncthreads();
    {
        const int mi = wave >> 1, ni = wave & 1;
        f32x16 aK, aQ;
#pragma unroll
        for (int e = 0; e < 16; ++e) { aK[e] = 0.f; aQ[e] = 0.f; }
#pragma unroll
        for (int ks = 0; ks < 8; ++ks) {
            const bf16x8 ak = *(const bf16x8*)(kbf + (mi * 32 + r) * 136 + ks * 16 + h2 * 8);
            const bf16x8 bk = *(const bf16x8*)(kbf + (ni * 32 + r) * 136 + ks * 16 + h2 * 8);
            const bf16x8 aq = *(const bf16x8*)(qbf + (mi * 32 + r) * 136 + ks * 16 + h2 * 8);
            aK = MFMA32(ak, bk, aK); aQ = MFMA32(aq, bk, aQ);
        }
        const int j = ni * 32 + r;
        const float gj = sgam[j];
        bf16_t* qkout = (bf16_t*)(P.ws + OFF_QK) + (size_t)ci * 4096;
#pragma unroll
        for (int e = 0; e < 16; ++e) {
            const int il = crow(e, h2), i = mi * 32 + il;
            const float dec = (i >= j) ? __expf(sgam[i] - gj) : 0.f;
            const float aij = (i > j) ? aK[e] * sbeta[i] * dec : 0.f;
            if (mi == ni) Ad[(mi * 32 + il) * 32 + r] = aij;
            else if (mi == 1) A10[il * 40 + r] = (bf16_t)f2bf(aij);
            qkout[(((i >> 5) * 4 + (j >> 4)) * 64 + (i & 31) + 32 * ((j >> 3) & 1)) * 8 + (j & 7)] = (bf16_t)f2bf((i >= j) ? aQ[e] * dec : 0.f);
        }
    }
    {
        const int i = tid >> 2, seg = tid & 3;
        const float eg = segam[i];
        bf16_t* qd = (bf16_t*)(P.ws + OFF_QD) + (size_t)ci * 8192;
#pragma unroll
        for (int sub = 0; sub < 4; ++sub) {
            const u32x4 v = *(const u32x4*)(qbf + i * 136 + seg * 32 + sub * 8);
            u32x4 o;
            o.x = pack2(bflo(v.x) * eg, bfhi(v.x) * eg); o.y = pack2(bflo(v.y) * eg, bfhi(v.y) * eg);
            o.z = pack2(bflo(v.z) * eg, bfhi(v.z) * eg); o.w = pack2(bflo(v.w) * eg, bfhi(v.w) * eg);
            *(u32x4*)(qd + ((((i >> 5) * 8 + seg * 2 + (sub >> 1)) * 64 + (i & 31) + 32 * (sub & 1)) * 8)) = o;
        }
        const int kidx = tid >> 1, cs = (tid & 1) * 32;
        bf16_t* kd = (bf16_t*)(P.ws + OFF_KDT) + (size_t)ci * 8192;
#pragma unroll
        for (int sub = 0; sub < 4; ++sub) {
            const u32x4 v = *(const u32x4*)(kT + kidx * 72 + cs + sub * 8);
            const f32x4 d0 = *(const f32x4*)(sdk + cs + sub * 8), d1 = *(const f32x4*)(sdk + cs + sub * 8 + 4);
            u32x4 o;
            o.x = pack2(bflo(v.x) * d0[0], bfhi(v.x) * d0[1]); o.y = pack2(bflo(v.y) * d0[2], bfhi(v.y) * d0[3]);
            o.z = pack2(bflo(v.z) * d1[0], bfhi(v.z) * d1[1]); o.w = pack2(bflo(v.w) * d1[2], bfhi(v.w) * d1[3]);
            *(u32x4*)(kd + ((((kidx >> 5) * 4 + ((cs + sub * 8) >> 4)) * 64 + (kidx & 31) + 32 * (sub & 1)) * 8)) = o;
        }
        if (tid == 0) ((float*)(P.ws + OFF_GLAST))[ci] = segam[63];
    }
    __syncthreads();
    {
        const int i = tid >> 2, seg = tid & 3;
        bf16_t* vt = vT + (seg * 32) * 72 + i;
#pragma unroll
        for (int e = 0; e < 16; ++e) { vt[(2 * e) * 72] = (bf16_t)(vkeep[e] & 0xffffu); vt[(2 * e + 1) * 72] = (bf16_t)(vkeep[e] >> 16); }
        if (tid >= 64) {
            for (int idx = tid - 64; idx < 1024; idx += 192) { const int rr = idx >> 5, cc = 32 + (idx & 31); Tb[rr * 72 + cc] = 0; Tg[rr * 72 + cc] = 0; }
        } else {
            const int blk = tid >> 5, c = tid & 31;
            float x[32];
#pragma unroll
            for (int e = 0; e < 32; ++e) x[e] = (e == c) ? 1.f : 0.f;
            const unsigned ad_lds = (unsigned)(size_t)(Ad + blk * 1024);
#pragma unroll
            for (int ib = 0; ib < 8; ++ib) {
                const int i0 = ib * 4;
                float s0 = x[i0], s1 = x[i0 + 1], s2 = x[i0 + 2], s3 = x[i0 + 3];
#pragma unroll
                for (int mb = 0; mb <= ib; mb += 2) {
                    f32x4 a[4][2];
                    lds_read8s(ad_lds + (unsigned)((i0 * 32 + mb * 4) * 4), a);
#pragma unroll
                    for (int cb = 0; cb < 2; ++cb) {
                        const int m4 = mb + cb;
                        if (m4 < ib) {
#pragma unroll
                            for (int e = 0; e < 4; ++e) {
                                const float xx = x[m4 * 4 + e];
                                s0 -= a[0][cb][e] * xx; s1 -= a[1][cb][e] * xx; s2 -= a[2][cb][e] * xx; s3 -= a[3][cb][e] * xx;
                            }
                        } else if (m4 == ib) {
                            s1 -= a[1][cb][0] * s0;
                            s2 -= a[2][cb][0] * s0; s2 -= a[2][cb][1] * s1;
                            s3 -= a[3][cb][0] * s0; s3 -= a[3][cb][1] * s1; s3 -= a[3][cb][2] * s2;
                        }
                    }
                    __builtin_amdgcn_sched_barrier(0);
                }
                x[i0] = s0; x[i0 + 1] = s1; x[i0 + 2] = s2; x[i0 + 3] = s3;
            }
            bf16_t* dt = DT + (blk * 32 + c) * 40;
#pragma unroll
            for (int q4 = 0; q4 < 4; ++q4) {
                u32x4 o; o.x = pack2(x[8 * q4], x[8 * q4 + 1]); o.y = pack2(x[8 * q4 + 2], x[8 * q4 + 3]); o.z = pack2(x[8 * q4 + 4], x[8 * q4 + 5]); o.w = pack2(x[8 * q4 + 6], x[8 * q4 + 7]);
                *(u32x4*)(dt + q4 * 8) = o;
            }
            const int cg = blk * 32 + c;
            const float bc = sbeta[cg], bg = bc * segam[cg];
#pragma unroll
            for (int rr = 0; rr < 32; ++rr) {
                if (blk == 1) D1R[rr * 40 + c] = (bf16_t)f2bf(x[rr]);
                Tb[(blk * 32 + rr) * 72 + cg] = (bf16_t)f2bf(x[rr] * bc);
                Tg[(blk * 32 + rr) * 72 + cg] = (bf16_t)f2bf(x[rr] * bg);
            }
        }
    }
    __syncthreads();
    if (wave == 0) {
        f32x16 Pm, Qm;
#pragma unroll
        for (int e = 0; e < 16; ++e) { Pm[e] = 0.f; Qm[e] = 0.f; }
#pragma unroll
        for (int ks = 0; ks < 2; ++ks) {
            const bf16x8 a = *(const bf16x8*)(A10 + r * 40 + ks * 16 + h2 * 8);
            const bf16x8 bb = *(const bf16x8*)(DT + r * 40 + ks * 16 + h2 * 8);
            Pm = MFMA32(a, bb, Pm);
        }
#pragma unroll
        for (int sq = 0; sq < 2; ++sq) {
            u32x4 pw;
            pw.x = pack2(Pm[8 * sq + 0], Pm[8 * sq + 1]); pw.y = pack2(Pm[8 * sq + 2], Pm[8 * sq + 3]);
            pw.z = pack2(Pm[8 * sq + 4], Pm[8 * sq + 5]); pw.w = pack2(Pm[8 * sq + 6], Pm[8 * sq + 7]);
            const bf16_t* dp = D1R + r * 40 + 16 * sq + 4 * h2;
            const u32x2 lo = *(const u32x2*)dp, hi = *(const u32x2*)(dp + 8);
            u32x4 aw; aw.x = lo.x; aw.y = lo.y; aw.z = hi.x; aw.w = hi.y;
            Qm = MFMA32(__builtin_bit_cast(bf16x8, aw), __builtin_bit_cast(bf16x8, pw), Qm);
        }
        const float bc = sbeta[r], bg = bc * segam[r];
#pragma unroll
        for (int e = 0; e < 16; ++e) {
            const int il = crow(e, h2);
            Tb[(32 + il) * 72 + r] = (bf16_t)f2bf(-Qm[e] * bc);
            Tg[(32 + il) * 72 + r] = (bf16_t)f2bf(-Qm[e] * bg);
        }
    }
    __syncthreads();
    {
        const int nt = wave;
        f32x16 aU[2], aW[2];
#pragma unroll
        for (int e = 0; e < 16; ++e) { aU[0][e] = 0.f; aU[1][e] = 0.f; aW[0][e] = 0.f; aW[1][e] = 0.f; }
#pragma unroll
        for (int ks = 0; ks < 4; ++ks) {
            const bf16x8 bv = *(const bf16x8*)(vT + (nt * 32 + r) * 72 + ks * 16 + h2 * 8);
            const bf16x8 bk = *(const bf16x8*)(kT + (nt * 32 + r) * 72 + ks * 16 + h2 * 8);
#pragma unroll
            for (int mt = 0; mt < 2; ++mt) {
                const bf16x8 ab = *(const bf16x8*)(Tb + (mt * 32 + r) * 72 + ks * 16 + h2 * 8);
                const bf16x8 ag = *(const bf16x8*)(Tg + (mt * 32 + r) * 72 + ks * 16 + h2 * 8);
                aU[mt] = MFMA32(ab, bv, aU[mt]); aW[mt] = MFMA32(ag, bk, aW[mt]);
            }
        }
        bf16_t* u = (bf16_t*)(P.ws + OFF_U) + (size_t)ci * 8192;
        bf16_t* w = (bf16_t*)(P.ws + OFF_W) + (size_t)ci * 8192;
#pragma unroll
        for (int mt = 0; mt < 2; ++mt) {
            u32x4 o0, o1;
            o0.x = pack2(aU[mt][0], aU[mt][1]); o0.y = pack2(aU[mt][2], aU[mt][3]); o0.z = pack2(aU[mt][4], aU[mt][5]); o0.w = pack2(aU[mt][6], aU[mt][7]);
            o1.x = pack2(aU[mt][8], aU[mt][9]); o1.y = pack2(aU[mt][10], aU[mt][11]); o1.z = pack2(aU[mt][12], aU[mt][13]); o1.w = pack2(aU[mt][14], aU[mt][15]);
            bf16_t* d = u + (((nt * 2 + mt) * 64 + lane) * 16);
            *(u32x4*)d = o0; *(u32x4*)(d + 8) = o1;
            bf16_t* wb = w + (((mt * 8 + nt * 2 + (r >> 4)) * 64 + 32 * ((r >> 3) & 1)) * 8) + (r & 7);
#pragma unroll
            for (int e = 0; e < 16; ++e) wb[crow(e, h2) * 8] = (bf16_t)f2bf(aW[mt][e]);
        }
    }
    __syncthreads();
}

DI void fox_cumsum(const Params& P, int bh, unsigned char* smem, int tt) {
    const int tid = tt, lane = tid & 63, wave = tid >> 6;
    const int b = bh >> 3, hh = bh & 7;
    float* wsum = (float*)smem;
    const float* gates = (const float*)(P.ws + OFF_GATES);
    const float bf = P.in[9][hh];
    float v[8]; float run = 0.f;
#pragma unroll
    for (int e = 0; e < 8; ++e) {
        const float xx = gates[((size_t)b * TSEQ + tid * 8 + e) * 16 + 8 + hh] + bf;
        const float ls = fminf(xx, 0.f) - log1pf(__expf(-fabsf(xx)));
        run += ls; v[e] = run;
    }
    float sc = run;
#pragma unroll
    for (int o = 1; o < 64; o <<= 1) { const float t = shup(sc, o, lane); if (lane >= o) sc += t; }
    if (lane == 63) wsum[wave] = sc;
    __syncthreads();
    float off = sc - run;
    for (int w = 0; w < wave; ++w) off += wsum[w];
    float* cf = (float*)(P.ws + OFF_CF) + (size_t)bh * TSEQ + tid * 8;
#pragma unroll
    for (int e = 0; e < 8; ++e) cf[e] = v[e] + off;
    __syncthreads();
}

DI void gdn_scan(const Params& P, int item, unsigned char* smem, int tt) {
    const int tid = tt, lane = tid & 63, wave = tid >> 6, r = lane & 31, h2 = lane >> 5;
    const int bh = item >> 2, vs = item & 3, b = bh >> 2, hd = bh & 3;
    const int cb = bh * 32;
    bf16_t* SbT = (bf16_t*)smem;
    bf16_t* VnT = SbT + 32 * 136;
    const bool w01 = wave < 2;
    const int mt = wave & 1;
    const bf16_t* Ubase = (const bf16_t*)(P.ws + OFF_U);
    const bf16_t* Abase = (const bf16_t*)(P.ws + (w01 ? OFF_W : OFF_QD));
    const bf16_t* Kbase = (const bf16_t*)(P.ws + OFF_KDT);
    const bf16_t* QKbase = (const bf16_t*)(P.ws + OFF_QK);
    const float* glast = (const float*)(P.ws + OFF_GLAST);
    bf16_t* og = (bf16_t*)(P.ws + OFF_OG);
    f32x16 S;
#pragma unroll
    for (int e = 0; e < 16; ++e) S[e] = 0.f;
    for (int i = tid; i < 32 * 136 / 2; i += 256) ((unsigned*)SbT)[i] = 0u;
#define SCAN_LOAD_A(AF, ci_) do { const bf16_t* ap_ = Abase + (size_t)(ci_) * 8192 + (mt * 8 * 64 + lane) * 8; \
        _Pragma("unroll") for (int ks = 0; ks < 8; ++ks) AF[ks] = *(const bf16x8*)(ap_ + ks * 512); } while (0)
#define SCAN_LOAD_K(ci_) do { const bf16_t* kp_ = Kbase + (size_t)(ci_) * 8192 + (wave * 4 * 64 + lane) * 8; \
        _Pragma("unroll") for (int ks = 0; ks < 4; ++ks) Kf[ks] = *(const bf16x8*)(kp_ + ks * 512); } while (0)
#define SCAN_LOAD_X(ci_) do { if (w01) { const bf16_t* up_ = Ubase + (size_t)(ci_) * 8192 + ((vs * 2 + mt) * 64 + lane) * 16; \
            Xa = *(const u32x4*)up_; Xb = *(const u32x4*)(up_ + 8); } \
        else { const bf16_t* qp_ = QKbase + (size_t)(ci_) * 4096 + (mt * 4 * 64 + lane) * 8; \
            Xa = *(const u32x4*)qp_; Xb = *(const u32x4*)(qp_ + 512); Xc = *(const u32x4*)(qp_ + 1024); Xd = *(const u32x4*)(qp_ + 1536); } } while (0)
#define SCAN_STEP(AF, n_) do { \
        const int cn1 = cb + ((n_) + 1 < 32 ? (n_) + 1 : 31); const int cn2 = cb + ((n_) + 2 < 32 ? (n_) + 2 : 31); \
        const float gl = shlane(glreg, (n_)); \
        f32x16 acc1; \
        bf16x8 sf[8]; \
        _Pragma("unroll") for (int ks = 0; ks < 8; ++ks) sf[ks] = *(const bf16x8*)(SbT + r * 136 + ks * 16 + h2 * 8); \
        _Pragma("unroll") for (int e = 0; e < 16; ++e) acc1[e] = 0.f; \
        __builtin_amdgcn_sched_barrier(0); \
        _Pragma("unroll") for (int ks = 0; ks < 8; ++ks) acc1 = MFMA32(AF[ks], sf[ks], acc1); \
        __builtin_amdgcn_sched_barrier(0); \
        SCAN_LOAD_A(AF, cn2); \
        if (w01) { \
            u32x2 ov; \
            ov.x = pack2(bflo(Xa.x) - acc1[0], bfhi(Xa.x) - acc1[1]); ov.y = pack2(bflo(Xa.y) - acc1[2], bfhi(Xa.y) - acc1[3]); *(u32x2*)(VnT + r * 72 + mt * 32 + 0 + 4 * h2) = ov; \
            ov.x = pack2(bflo(Xa.z) - acc1[4], bfhi(Xa.z) - acc1[5]); ov.y = pack2(bflo(Xa.w) - acc1[6], bfhi(Xa.w) - acc1[7]); *(u32x2*)(VnT + r * 72 + mt * 32 + 8 + 4 * h2) = ov; \
            ov.x = pack2(bflo(Xb.x) - acc1[8], bfhi(Xb.x) - acc1[9]); ov.y = pack2(bflo(Xb.y) - acc1[10], bfhi(Xb.y) - acc1[11]); *(u32x2*)(VnT + r * 72 + mt * 32 + 16 + 4 * h2) = ov; \
            ov.x = pack2(bflo(Xb.z) - acc1[12], bfhi(Xb.z) - acc1[13]); ov.y = pack2(bflo(Xb.w) - acc1[14], bfhi(Xb.w) - acc1[15]); *(u32x2*)(VnT + r * 72 + mt * 32 + 24 + 4 * h2) = ov; \
        } \
        __syncthreads(); \
        bf16x8 Vf[4]; \
        _Pragma("unroll") for (int ks = 0; ks < 4; ++ks) Vf[ks] = *(const bf16x8*)(VnT + r * 72 + ks * 16 + h2 * 8); \
        _Pragma("unroll") for (int e = 0; e < 16; ++e) S[e] *= gl; \
        __builtin_amdgcn_sched_barrier(0); \
        _Pragma("unroll") for (int ks = 0; ks < 4; ++ks) S = MFMA32(Kf[ks], Vf[ks], S); \
        if (!w01) { \
            acc1 = MFMA32(__builtin_bit_cast(bf16x8, Xa), Vf[0], acc1); acc1 = MFMA32(__builtin_bit_cast(bf16x8, Xb), Vf[1], acc1); \
            acc1 = MFMA32(__builtin_bit_cast(bf16x8, Xc), Vf[2], acc1); acc1 = MFMA32(__builtin_bit_cast(bf16x8, Xd), Vf[3], acc1); \
        } \
        __builtin_amdgcn_sched_barrier(0); \
        SCAN_LOAD_K(cn1); \
        SCAN_LOAD_X(cn1); \
        _Pragma("unroll") for (int g = 0; g < 4; ++g) { u32x2 ov; ov.x = pack2(S[4 * g + 0], S[4 * g + 1]); ov.y = pack2(S[4 * g + 2], S[4 * g + 3]); \
            *(u32x2*)(SbT + r * 136 + wave * 32 + 8 * g + 4 * h2) = ov; } \
        if (!w01) { \
            bf16_t* op = og + ((size_t)b * TSEQ + (n_) * 64 + mt * 32) * 512 + hd * 128 + vs * 32 + r; \
            _Pragma("unroll") for (int e = 0; e < 16; ++e) op[(size_t)crow(e, h2) * 512] = (bf16_t)f2bf(acc1[e]); \
        } \
        __syncthreads(); \
    } while (0)
    const float glreg = glast[cb + (lane & 31)];
    bf16x8 Af0[8], Af1[8], Kf[4];
    u32x4 Xa, Xb, Xc, Xd;
    Xc = Xd = (u32x4){0u, 0u, 0u, 0u};
    SCAN_LOAD_A(Af0, cb); SCAN_LOAD_K(cb); SCAN_LOAD_X(cb);
    SCAN_LOAD_A(Af1, cb + 1);
    __syncthreads();
#pragma unroll 1
    for (int n = 0; n < 32; n += 2) {
        SCAN_STEP(Af0, n);
        SCAN_STEP(Af1, n + 1);
    }
#undef SCAN_LOAD_A
#undef SCAN_LOAD_K
#undef SCAN_LOAD_X
#undef SCAN_STEP
}

DI void fox_attn(const Params& P, int bh, int qb, unsigned char* smem, int tt) {
    const int tid = tt, lane = tid & 63, wave = tid >> 6, r = lane & 31, h2 = lane >> 5;
    const int b = bh >> 3, hh = bh & 7;
    constexpr int BUFB = 2 * 64 * 72 * 2 + 256;
    constexpr float L2E = 1.4426950408889634f;
    const bf16_t* fqk = (const bf16_t*)(P.ws + OFF_FQK);
    const bf16_t* vT = (const bf16_t*)(P.ws + OFF_VT) + (size_t)bh * 64 * TSEQ;
    const float* cf = (const float*)(P.ws + OFF_CF) + (size_t)bh * TSEQ;
    const int q = qb * 128 + wave * 32 + r;
    bf16x8 Qf[4];
    {
        const bf16_t* qp = fqk + ((size_t)b * TSEQ + q) * 1024 + hh * 64 + h2 * 8;
#pragma unroll
        for (int ks = 0; ks < 4; ++ks) Qf[ks] = *(const bf16x8*)(qp + ks * 16);
    }
    const float cq = cf[q] * L2E;
    float m = -1e30f, l = 0.f;
    f32x16 O[2];
#pragma unroll
    for (int e = 0; e < 16; ++e) { O[0][e] = 0.f; O[1][e] = 0.f; }
    const int ntiles = 2 * qb + 2;
    const int srow = tid >> 3, scol = (tid & 7) * 8;
    const bf16_t* kg = fqk + ((size_t)b * TSEQ + srow) * 1024 + 512 + hh * 64 + scol;
    const bf16_t* vg = vT + (size_t)srow * TSEQ + scol;
    u32x4 rk0, rk1, rv0, rv1; float rc = 0.f;
    rk0 = *(const u32x4*)kg; rk1 = *(const u32x4*)(kg + 32 * 1024);
    rv0 = *(const u32x4*)vg; rv1 = *(const u32x4*)(vg + 32 * TSEQ);
    if (tid < 64) rc = cf[tid] * L2E;
    {
        bf16_t* Ks = (bf16_t*)smem; bf16_t* VTs = Ks + 64 * 72; float* cks = (float*)(smem + 2 * 64 * 72 * 2);
        *(u32x4*)(Ks + srow * 72 + scol) = rk0; *(u32x4*)(Ks + (srow + 32) * 72 + scol) = rk1;
        *(u32x4*)(VTs + srow * 72 + scol) = rv0; *(u32x4*)(VTs + (srow + 32) * 72 + scol) = rv1;
        if (tid < 64) cks[tid] = rc;
    }
    __syncthreads();
#pragma unroll 1
    for (int kt = 0; kt < ntiles; ++kt) {
        const unsigned char* bufc = smem + (kt & 1) * BUFB;
        const bf16_t* Ks = (const bf16_t*)bufc; const bf16_t* VTs = Ks + 64 * 72; const float* cks = (const float*)(bufc + 2 * 64 * 72 * 2);
        const bool more = kt + 1 < ntiles;
        if (more) {
            const bf16_t* kg2 = kg + (size_t)(kt + 1) * 64 * 1024; const bf16_t* vg2 = vg + (kt + 1) * 64;
            rk0 = *(const u32x4*)kg2; rk1 = *(const u32x4*)(kg2 + 32 * 1024);
            rv0 = *(const u32x4*)vg2; rv1 = *(const u32x4*)(vg2 + 32 * TSEQ);
            if (tid < 64) rc = cf[(kt + 1) * 64 + tid] * L2E;
        }
        f32x16 sacc[2];
        f32x4 ckv[2][4];
        {
            bf16x8 kf[2][4];
#pragma unroll
            for (int mt = 0; mt < 2; ++mt)
#pragma unroll
                for (int ks = 0; ks < 4; ++ks) kf[mt][ks] = *(const bf16x8*)(Ks + (mt * 32 + r) * 72 + ks * 16 + h2 * 8);
#pragma unroll
            for (int mt = 0; mt < 2; ++mt)
#pragma unroll
                for (int g = 0; g < 4; ++g) ckv[mt][g] = *(const f32x4*)(cks + mt * 32 + 8 * g + 4 * h2);
#pragma unroll
            for (int e = 0; e < 16; ++e) { sacc[0][e] = 0.f; sacc[1][e] = 0.f; }
            __builtin_amdgcn_sched_barrier(0);
#pragma unroll
            for (int ks = 0; ks < 4; ++ks) { sacc[0] = MFMA32(kf[0][ks], Qf[ks], sacc[0]); sacc[1] = MFMA32(kf[1][ks], Qf[ks], sacc[1]); }
        }
        const bool diag = kt >= ntiles - 2;
        float mx = -1e30f;
        {
            const f32x2v csc = {0.125f * L2E, 0.125f * L2E};
#pragma unroll
            for (int mt = 0; mt < 2; ++mt)
#pragma unroll
                for (int g = 0; g < 4; ++g) {
                    const f32x4 ck4 = ckv[mt][g];
                    const f32x2v c01 = {ck4[0], ck4[1]}, c23 = {ck4[2], ck4[3]};
                    const f32x2v a01 = {sacc[mt][4 * g], sacc[mt][4 * g + 1]}, a23 = {sacc[mt][4 * g + 2], sacc[mt][4 * g + 3]};
                    const f32x2v s01 = a01 * csc - c01, s23 = a23 * csc - c23;
                    sacc[mt][4 * g] = s01.x; sacc[mt][4 * g + 1] = s01.y; sacc[mt][4 * g + 2] = s23.x; sacc[mt][4 * g + 3] = s23.y;
                    mx = fmaxf(fmaxf(mx, s01.x), s01.y); mx = fmaxf(fmaxf(mx, s23.x), s23.y);
                }
        }
        if (diag) {
            mx = -1e30f;
            const int qrel = q - kt * 64 - 4 * h2;
#pragma unroll
            for (int mt = 0; mt < 2; ++mt)
#pragma unroll
                for (int e = 0; e < 16; ++e) {
                    const int krel = mt * 32 + (e & 3) + 8 * (e >> 2);
                    const float sv = (krel > qrel) ? -1e30f : sacc[mt][e];
                    sacc[mt][e] = sv;
                    mx = fmaxf(mx, sv);
                }
        }
        mx = fmaxf(mx, shx(mx, 32, lane));
        if (__builtin_amdgcn_ballot_w64(mx + cq - m > 8.f) != 0ull) {
            const float mn = fmaxf(m, mx + cq);
            const float alpha = __builtin_amdgcn_exp2f(m - mn);
            m = mn;
            l *= alpha;
            const f32x2v al2 = {alpha, alpha};
#pragma unroll
            for (int dt = 0; dt < 2; ++dt)
#pragma unroll
                for (int p2 = 0; p2 < 8; ++p2) {
                    f32x2v ov = {O[dt][2 * p2], O[dt][2 * p2 + 1]};
                    ov = ov * al2;
                    O[dt][2 * p2] = ov.x; O[dt][2 * p2 + 1] = ov.y;
                }
        }
        {
            const float sh = cq - m;
            const f32x2v sh2 = {sh, sh};
            f32x2v rs2 = {0.f, 0.f};
#pragma unroll
            for (int mt = 0; mt < 2; ++mt)
#pragma unroll
                for (int p2 = 0; p2 < 8; ++p2) {
                    const f32x2v sv = {sacc[mt][2 * p2], sacc[mt][2 * p2 + 1]};
                    const f32x2v t = sv + sh2;
                    f32x2v pp; pp.x = __builtin_amdgcn_exp2f(t.x); pp.y = __builtin_amdgcn_exp2f(t.y);
                    sacc[mt][2 * p2] = pp.x; sacc[mt][2 * p2 + 1] = pp.y;
                    rs2 = rs2 + pp;
                }
            l += rs2.x + rs2.y;
        }
        {
            u32x4 vw[2][2][2];
#pragma unroll
            for (int mt = 0; mt < 2; ++mt)
#pragma unroll
                for (int s = 0; s < 2; ++s)
#pragma unroll
                    for (int dt = 0; dt < 2; ++dt) {
                        const bf16_t* vp = VTs + (dt * 32 + r) * 72 + mt * 32 + 16 * s + 4 * h2;
                        const u32x2 lo = *(const u32x2*)vp, hi = *(const u32x2*)(vp + 8);
                        vw[mt][s][dt].x = lo.x; vw[mt][s][dt].y = lo.y; vw[mt][s][dt].z = hi.x; vw[mt][s][dt].w = hi.y;
                    }
            u32x4 pw[2][2];
#pragma unroll
            for (int mt = 0; mt < 2; ++mt)
#pragma unroll
                for (int s = 0; s < 2; ++s) {
                    pw[mt][s].x = pack2(sacc[mt][8 * s + 0], sacc[mt][8 * s + 1]); pw[mt][s].y = pack2(sacc[mt][8 * s + 2], sacc[mt][8 * s + 3]);
                    pw[mt][s].z = pack2(sacc[mt][8 * s + 4], sacc[mt][8 * s + 5]); pw[mt][s].w = pack2(sacc[mt][8 * s + 6], sacc[mt][8 * s + 7]);
                }
            __builtin_amdgcn_sched_barrier(0);
#pragma unroll
            for (int mt = 0; mt < 2; ++mt)
#pragma unroll
                for (int s = 0; s < 2; ++s) {
                    const bf16x8 pf = __builtin_bit_cast(bf16x8, pw[mt][s]);
                    O[0] = MFMA32(__builtin_bit_cast(bf16x8, vw[mt][s][0]), pf, O[0]);
                    O[1] = MFMA32(__builtin_bit_cast(bf16x8, vw[mt][s][1]), pf, O[1]);
                }
        }
        if (more) {
            unsigned char* bufn = smem + ((kt + 1) & 1) * BUFB;
            bf16_t* Kn = (bf16_t*)bufn; bf16_t* VTn = Kn + 64 * 72; float* ckn = (float*)(bufn + 2 * 64 * 72 * 2);
            *(u32x4*)(Kn + srow * 72 + scol) = rk0; *(u32x4*)(Kn + (srow + 32) * 72 + scol) = rk1;
            *(u32x4*)(VTn + srow * 72 + scol) = rv0; *(u32x4*)(VTn + (srow + 32) * 72 + scol) = rv1;
            if (tid < 64) ckn[tid] = rc;
        }
        __syncthreads();
    }
    l += shx(l, 32, lane);
    const float inv = 1.f / l;
    float ss = 0.f;
#pragma unroll
    for (int e = 0; e < 16; ++e) { O[0][e] *= inv; O[1][e] *= inv; ss += O[0][e] * O[0][e] + O[1][e] * O[1][e]; }
    ss += shx(ss, 32, lane);
    const float sc = rsqrtf(ss * (1.f / 64.f) + 1e-6f);
    bf16_t* op = (bf16_t*)(P.ws + OFF_MIX) + ((size_t)b * TSEQ + q) * 1024 + 512 + hh * 64;
    const float* fg = P.in[10];
    f32x4 ggv[2][4];
#pragma unroll
    for (int dt = 0; dt < 2; ++dt)
#pragma unroll
        for (int g = 0; g < 4; ++g) ggv[dt][g] = *(const f32x4*)(fg + dt * 32 + 8 * g + 4 * h2);
#pragma unroll
    for (int dt = 0; dt < 2; ++dt)
#pragma unroll
        for (int g = 0; g < 4; ++g) {
            const int d0 = dt * 32 + 8 * g + 4 * h2;
            const f32x4 gg = ggv[dt][g];
            u32x2 o;
            o.x = pack2(O[dt][4 * g + 0] * sc * gg[0], O[dt][4 * g + 1] * sc * gg[1]); o.y = pack2(O[dt][4 * g + 2] * sc * gg[2], O[dt][4 * g + 3] * sc * gg[3]);
            *(u32x2*)(op + d0) = o;
        }
}

#define XB_TMO      128
#define XB_XCNT(j)  (256  + 64 * (j))
#define XB_XSUB(j)  (1280 + 64 * (j))
#define XB_XGEN(j)  (2304 + 64 * (j))
#define XB_TOP      3328
#define XB_TOPGEN   3392
#define XCD_BAR_WORDS 3456
#define XB_SPIN_CAP (1u << 18)
#define LAS __attribute__((address_space(3)))
DI unsigned xb_ld(unsigned* p)              { return __hip_atomic_load(p, __ATOMIC_RELAXED, __HIP_MEMORY_SCOPE_AGENT); }
DI unsigned xb_add(unsigned* p, unsigned v) { return __hip_atomic_fetch_add(p, v, __ATOMIC_RELAXED, __HIP_MEMORY_SCOPE_AGENT); }
DI unsigned xb_xcc_id() { return (unsigned)__builtin_amdgcn_s_getreg((3 << 11) | 20) & 0xFu; }
#define XB_SPIN(cond, bar) do { unsigned _sp = 0; while (cond) { __builtin_amdgcn_s_sleep(1); \
    if ((++_sp & 255u) == 0u) { if (xb_ld(&(bar)[XB_TMO])) break; if (_sp > XB_SPIN_CAP) { atomicAdd(&(bar)[XB_TMO], 1u); break; } } } } while (0)
struct XcdBarrier { unsigned* bar; unsigned x; volatile LAS unsigned* st; };
DI XcdBarrier xcd_barrier_post(unsigned* bar, volatile LAS unsigned* st, int tid0) {
    XcdBarrier b; b.bar = bar; b.x = xb_xcc_id(); b.st = st;
    if (tid0 == 0) (void)xb_add(&bar[XB_XCNT(b.x)], 1u);
    return b;
}
DI void xcd_barrier_complete(unsigned* bar, unsigned x, unsigned& nloc, unsigned& nx) {
    const unsigned G = gridDim.x * gridDim.y * gridDim.z;
    unsigned sum, cnt, mine, sp = 0u;
    for (;;) {
        sum = 0u; cnt = 0u; mine = 0u;
#pragma unroll
        for (unsigned j = 0; j < 16; ++j) { const unsigned c = xb_ld(&bar[XB_XCNT(j)]); sum += c; cnt += (c > 0u) ? 1u : 0u; mine = (j == x) ? c : mine; }
        if (sum == G) break;
        __builtin_amdgcn_s_sleep(1);
        if ((++sp & 255u) == 0u) { if (xb_ld(&bar[XB_TMO])) break; if (sp > XB_SPIN_CAP) { atomicAdd(&bar[XB_TMO], 1u); break; } }
    }
    nloc = mine > 0u ? mine : 1u; nx = cnt > 0u ? cnt : 1u;
}
DI void xcd_barrier(const XcdBarrier& b, const int wid_s) {
    asm volatile("s_waitcnt vmcnt(0)" ::: "memory");
    __syncthreads();
    if (fresh_tid(wid_s) == 0) {
        unsigned* bar = b.bar;
        __builtin_amdgcn_s_waitcnt(0);
        unsigned nloc = b.st[0], nx = b.st[1];
        if (nloc == 0u) { xcd_barrier_complete(bar, b.x, nloc, nx); b.st[0] = nloc; b.st[1] = nx; }
        const unsigned old = xb_add(&bar[XB_XSUB(b.x)], 1u);
        const unsigned gen = old / nloc;
        if (old + 1u == (gen + 1u) * nloc) {
            __builtin_amdgcn_fence(__ATOMIC_RELEASE, "agent");
            asm volatile("s_waitcnt vmcnt(0)" ::: "memory");
            const unsigned og = xb_add(&bar[XB_TOP], 1u);
            const unsigned tg = og / nx;
            if (og + 1u == (tg + 1u) * nx) xb_add(&bar[XB_TOPGEN], 1u);
            else XB_SPIN(xb_ld(&bar[XB_TOPGEN]) == tg, bar);
            __builtin_amdgcn_fence(__ATOMIC_ACQUIRE, "agent");
            xb_add(&bar[XB_XGEN(b.x)], 1u);
            asm volatile("s_waitcnt vmcnt(0)" ::: "memory");
        } else {
            XB_SPIN(xb_ld(&bar[XB_XGEN(b.x)]) == gen, bar);
            __builtin_amdgcn_fence(__ATOMIC_ACQUIRE, "agent");
            asm volatile("s_waitcnt vmcnt(0)" ::: "memory");
        }
    }
    __syncthreads();
}


template <int MODE> struct EpiLnFused {
    static constexpr bool PERM = true, AFTER_DRAIN = true;
    const float* x; const float* g_in; const float* b_in; const float* stats;
    const bf16_t* h1; const bf16_t* pg;
    float* xbuf; unsigned* cnt; const float* g; const float* b; float* outf; bf16_t* outb;
    DI void operator()(const pg8::f32x4 (&)[2][2][4][2], const pg8::Unit&, int, int, int, int) const {}
    DI void fused(pg8::f32x4 (&acc)[2][2][4][2], const pg8::Unit& u, int wr, int wc, int fr, int fq, pg8::PG8_LAS_T ldsp, int wid, int lane) const {
        float* P = (float*)(unsigned char*)ldsp;
        float* ST = P + 2048;
        const int tid = wid * 64 + lane;
        f32x4 gi[2][2], bi[2][2];
#pragma unroll
        for (int bj = 0; bj < 2; ++bj) {
            const int col = u.pn * 256 + bj * 128 + wc * 32 + 8 * fq;
            if (MODE == 0) { gi[bj][0] = *(const f32x4*)(g_in + col); gi[bj][1] = *(const f32x4*)(g_in + col + 4); bi[bj][0] = *(const f32x4*)(b_in + col); bi[bj][1] = *(const f32x4*)(b_in + col + 4); }
        }
#pragma unroll
        for (int ai = 0; ai < 2; ++ai)
#pragma unroll
            for (int m = 0; m < 4; ++m) {
                const int rt = ai * 128 + wr * 64 + m * 16 + fr, row = u.pm * 256 + rt;
                float sm = 0.f, sq = 0.f;
                float mu = 0.f, rs = 0.f;
                if (MODE == 0) { mu = stats[row * 2]; rs = stats[row * 2 + 1]; }
#pragma unroll
                for (int bj = 0; bj < 2; ++bj) {
                    const int col = u.pn * 256 + bj * 128 + wc * 32 + 8 * fq;
                    const size_t idx = (size_t)row * DM + col;
                    f32x4 v0, v1;
                    if (MODE == 0) {
                        const f32x4 x0 = *(const f32x4*)(x + idx), x1 = *(const f32x4*)(x + idx + 4);
                        v0 = ((x0 - mu) * rs * gi[bj][0] + bi[bj][0]) * ALPHA + acc[ai][bj][m][0];
                        v1 = ((x1 - mu) * rs * gi[bj][1] + bi[bj][1]) * ALPHA + acc[ai][bj][m][1];
                    } else {
                        const u32x4 w = *(const u32x4*)(pg + idx);
                        const u32x4 hw = *(const u32x4*)(h1 + idx);
                        v0 = (f32x4){bflo(hw.x), bfhi(hw.x), bflo(hw.y), bfhi(hw.y)} * ALPHA + acc[ai][bj][m][0];
                        v1 = (f32x4){bflo(hw.z), bfhi(hw.z), bflo(hw.w), bfhi(hw.w)} * ALPHA + acc[ai][bj][m][1];
                        v0[0] += bflo(w.x); v0[1] += bfhi(w.x); v0[2] += bflo(w.y); v0[3] += bfhi(w.y);
                        v1[0] += bflo(w.z); v1[1] += bfhi(w.z); v1[2] += bflo(w.w); v1[3] += bfhi(w.w);
                    }
                    acc[ai][bj][m][0] = v0; acc[ai][bj][m][1] = v1;
#pragma unroll
                    for (int e = 0; e < 4; ++e) { sm += v0[e] + v1[e]; sq += v0[e] * v0[e] + v1[e] * v1[e]; }
                }
                sm += shx(sm, 16, lane); sm += shx(sm, 32, lane);
                sq += shx(sq, 16, lane); sq += shx(sq, 32, lane);
                if (fq == 0) { P[(rt * 4 + wc) * 2] = sm; P[(rt * 4 + wc) * 2 + 1] = sq; }
            }
        __syncthreads();
        if (tid < 256) {
            const f32x4 a = *(const f32x4*)(P + tid * 8), c = *(const f32x4*)(P + tid * 8 + 4);
            float* slot = xbuf + ((size_t)(u.pm * 256 + tid) * 4 + u.pn) * 2;
            __hip_atomic_store(slot, (a[0] + a[2]) + (c[0] + c[2]), __ATOMIC_RELAXED, __HIP_MEMORY_SCOPE_AGENT);
            __hip_atomic_store(slot + 1, (a[1] + a[3]) + (c[1] + c[3]), __ATOMIC_RELAXED, __HIP_MEMORY_SCOPE_AGENT);
        }
        asm volatile("s_waitcnt vmcnt(0)" ::: "memory");
        __syncthreads();
        if (tid == 0) {
            xb_add(cnt + u.pm, 1u);
            unsigned sp = 0;
            while (xb_ld(cnt + u.pm) < 4u) { __builtin_amdgcn_s_sleep(1); if (++sp > (1u << 22)) break; }
        }
        __syncthreads();
        if (tid < 256) {
            float* slot = xbuf + (size_t)(u.pm * 256 + tid) * 8;
            float pv[8];
#pragma unroll
            for (int e = 0; e < 8; ++e) pv[e] = __hip_atomic_load(slot + e, __ATOMIC_RELAXED, __HIP_MEMORY_SCOPE_AGENT);
            const float sm = (pv[0] + pv[2]) + (pv[4] + pv[6]), sq = (pv[1] + pv[3]) + (pv[5] + pv[7]);
            const float mean = sm * (1.f / 1024.f);
            const float var = fmaxf(sq * (1.f / 1024.f) - mean * mean, 0.f);
            ST[tid * 2] = mean; ST[tid * 2 + 1] = rsqrtf(var + 1e-5f);
        }
        __syncthreads();
        f32x4 go[2][2], bo[2][2];
#pragma unroll
        for (int bj = 0; bj < 2; ++bj) {
            const int col = u.pn * 256 + bj * 128 + wc * 32 + 8 * fq;
            go[bj][0] = *(const f32x4*)(g + col); go[bj][1] = *(const f32x4*)(g + col + 4); bo[bj][0] = *(const f32x4*)(b + col); bo[bj][1] = *(const f32x4*)(b + col + 4);
        }
#pragma unroll
        for (int ai = 0; ai < 2; ++ai)
#pragma unroll
            for (int m = 0; m < 4; ++m) {
                const int rt = ai * 128 + wr * 64 + m * 16 + fr, row = u.pm * 256 + rt;
                const float mean = ST[rt * 2], rstd = ST[rt * 2 + 1];
#pragma unroll
                for (int bj = 0; bj < 2; ++bj) {
                    const int col = u.pn * 256 + bj * 128 + wc * 32 + 8 * fq;
                    const size_t idx = (size_t)row * DM + col;
                    const f32x4 o0 = (acc[ai][bj][m][0] - mean) * rstd * go[bj][0] + bo[bj][0], o1 = (acc[ai][bj][m][1] - mean) * rstd * go[bj][1] + bo[bj][1];
                    if (outf) { *(f32x4*)(outf + idx) = o0; *(f32x4*)(outf + idx + 4) = o1; }
                    if (outb) *(u32x4*)(outb + idx) = pack8(o0, o1);
                }
            }
    }
};

template <class Epi> DI void run_gemm(pg8::PG8_LAS_T lds, const bf16_t* A, const bf16_t* Bt, int N, int K, const Epi& E, const int wid_s) {
    pg8::Gemm g{A, Bt, M_TOK, N, K}; pg8::StaticOrder S; S.init(M_TOK, N, (int)gridDim.x, (int)blockIdx.x);
    pg8::gemm_phase<Epi, pg8::StaticOrder, true, true>(lds, g, S, E, wid_s);
}
__global__ void __launch_bounds__(512, 2) fwd_mega(Params P) {
    cg::grid_group grid = cg::this_grid();
    extern __shared__ __attribute__((aligned(16))) unsigned char lds[];
    pg8::PG8_LAS_T glds = (pg8::PG8_LAS_T)lds;
    volatile LAS unsigned* xb_words = (volatile LAS unsigned*)(glds + LDS_MISC);
    volatile int* s_item = (volatile int*)(lds + LDS_MISC + 16);
    const int nblk = gridDim.x, bid = blockIdx.x;
    unsigned char* ws = P.ws;

    const int wid_s = __builtin_amdgcn_readfirstlane((int)threadIdx.x >> 6);
    if (threadIdx.x < 4) xb_words[threadIdx.x] = 0u;
    __syncthreads();
    const XcdBarrier xbar = xcd_barrier_post((unsigned*)(ws + OFF_BAR), xb_words, (int)threadIdx.x);
    if (P.out == nullptr) grid.sync();

    {
    for (int base = bid * 2; base < 3584 + 4096; base += nblk * 2) {
        PHASE_IDS
        const int it = base + team;
        if (it < 3584) {
            const float* W; int K, N, mode = 0, loc, nnt; bf16_t* Wt;
            if (it < 960) { W = P.in[4]; K = 1024; N = 3600; mode = 1; Wt = (bf16_t*)(ws + OFF_WIN); loc = it; nnt = 60; }
            else if (it < 1216) { W = P.in[11]; K = 1024; N = 1024; Wt = (bf16_t*)(ws + OFF_WOUT); loc = it - 960; nnt = 16; }
            else if (it < 2240) { W = P.in[14]; K = 1024; N = 4096; Wt = (bf16_t*)(ws + OFF_WUP); loc = it - 1216; nnt = 64; }
            else if (it < 3264) { W = P.in[15]; K = 4096; N = 1024; Wt = (bf16_t*)(ws + OFF_WDOWN); loc = it - 2240; nnt = 16; }
            else if (it < 3520) { W = P.in[17]; K = 1024; N = 1024; Wt = (bf16_t*)(ws + OFF_WG); loc = it - 3264; nnt = 16; }
            else { W = P.in[16]; K = 256; N = 1024; Wt = (bf16_t*)(ws + OFF_WPLE); loc = it - 3520; nnt = 16; }
            transpose_tile(W, K, N, Wt, loc / nnt, loc % nnt, mode, (float*)smem, tt);
        } else {
            const int row = (it - 3584) * 4 + tw;
            ln_row(P.in[0] + (size_t)row * DM, P.in[2], P.in[3], nullptr, (bf16_t*)(ws + OFF_HB) + (size_t)row * DM, (float*)(ws + OFF_STATS) + row * 2, lane);
            { const f32x4 pv = *(const f32x4*)(P.in[1] + (size_t)row * 256 + lane * 4); u32x2 w; w.x = pack2(pv[0], pv[1]); w.y = pack2(pv[2], pv[3]);
              *(u32x2*)((bf16_t*)(ws + OFF_PB) + (size_t)row * 256 + lane * 4) = w; }
        }
    }
    }
    xcd_barrier(xbar, wid_s);

    { EpiProj E{ws}; run_gemm(glds, (const bf16_t*)(ws + OFF_HB), (const bf16_t*)(ws + OFF_WIN), NPROJ, DM, E, wid_s); }
    xcd_barrier(xbar, wid_s);

    for (int rep = 0; rep < NREP(2); ++rep)
    {
    for (int base = bid * 2; base < 1024 + 64; base += nblk * 2) {
        PHASE_IDS
        const int it = base + team;
        if (it < 1024) prep_chunk(P, it, smem, tt); else fox_cumsum(P, it - 1024, smem, tt);
    }
    }
    xcd_barrier(xbar, wid_s);

    for (int rep = 0; rep < NREP(3); ++rep)
    {
    for (;;) {
        PHASE_IDS
        __syncthreads();
        if (tid == 0) *s_item = atomicAdd((int*)(ws + OFF_CTR) + rep, 1);
        __syncthreads();
        const int pr = *s_item;
        if (pr >= 64 + 512) break;
        if (pr < 64) gdn_scan(P, pr * 2 + team, smem, tt);
        else { const int fj = pr - 64; fox_attn(P, (fj & 31) * 2 + team, 15 - (fj >> 5), smem, tt); }
    }
    }
    xcd_barrier(xbar, wid_s);

    { PHASE_IDS
    for (int it = bid; it < M_TOK / 8; it += nblk) {
        const int row = it * 8 + wave8;
        bf16_t* mix = (bf16_t*)(ws + OFF_MIX) + (size_t)row * DM;
        {
            const int col = lane * 8;
            const u32x4 ov = *(const u32x4*)((const bf16_t*)(ws + OFF_OG) + (size_t)row * 512 + col);
            const u32x4 zv = *(const u32x4*)((const bf16_t*)(ws + OFF_Z) + (size_t)row * 512 + col);
            float o[8] = {bflo(ov.x), bfhi(ov.x), bflo(ov.y), bfhi(ov.y), bflo(ov.z), bfhi(ov.z), bflo(ov.w), bfhi(ov.w)};
            float z[8] = {bflo(zv.x), bfhi(zv.x), bflo(zv.y), bfhi(zv.y), bflo(zv.z), bfhi(zv.z), bflo(zv.w), bfhi(zv.w)};
            float ss = 0.f;
#pragma unroll
            for (int e = 0; e < 8; ++e) ss += o[e] * o[e];
            ss += shx(ss, 1, lane); ss += shx(ss, 2, lane); ss += shx(ss, 4, lane); ss += shx(ss, 8, lane);
            const float sc = rsqrtf(ss * (1.f / 128.f) + 1e-6f);
            const float* gg = P.in[8] + (col & 127);
            float v[8];
#pragma unroll
            for (int e = 0; e < 8; ++e) v[e] = o[e] * sc * gg[e] * siluf(z[e]);
            u32x4 w; w.x = pack2(v[0], v[1]); w.y = pack2(v[2], v[3]); w.z = pack2(v[4], v[5]); w.w = pack2(v[6], v[7]);
            *(u32x4*)(mix + col) = w;
        }
    }
    }
    xcd_barrier(xbar, wid_s);

    { EpiLnFused<0> E{P.in[0], P.in[2], P.in[3], (const float*)(ws + OFF_STATS), nullptr, nullptr, (float*)(ws + OFF_XBUF), (unsigned*)(ws + OFF_PCNT), P.in[12], P.in[13], nullptr, (bf16_t*)(ws + OFF_H1B)};
      run_gemm(glds, (const bf16_t*)(ws + OFF_MIX), (const bf16_t*)(ws + OFF_WOUT), DM, DM, E, wid_s); }
    xcd_barrier(xbar, wid_s);

    { EpiUp E{(bf16_t*)(ws + OFF_FFB)}; run_gemm(glds, (const bf16_t*)(ws + OFF_H1B), (const bf16_t*)(ws + OFF_WUP), 4096, DM, E, wid_s); }
    { EpiGate E{(bf16_t*)(ws + OFF_PG), P.in[18]}; run_gemm(glds, (const bf16_t*)(ws + OFF_H1B), (const bf16_t*)(ws + OFF_WG), DM, DM, E, wid_s); }
    { EpiPle E{(bf16_t*)(ws + OFF_PG)}; run_gemm(glds, (const bf16_t*)(ws + OFF_PB), (const bf16_t*)(ws + OFF_WPLE), DM, 256, E, wid_s); }
    xcd_barrier(xbar, wid_s);

    { EpiLnFused<1> E{nullptr, nullptr, nullptr, nullptr, (const bf16_t*)(ws + OFF_H1B), (const bf16_t*)(ws + OFF_PG), (float*)(ws + OFF_XBUF) + (size_t)M_TOK * 8, (unsigned*)(ws + OFF_PCNT) + 64, P.in[19], P.in[20], P.out, nullptr};
      run_gemm(glds, (const bf16_t*)(ws + OFF_FFB), (const bf16_t*)(ws + OFF_WDOWN), DM, 4096, E, wid_s); }
}

extern "C" void kernel_launch(void* const* d_in, const int* in_sizes, int n_in, void* d_out, int out_size, void* d_ws, size_t ws_size, hipStream_t stream) {
    static int grid_blocks = 0;
    if (!grid_blocks) {
        int dev = 0, cus = 0, per_cu = 0;
        (void)hipGetDevice(&dev);
        (void)hipDeviceGetAttribute(&cus, hipDeviceAttributeMultiprocessorCount, dev);
        if (hipFuncSetAttribute((const void*)fwd_mega, hipFuncAttributeMaxDynamicSharedMemorySize, LDS_BYTES) != hipSuccess) fprintf(stderr, "kernel_launch: hipFuncSetAttribute failed\n");
        (void)hipOccupancyMaxActiveBlocksPerMultiprocessor(&per_cu, (const void*)fwd_mega, 512, LDS_BYTES);
        if (per_cu < 1) fprintf(stderr, "kernel_launch: occupancy query reports %d blocks per CU\n", per_cu);
        (void)hipGetLastError();
        grid_blocks = cus;
        if (ws_size < 232 * MBy) fprintf(stderr, "kernel_launch: workspace too small (%zu)\n", ws_size);
    }
    Params p{};
    for (int i = 0; i < 21; ++i) p.in[i] = (const float*)d_in[i];
    p.out = (float*)d_out; p.ws = (unsigned char*)d_ws;
    (void)hipMemsetAsync((unsigned char*)d_ws + OFF_BAR, 0, 16384, stream);
    void* args[] = {&p};
    hipError_t e = hipLaunchCooperativeKernel((void*)fwd_mega, dim3(grid_blocks), dim3(512), args, LDS_BYTES, stream);
    if (e != hipSuccess) fprintf(stderr, "cooperative launch failed: %s (grid %d)\n", hipGetErrorString(e), grid_blocks);
}
```

```cpp
#include <hip/hip_runtime.h>
#include <hip/hip_cooperative_groups.h>
#include <cstdio>
namespace cg = cooperative_groups;

typedef unsigned short bf16_t;
typedef short bf16x8 __attribute__((ext_vector_type(8)));
typedef short s16x4 __attribute__((ext_vector_type(4)));
typedef float f32x16 __attribute__((ext_vector_type(16)));
typedef float f32x4 __attribute__((ext_vector_type(4)));
typedef unsigned u32x4 __attribute__((ext_vector_type(4)));
typedef unsigned u32x2 __attribute__((ext_vector_type(2)));
typedef float f32x2v __attribute__((ext_vector_type(2)));

#define DI __device__ __forceinline__
#define MFMA32(a, b, c) __builtin_amdgcn_mfma_f32_32x32x16_bf16((a), (b), (c), 0, 0, 0)

constexpr int M_TOK = 16384, DM = 1024, TSEQ = 2048;
constexpr int NPROJ = 3840;
constexpr size_t MBy = 1u << 20;
constexpr size_t OFF_WIN = 0, OFF_WOUT = 8 * MBy, OFF_WUP = 10 * MBy, OFF_WDOWN = 18 * MBy, OFF_WG = 26 * MBy, OFF_WPLE = 28 * MBy;
constexpr size_t OFF_STATS = 28 * MBy + 512 * 1024, OFF_GLAST = 28 * MBy + 640 * 1024, OFF_BAR = 29 * MBy + 512 * 1024, OFF_CTR = OFF_BAR + 14336, OFF_CF = 28 * MBy + 768 * 1024;
constexpr size_t OFF_XBUF = 31 * MBy, OFF_PCNT = OFF_BAR + 14848;
constexpr size_t OFF_GATES = 30 * MBy, OFF_GQKV = 32 * MBy, OFF_Z = 80 * MBy, OFF_FQK = 96 * MBy, OFF_VT = 128 * MBy, OFF_HB = 144 * MBy;
constexpr size_t OFF_U = 144 * MBy, OFF_W = 160 * MBy, OFF_QD = 176 * MBy, OFF_KDT = 192 * MBy, OFF_QK = 208 * MBy;
constexpr size_t OFF_OG = 32 * MBy, OFF_MIX = 216 * MBy;
constexpr size_t OFF_H1B = 32 * MBy, OFF_PB = 248 * MBy, OFF_FFB = 72 * MBy, OFF_PG = 200 * MBy;
constexpr float ALPHA = 1.189207115002721f;
constexpr int TEAM_LDS = 76800, LDS_MISC = 153600, LDS_BYTES = 153600 + 256;
#ifndef REP_MASK
#define REP_MASK 0
#endif
#define NREP(k) (1 + ((REP_MASK >> (k)) & 1))

struct Params { const float* in[21]; float* out; unsigned char* ws; };

DI float bf2f(unsigned b) { return __uint_as_float(b << 16); }
typedef float f32x2_t __attribute__((ext_vector_type(2))); typedef __bf16 bf16x2_t __attribute__((ext_vector_type(2)));
DI unsigned pack2(float lo, float hi) { f32x2_t v = {lo, hi}; bf16x2_t b = __builtin_convertvector(v, bf16x2_t); return __builtin_bit_cast(unsigned, b); }
DI unsigned f2bf(float x) { return pack2(x, 0.f) & 0xffffu; }
DI float bflo(unsigned w) { return __uint_as_float(w << 16); }
DI float bfhi(unsigned w) { return __uint_as_float(w & 0xffff0000u); }
DI int crow(int e, int h) { return (e & 3) + 8 * (e >> 2) + 4 * h; }
DI float shx(float v, int mask, int lane) { return __int_as_float(__builtin_amdgcn_ds_bpermute((lane ^ mask) << 2, __float_as_int(v))); }
DI float shup(float v, int o, int lane) { return __int_as_float(__builtin_amdgcn_ds_bpermute(((lane - o) & 63) << 2, __float_as_int(v))); }
DI float shlane(float v, int src) { return __int_as_float(__builtin_amdgcn_readlane(__float_as_int(v), src)); }
DI float wave_sum(float v, int lane) { for (int o = 32; o > 0; o >>= 1) v += shx(v, o, lane); return v; }
DI float siluf(float x) { return x * __builtin_amdgcn_rcpf(1.f + __expf(-x)); }
DI float sigmoidf_(float x) { return __builtin_amdgcn_rcpf(1.f + __expf(-x)); }
DI int fresh_tid(int wid_s) { int l; asm volatile("v_mbcnt_lo_u32_b32 %0, -1, 0\n\tv_mbcnt_hi_u32_b32 %0, -1, %0" : "=v"(l)); return wid_s * 64 + l; }
#define PHASE_IDS const int tid = fresh_tid(wid_s), lane = tid & 63, wave8 = tid >> 6, team = tid >> 8, tt = tid & 255, tw = tt >> 6; unsigned char* smem = lds + team * TEAM_LDS; (void)lane; (void)wave8; (void)tt; (void)tw; (void)smem;

DI void ln_row(const float* src, const float* __restrict__ g, const float* __restrict__ b, float* dstf, bf16_t* dstb, float* stats, int lane) {
    f32x4 v[4];
#pragma unroll
    for (int i = 0; i < 4; ++i) v[i] = *(const f32x4*)(src + i * 256 + lane * 4);
    float s = 0.f;
#pragma unroll
    for (int i = 0; i < 4; ++i) s += (v[i][0] + v[i][1]) + (v[i][2] + v[i][3]);
    s = wave_sum(s, lane);
    const float mu = s * (1.f / 1024.f);
    float q = 0.f;
#pragma unroll
    for (int i = 0; i < 4; ++i) { f32x4 d = v[i] - mu; q += (d[0] * d[0] + d[1] * d[1]) + (d[2] * d[2] + d[3] * d[3]); }
    q = wave_sum(q, lane);
    const float rstd = rsqrtf(q * (1.f / 1024.f) + 1e-5f);
    f32x4 gv[4], bv[4];
#pragma unroll
    for (int i = 0; i < 4; ++i) { gv[i] = *(const f32x4*)(g + i * 256 + lane * 4); bv[i] = *(const f32x4*)(b + i * 256 + lane * 4); }
#pragma unroll
    for (int i = 0; i < 4; ++i) {
        const f32x4 gg = gv[i], bb = bv[i];
        const f32x4 o = (v[i] - mu) * rstd * gg + bb;
        if (dstf) *(f32x4*)(dstf + i * 256 + lane * 4) = o;
        if (dstb) { u32x2 w; w.x = pack2(o[0], o[1]); w.y = pack2(o[2], o[3]); *(u32x2*)(dstb + i * 256 + lane * 4) = w; }
    }
    if (stats && lane == 0) { stats[0] = mu; stats[1] = rstd; }
}

DI void transpose_tile(const float* __restrict__ W, int K, int N, bf16_t* __restrict__ Wt, int kt, int nt, int mode, float* tile, int tt) {
    const int tid = tt;
    const int k0 = kt * 64, n0 = nt * 64;
    {
        const int c = tid & 63, n = n0 + c;
        int sc = n;
        if (mode == 1) { sc = (n < 2048) ? n : (n < 3584) ? n + 8 : (n < 3592) ? 2048 + (n - 3584) : (n < 3600) ? n : -1; }
        const int scc = sc >= 0 ? sc : 0;
        const float mk = sc >= 0 ? 1.f : 0.f;
        float wv[16];
#pragma unroll
        for (int i = 0; i < 16; ++i) wv[i] = W[(size_t)(k0 + (tid >> 6) + 4 * i) * N + scc];
#pragma unroll
        for (int i = 0; i < 16; ++i) tile[((tid >> 6) + 4 * i) * 65 + c] = wv[i] * mk;
    }
    __syncthreads();
    {
        const int n = tid >> 2, ks = (tid & 3) * 16;
        u32x4 o0, o1;
        o0.x = pack2(tile[(ks + 0) * 65 + n], tile[(ks + 1) * 65 + n]); o0.y = pack2(tile[(ks + 2) * 65 + n], tile[(ks + 3) * 65 + n]);
        o0.z = pack2(tile[(ks + 4) * 65 + n], tile[(ks + 5) * 65 + n]); o0.w = pack2(tile[(ks + 6) * 65 + n], tile[(ks + 7) * 65 + n]);
        o1.x = pack2(tile[(ks + 8) * 65 + n], tile[(ks + 9) * 65 + n]); o1.y = pack2(tile[(ks + 10) * 65 + n], tile[(ks + 11) * 65 + n]);
        o1.z = pack2(tile[(ks + 12) * 65 + n], tile[(ks + 13) * 65 + n]); o1.w = pack2(tile[(ks + 14) * 65 + n], tile[(ks + 15) * 65 + n]);
        bf16_t* dst = Wt + (size_t)(n0 + n) * K + k0 + ks;
        *(u32x4*)dst = o0; *(u32x4*)(dst + 8) = o1;
    }
    __syncthreads();
}

namespace pg8 {
#define PG8_LAS __attribute__((address_space(3)))
typedef PG8_LAS unsigned char* PG8_LAS_T;
typedef unsigned short bf16_t;
typedef short bf16x8 __attribute__((ext_vector_type(8)));
typedef float f32x4 __attribute__((ext_vector_type(4)));
typedef unsigned u32x4 __attribute__((ext_vector_type(4)));
constexpr int BM = 256, BK = 64, HALF = 128, HTB = HALF * BK * 2  , STAGE_BYTES = 8 * HTB, NXCD = 8, WGM = 8;

__host__ __device__ __forceinline__ int lds_byte(int r, int c) { const int st = (r >> 4) * 2 + (c >> 5), rr = r & 15, cc = c & 31, ob = rr * 64 + cc * 2; return st * 1024 + (ob ^ (((ob >> 9) & 1) << 5)); }
__host__ __device__ __forceinline__ void stage_rc(int b, int& R, int& C) { const int st = b / 1024, sb = b % 1024, swz = sb ^ (((sb >> 9) & 1) << 5); R = (st >> 1) * 16 + swz / 64; C = (st & 1) * 32 + (swz % 64) / 2; }
__host__ __device__ __forceinline__ int perm32(int rho) { const int n = rho >> 4, i = rho & 15; return 8 * (i >> 2) + 4 * n + (i & 3); }

struct Unit { int pm, pn; };
struct Gemm { const bf16_t* A; const bf16_t* Bt; int M, N, K; };

struct StaticOrder {
    int nM, nN, nwg, G, c;
    __host__ __device__ void init(int M, int N, int G_, int c_) { nM = M / BM; nN = N / BM; nwg = nM * nN; G = G_; c = c_; }
    __host__ __device__ bool next(int i, Unit& u) const {
        const long L = (long)i * G + c; if (L >= nwg) return false;
        int wgid = (int)L; { const int q = nwg / NXCD, r = nwg % NXCD, xcd = wgid % NXCD, off = wgid / NXCD; wgid = (xcd < r ? xcd * (q + 1) : r * (q + 1) + (xcd - r) * q) + off; }
        const int nig = WGM * nN, gid = wgid / nig, fm = gid * WGM, gsz = (nM - fm) < WGM ? (nM - fm) : WGM;
        u.pm = fm + ((wgid % nig) % gsz); u.pn = (wgid % nig) / gsz; return true;
    }
    __device__ __forceinline__ void a_ready(const Unit&) const {}
    __device__ __forceinline__ void done(const Unit&) const {}
};
template <class Epi, class Sched, bool ALIGN_EPI = false, bool SP2 = false>
__device__ __forceinline__ void gemm_phase(PG8_LAS unsigned char* lds, const Gemm g, const Sched& S, const Epi& E, const int wid_s) {
    const int tid = fresh_tid(wid_s), wid = wid_s, lane = tid & 63, wr = wid >> 2, wc = wid & 3, fr = lane & 15, fq = lane >> 4;
    const int K = g.K, nt = K / BK;
    unsigned voffA[2], voffB[2];
#pragma unroll
    for (int i = 0; i < 2; ++i) { int R, C; stage_rc(tid * 16 + i * 8192, R, C); const int Rb = Epi::PERM ? ((R & ~31) + perm32(R & 31)) : R;
        voffA[i] = (unsigned)(R * K + C) * 2u; voffB[i] = (unsigned)(Rb * K + C) * 2u; }
    const size_t kstep = (size_t)(BK * 2);
    const size_t hstep = (size_t)HALF * K * 2;
    const size_t tstep = 2 * hstep;
    const unsigned ldsw = (unsigned)wid * 1024u;
    const int aoff = lds_byte(wr * 64 + fr, fq * 8), boff = lds_byte(wc * 32 + fr, fq * 8);
#define PG8_SA(b, h) (((b) * 2 + (h)) * HTB)
#define PG8_SB(b, h) ((4 + (b) * 2 + (h)) * HTB)
#define PG8_STAGE(bufoff, gbase, voff) do { _Pragma("unroll") for (int _i = 0; _i < 2; ++_i) \
        __builtin_amdgcn_global_load_lds((const unsigned*)((const char*)(gbase) + (voff)[_i]), (PG8_LAS unsigned*)(lds + (bufoff) + ldsw + _i * 8192), 16, 0, 0); } while (0)
#define PG8_LDA(dst, b, h) do { _Pragma("unroll") for (int m = 0; m < 4; ++m) _Pragma("unroll") for (int k = 0; k < 2; ++k) dst[m][k] = *(const PG8_LAS bf16x8*)(lds + PG8_SA(b, h) + aoff + m * 2048 + k * 1024); } while (0)
#define PG8_LDB(dst, b, h) do { _Pragma("unroll") for (int n = 0; n < 2; ++n) _Pragma("unroll") for (int k = 0; k < 2; ++k) dst[n][k] = *(const PG8_LAS bf16x8*)(lds + PG8_SB(b, h) + boff + n * 2048 + k * 1024); } while (0)
#define PG8_MMA(ai, bj, At, Bt) do { __builtin_amdgcn_s_setprio(1); _Pragma("unroll") for (int m = 0; m < 4; ++m) _Pragma("unroll") for (int n = 0; n < 2; ++n) _Pragma("unroll") for (int k = 0; k < 2; ++k) \
        acc[ai][bj][m][n] = __builtin_amdgcn_mfma_f32_16x16x32_bf16(Bt[n][k], At[m][k], acc[ai][bj][m][n], 0, 0, 0); __builtin_amdgcn_s_setprio(0); } while (0)
#define PG8_WAIT_V(n) asm volatile("s_waitcnt vmcnt(" #n ")" ::: "memory")
#define PG8_WAIT_L(n) asm volatile("s_waitcnt lgkmcnt(" #n ")" ::: "memory")
#define PG8_BAR __builtin_amdgcn_s_barrier()
#define PG8_SCHED __builtin_amdgcn_sched_barrier(0)
    Unit cur, nxt; int ui = 0;
    if (!S.next(0, cur)) return;
    f32x4 acc[2][2][4][2];
#pragma unroll
    for (int a = 0; a < 2; ++a)
#pragma unroll
        for (int b = 0; b < 2; ++b)
#pragma unroll
            for (int m = 0; m < 4; ++m)
#pragma unroll
                for (int n = 0; n < 2; ++n) acc[a][b][m][n] = (f32x4){0.f, 0.f, 0.f, 0.f};
    bf16x8 At[4][2], B0[2][2], B1[2][2];
    const char* cA = (const char*)g.A + (size_t)cur.pm * tstep; const char* cB = (const char*)g.Bt + (size_t)cur.pn * tstep;
    S.a_ready(cur);
    if constexpr (SP2) {
        PG8_STAGE(PG8_SB(0, 0), cB, voffB); PG8_STAGE(PG8_SB(0, 1), cB + hstep, voffB); PG8_STAGE(PG8_SA(0, 0), cA, voffA); PG8_STAGE(PG8_SA(0, 1), cA + hstep, voffA);
        if (wr == 1) PG8_BAR;
        PG8_WAIT_V(2); PG8_BAR;
        PG8_STAGE(PG8_SB(1, 0), cB + kstep, voffB); PG8_STAGE(PG8_SA(1, 0), cA + kstep, voffA); PG8_STAGE(PG8_SB(1, 1), cB + hstep + kstep, voffB);
        PG8_WAIT_V(6); PG8_BAR;
    } else {
        PG8_STAGE(PG8_SB(0, 0), cB, voffB); PG8_STAGE(PG8_SA(0, 0), cA, voffA); PG8_STAGE(PG8_SB(0, 1), cB + hstep, voffB); PG8_STAGE(PG8_SA(0, 1), cA + hstep, voffA);
        if (wr == 1) PG8_BAR;
        PG8_WAIT_V(4); PG8_BAR;
        PG8_STAGE(PG8_SB(1, 0), cB + kstep, voffB); PG8_STAGE(PG8_SA(1, 0), cA + kstep, voffA); PG8_STAGE(PG8_SB(1, 1), cB + hstep + kstep, voffB);
        PG8_WAIT_V(6); PG8_BAR;
    }
    for (;;) {
        const bool has_next = S.next(ui + 1, nxt);
        const char* nA = has_next ? (const char*)g.A + (size_t)nxt.pm * tstep : cA; const char* nB = has_next ? (const char*)g.Bt + (size_t)nxt.pn * tstep : cB;
        for (int t = 0; t < nt; t += 2) {
            const bool last = (t == nt - 2);
            const char* a1 = cA + (size_t)(t + 1) * kstep;
            const char* a2 = last ? nA : cA + (size_t)(t + 2) * kstep; const char* b2 = last ? nB : cB + (size_t)(t + 2) * kstep;
            const char* a3 = a2 + kstep; const char* b3 = b2 + kstep;
            if (last && has_next) S.a_ready(nxt);
            if constexpr (SP2) {
            PG8_LDB(B0, 0, 0); PG8_LDB(B1, 0, 1); PG8_SCHED; PG8_LDA(At, 0, 0); PG8_STAGE(PG8_SA(1, 1), a1 + hstep, voffA);
            PG8_WAIT_V(8); PG8_WAIT_L(0); PG8_BAR; PG8_MMA(0, 0, At, B0); PG8_MMA(0, 1, At, B1); PG8_BAR; PG8_SCHED;
            PG8_LDA(At, 0, 1); PG8_STAGE(PG8_SB(0, 0), b2, voffB); PG8_STAGE(PG8_SB(0, 1), b2 + hstep, voffB); PG8_STAGE(PG8_SA(0, 0), a2, voffA);
            PG8_WAIT_V(8); PG8_WAIT_L(0); PG8_BAR; PG8_MMA(1, 0, At, B0); PG8_MMA(1, 1, At, B1); PG8_BAR; PG8_SCHED;
            PG8_LDB(B0, 1, 0); PG8_LDB(B1, 1, 1); PG8_SCHED; PG8_LDA(At, 1, 0); PG8_STAGE(PG8_SA(0, 1), a2 + hstep, voffA);
            PG8_WAIT_V(8); PG8_WAIT_L(0); PG8_BAR; PG8_MMA(0, 0, At, B0); PG8_MMA(0, 1, At, B1); PG8_BAR; PG8_SCHED;
            PG8_LDA(At, 1, 1); PG8_STAGE(PG8_SB(1, 0), b3, voffB); PG8_STAGE(PG8_SB(1, 1), b3 + hstep, voffB); PG8_STAGE(PG8_SA(1, 0), a3, voffA);
            PG8_WAIT_V(8); PG8_WAIT_L(0); PG8_BAR; PG8_MMA(1, 0, At, B0); PG8_MMA(1, 1, At, B1); PG8_BAR; PG8_SCHED;
            } else {
            PG8_LDB(B0, 0, 0); PG8_SCHED; PG8_LDA(At, 0, 0); PG8_STAGE(PG8_SA(1, 1), a1 + hstep, voffA);
            PG8_WAIT_L(8); PG8_BAR; PG8_WAIT_L(0); PG8_MMA(0, 0, At, B0); PG8_BAR; PG8_SCHED;
            PG8_LDB(B1, 0, 1); PG8_STAGE(PG8_SB(0, 0), b2, voffB);
            PG8_BAR; PG8_WAIT_L(0); PG8_MMA(0, 1, At, B1); PG8_BAR;
            PG8_LDA(At, 0, 1); PG8_STAGE(PG8_SA(0, 0), a2, voffA);
            PG8_BAR; PG8_WAIT_L(0); PG8_MMA(1, 0, At, B0); PG8_BAR; PG8_SCHED;
            PG8_STAGE(PG8_SB(0, 1), b2 + hstep, voffB);
            PG8_WAIT_V(6); PG8_BAR; PG8_MMA(1, 1, At, B1); PG8_BAR;
            PG8_LDB(B0, 1, 0); PG8_SCHED; PG8_LDA(At, 1, 0); PG8_STAGE(PG8_SA(0, 1), a2 + hstep, voffA);
            PG8_WAIT_L(8); PG8_BAR; PG8_WAIT_L(0); PG8_MMA(0, 0, At, B0); PG8_BAR; PG8_SCHED;
            PG8_LDB(B1, 1, 1); PG8_STAGE(PG8_SB(1, 0), b3, voffB);
            PG8_BAR; PG8_WAIT_L(0); PG8_MMA(0, 1, At, B1); PG8_BAR;
            PG8_LDA(At, 1, 1); PG8_STAGE(PG8_SA(1, 0), a3, voffA);
            PG8_BAR; PG8_WAIT_L(0); PG8_MMA(1, 0, At, B0); PG8_BAR; PG8_SCHED;
            PG8_STAGE(PG8_SB(1, 1), b3 + hstep, voffB);
            PG8_WAIT_V(6); PG8_BAR; PG8_MMA(1, 1, At, B1); PG8_BAR;
            }
        }
        if constexpr (ALIGN_EPI) { if (wr == 0) PG8_BAR; }
        if constexpr (!Epi::AFTER_DRAIN) { E(acc, cur, wr, wc, fr, fq); S.done(cur); }
        if (!has_next) break;
#pragma unroll
        for (int a = 0; a < 2; ++a)
#pragma unroll
            for (int b = 0; b < 2; ++b)
#pragma unroll
                for (int m = 0; m < 4; ++m)
#pragma unroll
                    for (int n = 0; n < 2; ++n) acc[a][b][m][n] = (f32x4){0.f, 0.f, 0.f, 0.f};
        cur = nxt; cA = nA; cB = nB; ++ui;
        if constexpr (ALIGN_EPI) { if (wr == 1) PG8_BAR; }
    }
    PG8_WAIT_V(0);
    if constexpr (!ALIGN_EPI) { if (wr == 0) PG8_BAR; }
    PG8_BAR;
    if constexpr (Epi::AFTER_DRAIN) { E.fused(acc, cur, wr, wc, fr, fq, lds, wid, lane); S.done(cur); }
#undef PG8_SA
#undef PG8_SB
#undef PG8_STAGE
#undef PG8_LDA
#undef PG8_LDB
#undef PG8_MMA
#undef PG8_WAIT_V
#undef PG8_WAIT_L
#undef PG8_BAR
#undef PG8_SCHED
}
}

template <class F> DI void epi_rows(const pg8::f32x4 (&acc)[2][2][4][2], const pg8::Unit& u, int wr, int wc, int fr, int fq, F f) {
#pragma unroll
    for (int ai = 0; ai < 2; ++ai)
#pragma unroll
        for (int m = 0; m < 4; ++m) {
            const int row = u.pm * 256 + ai * 128 + wr * 64 + m * 16 + fr;
#pragma unroll
            for (int bj = 0; bj < 2; ++bj) f(row, u.pn * 256 + bj * 128 + wc * 32 + 8 * fq, acc[ai][bj][m][0], acc[ai][bj][m][1]);
        }
}
DI u32x4 pack8(const f32x4& a, const f32x4& b) { u32x4 w; w.x = pack2(a[0], a[1]); w.y = pack2(a[2], a[3]); w.z = pack2(b[0], b[1]); w.w = pack2(b[2], b[3]); return w; }
struct EpiProj {
    static constexpr bool PERM = true, AFTER_DRAIN = false;
    unsigned char* ws;
    DI void operator()(const pg8::f32x4 (&acc)[2][2][4][2], const pg8::Unit& u, int wr, int wc, int fr, int fq) const {
        const int pn = u.pn;
        if (pn < 12) {
            bf16_t* dst; int ld, cofs;
            if (pn < 6) { dst = (bf16_t*)(ws + OFF_GQKV); ld = 1536; cofs = 0; }
            else if (pn < 8) { dst = (bf16_t*)(ws + OFF_Z); ld = 512; cofs = 1536; }
            else { dst = (bf16_t*)(ws + OFF_FQK); ld = 1024; cofs = 2048; }
            epi_rows(acc, u, wr, wc, fr, fq, [&](int row, int col, const f32x4& a, const f32x4& b) { *(u32x4*)(dst + (size_t)row * ld + (col - cofs)) = pack8(a, b); });
        } else if (pn < 14) {
            bf16_t* vT = (bf16_t*)(ws + OFF_VT);
            epi_rows(acc, u, wr, wc, fr, fq, [&](int row, int col, const f32x4& a, const f32x4& b) {
                const int c = col - 3072, hh = c >> 6, d0 = c & 63, bb = row >> 11, t = row & 2047;
                bf16_t* p = vT + ((size_t)(bb * 8 + hh) * 64 + d0) * TSEQ + t;
#pragma unroll
                for (int e = 0; e < 4; ++e) { p[(size_t)e * TSEQ] = (bf16_t)f2bf(a[e]); p[(size_t)(e + 4) * TSEQ] = (bf16_t)f2bf(b[e]); }
            });
        } else {
            float* gates = (float*)(ws + OFF_GATES);
            epi_rows(acc, u, wr, wc, fr, fq, [&](int row, int col, const f32x4& a, const f32x4& b) {
                const int c = col - 3584;
                if (c < 16) { *(f32x4*)(gates + (size_t)row * 16 + c) = a; *(f32x4*)(gates + (size_t)row * 16 + c + 4) = b; }
            });
        }
    }
};
struct EpiOutProj {
    static constexpr bool PERM = true, AFTER_DRAIN = false;
    const float* x; const float* g; const float* b; const float* stats; float* out;
    DI void operator()(const pg8::f32x4 (&acc)[2][2][4][2], const pg8::Unit& u, int wr, int wc, int fr, int fq) const {
        epi_rows(acc, u, wr, wc, fr, fq, [&](int row, int col, const f32x4& a0, const f32x4& a1) {
            const float mu = stats[row * 2], rs = stats[row * 2 + 1];
            const size_t idx = (size_t)row * DM + col;
            const f32x4 x0 = *(const f32x4*)(x + idx), x1 = *(const f32x4*)(x + idx + 4);
            const f32x4 g0 = *(const f32x4*)(g + col), g1 = *(const f32x4*)(g + col + 4), b0 = *(const f32x4*)(b + col), b1 = *(const f32x4*)(b + col + 4);
            *(f32x4*)(out + idx) = ((x0 - mu) * rs * g0 + b0) * ALPHA + a0;
            *(f32x4*)(out + idx + 4) = ((x1 - mu) * rs * g1 + b1) * ALPHA + a1;
        });
    }
};
struct EpiUp {
    static constexpr bool PERM = true, AFTER_DRAIN = false;
    bf16_t* ffb;
    DI void operator()(const pg8::f32x4 (&acc)[2][2][4][2], const pg8::Unit& u, int wr, int wc, int fr, int fq) const {
        epi_rows(acc, u, wr, wc, fr, fq, [&](int row, int col, const f32x4& a, const f32x4& b) {
            f32x4 ra, rb;
#pragma unroll
            for (int e = 0; e < 4; ++e) { const float va = fmaxf(a[e], 0.f), vb = fmaxf(b[e], 0.f); ra[e] = va * va; rb[e] = vb * vb; }
            *(u32x4*)(ffb + (size_t)row * 4096 + col) = pack8(ra, rb);
        });
    }
};
struct EpiGate {
    static constexpr bool PERM = true, AFTER_DRAIN = false;
    bf16_t* pg; const float* bias;
    DI void operator()(const pg8::f32x4 (&acc)[2][2][4][2], const pg8::Unit& u, int wr, int wc, int fr, int fq) const {
        f32x4 bv[2][2];
#pragma unroll
        for (int bj = 0; bj < 2; ++bj) { const int c0 = u.pn * 256 + bj * 128 + wc * 32 + 8 * fq; bv[bj][0] = *(const f32x4*)(bias + c0); bv[bj][1] = *(const f32x4*)(bias + c0 + 4); }
        epi_rows(acc, u, wr, wc, fr, fq, [&](int row, int col, const f32x4& a, const f32x4& b) {
            const int bj = (col >> 7) & 1;
            const f32x4 b0 = bv[bj][0], b1 = bv[bj][1];
            f32x4 ra, rb;
#pragma unroll
            for (int e = 0; e < 4; ++e) { ra[e] = sigmoidf_(a[e] + b0[e]); rb[e] = sigmoidf_(b[e] + b1[e]); }
            *(u32x4*)(pg + (size_t)row * DM + col) = pack8(ra, rb);
        });
    }
};
struct EpiPle {
    static constexpr bool PERM = true, AFTER_DRAIN = false;
    bf16_t* pg;
    DI void operator()(const pg8::f32x4 (&acc)[2][2][4][2], const pg8::Unit& u, int wr, int wc, int fr, int fq) const {
        epi_rows(acc, u, wr, wc, fr, fq, [&](int row, int col, const f32x4& a, const f32x4& b) {
            u32x4* p = (u32x4*)(pg + (size_t)row * DM + col);
            const u32x4 w = *p;
            f32x4 ra, rb;
            ra[0] = a[0] * bflo(w.x); ra[1] = a[1] * bfhi(w.x); ra[2] = a[2] * bflo(w.y); ra[3] = a[3] * bfhi(w.y);
            rb[0] = b[0] * bflo(w.z); rb[1] = b[1] * bfhi(w.z); rb[2] = b[2] * bflo(w.w); rb[3] = b[3] * bfhi(w.w);
            *p = pack8(ra, rb);
        });
    }
};
struct EpiDown {
    static constexpr bool PERM = true, AFTER_DRAIN = false;
    const bf16_t* pg; float* out;
    DI void operator()(const pg8::f32x4 (&acc)[2][2][4][2], const pg8::Unit& u, int wr, int wc, int fr, int fq) const {
        epi_rows(acc, u, wr, wc, fr, fq, [&](int row, int col, const f32x4& a, const f32x4& b) {
            const size_t idx = (size_t)row * DM + col;
            const u32x4 w = *(const u32x4*)(pg + idx);
            f32x4 o0 = *(const f32x4*)(out + idx), o1 = *(const f32x4*)(out + idx + 4);
            o0 = o0 * ALPHA + a; o1 = o1 * ALPHA + b;
            o0[0] += bflo(w.x); o0[1] += bfhi(w.x); o0[2] += bflo(w.y); o0[3] += bfhi(w.y);
            o1[0] += bflo(w.z); o1[1] += bfhi(w.z); o1[2] += bflo(w.w); o1[3] += bfhi(w.w);
            *(f32x4*)(out + idx) = o0; *(f32x4*)(out + idx + 4) = o1;
        });
    }
};
DI void lds_read8(unsigned addr, f32x4 (&a)[4][2]) {
    asm volatile(
        "ds_read_b128 %0, %8\n\tds_read_b128 %1, %8 offset:16\n\t"
        "ds_read_b128 %2, %8 offset:256\n\tds_read_b128 %3, %8 offset:272\n\t"
        "ds_read_b128 %4, %8 offset:512\n\tds_read_b128 %5, %8 offset:528\n\t"
        "ds_read_b128 %6, %8 offset:768\n\tds_read_b128 %7, %8 offset:784\n\t"
        "s_waitcnt lgkmcnt(0)"
        : "=&v"(a[0][0]), "=&v"(a[0][1]), "=&v"(a[1][0]), "=&v"(a[1][1]), "=&v"(a[2][0]), "=&v"(a[2][1]), "=&v"(a[3][0]), "=&v"(a[3][1])
        : "v"(addr) : "memory");
}
DI void lds_read8s(unsigned addr, f32x4 (&a)[4][2]) {
    asm volatile(
        "ds_read_b128 %0, %8\n\tds_read_b128 %1, %8 offset:16\n\t"
        "ds_read_b128 %2, %8 offset:128\n\tds_read_b128 %3, %8 offset:144\n\t"
        "ds_read_b128 %4, %8 offset:256\n\tds_read_b128 %5, %8 offset:272\n\t"
        "ds_read_b128 %6, %8 offset:384\n\tds_read_b128 %7, %8 offset:400\n\t"
        "s_waitcnt lgkmcnt(0)"
        : "=&v"(a[0][0]), "=&v"(a[0][1]), "=&v"(a[1][0]), "=&v"(a[1][1]), "=&v"(a[2][0]), "=&v"(a[2][1]), "=&v"(a[3][0]), "=&v"(a[3][1])
        : "v"(addr) : "memory");
}
DI void prep_chunk(const Params& P, int ci, unsigned char* smem, int tt) {
    const int tid = tt, lane = tid & 63, wave = tid >> 6, r = lane & 31, h2 = lane >> 5;
    const int b = ci >> 7, hd = (ci >> 5) & 3, n = ci & 31, t0 = n * 64;
    const size_t rowbase = (size_t)b * TSEQ + t0;
    bf16_t* kbf = (bf16_t*)smem;
    bf16_t* qbf = kbf + 64 * 136;
    bf16_t* vT  = (bf16_t*)smem;
    bf16_t* Tb  = (bf16_t*)(smem + 18432);
    bf16_t* Tg  = (bf16_t*)(smem + 27648);
    bf16_t* kT  = (bf16_t*)(smem + 36864);
    float*  Ad  = (float*)(smem + 55296);
    bf16_t* A10 = (bf16_t*)(smem + 63488);
    bf16_t* DT  = (bf16_t*)(smem + 66048);
    float* sbeta = (float*)(smem + 71168);
    float* sgam = sbeta + 64; float* segam = sgam + 64; float* sdk = segam + 64;
    bf16_t* D1R = (bf16_t*)(smem + 72192);
    const bf16_t* gq = (const bf16_t*)(P.ws + OFF_GQKV);
    const float* gates = (const float*)(P.ws + OFF_GATES);
    const float* cw = P.in[5];
    if (tid < 64) {
        const float* gt = gates + (rowbase + tid) * 16;
        const float be = sigmoidf_(gt[hd]);
        const float a = gt[4 + hd] + P.in[7][hd];
        const float sp = fmaxf(a, 0.f) + log1pf(__expf(-fabsf(a)));
        float lg = -__expf(P.in[6][hd]) * sp;
#pragma unroll
        for (int o = 1; o < 64; o <<= 1) { const float t = shup(lg, o, lane); if (lane >= o) lg += t; }
        const float gl = shlane(lg, 63);
        sbeta[tid] = be; sgam[tid] = lg; segam[tid] = __expf(lg); sdk[tid] = __expf(gl - lg);
    }
    {
        float* wl = Ad;
        for (int idx = tid; idx < 384; idx += 256) {
            const int wh = idx >> 7, rem = idx & 127, j = rem >> 5, c4 = (rem & 31) * 4;
            const int cbw = (wh == 0 ? 512 : wh == 1 ? 0 : 1024) + hd * 128;
            *(f32x4*)(wl + (wh * 4 + j) * 128 + c4) = *(const f32x4*)(cw + j * 1536 + cbw + c4);
        }
    }
    __syncthreads();
    unsigned vkeep[16];
#pragma unroll
    for (int e = 0; e < 16; ++e) vkeep[e] = 0u;
    {
        const int i = tid >> 2, seg = tid & 3;
        const float* wl = Ad;
#pragma unroll 1
        for (int which = 0; which < 3; ++which) {
            const int colbase = (which == 0 ? 512 : which == 1 ? 0 : 1024) + hd * 128 + seg * 32;
            u32x4 xr[4][4];
#pragma unroll
            for (int j = 0; j < 4; ++j) {
                const int t = t0 + i - 3 + j;
                const int tc = t < 0 ? 0 : t;
                const bf16_t* xp = gq + ((size_t)b * TSEQ + tc) * 1536 + colbase;
#pragma unroll
                for (int sub = 0; sub < 4; ++sub) xr[j][sub] = *(const u32x4*)(xp + sub * 8);
            }
            float val[32];
#pragma unroll
            for (int sub = 0; sub < 4; ++sub) {
                float a8[8];
#pragma unroll
                for (int e = 0; e < 8; ++e) a8[e] = 0.f;
#pragma unroll
                for (int j = 0; j < 4; ++j) {
                    const float mk = (t0 + i - 3 + j) < 0 ? 0.f : 1.f;
                    const u32x4 xv = xr[j][sub];
                    f32x4 w0 = *(const f32x4*)(wl + (which * 4 + j) * 128 + seg * 32 + sub * 8), w1 = *(const f32x4*)(wl + (which * 4 + j) * 128 + seg * 32 + sub * 8 + 4);
                    w0 = w0 * mk; w1 = w1 * mk;
                    a8[0] += w0[0] * bflo(xv.x); a8[1] += w0[1] * bfhi(xv.x); a8[2] += w0[2] * bflo(xv.y); a8[3] += w0[3] * bfhi(xv.y);
                    a8[4] += w1[0] * bflo(xv.z); a8[5] += w1[1] * bfhi(xv.z); a8[6] += w1[2] * bflo(xv.w); a8[7] += w1[3] * bfhi(xv.w);
                }
#pragma unroll
                for (int e = 0; e < 8; ++e) val[sub * 8 + e] = siluf(a8[e]);
            }
            float ss = 0.f;
#pragma unroll
            for (int e = 0; e < 32; ++e) ss += val[e] * val[e];
            ss += shx(ss, 1, lane); ss += shx(ss, 2, lane);
            const float sc = (which == 2) ? 1.f : rsqrtf(ss + 1e-6f) * (which == 1 ? 0.08838834764831845f : 1.f);
            unsigned pk[16];
#pragma unroll
            for (int e = 0; e < 16; ++e) pk[e] = pack2(val[2 * e] * sc, val[2 * e + 1] * sc);
            if (which == 2) {
#pragma unroll
                for (int e = 0; e < 16; ++e) vkeep[e] = pk[e];
            } else {
                bf16_t* dst = (which == 0 ? kbf : qbf) + i * 136 + seg * 32;
#pragma unroll
                for (int sub = 0; sub < 4; ++sub) { u32x4 o; o.x = pk[4 * sub]; o.y = pk[4 * sub + 1]; o.z = pk[4 * sub + 2]; o.w = pk[4 * sub + 3]; *(u32x4*)(dst + sub * 8) = o; }
                if (which == 0) {
                    bf16_t* kt = kT + (seg * 32) * 72 + i;
#pragma unroll
                    for (int e = 0; e < 16; ++e) { kt[(2 * e) * 72] = (bf16_t)(pk[e] & 0xffffu); kt[(2 * e + 1) * 72] = (bf16_t)(pk[e] >> 16); }
                }
            }
        }
    }
    __syncthreads();
    {
        const int mi = wave >> 1, ni = wave & 1;
        f32x16 aK, aQ;
#pragma unroll
        for (int e = 0; e < 16; ++e) { aK[e] = 0.f; aQ[e] = 0.f; }
#pragma unroll
        for (int ks = 0; ks < 8; ++ks) {
            const bf16x8 ak = *(const bf16x8*)(kbf + (mi * 32 + r) * 136 + ks * 16 + h2 * 8);
            const bf16x8 bk = *(const bf16x8*)(kbf + (ni * 32 + r) * 136 + ks * 16 + h2 * 8);
            const bf16x8 aq = *(const bf16x8*)(qbf + (mi * 32 + r) * 136 + ks * 16 + h2 * 8);
            aK = MFMA32(ak, bk, aK); aQ = MFMA32(aq, bk, aQ);
        }
        const int j = ni * 32 + r;
        const float gj = sgam[j];
        bf16_t* qkout = (bf16_t*)(P.ws + OFF_QK) + (size_t)ci * 4096;
#pragma unroll
        for (int e = 0; e < 16; ++e) {
            const int il = crow(e, h2), i = mi * 32 + il;
            const float dec = (i >= j) ? __expf(sgam[i] - gj) : 0.f;
            const float aij = (i > j) ? aK[e] * sbeta[i] * dec : 0.f;
            if (mi == ni) Ad[(mi * 32 + il) * 32 + r] = aij;
            else if (mi == 1) A10[il * 40 + r] = (bf16_t)f2bf(aij);
            qkout[(((i >> 5) * 4 + (j >> 4)) * 64 + (i & 31) + 32 * ((j >> 3) & 1)) * 8 + (j & 7)] = (bf16_t)f2bf((i >= j) ? aQ[e] * dec : 0.f);
        }
    }
    {
        const int i = tid >> 2, seg = tid & 3;
        const float eg = segam[i];
        bf16_t* qd = (bf16_t*)(P.ws + OFF_QD) + (size_t)ci * 8192;
#pragma unroll
        for (int sub = 0; sub < 4; ++sub) {
            const u32x4 v = *(const u32x4*)(qbf + i * 136 + seg * 32 + sub * 8);
            u32x4 o;
            o.x = pack2(bflo(v.x) * eg, bfhi(v.x) * eg); o.y = pack2(bflo(v.y) * eg, bfhi(v.y) * eg);
            o.z = pack2(bflo(v.z) * eg, bfhi(v.z) * eg); o.w = pack2(bflo(v.w) * eg, bfhi(v.w) * eg);
            *(u32x4*)(qd + ((((i >> 5) * 8 + seg * 2 + (sub >> 1)) * 64 + (i & 31) + 32 * (sub & 1)) * 8)) = o;
        }
        const int kidx = tid >> 1, cs = (tid & 1) * 32;
        bf16_t* kd = (bf16_t*)(P.ws + OFF_KDT) + (size_t)ci * 8192;
#pragma unroll
        for (int sub = 0; sub < 4; ++sub) {
            const u32x4 v = *(const u32x4*)(kT + kidx * 72 + cs + sub * 8);
            const f32x4 d0 = *(const f32x4*)(sdk + cs + sub * 8), d1 = *(const f32x4*)(sdk + cs + sub * 8 + 4);
            u32x4 o;
            o.x = pack2(bflo(v.x) * d0[0], bfhi(v.x) * d0[1]); o.y = pack2(bflo(v.y) * d0[2], bfhi(v.y) * d0[3]);
            o.z = pack2(bflo(v.z) * d1[0], bfhi(v.z) * d1[1]); o.w = pack2(bflo(v.w) * d1[2], bfhi(v.w) * d1[3]);
            *(u32x4*)(kd + ((((kidx >> 5) * 4 + ((cs + sub * 8) >> 4)) * 64 + (kidx & 31) + 32 * (sub & 1)) * 8)) = o;
        }
        if (tid == 0) ((float*)(P.ws + OFF_GLAST))[ci] = segam[63];
    }
    __syncthreads();
    {
        const int i = tid >> 2, seg = tid & 3;
        bf16_t* vt = vT + (seg * 32) * 72 + i;
#pragma unroll
        for (int e = 0; e < 16; ++e) { vt[(2 * e) * 72] = (bf16_t)(vkeep[e] & 0xffffu); vt[(2 * e + 1) * 72] = (bf16_t)(vkeep[e] >> 16); }
        if (tid >= 64) {
            for (int idx = tid - 64; idx < 1024; idx += 192) { const int rr = idx >> 5, cc = 32 + (idx & 31); Tb[rr * 72 + cc] = 0; Tg[rr * 72 + cc] = 0; }
        } else {
            const int blk = tid >> 5, c = tid & 31;
            float x[32];
#pragma unroll
            for (int e = 0; e < 32; ++e) x[e] = (e == c) ? 1.f : 0.f;
            const unsigned ad_lds = (unsigned)(size_t)(Ad + blk * 1024);
#pragma unroll
            for (int ib = 0; ib < 8; ++ib) {
                const int i0 = ib * 4;
                float s0 = x[i0], s1 = x[i0 + 1], s2 = x[i0 + 2], s3 = x[i0 + 3];
#pragma unroll
                for (int mb = 0; mb <= ib; mb += 2) {
                    f32x4 a[4][2];
                    lds_read8s(ad_lds + (unsigned)((i0 * 32 + mb * 4) * 4), a);
#pragma unroll
                    for (int cb = 0; cb < 2; ++cb) {
                        const int m4 = mb + cb;
                        if (m4 < ib) {
#pragma unroll
                            for (int e = 0; e < 4; ++e) {
                                const float xx = x[m4 * 4 + e];
                                s0 -= a[0][cb][e] * xx; s1 -= a[1][cb][e] * xx; s2 -= a[2][cb][e] * xx; s3 -= a[3][cb][e] * xx;
                            }
                        } else if (m4 == ib) {
                            s1 -= a[1][cb][0] * s0;
                            s2 -= a[2][cb][0] * s0; s2 -= a[2][cb][1] * s1;
                            s3 -= a[3][cb][0] * s0; s3 -= a[3][cb][1] * s1; s3 -= a[3][cb][2] * s2;
                        }
                    }
                    __builtin_amdgcn_sched_barrier(0);
                }
                x[i0] = s0; x[i0 + 1] = s1; x[i0 + 2] = s2; x[i0 + 3] = s3;
            }
            bf16_t* dt = DT + (blk * 32 + c) * 40;
#pragma unroll
            for (int q4 = 0; q4 < 4; ++q4) {
                u32x4 o; o.x = pack2(x[8 * q4], x[8 * q4 + 1]); o.y = pack2(x[8 * q4 + 2], x[8 * q4 + 3]); o.z = pack2(x[8 * q4 + 4], x[8 * q4 + 5]); o.w = pack2(x[8 * q4 + 6], x[8 * q4 + 7]);
                *(u32x4*)(dt + q4 * 8) = o;
            }
            const int cg = blk * 32 + c;
            const float bc = sbeta[cg], bg = bc * segam[cg];
#pragma unroll
            for (int rr = 0; rr < 32; ++rr) {
                if (blk == 1) D1R[rr * 40 + c] = (bf16_t)f2bf(x[rr]);
                Tb[(blk * 32 + rr) * 72 + cg] = (bf16_t)f2bf(x[rr] * bc);
                Tg[(blk * 32 + rr) * 72 + cg] = (bf16_t)f2bf(x[rr] * bg);
            }
        }
    }
    __syncthreads();
    if (wave == 0) {
        f32x16 Pm, Qm;
#pragma unroll
        for (int e = 0; e < 16; ++e) { Pm[e] = 0.f; Qm[e] = 0.f; }
#pragma unroll
        for (int ks = 0; ks < 2; ++ks) {
            const bf16x8 a = *(const bf16x8*)(A10 + r * 40 + ks * 16 + h2 * 8);
            const bf16x8 bb = *(const bf16x8*)(DT + r * 40 + ks * 16 + h2 * 8);
            Pm = MFMA32(a, bb, Pm);
        }
#pragma unroll
        for (int sq = 0; sq < 2; ++sq) {
            u32x4 pw;
            pw.x = pack2(Pm[8 * sq + 0], Pm[8 * sq + 1]); pw.y = pack2(Pm[8 * sq + 2], Pm[8 * sq + 3]);
            pw.z = pack2(Pm[8 * sq + 4], Pm[8 * sq + 5]); pw.w = pack2(Pm[8 * sq + 6], Pm[8 * sq + 7]);
            const bf16_t* dp = D1R + r * 40 + 16 * sq + 4 * h2;
            const u32x2 lo = *(const u32x2*)dp, hi = *(const u32x2*)(dp + 8);
            u32x4 aw; aw.x = lo.x; aw.y = lo.y; aw.z = hi.x; aw.w = hi.y;
            Qm = MFMA32(__builtin_bit_cast(bf16x8, aw), __builtin_bit_cast(bf16x8, pw), Qm);
        }
        const float bc = sbeta[r], bg = bc * segam[r];
#pragma unroll
        for (int e = 0; e < 16; ++e) {
            const int il = crow(e, h2);
            Tb[(32 + il) * 72 + r] = (bf16_t)f2bf(-Qm[e] * bc);
            Tg[(32 + il) * 72 + r] = (bf16_t)f2bf(-Qm[e] * bg);
        }
    }
    __syncthreads();
    {
        const int nt = wave;
        f32x16 aU[2], aW[2];
#pragma unroll
        for (int e = 0; e < 16; ++e) { aU[0][e] = 0.f; aU[1][e] = 0.f; aW[0][e] = 0.f; aW[1][e] = 0.f; }
#pragma unroll
        for (int ks = 0; ks < 4; ++ks) {
            const bf16x8 bv = *(const bf16x8*)(vT + (nt * 32 + r) * 72 + ks * 16 + h2 * 8);
            const bf16x8 bk = *(const bf16x8*)(kT + (nt * 32 + r) * 72 + ks * 16 + h2 * 8);
#pragma unroll
            for (int mt = 0; mt < 2; ++mt) {
                const bf16x8 ab = *(const bf16x8*)(Tb + (mt * 32 + r) * 72 + ks * 16 + h2 * 8);
                const bf16x8 ag = *(const bf16x8*)(Tg + (mt * 32 + r) * 72 + ks * 16 + h2 * 8);
                aU[mt] = MFMA32(ab, bv, aU[mt]); aW[mt] = MFMA32(ag, bk, aW[mt]);
            }
        }
        bf16_t* u = (bf16_t*)(P.ws + OFF_U) + (size_t)ci * 8192;
        bf16_t* w = (bf16_t*)(P.ws + OFF_W) + (size_t)ci * 8192;
#pragma unroll
        for (int mt = 0; mt < 2; ++mt) {
            u32x4 o0, o1;
            o0.x = pack2(aU[mt][0], aU[mt][1]); o0.y = pack2(aU[mt][2], aU[mt][3]); o0.z = pack2(aU[mt][4], aU[mt][5]); o0.w = pack2(aU[mt][6], aU[mt][7]);
            o1.x = pack2(aU[mt][8], aU[mt][9]); o1.y = pack2(aU[mt][10], aU[mt][11]); o1.z = pack2(aU[mt][12], aU[mt][13]); o1.w = pack2(aU[mt][14], aU[mt][15]);
            bf16_t* d = u + (((nt * 2 + mt) * 64 + lane) * 16);
            *(u32x4*)d = o0; *(u32x4*)(d + 8) = o1;
            bf16_t* wb = w + (((mt * 8 + nt * 2 + (r >> 4)) * 64 + 32 * ((r >> 3) & 1)) * 8) + (r & 7);
#pragma unroll
            for (int e = 0; e < 16; ++e) wb[crow(e, h2) * 8] = (bf16_t)f2bf(aW[mt][e]);
        }
    }
    __syncthreads();
}

DI void fox_cumsum(const Params& P, int bh, unsigned char* smem, int tt) {
    const int tid = tt, lane = tid & 63, wave = tid >> 6;
    const int b = bh >> 3, hh = bh & 7;
    float* wsum = (float*)smem;
    const float* gates = (const float*)(P.ws + OFF_GATES);
    const float bf = P.in[9][hh];
    float v[8]; float run = 0.f;
#pragma unroll
    for (int e = 0; e < 8; ++e) {
        const float xx = gates[((size_t)b * TSEQ + tid * 8 + e) * 16 + 8 + hh] + bf;
        const float ls = fminf(xx, 0.f) - log1pf(__expf(-fabsf(xx)));
        run += ls; v[e] = run;
    }
    float sc = run;
#pragma unroll
    for (int o = 1; o < 64; o <<= 1) { const float t = shup(sc, o, lane); if (lane >= o) sc += t; }
    if (lane == 63) wsum[wave] = sc;
    __syncthreads();
    float off = sc - run;
    for (int w = 0; w < wave; ++w) off += wsum[w];
    float* cf = (float*)(P.ws + OFF_CF) + (size_t)bh * TSEQ + tid * 8;
#pragma unroll
    for (int e = 0; e < 8; ++e) cf[e] = v[e] + off;
    __syncthreads();
}

DI void gdn_scan(const Params& P, int item, unsigned char* smem, int tt) {
    const int tid = tt, lane = tid & 63, wave = tid >> 6, r = lane & 31, h2 = lane >> 5;
    const int bh = item >> 2, vs = item & 3, b = bh >> 2, hd = bh & 3;
    const int cb = bh * 32;
    bf16_t* SbT = (bf16_t*)smem;
    bf16_t* VnT = SbT + 32 * 136;
    const bool w01 = wave < 2;
    const int mt = wave & 1;
    const bf16_t* Ubase = (const bf16_t*)(P.ws + OFF_U);
    const bf16_t* Abase = (const bf16_t*)(P.ws + (w01 ? OFF_W : OFF_QD));
    const bf16_t* Kbase = (const bf16_t*)(P.ws + OFF_KDT);
    const bf16_t* QKbase = (const bf16_t*)(P.ws + OFF_QK);
    const float* glast = (const float*)(P.ws + OFF_GLAST);
    bf16_t* og = (bf16_t*)(P.ws + OFF_OG);
    f32x16 S;
#pragma unroll
    for (int e = 0; e < 16; ++e) S[e] = 0.f;
    for (int i = tid; i < 32 * 136 / 2; i += 256) ((unsigned*)SbT)[i] = 0u;
#define SCAN_LOAD_A(AF, ci_) do { const bf16_t* ap_ = Abase + (size_t)(ci_) * 8192 + (mt * 8 * 64 + lane) * 8; \
        _Pragma("unroll") for (int ks = 0; ks < 8; ++ks) AF[ks] = *(const bf16x8*)(ap_ + ks * 512); } while (0)
#define SCAN_LOAD_K(ci_) do { const bf16_t* kp_ = Kbase + (size_t)(ci_) * 8192 + (wave * 4 * 64 + lane) * 8; \
        _Pragma("unroll") for (int ks = 0; ks < 4; ++ks) Kf[ks] = *(const bf16x8*)(kp_ + ks * 512); } while (0)
#define SCAN_LOAD_X(ci_) do { if (w01) { const bf16_t* up_ = Ubase + (size_t)(ci_) * 8192 + ((vs * 2 + mt) * 64 + lane) * 16; \
            Xa = *(const u32x4*)up_; Xb = *(const u32x4*)(up_ + 8); } \
        else { const bf16_t* qp_ = QKbase + (size_t)(ci_) * 4096 + (mt * 4 * 64 + lane) * 8; \
            Xa = *(const u32x4*)qp_; Xb = *(const u32x4*)(qp_ + 512); Xc = *(const u32x4*)(qp_ + 1024); Xd = *(const u32x4*)(qp_ + 1536); } } while (0)
#define SCAN_STEP(AF, n_) do { \
        const int cn1 = cb + ((n_) + 1 < 32 ? (n_) + 1 : 31); const int cn2 = cb + ((n_) + 2 < 32 ? (n_) + 2 : 31); \
        const float gl = shlane(glreg, (n_)); \
        f32x16 acc1; \
        bf16x8 sf[8]; \
        _Pragma("unroll") for (int ks = 0; ks < 8; ++ks) sf[ks] = *(const bf16x8*)(SbT + r * 136 + ks * 16 + h2 * 8); \
        _Pragma("unroll") for (int e = 0; e < 16; ++e) acc1[e] = 0.f; \
        __builtin_amdgcn_sched_barrier(0); \
        _Pragma("unroll") for (int ks = 0; ks < 8; ++ks) acc1 = MFMA32(AF[ks], sf[ks], acc1); \
        __builtin_amdgcn_sched_barrier(0); \
        SCAN_LOAD_A(AF, cn2); \
        if (w01) { \
            u32x2 ov; \
            ov.x = pack2(bflo(Xa.x) - acc1[0], bfhi(Xa.x) - acc1[1]); ov.y = pack2(bflo(Xa.y) - acc1[2], bfhi(Xa.y) - acc1[3]); *(u32x2*)(VnT + r * 72 + mt * 32 + 0 + 4 * h2) = ov; \
            ov.x = pack2(bflo(Xa.z) - acc1[4], bfhi(Xa.z) - acc1[5]); ov.y = pack2(bflo(Xa.w) - acc1[6], bfhi(Xa.w) - acc1[7]); *(u32x2*)(VnT + r * 72 + mt * 32 + 8 + 4 * h2) = ov; \
            ov.x = pack2(bflo(Xb.x) - acc1[8], bfhi(Xb.x) - acc1[9]); ov.y = pack2(bflo(Xb.y) - acc1[10], bfhi(Xb.y) - acc1[11]); *(u32x2*)(VnT + r * 72 + mt * 32 + 16 + 4 * h2) = ov; \
            ov.x = pack2(bflo(Xb.z) - acc1[12], bfhi(Xb.z) - acc1[13]); ov.y = pack2(bflo(Xb.w) - acc1[14], bfhi(Xb.w) - acc1[15]); *(u32x2*)(VnT + r * 72 + mt * 32 + 24 + 4 * h2) = ov; \
        } \
        __syncthreads(); \
        bf16x8 Vf[4]; \
        _Pragma("unroll") for (int ks = 0; ks < 4; ++ks) Vf[ks] = *(const bf16x8*)(VnT + r * 72 + ks * 16 + h2 * 8); \
        _Pragma("unroll") for (int e = 0; e < 16; ++e) S[e] *= gl; \
        __builtin_amdgcn_sched_barrier(0); \
        _Pragma("unroll") for (int ks = 0; ks < 4; ++ks) S = MFMA32(Kf[ks], Vf[ks], S); \
        if (!w01) { \
            acc1 = MFMA32(__builtin_bit_cast(bf16x8, Xa), Vf[0], acc1); acc1 = MFMA32(__builtin_bit_cast(bf16x8, Xb), Vf[1], acc1); \
            acc1 = MFMA32(__builtin_bit_cast(bf16x8, Xc), Vf[2], acc1); acc1 = MFMA32(__builtin_bit_cast(bf16x8, Xd), Vf[3], acc1); \
        } \
        __builtin_amdgcn_sched_barrier(0); \
        SCAN_LOAD_K(cn1); \
        SCAN_LOAD_X(cn1); \
        _Pragma("unroll") for (int g = 0; g < 4; ++g) { u32x2 ov; ov.x = pack2(S[4 * g + 0], S[4 * g + 1]); ov.y = pack2(S[4 * g + 2], S[4 * g + 3]); \
            *(u32x2*)(SbT + r * 136 + wave * 32 + 8 * g + 4 * h2) = ov; } \
        if (!w01) { \
            bf16_t* op = og + ((size_t)b * TSEQ + (n_) * 64 + mt * 32) * 512 + hd * 128 + vs * 32 + r; \
            _Pragma("unroll") for (int e = 0; e < 16; ++e) op[(size_t)crow(e, h2) * 512] = (bf16_t)f2bf(acc1[e]); \
        } \
        __syncthreads(); \
    } while (0)
    const float glreg = glast[cb + (lane & 31)];
    bf16x8 Af0[8], Af1[8], Kf[4];
    u32x4 Xa, Xb, Xc, Xd;
    Xc = Xd = (u32x4){0u, 0u, 0u, 0u};
    SCAN_LOAD_A(Af0, cb); SCAN_LOAD_K(cb); SCAN_LOAD_X(cb);
    SCAN_LOAD_A(Af1, cb + 1);
    __syncthreads();
#pragma unroll 1
    for (int n = 0; n < 32; n += 2) {
        SCAN_STEP(Af0, n);
        SCAN_STEP(Af1, n + 1);
    }
#undef SCAN_LOAD_A
#undef SCAN_LOAD_K
#undef SCAN_LOAD_X
#undef SCAN_STEP
}

DI void fox_attn(const Params& P, int bh, int qb, unsigned char* smem, int tt) {
    const int tid = tt, lane = tid & 63, wave = tid >> 6, r = lane & 31, h2 = lane >> 5;
    const int b = bh >> 3, hh = bh & 7;
    constexpr int BUFB = 2 * 64 * 72 * 2 + 256;
    constexpr float L2E = 1.4426950408889634f;
    const bf16_t* fqk = (const bf16_t*)(P.ws + OFF_FQK);
    const bf16_t* vT = (const bf16_t*)(P.ws + OFF_VT) + (size_t)bh * 64 * TSEQ;
    const float* cf = (const float*)(P.ws + OFF_CF) + (size_t)bh * TSEQ;
    const int q = qb * 128 + wave * 32 + r;
    bf16x8 Qf[4];
    {
        const bf16_t* qp = fqk + ((size_t)b * TSEQ + q) * 1024 + hh * 64 + h2 * 8;
#pragma unroll
        for (int ks = 0; ks < 4; ++ks) Qf[ks] = *(const bf16x8*)(qp + ks * 16);
    }
    const float cq = cf[q] * L2E;
    float m = -1e30f, l = 0.f;
    f32x16 O[2];
#pragma unroll
    for (int e = 0; e < 16; ++e) { O[0][e] = 0.f; O[1][e] = 0.f; }
    const int ntiles = 2 * qb + 2;
    const int srow = tid >> 3, scol = (tid & 7) * 8;
    const bf16_t* kg = fqk + ((size_t)b * TSEQ + srow) * 1024 + 512 + hh * 64 + scol;
    const bf16_t* vg = vT + (size_t)srow * TSEQ + scol;
    u32x4 rk0, rk1, rv0, rv1; float rc = 0.f;
    rk0 = *(const u32x4*)kg; rk1 = *(const u32x4*)(kg + 32 * 1024);
    rv0 = *(const u32x4*)vg; rv1 = *(const u32x4*)(vg + 32 * TSEQ);
    if (tid < 64) rc = cf[tid] * L2E;
    {
        bf16_t* Ks = (bf16_t*)smem; bf16_t* VTs = Ks + 64 * 72; float* cks = (float*)(smem + 2 * 64 * 72 * 2);
        *(u32x4*)(Ks + srow * 72 + scol) = rk0; *(u32x4*)(Ks + (srow + 32) * 72 + scol) = rk1;
        *(u32x4*)(VTs + srow * 72 + scol) = rv0; *(u32x4*)(VTs + (srow + 32) * 72 + scol) = rv1;
        if (tid < 64) cks[tid] = rc;
    }
    __syncthreads();
#pragma unroll 1
    for (int kt = 0; kt < ntiles; ++kt) {
        const unsigned char* bufc = smem + (kt & 1) * BUFB;
        const bf16_t* Ks = (const bf16_t*)bufc; const bf16_t* VTs = Ks + 64 * 72; const float* cks = (const float*)(bufc + 2 * 64 * 72 * 2);
        const bool more = kt + 1 < ntiles;
        if (more) {
            const bf16_t* kg2 = kg + (size_t)(kt + 1) * 64 * 1024; const bf16_t* vg2 = vg + (kt + 1) * 64;
            rk0 = *(const u32x4*)kg2; rk1 = *(const u32x4*)(kg2 + 32 * 1024);
            rv0 = *(const u32x4*)vg2; rv1 = *(const u32x4*)(vg2 + 32 * TSEQ);
            if (tid < 64) rc = cf[(kt + 1) * 64 + tid] * L2E;
        }
        f32x16 sacc[2];
        f32x4 ckv[2][4];
        {
            bf16x8 kf[2][4];
#pragma unroll
            for (int mt = 0; mt < 2; ++mt)
#pragma unroll
                for (int ks = 0; ks < 4; ++ks) kf[mt][ks] = *(const bf16x8*)(Ks + (mt * 32 + r) * 72 + ks * 16 + h2 * 8);
#pragma unroll
            for (int mt = 0; mt < 2; ++mt)
#pragma unroll
                for (int g = 0; g < 4; ++g) ckv[mt][g] = *(const f32x4*)(cks + mt * 32 + 8 * g + 4 * h2);
#pragma unroll
            for (int e = 0; e < 16; ++e) { sacc[0][e] = 0.f; sacc[1][e] = 0.f; }
            __builtin_amdgcn_sched_barrier(0);
#pragma unroll
            for (int ks = 0; ks < 4; ++ks) { sacc[0] = MFMA32(kf[0][ks], Qf[ks], sacc[0]); sacc[1] = MFMA32(kf[1][ks], Qf[ks], sacc[1]); }
        }
        const bool diag = kt >= ntiles - 2;
        float mx = -1e30f;
        {
            const f32x2v csc = {0.125f * L2E, 0.125f * L2E};
#pragma unroll
            for (int mt = 0; mt < 2; ++mt)
#pragma unroll
                for (int g = 0; g < 4; ++g) {
                    const f32x4 ck4 = ckv[mt][g];
                    const f32x2v c01 = {ck4[0], ck4[1]}, c23 = {ck4[2], ck4[3]};
                    const f32x2v a01 = {sacc[mt][4 * g], sacc[mt][4 * g + 1]}, a23 = {sacc[mt][4 * g + 2], sacc[mt][4 * g + 3]};
                    const f32x2v s01 = a01 * csc - c01, s23 = a23 * csc - c23;
                    sacc[mt][4 * g] = s01.x; sacc[mt][4 * g + 1] = s01.y; sacc[mt][4 * g + 2] = s23.x; sacc[mt][4 * g + 3] = s23.y;
                    mx = fmaxf(fmaxf(mx, s01.x), s01.y); mx = fmaxf(fmaxf(mx, s23.x), s23.y);
                }
        }
        if (diag) {
            mx = -1e30f;
            const int qrel = q - kt * 64 - 4 * h2;
#pragma unroll
            for (int mt = 0; mt < 2; ++mt)
#pragma unroll
                for (int e = 0; e < 16; ++e) {
                    const int krel = mt * 32 + (e & 3) + 8 * (e >> 2);
                    const float sv = (krel > qrel) ? -1e30f : sacc[mt][e];
                    sacc[mt][e] = sv;
                    mx = fmaxf(mx, sv);
                }
        }
        mx = fmaxf(mx, shx(mx, 32, lane));
        if (__builtin_amdgcn_ballot_w64(mx + cq - m > 8.f) != 0ull) {
            const float mn = fmaxf(m, mx + cq);
            const float alpha = __builtin_amdgcn_exp2f(m - mn);
            m = mn;
            l *= alpha;
            const f32x2v al2 = {alpha, alpha};
#pragma unroll
            for (int dt = 0; dt < 2; ++dt)
#pragma unroll
                for (int p2 = 0; p2 < 8; ++p2) {
                    f32x2v ov = {O[dt][2 * p2], O[dt][2 * p2 + 1]};
                    ov = ov * al2;
                    O[dt][2 * p2] = ov.x; O[dt][2 * p2 + 1] = ov.y;
                }
        }
        {
            const float sh = cq - m;
            const f32x2v sh2 = {sh, sh};
            f32x2v rs2 = {0.f, 0.f};
#pragma unroll
            for (int mt = 0; mt < 2; ++mt)
#pragma unroll
                for (int p2 = 0; p2 < 8; ++p2) {
                    const f32x2v sv = {sacc[mt][2 * p2], sacc[mt][2 * p2 + 1]};
                    const f32x2v t = sv + sh2;
                    f32x2v pp; pp.x = __builtin_amdgcn_exp2f(t.x); pp.y = __builtin_amdgcn_exp2f(t.y);
                    sacc[mt][2 * p2] = pp.x; sacc[mt][2 * p2 + 1] = pp.y;
                    rs2 = rs2 + pp;
                }
            l += rs2.x + rs2.y;
        }
        {
            u32x4 vw[2][2][2];
#pragma unroll
            for (int mt = 0; mt < 2; ++mt)
#pragma unroll
                for (int s = 0; s < 2; ++s)
#pragma unroll
                    for (int dt = 0; dt < 2; ++dt) {
                        const bf16_t* vp = VTs + (dt * 32 + r) * 72 + mt * 32 + 16 * s + 4 * h2;
                        const u32x2 lo = *(const u32x2*)vp, hi = *(const u32x2*)(vp + 8);
                        vw[mt][s][dt].x = lo.x; vw[mt][s][dt].y = lo.y; vw[mt][s][dt].z = hi.x; vw[mt][s][dt].w = hi.y;
                    }
            u32x4 pw[2][2];
#pragma unroll
            for (int mt = 0; mt < 2; ++mt)
#pragma unroll
                for (int s = 0; s < 2; ++s) {
                    pw[mt][s].x = pack2(sacc[mt][8 * s + 0], sacc[mt][8 * s + 1]); pw[mt][s].y = pack2(sacc[mt][8 * s + 2], sacc[mt][8 * s + 3]);
                    pw[mt][s].z = pack2(sacc[mt][8 * s + 4], sacc[mt][8 * s + 5]); pw[mt][s].w = pack2(sacc[mt][8 * s + 6], sacc[mt][8 * s + 7]);
                }
            __builtin_amdgcn_sched_barrier(0);
#pragma unroll
            for (int mt = 0; mt < 2; ++mt)
#pragma unroll
                for (int s = 0; s < 2; ++s) {
                    const bf16x8 pf = __builtin_bit_cast(bf16x8, pw[mt][s]);
                    O[0] = MFMA32(__builtin_bit_cast(bf16x8, vw[mt][s][0]), pf, O[0]);
                    O[1] = MFMA32(__builtin_bit_cast(bf16x8, vw[mt][s][1]), pf, O[1]);
                }
        }
        if (more) {
            unsigned char* bufn = smem + ((kt + 1) & 1) * BUFB;
            bf16_t* Kn = (bf16_t*)bufn; bf16_t* VTn = Kn + 64 * 72; float* ckn = (float*)(bufn + 2 * 64 * 72 * 2);
            *(u32x4*)(Kn + srow * 72 + scol) = rk0; *(u32x4*)(Kn + (srow + 32) * 72 + scol) = rk1;
            *(u32x4*)(VTn + srow * 72 + scol) = rv0; *(u32x4*)(VTn + (srow + 32) * 72 + scol) = rv1;
            if (tid < 64) ckn[tid] = rc;
        }
        __syncthreads();
    }
    l += shx(l, 32, lane);
    const float inv = 1.f / l;
    float ss = 0.f;
#pragma unroll
    for (int e = 0; e < 16; ++e) { O[0][e] *= inv; O[1][e] *= inv; ss += O[0][e] * O[0][e] + O[1][e] * O[1][e]; }
    ss += shx(ss, 32, lane);
    const float sc = rsqrtf(ss * (1.f / 64.f) + 1e-6f);
    bf16_t* op = (bf16_t*)(P.ws + OFF_MIX) + ((size_t)b * TSEQ + q) * 1024 + 512 + hh * 64;
    const float* fg = P.in[10];
    f32x4 ggv[2][4];
#pragma unroll
    for (int dt = 0; dt < 2; ++dt)
#pragma unroll
        for (int g = 0; g < 4; ++g) ggv[dt][g] = *(const f32x4*)(fg + dt * 32 + 8 * g + 4 * h2);
#pragma unroll
    for (int dt = 0; dt < 2; ++dt)
#pragma unroll
        for (int g = 0; g < 4; ++g) {
            const int d0 = dt * 32 + 8 * g + 4 * h2;
            const f32x4 gg = ggv[dt][g];
            u32x2 o;
            o.x = pack2(O[dt][4 * g + 0] * sc * gg[0], O[dt][4 * g + 1] * sc * gg[1]); o.y = pack2(O[dt][4 * g + 2] * sc * gg[2], O[dt][4 * g + 3] * sc * gg[3]);
            *(u32x2*)(op + d0) = o;
        }
}

#define XB_TMO      128
#define XB_XCNT(j)  (256  + 64 * (j))
#define XB_XSUB(j)  (1280 + 64 * (j))
#define XB_XGEN(j)  (2304 + 64 * (j))
#define XB_TOP      3328
#define XB_TOPGEN   3392
#define XCD_BAR_WORDS 3456
#define XB_SPIN_CAP (1u << 18)
#define LAS __attribute__((address_space(3)))
DI unsigned xb_ld(unsigned* p)              { return __hip_atomic_load(p, __ATOMIC_RELAXED, __HIP_MEMORY_SCOPE_AGENT); }
DI unsigned xb_add(unsigned* p, unsigned v) { return __hip_atomic_fetch_add(p, v, __ATOMIC_RELAXED, __HIP_MEMORY_SCOPE_AGENT); }
DI unsigned xb_xcc_id() { return (unsigned)__builtin_amdgcn_s_getreg((3 << 11) | 20) & 0xFu; }
#define XB_SPIN(cond, bar) do { unsigned _sp = 0; while (cond) { __builtin_amdgcn_s_sleep(1); \
    if ((++_sp & 255u) == 0u) { if (xb_ld(&(bar)[XB_TMO])) break; if (_sp > XB_SPIN_CAP) { atomicAdd(&(bar)[XB_TMO], 1u); break; } } } } while (0)
struct XcdBarrier { unsigned* bar; unsigned x; volatile LAS unsigned* st; };
DI XcdBarrier xcd_barrier_post(unsigned* bar, volatile LAS unsigned* st, int tid0) {
    XcdBarrier b; b.bar = bar; b.x = xb_xcc_id(); b.st = st;
    if (tid0 == 0) (void)xb_add(&bar[XB_XCNT(b.x)], 1u);
    return b;
}
DI void xcd_barrier_complete(unsigned* bar, unsigned x, unsigned& nloc, unsigned& nx) {
    const unsigned G = gridDim.x * gridDim.y * gridDim.z;
    unsigned sum, cnt, mine, sp = 0u;
    for (;;) {
        sum = 0u; cnt = 0u; mine = 0u;
#pragma unroll
        for (unsigned j = 0; j < 16; ++j) { const unsigned c = xb_ld(&bar[XB_XCNT(j)]); sum += c; cnt += (c > 0u) ? 1u : 0u; mine = (j == x) ? c : mine; }
        if (sum == G) break;
        __builtin_amdgcn_s_sleep(1);
        if ((++sp & 255u) == 0u) { if (xb_ld(&bar[XB_TMO])) break; if (sp > XB_SPIN_CAP) { atomicAdd(&bar[XB_TMO], 1u); break; } }
    }
    nloc = mine > 0u ? mine : 1u; nx = cnt > 0u ? cnt : 1u;
}
DI void xcd_barrier(const XcdBarrier& b, const int wid_s) {
    asm volatile("s_waitcnt vmcnt(0)" ::: "memory");
    __syncthreads();
    if (fresh_tid(wid_s) == 0) {
        unsigned* bar = b.bar;
        __builtin_amdgcn_s_waitcnt(0);
        unsigned nloc = b.st[0], nx = b.st[1];
        if (nloc == 0u) { xcd_barrier_complete(bar, b.x, nloc, nx); b.st[0] = nloc; b.st[1] = nx; }
        const unsigned old = xb_add(&bar[XB_XSUB(b.x)], 1u);
        const unsigned gen = old / nloc;
        if (old + 1u == (gen + 1u) * nloc) {
            __builtin_amdgcn_fence(__ATOMIC_RELEASE, "agent");
            asm volatile("s_waitcnt vmcnt(0)" ::: "memory");
            const unsigned og = xb_add(&bar[XB_TOP], 1u);
            const unsigned tg = og / nx;
            if (og + 1u == (tg + 1u) * nx) xb_add(&bar[XB_TOPGEN], 1u);
            else XB_SPIN(xb_ld(&bar[XB_TOPGEN]) == tg, bar);
            __builtin_amdgcn_fence(__ATOMIC_ACQUIRE, "agent");
            xb_add(&bar[XB_XGEN(b.x)], 1u);
            asm volatile("s_waitcnt vmcnt(0)" ::: "memory");
        } else {
            XB_SPIN(xb_ld(&bar[XB_XGEN(b.x)]) == gen, bar);
            __builtin_amdgcn_fence(__ATOMIC_ACQUIRE, "agent");
            asm volatile("s_waitcnt vmcnt(0)" ::: "memory");
        }
    }
    __syncthreads();
}


template <int MODE> struct EpiLnFused {
    static constexpr bool PERM = true, AFTER_DRAIN = true;
    const float* x; const float* g_in; const float* b_in; const float* stats;
    const bf16_t* h1; const bf16_t* pg;
    float* xbuf; unsigned* cnt; const float* g; const float* b; float* outf; bf16_t* outb;
    DI void operator()(const pg8::f32x4 (&)[2][2][4][2], const pg8::Unit&, int, int, int, int) const {}
    DI void fused(pg8::f32x4 (&acc)[2][2][4][2], const pg8::Unit& u, int wr, int wc, int fr, int fq, pg8::PG8_LAS_T ldsp, int wid, int lane) const {
        float* P = (float*)(unsigned char*)ldsp;
        float* ST = P + 2048;
        const int tid = wid * 64 + lane;
        f32x4 gi[2][2], bi[2][2];
#pragma unroll
        for (int bj = 0; bj < 2; ++bj) {
            const int col = u.pn * 256 + bj * 128 + wc * 32 + 8 * fq;
            if (MODE == 0) { gi[bj][0] = *(const f32x4*)(g_in + col); gi[bj][1] = *(const f32x4*)(g_in + col + 4); bi[bj][0] = *(const f32x4*)(b_in + col); bi[bj][1] = *(const f32x4*)(b_in + col + 4); }
        }
#pragma unroll
        for (int ai = 0; ai < 2; ++ai)
#pragma unroll
            for (int m = 0; m < 4; ++m) {
                const int rt = ai * 128 + wr * 64 + m * 16 + fr, row = u.pm * 256 + rt;
                float sm = 0.f, sq = 0.f;
                float mu = 0.f, rs = 0.f;
                if (MODE == 0) { mu = stats[row * 2]; rs = stats[row * 2 + 1]; }
#pragma unroll
                for (int bj = 0; bj < 2; ++bj) {
                    const int col = u.pn * 256 + bj * 128 + wc * 32 + 8 * fq;
                    const size_t idx = (size_t)row * DM + col;
                    f32x4 v0, v1;
                    if (MODE == 0) {
                        const f32x4 x0 = *(const f32x4*)(x + idx), x1 = *(const f32x4*)(x + idx + 4);
                        v0 = ((x0 - mu) * rs * gi[bj][0] + bi[bj][0]) * ALPHA + acc[ai][bj][m][0];
                        v1 = ((x1 - mu) * rs * gi[bj][1] + bi[bj][1]) * ALPHA + acc[ai][bj][m][1];
                    } else {
                        const u32x4 w = *(const u32x4*)(pg + idx);
                        const u32x4 hw = *(const u32x4*)(h1 + idx);
                        v0 = (f32x4){bflo(hw.x), bfhi(hw.x), bflo(hw.y), bfhi(hw.y)} * ALPHA + acc[ai][bj][m][0];
                        v1 = (f32x4){bflo(hw.z), bfhi(hw.z), bflo(hw.w), bfhi(hw.w)} * ALPHA + acc[ai][bj][m][1];
                        v0[0] += bflo(w.x); v0[1] += bfhi(w.x); v0[2] += bflo(w.y); v0[3] += bfhi(w.y);
                        v1[0] += bflo(w.z); v1[1] += bfhi(w.z); v1[2] += bflo(w.w); v1[3] += bfhi(w.w);
                    }
                    acc[ai][bj][m][0] = v0; acc[ai][bj][m][1] = v1;
#pragma unroll
                    for (int e = 0; e < 4; ++e) { sm += v0[e] + v1[e]; sq += v0[e] * v0[e] + v1[e] * v1[e]; }
                }
                sm += shx(sm, 16, lane); sm += shx(sm, 32, lane);
                sq += shx(sq, 16, lane); sq += shx(sq, 32, lane);
                if (fq == 0) { P[(rt * 4 + wc) * 2] = sm; P[(rt * 4 + wc) * 2 + 1] = sq; }
            }
        __syncthreads();
        if (tid < 256) {
            const f32x4 a = *(const f32x4*)(P + tid * 8), c = *(const f32x4*)(P + tid * 8 + 4);
            float* slot = xbuf + ((size_t)(u.pm * 256 + tid) * 4 + u.pn) * 2;
            __hip_atomic_store(slot, (a[0] + a[2]) + (c[0] + c[2]), __ATOMIC_RELAXED, __HIP_MEMORY_SCOPE_AGENT);
            __hip_atomic_store(slot + 1, (a[1] + a[3]) + (c[1] + c[3]), __ATOMIC_RELAXED, __HIP_MEMORY_SCOPE_AGENT);
        }
        asm volatile("s_waitcnt vmcnt(0)" ::: "memory");
        __syncthreads();
        if (tid == 0) {
            xb_add(cnt + u.pm, 1u);
            unsigned sp = 0;
            while (xb_ld(cnt + u.pm) < 4u) { __builtin_amdgcn_s_sleep(1); if (++sp > (1u << 22)) break; }
        }
        __syncthreads();
        if (tid < 256) {
            float* slot = xbuf + (size_t)(u.pm * 256 + tid) * 8;
            float pv[8];
#pragma unroll
            for (int e = 0; e < 8; ++e) pv[e] = __hip_atomic_load(slot + e, __ATOMIC_RELAXED, __HIP_MEMORY_SCOPE_AGENT);
            const float sm = (pv[0] + pv[2]) + (pv[4] + pv[6]), sq = (pv[1] + pv[3]) + (pv[5] + pv[7]);
            const float mean = sm * (1.f / 1024.f);
            const float var = fmaxf(sq * (1.f / 1024.f) - mean * mean, 0.f);
            ST[tid * 2] = mean; ST[tid * 2 + 1] = rsqrtf(var + 1e-5f);
        }
        __syncthreads();
        f32x4 go[2][2], bo[2][2];
#pragma unroll
        for (int bj = 0; bj < 2; ++bj) {
            const int col = u.pn * 256 + bj * 128 + wc * 32 + 8 * fq;
            go[bj][0] = *(const f32x4*)(g + col); go[bj][1] = *(const f32x4*)(g + col + 4); bo[bj][0] = *(const f32x4*)(b + col); bo[bj][1] = *(const f32x4*)(b + col + 4);
        }
#pragma unroll
        for (int ai = 0; ai < 2; ++ai)
#pragma unroll
            for (int m = 0; m < 4; ++m) {
                const int rt = ai * 128 + wr * 64 + m * 16 + fr, row = u.pm * 256 + rt;
                const float mean = ST[rt * 2], rstd = ST[rt * 2 + 1];
#pragma unroll
                for (int bj = 0; bj < 2; ++bj) {
                    const int col = u.pn * 256 + bj * 128 + wc * 32 + 8 * fq;
                    const size_t idx = (size_t)row * DM + col;
                    const f32x4 o0 = (acc[ai][bj][m][0] - mean) * rstd * go[bj][0] + bo[bj][0], o1 = (acc[ai][bj][m][1] - mean) * rstd * go[bj][1] + bo[bj][1];
                    if (outf) { *(f32x4*)(outf + idx) = o0; *(f32x4*)(outf + idx + 4) = o1; }
                    if (outb) *(u32x4*)(outb + idx) = pack8(o0, o1);
                }
            }
    }
};

template <class Epi> DI void run_gemm(pg8::PG8_LAS_T lds, const bf16_t* A, const bf16_t* Bt, int N, int K, const Epi& E, const int wid_s) {
    pg8::Gemm g{A, Bt, M_TOK, N, K}; pg8::StaticOrder S; S.init(M_TOK, N, (int)gridDim.x, (int)blockIdx.x);
    pg8::gemm_phase<Epi, pg8::StaticOrder, true, true>(lds, g, S, E, wid_s);
}
__global__ void __launch_bounds__(512, 2) fwd_mega(Params P) {
    cg::grid_group grid = cg::this_grid();
    extern __shared__ __attribute__((aligned(16))) unsigned char lds[];
    pg8::PG8_LAS_T glds = (pg8::PG8_LAS_T)lds;
    volatile LAS unsigned* xb_words = (volatile LAS unsigned*)(glds + LDS_MISC);
    volatile int* s_item = (volatile int*)(lds + LDS_MISC + 16);
    const int nblk = gridDim.x, bid = blockIdx.x;
    unsigned char* ws = P.ws;

    const int wid_s = __builtin_amdgcn_readfirstlane((int)threadIdx.x >> 6);
    if (threadIdx.x < 4) xb_words[threadIdx.x] = 0u;
    __syncthreads();
    const XcdBarrier xbar = xcd_barrier_post((unsigned*)(ws + OFF_BAR), xb_words, (int)threadIdx.x);
    if (P.out == nullptr) grid.sync();

    {
    for (int base = bid * 2; base < 1984 + 4096; base += nblk * 2) {
        PHASE_IDS
        const int it = base + team;
        if (it < 960) {
            transpose_tile(P.in[4], 1024, 3600, (bf16_t*)(ws + OFF_WIN), it / 60, it % 60, 1, (float*)smem, tt);
        } else if (it < 1984) {
            const int loc = it - 960;
            transpose_tile(P.in[15], 4096, 1024, (bf16_t*)(ws + OFF_WDOWN), loc / 16, loc % 16, 0, (float*)smem, tt);
        } else {
            const int row = (it - 1984) * 4 + tw;
            ln_row(P.in[0] + (size_t)row * DM, P.in[2], P.in[3], nullptr, (bf16_t*)(ws + OFF_HB) + (size_t)row * DM, (float*)(ws + OFF_STATS) + row * 2, lane);
            { const f32x4 pv = *(const f32x4*)(P.in[1] + (size_t)row * 256 + lane * 4); u32x2 w; w.x = pack2(pv[0], pv[1]); w.y = pack2(pv[2], pv[3]);
              *(u32x2*)((bf16_t*)(ws + OFF_PB) + (size_t)row * 256 + lane * 4) = w; }
        }
    }
    }
    xcd_barrier(xbar, wid_s);

    { EpiProj E{ws}; run_gemm(glds, (const bf16_t*)(ws + OFF_HB), (const bf16_t*)(ws + OFF_WIN), NPROJ, DM, E, wid_s); }
    {
        const int nun = (M_TOK / 256) * (NPROJ / 256);
        const int maxu = (nun + nblk - 1) / nblk;
        int first_short = nun - (maxu - 1) * nblk, nshort = nblk - first_short;
        if (nshort <= 0) { first_short = 0; nshort = nblk; }
        if (bid >= first_short) {
            for (int base = (bid - first_short) * 2; base < 1600; base += nshort * 2) {
                PHASE_IDS
                const int j = base + team;
                const float* W; int K, N, loc, nnt; bf16_t* Wt;
                if (j < 256) { W = P.in[11]; K = 1024; N = 1024; Wt = (bf16_t*)(ws + OFF_WOUT); loc = j; nnt = 16; }
                else if (j < 1280) { W = P.in[14]; K = 1024; N = 4096; Wt = (bf16_t*)(ws + OFF_WUP); loc = j - 256; nnt = 64; }
                else if (j < 1536) { W = P.in[17]; K = 1024; N = 1024; Wt = (bf16_t*)(ws + OFF_WG); loc = j - 1280; nnt = 16; }
                else { W = P.in[16]; K = 256; N = 1024; Wt = (bf16_t*)(ws + OFF_WPLE); loc = j - 1536; nnt = 16; }
                transpose_tile(W, K, N, Wt, loc / nnt, loc % nnt, 0, (float*)smem, tt);
            }
        }
    }
    xcd_barrier(xbar, wid_s);

    for (int rep = 0; rep < NREP(2); ++rep)
    {
    for (int base = bid * 2; base < 1024 + 64; base += nblk * 2) {
        PHASE_IDS
        const int it = base + team;
        if (it < 1024) prep_chunk(P, it, smem, tt); else fox_cumsum(P, it - 1024, smem, tt);
    }
    }
    xcd_barrier(xbar, wid_s);

    for (int rep = 0; rep < NREP(3); ++rep)
    {
    for (;;) {
        PHASE_IDS
        __syncthreads();
        if (tid == 0) *s_item = atomicAdd((int*)(ws + OFF_CTR) + rep, 1);
        __syncthreads();
        const int pr = *s_item;
        if (pr >= 64 + 512) break;
        if (pr < 64) gdn_scan(P, pr * 2 + team, smem, tt);
        else { const int fj = pr - 64; fox_attn(P, (fj & 31) * 2 + team, 15 - (fj >> 5), smem, tt); }
    }
    }
    xcd_barrier(xbar, wid_s);

    { PHASE_IDS
    for (int it = bid; it < M_TOK / 8; it += nblk) {
        const int row = it * 8 + wave8;
        bf16_t* mix = (bf16_t*)(ws + OFF_MIX) + (size_t)row * DM;
        {
            const int col = lane * 8;
            const u32x4 ov = *(const u32x4*)((const bf16_t*)(ws + OFF_OG) + (size_t)row * 512 + col);
            const u32x4 zv = *(const u32x4*)((const bf16_t*)(ws + OFF_Z) + (size_t)row * 512 + col);
            float o[8] = {bflo(ov.x), bfhi(ov.x), bflo(ov.y), bfhi(ov.y), bflo(ov.z), bfhi(ov.z), bflo(ov.w), bfhi(ov.w)};
            float z[8] = {bflo(zv.x), bfhi(zv.x), bflo(zv.y), bfhi(zv.y), bflo(zv.z), bfhi(zv.z), bflo(zv.w), bfhi(zv.w)};
            float ss = 0.f;
#pragma unroll
            for (int e = 0; e < 8; ++e) ss += o[e] * o[e];
            ss += shx(ss, 1, lane); ss += shx(ss, 2, lane); ss += shx(ss, 4, lane); ss += shx(ss, 8, lane);
            const float sc = rsqrtf(ss * (1.f / 128.f) + 1e-6f);
            const float* gg = P.in[8] + (col & 127);
            float v[8];
#pragma unroll
            for (int e = 0; e < 8; ++e) v[e] = o[e] * sc * gg[e] * siluf(z[e]);
            u32x4 w; w.x = pack2(v[0], v[1]); w.y = pack2(v[2], v[3]); w.z = pack2(v[4], v[5]); w.w = pack2(v[6], v[7]);
            *(u32x4*)(mix + col) = w;
        }
    }
    }
    xcd_barrier(xbar, wid_s);

    { EpiLnFused<0> E{P.in[0], P.in[2], P.in[3], (const float*)(ws + OFF_STATS), nullptr, nullptr, (float*)(ws + OFF_XBUF), (unsigned*)(ws + OFF_PCNT), P.in[12], P.in[13], nullptr, (bf16_t*)(ws + OFF_H1B)};
      run_gemm(glds, (const bf16_t*)(ws + OFF_MIX), (const bf16_t*)(ws + OFF_WOUT), DM, DM, E, wid_s); }
    xcd_barrier(xbar, wid_s);

    { EpiUp E{(bf16_t*)(ws + OFF_FFB)}; run_gemm(glds, (const bf16_t*)(ws + OFF_H1B), (const bf16_t*)(ws + OFF_WUP), 4096, DM, E, wid_s); }
    { EpiGate E{(bf16_t*)(ws + OFF_PG), P.in[18]}; run_gemm(glds, (const bf16_t*)(ws + OFF_H1B), (const bf16_t*)(ws + OFF_WG), DM, DM, E, wid_s); }
    { EpiPle E{(bf16_t*)(ws + OFF_PG)}; run_gemm(glds, (const bf16_t*)(ws + OFF_PB), (const bf16_t*)(ws + OFF_WPLE), DM, 256, E, wid_s); }
    xcd_barrier(xbar, wid_s);

    { EpiLnFused<1> E{nullptr, nullptr, nullptr, nullptr, (const bf16_t*)(ws + OFF_H1B), (const bf16_t*)(ws + OFF_PG), (float*)(ws + OFF_XBUF) + (size_t)M_TOK * 8, (unsigned*)(ws + OFF_PCNT) + 64, P.in[19], P.in[20], P.out, nullptr};
      run_gemm(glds, (const bf16_t*)(ws + OFF_FFB), (const bf16_t*)(ws + OFF_WDOWN), DM, 4096, E, wid_s); }
}

extern "C" void kernel_launch(void* const* d_in, const int* in_sizes, int n_in, void* d_out, int out_size, void* d_ws, size_t ws_size, hipStream_t stream) {
    static int grid_blocks = 0;
    if (!grid_blocks) {
        int dev = 0, cus = 0, per_cu = 0;
        (void)hipGetDevice(&dev);
        (void)hipDeviceGetAttribute(&cus, hipDeviceAttributeMultiprocessorCount, dev);
        if (hipFuncSetAttribute((const void*)fwd_mega, hipFuncAttributeMaxDynamicSharedMemorySize, LDS_BYTES) != hipSuccess) fprintf(stderr, "kernel_launch: hipFuncSetAttribute failed\n");
        (void)hipOccupancyMaxActiveBlocksPerMultiprocessor(&per_cu, (const void*)fwd_mega, 512, LDS_BYTES);
        if (per_cu < 1) fprintf(stderr, "kernel_launch: occupancy query reports %d blocks per CU\n", per_cu);
        (void)hipGetLastError();
        grid_blocks = cus;
        if (ws_size < 232 * MBy) fprintf(stderr, "kernel_launch: workspace too small (%zu)\n", ws_size);
    }
    Params p{};
    for (int i = 0; i < 21; ++i) p.in[i] = (const float*)d_in[i];
    p.out = (float*)d_out; p.ws = (unsigned char*)d_ws;
    (void)hipMemsetAsync((unsigned char*)d_ws + OFF_BAR, 0, 16384, stream);
    void* args[] = {&p};
    hipError_t e = hipLaunchCooperativeKernel((void*)fwd_mega, dim3(grid_blocks), dim3(512), args, LDS_BYTES, stream);
    if (e != hipSuccess) fprintf(stderr, "cooperative launch failed: %s (grid %d)\n", hipGetErrorString(e), grid_blocks);
}
```

```cpp
#include <hip/hip_runtime.h>
#include <hip/hip_cooperative_groups.h>
#include <cstdio>
namespace cg = cooperative_groups;

typedef unsigned short bf16_t;
typedef short bf16x8 __attribute__((ext_vector_type(8)));
typedef short s16x4 __attribute__((ext_vector_type(4)));
typedef float f32x16 __attribute__((ext_vector_type(16)));
typedef float f32x4 __attribute__((ext_vector_type(4)));
typedef unsigned u32x4 __attribute__((ext_vector_type(4)));
typedef unsigned u32x2 __attribute__((ext_vector_type(2)));
typedef float f32x2v __attribute__((ext_vector_type(2)));

#define DI __device__ __forceinline__
#define MFMA32(a, b, c) __builtin_amdgcn_mfma_f32_32x32x16_bf16((a), (b), (c), 0, 0, 0)

constexpr int M_TOK = 16384, DM = 1024, TSEQ = 2048;
constexpr int NPROJ = 3840;
constexpr size_t MBy = 1u << 20;
constexpr size_t OFF_WIN = 0, OFF_WOUT = 8 * MBy, OFF_WUP = 10 * MBy, OFF_WDOWN = 18 * MBy, OFF_WG = 26 * MBy, OFF_WPLE = 28 * MBy;
constexpr size_t OFF_STATS = 28 * MBy + 512 * 1024, OFF_GLAST = 28 * MBy + 640 * 1024, OFF_BAR = 29 * MBy + 512 * 1024, OFF_CTR = OFF_BAR + 14336, OFF_CF = 28 * MBy + 768 * 1024;
constexpr size_t OFF_XBUF = 31 * MBy, OFF_PCNT = OFF_BAR + 14848;
constexpr size_t OFF_GATES = 30 * MBy, OFF_GQKV = 32 * MBy, OFF_Z = 80 * MBy, OFF_FQK = 96 * MBy, OFF_VT = 128 * MBy, OFF_HB = 144 * MBy;
constexpr size_t OFF_U = 144 * MBy, OFF_W = 160 * MBy, OFF_QD = 176 * MBy, OFF_KDT = 192 * MBy, OFF_QK = 208 * MBy;
constexpr size_t OFF_OG = 32 * MBy, OFF_MIX = 216 * MBy;
constexpr size_t OFF_H1B = 32 * MBy, OFF_PB = 248 * MBy, OFF_FFB = 72 * MBy, OFF_PG = 200 * MBy;
constexpr float ALPHA = 1.189207115002721f;
constexpr int TEAM_LDS = 76800, LDS_MISC = 153600, LDS_BYTES = 153600 + 256;
#ifndef REP_MASK
#define REP_MASK 0
#endif
#define NREP(k) (1 + ((REP_MASK >> (k)) & 1))

struct Params { const float* in[21]; float* out; unsigned char* ws; };

DI float bf2f(unsigned b) { return __uint_as_float(b << 16); }
typedef float f32x2_t __attribute__((ext_vector_type(2))); typedef __bf16 bf16x2_t __attribute__((ext_vector_type(2)));
DI unsigned pack2(float lo, float hi) { f32x2_t v = {lo, hi}; bf16x2_t b = __builtin_convertvector(v, bf16x2_t); return __builtin_bit_cast(unsigned, b); }
DI unsigned f2bf(float x) { return pack2(x, 0.f) & 0xffffu; }
DI float bflo(unsigned w) { return __uint_as_float(w << 16); }
DI float bfhi(unsigned w) { return __uint_as_float(w & 0xffff0000u); }
DI int crow(int e, int h) { return (e & 3) + 8 * (e >> 2) + 4 * h; }
DI float shx(float v, int mask, int lane) { return __int_as_float(__builtin_amdgcn_ds_bpermute((lane ^ mask) << 2, __float_as_int(v))); }
DI float shup(float v, int o, int lane) { return __int_as_float(__builtin_amdgcn_ds_bpermute(((lane - o) & 63) << 2, __float_as_int(v))); }
DI float shlane(float v, int src) { return __int_as_float(__builtin_amdgcn_readlane(__float_as_int(v), src)); }
DI float wave_sum(float v, int lane) { for (int o = 32; o > 0; o >>= 1) v += shx(v, o, lane); return v; }
DI float siluf(float x) { return x * __builtin_amdgcn_rcpf(1.f + __expf(-x)); }
DI float sigmoidf_(float x) { return __builtin_amdgcn_rcpf(1.f + __expf(-x)); }
DI int fresh_tid(int wid_s) { int l; asm volatile("v_mbcnt_lo_u32_b32 %0, -1, 0\n\tv_mbcnt_hi_u32_b32 %0, -1, %0" : "=v"(l)); return wid_s * 64 + l; }
#define PHASE_IDS const int tid = fresh_tid(wid_s), lane = tid & 63, wave8 = tid >> 6, team = tid >> 8, tt = tid & 255, tw = tt >> 6; unsigned char* smem = lds + team * TEAM_LDS; (void)lane; (void)wave8; (void)tt; (void)tw; (void)smem;

DI void ln_row(const float* src, const float* __restrict__ g, const float* __restrict__ b, float* dstf, bf16_t* dstb, float* stats, int lane) {
    f32x4 v[4];
#pragma unroll
    for (int i = 0; i < 4; ++i) v[i] = *(const f32x4*)(src + i * 256 + lane * 4);
    float s = 0.f;
#pragma unroll
    for (int i = 0; i < 4; ++i) s += (v[i][0] + v[i][1]) + (v[i][2] + v[i][3]);
    s = wave_sum(s, lane);
    const float mu = s * (1.f / 1024.f);
    float q = 0.f;
#pragma unroll
    for (int i = 0; i < 4; ++i) { f32x4 d = v[i] - mu; q += (d[0] * d[0] + d[1] * d[1]) + (d[2] * d[2] + d[3] * d[3]); }
    q = wave_sum(q, lane);
    const float rstd = rsqrtf(q * (1.f / 1024.f) + 1e-5f);
    f32x4 gv[4], bv[4];
#pragma unroll
    for (int i = 0; i < 4; ++i) { gv[i] = *(const f32x4*)(g + i * 256 + lane * 4); bv[i] = *(const f32x4*)(b + i * 256 + lane * 4); }
#pragma unroll
    for (int i = 0; i < 4; ++i) {
        const f32x4 gg = gv[i], bb = bv[i];
        const f32x4 o = (v[i] - mu) * rstd * gg + bb;
        if (dstf) *(f32x4*)(dstf + i * 256 + lane * 4) = o;
        if (dstb) { u32x2 w; w.x = pack2(o[0], o[1]); w.y = pack2(o[2], o[3]); *(u32x2*)(dstb + i * 256 + lane * 4) = w; }
    }
    if (stats && lane == 0) { stats[0] = mu; stats[1] = rstd; }
}

DI void transpose_tile(const float* __restrict__ W, int K, int N, bf16_t* __restrict__ Wt, int kt, int nt, int mode, float* tile, int tt) {
    const int tid = tt;
    const int k0 = kt * 64, n0 = nt * 64;
    {
        const int c = tid & 63, n = n0 + c;
        int sc = n;
        if (mode == 1) { sc = (n < 2048) ? n : (n < 3584) ? n + 8 : (n < 3592) ? 2048 + (n - 3584) : (n < 3600) ? n : -1; }
        const int scc = sc >= 0 ? sc : 0;
        const float mk = sc >= 0 ? 1.f : 0.f;
        float wv[16];
#pragma unroll
        for (int i = 0; i < 16; ++i) wv[i] = W[(size_t)(k0 + (tid >> 6) + 4 * i) * N + scc];
#pragma unroll
        for (int i = 0; i < 16; ++i) tile[((tid >> 6) + 4 * i) * 65 + c] = wv[i] * mk;
    }
    __syncthreads();
    {
        const int n = tid >> 2, ks = (tid & 3) * 16;
        u32x4 o0, o1;
        o0.x = pack2(tile[(ks + 0) * 65 + n], tile[(ks + 1) * 65 + n]); o0.y = pack2(tile[(ks + 2) * 65 + n], tile[(ks + 3) * 65 + n]);
        o0.z = pack2(tile[(ks + 4) * 65 + n], tile[(ks + 5) * 65 + n]); o0.w = pack2(tile[(ks + 6) * 65 + n], tile[(ks + 7) * 65 + n]);
        o1.x = pack2(tile[(ks + 8) * 65 + n], tile[(ks + 9) * 65 + n]); o1.y = pack2(tile[(ks + 10) * 65 + n], tile[(ks + 11) * 65 + n]);
        o1.z = pack2(tile[(ks + 12) * 65 + n], tile[(ks + 13) * 65 + n]); o1.w = pack2(tile[(ks + 14) * 65 + n], tile[(ks + 15) * 65 + n]);
        bf16_t* dst = Wt + (size_t)(n0 + n) * K + k0 + ks;
        *(u32x4*)dst = o0; *(u32x4*)(dst + 8) = o1;
    }
    __syncthreads();
}

namespace pg8 {
#define PG8_LAS __attribute__((address_space(3)))
typedef PG8_LAS unsigned char* PG8_LAS_T;
typedef unsigned short bf16_t;
typedef short bf16x8 __attribute__((ext_vector_type(8)));
typedef float f32x4 __attribute__((ext_vector_type(4)));
typedef unsigned u32x4 __attribute__((ext_vector_type(4)));
constexpr int BM = 256, BK = 64, HALF = 128, HTB = HALF * BK * 2  , STAGE_BYTES = 8 * HTB, NXCD = 8, WGM = 8;

__host__ __device__ __forceinline__ int lds_byte(int r, int c) { const int st = (r >> 4) * 2 + (c >> 5), rr = r & 15, cc = c & 31, ob = rr * 64 + cc * 2; return st * 1024 + (ob ^ (((ob >> 9) & 1) << 5)); }
__host__ __device__ __forceinline__ void stage_rc(int b, int& R, int& C) { const int st = b / 1024, sb = b % 1024, swz = sb ^ (((sb >> 9) & 1) << 5); R = (st >> 1) * 16 + swz / 64; C = (st & 1) * 32 + (swz % 64) / 2; }
__host__ __device__ __forceinline__ int perm32(int rho) { const int n = rho >> 4, i = rho & 15; return 8 * (i >> 2) + 4 * n + (i & 3); }

struct Unit { int pm, pn; };
struct Gemm { const bf16_t* A; const bf16_t* Bt; int M, N, K; };

struct StaticOrder {
    int nM, nN, nwg, G, c;
    __host__ __device__ void init(int M, int N, int G_, int c_) { nM = M / BM; nN = N / BM; nwg = nM * nN; G = G_; c = c_; }
    __host__ __device__ bool next(int i, Unit& u) const {
        const long L = (long)i * G + c; if (L >= nwg) return false;
        int wgid = (int)L; { const int q = nwg / NXCD, r = nwg % NXCD, xcd = wgid % NXCD, off = wgid / NXCD; wgid = (xcd < r ? xcd * (q + 1) : r * (q + 1) + (xcd - r) * q) + off; }
        const int nig = WGM * nN, gid = wgid / nig, fm = gid * WGM, gsz = (nM - fm) < WGM ? (nM - fm) : WGM;
        u.pm = fm + ((wgid % nig) % gsz); u.pn = (wgid % nig) / gsz; return true;
    }
    __device__ __forceinline__ void a_ready(const Unit&) const {}
    __device__ __forceinline__ void done(const Unit&) const {}
};
template <class Epi, class Sched, bool ALIGN_EPI = false, bool SP2 = false>
__device__ __forceinline__ void gemm_phase(PG8_LAS unsigned char* lds, const Gemm g, const Sched& S, const Epi& E, const int wid_s) {
    const int tid = fresh_tid(wid_s), wid = wid_s, lane = tid & 63, wr = wid >> 2, wc = wid & 3, fr = lane & 15, fq = lane >> 4;
    const int K = g.K, nt = K / BK;
    unsigned voffA[2], voffB[2];
#pragma unroll
    for (int i = 0; i < 2; ++i) { int R, C; stage_rc(tid * 16 + i * 8192, R, C); const int Rb = Epi::PERM ? ((R & ~31) + perm32(R & 31)) : R;
        voffA[i] = (unsigned)(R * K + C) * 2u; voffB[i] = (unsigned)(Rb * K + C) * 2u; }
    const size_t kstep = (size_t)(BK * 2);
    const size_t hstep = (size_t)HALF * K * 2;
    const size_t tstep = 2 * hstep;
    const unsigned ldsw = (unsigned)wid * 1024u;
    const int aoff = lds_byte(wr * 64 + fr, fq * 8), boff = lds_byte(wc * 32 + fr, fq * 8);
#define PG8_SA(b, h) (((b) * 2 + (h)) * HTB)
#define PG8_SB(b, h) ((4 + (b) * 2 + (h)) * HTB)
#define PG8_STAGE(bufoff, gbase, voff) do { _Pragma("unroll") for (int _i = 0; _i < 2; ++_i) \
        __builtin_amdgcn_global_load_lds((const unsigned*)((const char*)(gbase) + (voff)[_i]), (PG8_LAS unsigned*)(lds + (bufoff) + ldsw + _i * 8192), 16, 0, 0); } while (0)
#define PG8_LDA(dst, b, h) do { _Pragma("unroll") for (int m = 0; m < 4; ++m) _Pragma("unroll") for (int k = 0; k < 2; ++k) dst[m][k] = *(const PG8_LAS bf16x8*)(lds + PG8_SA(b, h) + aoff + m * 2048 + k * 1024); } while (0)
#define PG8_LDB(dst, b, h) do { _Pragma("unroll") for (int n = 0; n < 2; ++n) _Pragma("unroll") for (int k = 0; k < 2; ++k) dst[n][k] = *(const PG8_LAS bf16x8*)(lds + PG8_SB(b, h) + boff + n * 2048 + k * 1024); } while (0)
#define PG8_MMA(ai, bj, At, Bt) do { __builtin_amdgcn_s_setprio(1); _Pragma("unroll") for (int m = 0; m < 4; ++m) _Pragma("unroll") for (int n = 0; n < 2; ++n) _Pragma("unroll") for (int k = 0; k < 2; ++k) \
        acc[ai][bj][m][n] = __builtin_amdgcn_mfma_f32_16x16x32_bf16(Bt[n][k], At[m][k], acc[ai][bj][m][n], 0, 0, 0); __builtin_amdgcn_s_setprio(0); } while (0)
#define PG8_WAIT_V(n) asm volatile("s_waitcnt vmcnt(" #n ")" ::: "memory")
#define PG8_WAIT_L(n) asm volatile("s_waitcnt lgkmcnt(" #n ")" ::: "memory")
#define PG8_BAR __builtin_amdgcn_s_barrier()
#define PG8_SCHED __builtin_amdgcn_sched_barrier(0)
    Unit cur, nxt; int ui = 0;
    if (!S.next(0, cur)) return;
    f32x4 acc[2][2][4][2];
#pragma unroll
    for (int a = 0; a < 2; ++a)
#pragma unroll
        for (int b = 0; b < 2; ++b)
#pragma unroll
            for (int m = 0; m < 4; ++m)
#pragma unroll
                for (int n = 0; n < 2; ++n) acc[a][b][m][n] = (f32x4){0.f, 0.f, 0.f, 0.f};
    bf16x8 At[4][2], B0[2][2], B1[2][2];
    const char* cA = (const char*)g.A + (size_t)cur.pm * tstep; const char* cB = (const char*)g.Bt + (size_t)cur.pn * tstep;
    S.a_ready(cur);
    if constexpr (SP2) {
        PG8_STAGE(PG8_SB(0, 0), cB, voffB); PG8_STAGE(PG8_SB(0, 1), cB + hstep, voffB); PG8_STAGE(PG8_SA(0, 0), cA, voffA); PG8_STAGE(PG8_SA(0, 1), cA + hstep, voffA);
        if (wr == 1) PG8_BAR;
        PG8_WAIT_V(2); PG8_BAR;
        PG8_STAGE(PG8_SB(1, 0), cB + kstep, voffB); PG8_STAGE(PG8_SA(1, 0), cA + kstep, voffA); PG8_STAGE(PG8_SB(1, 1), cB + hstep + kstep, voffB);
        PG8_WAIT_V(6); PG8_BAR;
    } else {
        PG8_STAGE(PG8_SB(0, 0), cB, voffB); PG8_STAGE(PG8_SA(0, 0), cA, voffA); PG8_STAGE(PG8_SB(0, 1), cB + hstep, voffB); PG8_STAGE(PG8_SA(0, 1), cA + hstep, voffA);
        if (wr == 1) PG8_BAR;
        PG8_WAIT_V(4); PG8_BAR;
        PG8_STAGE(PG8_SB(1, 0), cB + kstep, voffB); PG8_STAGE(PG8_SA(1, 0), cA + kstep, voffA); PG8_STAGE(PG8_SB(1, 1), cB + hstep + kstep, voffB);
        PG8_WAIT_V(6); PG8_BAR;
    }
    for (;;) {
        const bool has_next = S.next(ui + 1, nxt);
        const char* nA = has_next ? (const char*)g.A + (size_t)nxt.pm * tstep : cA; const char* nB = has_next ? (const char*)g.Bt + (size_t)nxt.pn * tstep : cB;
        for (int t = 0; t < nt; t += 2) {
            const bool last = (t == nt - 2);
            const char* a1 = cA + (size_t)(t + 1) * kstep;
            const char* a2 = last ? nA : cA + (size_t)(t + 2) * kstep; const char* b2 = last ? nB : cB + (size_t)(t + 2) * kstep;
            const char* a3 = a2 + kstep; const char* b3 = b2 + kstep;
            if (last && has_next) S.a_ready(nxt);
            if constexpr (SP2) {
            PG8_LDB(B0, 0, 0); PG8_LDB(B1, 0, 1); PG8_SCHED; PG8_LDA(At, 0, 0); PG8_STAGE(PG8_SA(1, 1), a1 + hstep, voffA);
            PG8_WAIT_V(8); PG8_WAIT_L(0); PG8_BAR; PG8_MMA(0, 0, At, B0); PG8_MMA(0, 1, At, B1); PG8_BAR; PG8_SCHED;
            PG8_LDA(At, 0, 1); PG8_STAGE(PG8_SB(0, 0), b2, voffB); PG8_STAGE(PG8_SB(0, 1), b2 + hstep, voffB); PG8_STAGE(PG8_SA(0, 0), a2, voffA);
            PG8_WAIT_V(8); PG8_WAIT_L(0); PG8_BAR; PG8_MMA(1, 0, At, B0); PG8_MMA(1, 1, At, B1); PG8_BAR; PG8_SCHED;
            PG8_LDB(B0, 1, 0); PG8_LDB(B1, 1, 1); PG8_SCHED; PG8_LDA(At, 1, 0); PG8_STAGE(PG8_SA(0, 1), a2 + hstep, voffA);
            PG8_WAIT_V(8); PG8_WAIT_L(0); PG8_BAR; PG8_MMA(0, 0, At, B0); PG8_MMA(0, 1, At, B1); PG8_BAR; PG8_SCHED;
            PG8_LDA(At, 1, 1); PG8_STAGE(PG8_SB(1, 0), b3, voffB); PG8_STAGE(PG8_SB(1, 1), b3 + hstep, voffB); PG8_STAGE(PG8_SA(1, 0), a3, voffA);
            PG8_WAIT_V(8); PG8_WAIT_L(0); PG8_BAR; PG8_MMA(1, 0, At, B0); PG8_MMA(1, 1, At, B1); PG8_BAR; PG8_SCHED;
            } else {
            PG8_LDB(B0, 0, 0); PG8_SCHED; PG8_LDA(At, 0, 0); PG8_STAGE(PG8_SA(1, 1), a1 + hstep, voffA);
            PG8_WAIT_L(8); PG8_BAR; PG8_WAIT_L(0); PG8_MMA(0, 0, At, B0); PG8_BAR; PG8_SCHED;
            PG8_LDB(B1, 0, 1); PG8_STAGE(PG8_SB(0, 0), b2, voffB);
            PG8_BAR; PG8_WAIT_L(0); PG8_MMA(0, 1, At, B1); PG8_BAR;
            PG8_LDA(At, 0, 1); PG8_STAGE(PG8_SA(0, 0), a2, voffA);
            PG8_BAR; PG8_WAIT_L(0); PG8_MMA(1, 0, At, B0); PG8_BAR; PG8_SCHED;
            PG8_STAGE(PG8_SB(0, 1), b2 + hstep, voffB);
            PG8_WAIT_V(6); PG8_BAR; PG8_MMA(1, 1, At, B1); PG8_BAR;
            PG8_LDB(B0, 1, 0); PG8_SCHED; PG8_LDA(At, 1, 0); PG8_STAGE(PG8_SA(0, 1), a2 + hstep, voffA);
            PG8_WAIT_L(8); PG8_BAR; PG8_WAIT_L(0); PG8_MMA(0, 0, At, B0); PG8_BAR; PG8_SCHED;
            PG8_LDB(B1, 1, 1); PG8_STAGE(PG8_SB(1, 0), b3, voffB);
            PG8_BAR; PG8_WAIT_L(0); PG8_MMA(0, 1, At, B1); PG8_BAR;
            PG8_LDA(At, 1, 1); PG8_STAGE(PG8_SA(1, 0), a3, voffA);
            PG8_BAR; PG8_WAIT_L(0); PG8_MMA(1, 0, At, B0); PG8_BAR; PG8_SCHED;
            PG8_STAGE(PG8_SB(1, 1), b3 + hstep, voffB);
            PG8_WAIT_V(6); PG8_BAR; PG8_MMA(1, 1, At, B1); PG8_BAR;
            }
        }
        if constexpr (ALIGN_EPI) { if (wr == 0) PG8_BAR; }
        if constexpr (!Epi::AFTER_DRAIN) { E(acc, cur, wr, wc, fr, fq); S.done(cur); }
        if (!has_next) break;
#pragma unroll
        for (int a = 0; a < 2; ++a)
#pragma unroll
            for (int b = 0; b < 2; ++b)
#pragma unroll
                for (int m = 0; m < 4; ++m)
#pragma unroll
                    for (int n = 0; n < 2; ++n) acc[a][b][m][n] = (f32x4){0.f, 0.f, 0.f, 0.f};
        cur = nxt; cA = nA; cB = nB; ++ui;
        if constexpr (ALIGN_EPI) { if (wr == 1) PG8_BAR; }
    }
    PG8_WAIT_V(0);
    if constexpr (!ALIGN_EPI) { if (wr == 0) PG8_BAR; }
    PG8_BAR;
    if constexpr (Epi::AFTER_DRAIN) { E.fused(acc, cur, wr, wc, fr, fq, lds, wid, lane); S.done(cur); }
#undef PG8_SA
#undef PG8_SB
#undef PG8_STAGE
#undef PG8_LDA
#undef PG8_LDB
#undef PG8_MMA
#undef PG8_WAIT_V
#undef PG8_WAIT_L
#undef PG8_BAR
#undef PG8_SCHED
}
}

template <class F> DI void epi_rows(const pg8::f32x4 (&acc)[2][2][4][2], const pg8::Unit& u, int wr, int wc, int fr, int fq, F f) {
#pragma unroll
    for (int ai = 0; ai < 2; ++ai)
#pragma unroll
        for (int m = 0; m < 4; ++m) {
            const int row = u.pm * 256 + ai * 128 + wr * 64 + m * 16 + fr;
#pragma unroll
            for (int bj = 0; bj < 2; ++bj) f(row, u.pn * 256 + bj * 128 + wc * 32 + 8 * fq, acc[ai][bj][m][0], acc[ai][bj][m][1]);
        }
}
DI u32x4 pack8(const f32x4& a, const f32x4& b) { u32x4 w; w.x = pack2(a[0], a[1]); w.y = pack2(a[2], a[3]); w.z = pack2(b[0], b[1]); w.w = pack2(b[2], b[3]); return w; }
struct EpiProj {
    static constexpr bool PERM = true, AFTER_DRAIN = false;
    unsigned char* ws;
    DI void operator()(const pg8::f32x4 (&acc)[2][2][4][2], const pg8::Unit& u, int wr, int wc, int fr, int fq) const {
        const int pn = u.pn;
        if (pn < 12) {
            bf16_t* dst; int ld, cofs;
            if (pn < 6) { dst = (bf16_t*)(ws + OFF_GQKV); ld = 1536; cofs = 0; }
            else if (pn < 8) { dst = (bf16_t*)(ws + OFF_Z); ld = 512; cofs = 1536; }
            else { dst = (bf16_t*)(ws + OFF_FQK); ld = 1024; cofs = 2048; }
            epi_rows(acc, u, wr, wc, fr, fq, [&](int row, int col, const f32x4& a, const f32x4& b) { *(u32x4*)(dst + (size_t)row * ld + (col - cofs)) = pack8(a, b); });
        } else if (pn < 14) {
            bf16_t* vT = (bf16_t*)(ws + OFF_VT);
            epi_rows(acc, u, wr, wc, fr, fq, [&](int row, int col, const f32x4& a, const f32x4& b) {
                const int c = col - 3072, hh = c >> 6, d0 = c & 63, bb = row >> 11, t = row & 2047;
                bf16_t* p = vT + ((size_t)(bb * 8 + hh) * 64 + d0) * TSEQ + t;
#pragma unroll
                for (int e = 0; e < 4; ++e) { p[(size_t)e * TSEQ] = (bf16_t)f2bf(a[e]); p[(size_t)(e + 4) * TSEQ] = (bf16_t)f2bf(b[e]); }
            });
        } else {
            float* gates = (float*)(ws + OFF_GATES);
            epi_rows(acc, u, wr, wc, fr, fq, [&](int row, int col, const f32x4& a, const f32x4& b) {
                const int c = col - 3584;
                if (c < 16) { *(f32x4*)(gates + (size_t)row * 16 + c) = a; *(f32x4*)(gates + (size_t)row * 16 + c + 4) = b; }
            });
        }
    }
};
struct EpiOutProj {
    static constexpr bool PERM = true, AFTER_DRAIN = false;
    const float* x; const float* g; const float* b; const float* stats; float* out;
    DI void operator()(const pg8::f32x4 (&acc)[2][2][4][2], const pg8::Unit& u, int wr, int wc, int fr, int fq) const {
        epi_rows(acc, u, wr, wc, fr, fq, [&](int row, int col, const f32x4& a0, const f32x4& a1) {
            const float mu = stats[row * 2], rs = stats[row * 2 + 1];
            const size_t idx = (size_t)row * DM + col;
            const f32x4 x0 = *(const f32x4*)(x + idx), x1 = *(const f32x4*)(x + idx + 4);
            const f32x4 g0 = *(const f32x4*)(g + col), g1 = *(const f32x4*)(g + col + 4), b0 = *(const f32x4*)(b + col), b1 = *(const f32x4*)(b + col + 4);
            *(f32x4*)(out + idx) = ((x0 - mu) * rs * g0 + b0) * ALPHA + a0;
            *(f32x4*)(out + idx + 4) = ((x1 - mu) * rs * g1 + b1) * ALPHA + a1;
        });
    }
};
struct EpiUp {
    static constexpr bool PERM = true, AFTER_DRAIN = false;
    bf16_t* ffb;
    DI void operator()(const pg8::f32x4 (&acc)[2][2][4][2], const pg8::Unit& u, int wr, int wc, int fr, int fq) const {
        epi_rows(acc, u, wr, wc, fr, fq, [&](int row, int col, const f32x4& a, const f32x4& b) {
            f32x4 ra, rb;
#pragma unroll
            for (int e = 0; e < 4; ++e) { const float va = fmaxf(a[e], 0.f), vb = fmaxf(b[e], 0.f); ra[e] = va * va; rb[e] = vb * vb; }
            *(u32x4*)(ffb + (size_t)row * 4096 + col) = pack8(ra, rb);
        });
    }
};
struct EpiGate {
    static constexpr bool PERM = true, AFTER_DRAIN = false;
    bf16_t* pg; const float* bias;
    DI void operator()(const pg8::f32x4 (&acc)[2][2][4][2], const pg8::Unit& u, int wr, int wc, int fr, int fq) const {
        f32x4 bv[2][2];
#pragma unroll
        for (int bj = 0; bj < 2; ++bj) { const int c0 = u.pn * 256 + bj * 128 + wc * 32 + 8 * fq; bv[bj][0] = *(const f32x4*)(bias + c0); bv[bj][1] = *(const f32x4*)(bias + c0 + 4); }
        epi_rows(acc, u, wr, wc, fr, fq, [&](int row, int col, const f32x4& a, const f32x4& b) {
            const int bj = (col >> 7) & 1;
            const f32x4 b0 = bv[bj][0], b1 = bv[bj][1];
            f32x4 ra, rb;
#pragma unroll
            for (int e = 0; e < 4; ++e) { ra[e] = sigmoidf_(a[e] + b0[e]); rb[e] = sigmoidf_(b[e] + b1[e]); }
            *(u32x4*)(pg + (size_t)row * DM + col) = pack8(ra, rb);
        });
    }
};
struct EpiPle {
    static constexpr bool PERM = true, AFTER_DRAIN = false;
    bf16_t* pg;
    DI void operator()(const pg8::f32x4 (&acc)[2][2][4][2], const pg8::Unit& u, int wr, int wc, int fr, int fq) const {
        epi_rows(acc, u, wr, wc, fr, fq, [&](int row, int col, const f32x4& a, const f32x4& b) {
            u32x4* p = (u32x4*)(pg + (size_t)row * DM + col);
            const u32x4 w = *p;
            f32x4 ra, rb;
            ra[0] = a[0] * bflo(w.x); ra[1] = a[1] * bfhi(w.x); ra[2] = a[2] * bflo(w.y); ra[3] = a[3] * bfhi(w.y);
            rb[0] = b[0] * bflo(w.z); rb[1] = b[1] * bfhi(w.z); rb[2] = b[2] * bflo(w.w); rb[3] = b[3] * bfhi(w.w);
            *p = pack8(ra, rb);
        });
    }
};
struct EpiDown {
    static constexpr bool PERM = true, AFTER_DRAIN = false;
    const bf16_t* pg; float* out;
    DI void operator()(const pg8::f32x4 (&acc)[2][2][4][2], const pg8::Unit& u, int wr, int wc, int fr, int fq) const {
        epi_rows(acc, u, wr, wc, fr, fq, [&](int row, int col, const f32x4& a, const f32x4& b) {
            const size_t idx = (size_t)row * DM + col;
            const u32x4 w = *(const u32x4*)(pg + idx);
            f32x4 o0 = *(const f32x4*)(out + idx), o1 = *(const f32x4*)(out + idx + 4);
            o0 = o0 * ALPHA + a; o1 = o1 * ALPHA + b;
            o0[0] += bflo(w.x); o0[1] += bfhi(w.x); o0[2] += bflo(w.y); o0[3] += bfhi(w.y);
            o1[0] += bflo(w.z); o1[1] += bfhi(w.z); o1[2] += bflo(w.w); o1[3] += bfhi(w.w);
            *(f32x4*)(out + idx) = o0; *(f32x4*)(out + idx + 4) = o1;
        });
    }
};
DI void lds_read8(unsigned addr, f32x4 (&a)[4][2]) {
    asm volatile(
        "ds_read_b128 %0, %8\n\tds_read_b128 %1, %8 offset:16\n\t"
        "ds_read_b128 %2, %8 offset:256\n\tds_read_b128 %3, %8 offset:272\n\t"
        "ds_read_b128 %4, %8 offset:512\n\tds_read_b128 %5, %8 offset:528\n\t"
        "ds_read_b128 %6, %8 offset:768\n\tds_read_b128 %7, %8 offset:784\n\t"
        "s_waitcnt lgkmcnt(0)"
        : "=&v"(a[0][0]), "=&v"(a[0][1]), "=&v"(a[1][0]), "=&v"(a[1][1]), "=&v"(a[2][0]), "=&v"(a[2][1]), "=&v"(a[3][0]), "=&v"(a[3][1])
        : "v"(addr) : "memory");
}
DI void lds_read8s(unsigned addr, f32x4 (&a)[4][2]) {
    asm volatile(
        "ds_read_b128 %0, %8\n\tds_read_b128 %1, %8 offset:16\n\t"
        "ds_read_b128 %2, %8 offset:128\n\tds_read_b128 %3, %8 offset:144\n\t"
        "ds_read_b128 %4, %8 offset:256\n\tds_read_b128 %5, %8 offset:272\n\t"
        "ds_read_b128 %6, %8 offset:384\n\tds_read_b128 %7, %8 offset:400\n\t"
        "s_waitcnt lgkmcnt(0)"
        : "=&v"(a[0][0]), "=&v"(a[0][1]), "=&v"(a[1][0]), "=&v"(a[1][1]), "=&v"(a[2][0]), "=&v"(a[2][1]), "=&v"(a[3][0]), "=&v"(a[3][1])
        : "v"(addr) : "memory");
}
DI void prep_chunk(const Params& P, int ci, unsigned char* smem, int tt) {
    const int tid = tt, lane = tid & 63, wave = tid >> 6, r = lane & 31, h2 = lane >> 5;
    const int b = ci >> 7, hd = (ci >> 5) & 3, n = ci & 31, t0 = n * 64;
    const size_t rowbase = (size_t)b * TSEQ + t0;
    bf16_t* kbf = (bf16_t*)smem;
    bf16_t* qbf = kbf + 64 * 136;
    bf16_t* vT  = (bf16_t*)smem;
    bf16_t* Tb  = (bf16_t*)(smem + 18432);
    bf16_t* Tg  = (bf16_t*)(smem + 27648);
    bf16_t* kT  = (bf16_t*)(smem + 36864);
    float*  Ad  = (float*)(smem + 55296);
    bf16_t* A10 = (bf16_t*)(smem + 63488);
    bf16_t* DT  = (bf16_t*)(smem + 66048);
    float* sbeta = (float*)(smem + 71168);
    float* sgam = sbeta + 64; float* segam = sgam + 64; float* sdk = segam + 64;
    bf16_t* D1R = (bf16_t*)(smem + 72192);
    const bf16_t* gq = (const bf16_t*)(P.ws + OFF_GQKV);
    const float* gates = (const float*)(P.ws + OFF_GATES);
    const float* cw = P.in[5];
    if (tid < 64) {
        const float* gt = gates + (rowbase + tid) * 16;
        const float be = sigmoidf_(gt[hd]);
        const float a = gt[4 + hd] + P.in[7][hd];
        const float sp = fmaxf(a, 0.f) + log1pf(__expf(-fabsf(a)));
        float lg = -__expf(P.in[6][hd]) * sp;
#pragma unroll
        for (int o = 1; o < 64; o <<= 1) { const float t = shup(lg, o, lane); if (lane >= o) lg += t; }
        const float gl = shlane(lg, 63);
        sbeta[tid] = be; sgam[tid] = lg; segam[tid] = __expf(lg); sdk[tid] = __expf(gl - lg);
    }
    {
        float* wl = Ad;
        for (int idx = tid; idx < 384; idx += 256) {
            const int wh = idx >> 7, rem = idx & 127, j = rem >> 5, c4 = (rem & 31) * 4;
            const int cbw = (wh == 0 ? 512 : wh == 1 ? 0 : 1024) + hd * 128;
            *(f32x4*)(wl + (wh * 4 + j) * 128 + c4) = *(const f32x4*)(cw + j * 1536 + cbw + c4);
        }
    }
    __syncthreads();
    unsigned vkeep[16];
#pragma unroll
    for (int e = 0; e < 16; ++e) vkeep[e] = 0u;
    {
        const int i = tid >> 2, seg = tid & 3;
        const float* wl = Ad;
#pragma unroll 1
        for (int which = 0; which < 3; ++which) {
            const int colbase = (which == 0 ? 512 : which == 1 ? 0 : 1024) + hd * 128 + seg * 32;
            u32x4 xr[4][4];
#pragma unroll
            for (int j = 0; j < 4; ++j) {
                const int t = t0 + i - 3 + j;
                const int tc = t < 0 ? 0 : t;
                const bf16_t* xp = gq + ((size_t)b * TSEQ + tc) * 1536 + colbase;
#pragma unroll
                for (int sub = 0; sub < 4; ++sub) xr[j][sub] = *(const u32x4*)(xp + sub * 8);
            }
            float val[32];
#pragma unroll
            for (int sub = 0; sub < 4; ++sub) {
                float a8[8];
#pragma unroll
                for (int e = 0; e < 8; ++e) a8[e] = 0.f;
#pragma unroll
                for (int j = 0; j < 4; ++j) {
                    const float mk = (t0 + i - 3 + j) < 0 ? 0.f : 1.f;
                    const u32x4 xv = xr[j][sub];
                    f32x4 w0 = *(const f32x4*)(wl + (which * 4 + j) * 128 + seg * 32 + sub * 8), w1 = *(const f32x4*)(wl + (which * 4 + j) * 128 + seg * 32 + sub * 8 + 4);
                    w0 = w0 * mk; w1 = w1 * mk;
                    a8[0] += w0[0] * bflo(xv.x); a8[1] += w0[1] * bfhi(xv.x); a8[2] += w0[2] * bflo(xv.y); a8[3] += w0[3] * bfhi(xv.y);
                    a8[4] += w1[0] * bflo(xv.z); a8[5] += w1[1] * bfhi(xv.z); a8[6] += w1[2] * bflo(xv.w); a8[7] += w1[3] * bfhi(xv.w);
                }
#pragma unroll
                for (int e = 0; e < 8; ++e) val[sub * 8 + e] = siluf(a8[e]);
            }
            float ss = 0.f;
#pragma unroll
            for (int e = 0; e < 32; ++e) ss += val[e] * val[e];
            ss += shx(ss, 1, lane); ss += shx(ss, 2, lane);
            const float sc = (which == 2) ? 1.f : rsqrtf(ss + 1e-6f) * (which == 1 ? 0.08838834764831845f : 1.f);
            unsigned pk[16];
#pragma unroll
            for (int e = 0; e < 16; ++e) pk[e] = pack2(val[2 * e] * sc, val[2 * e + 1] * sc);
            if (which == 2) {
#pragma unroll
                for (int e = 0; e < 16; ++e) vkeep[e] = pk[e];
            } else {
                bf16_t* dst = (which == 0 ? kbf : qbf) + i * 136 + seg * 32;
#pragma unroll
                for (int sub = 0; sub < 4; ++sub) { u32x4 o; o.x = pk[4 * sub]; o.y = pk[4 * sub + 1]; o.z = pk[4 * sub + 2]; o.w = pk[4 * sub + 3]; *(u32x4*)(dst + sub * 8) = o; }
                if (which == 0) {
                    bf16_t* kt = kT + (seg * 32) * 72 + i;
#pragma unroll
                    for (int e = 0; e < 16; ++e) { kt[(2 * e) * 72] = (bf16_t)(pk[e] & 0xffffu); kt[(2 * e + 1) * 72] = (bf16_t)(pk[e] >> 16); }
                }
            }
        }
    }
    __syncthreads();
    {
        const int mi = wave >> 1, ni = wave & 1;
        f32x16 aK, aQ;
#pragma unroll
        for (int e = 0; e < 16; ++e) { aK[e] = 0.f; aQ[e] = 0.f; }
#pragma unroll
        for (int ks = 0; ks < 8; ++ks) {
            const bf16x8 ak = *(const bf16x8*)(kbf + (mi * 32 + r) * 136 + ks * 16 + h2 * 8);
            const bf16x8 bk = *(const bf16x8*)(kbf + (ni * 32 + r) * 136 + ks * 16 + h2 * 8);
            const bf16x8 aq = *(const bf16x8*)(qbf + (mi * 32 + r) * 136 + ks * 16 + h2 * 8);
            aK = MFMA32(ak, bk, aK); aQ = MFMA32(aq, bk, aQ);
        }
        const int j = ni * 32 + r;
        const float gj = sgam[j];
        bf16_t* qkout = (bf16_t*)(P.ws + OFF_QK) + (size_t)ci * 4096;
#pragma unroll
        for (int e = 0; e < 16; ++e) {
            const int il = crow(e, h2), i = mi * 32 + il;
            const float dec = (i >= j) ? __expf(sgam[i] - gj) : 0.f;
            const float aij = (i > j) ? aK[e] * sbeta[i] * dec : 0.f;
            if (mi == ni) Ad[(mi * 32 + il) * 32 + r] = aij;
            else if (mi == 1) A10[il * 40 + r] = (bf16_t)f2bf(aij);
            qkout[(((i >> 5) * 4 + (j >> 4)) * 64 + (i & 31) + 32 * ((j >> 3) & 1)) * 8 + (j & 7)] = (bf16_t)f2bf((i >= j) ? aQ[e] * dec : 0.f);
        }
    }
    {
        const int i = tid >> 2, seg = tid & 3;
        const float eg = segam[i];
        bf16_t* qd = (bf16_t*)(P.ws + OFF_QD) + (size_t)ci * 8192;
#pragma unroll
        for (int sub = 0; sub < 4; ++sub) {
            const u32x4 v = *(const u32x4*)(qbf + i * 136 + seg * 32 + sub * 8);
            u32x4 o;
            o.x = pack2(bflo(v.x) * eg, bfhi(v.x) * eg); o.y = pack2(bflo(v.y) * eg, bfhi(v.y) * eg);
            o.z = pack2(bflo(v.z) * eg, bfhi(v.z) * eg); o.w = pack2(bflo(v.w) * eg, bfhi(v.w) * eg);
            *(u32x4*)(qd + ((((i >> 5) * 8 + seg * 2 + (sub >> 1)) * 64 + (i & 31) + 32 * (sub & 1)) * 8)) = o;
        }
        const int kidx = tid >> 1, cs = (tid & 1) * 32;
        bf16_t* kd = (bf16_t*)(P.ws + OFF_KDT) + (size_t)ci * 8192;
#pragma unroll
        for (int sub = 0; sub < 4; ++sub) {
            const u32x4 v = *(const u32x4*)(kT + kidx * 72 + cs + sub * 8);
            const f32x4 d0 = *(const f32x4*)(sdk + cs + sub * 8), d1 = *(const f32x4*)(sdk + cs + sub * 8 + 4);
            u32x4 o;
            o.x = pack2(bflo(v.x) * d0[0], bfhi(v.x) * d0[1]); o.y = pack2(bflo(v.y) * d0[2], bfhi(v.y) * d0[3]);
            o.z = pack2(bflo(v.z) * d1[0], bfhi(v.z) * d1[1]); o.w = pack2(bflo(v.w) * d1[2], bfhi(v.w) * d1[3]);
            *(u32x4*)(kd + ((((kidx >> 5) * 4 + ((cs + sub * 8) >> 4)) * 64 + (kidx & 31) + 32 * (sub & 1)) * 8)) = o;
        }
        if (tid == 0) ((float*)(P.ws + OFF_GLAST))[ci] = segam[63];
    }
    __syncthreads();
    {
        const int i = tid >> 2, seg = tid & 3;
        bf16_t* vt = vT + (seg * 32) * 72 + i;
#pragma unroll
        for (int e = 0; e < 16; ++e) { vt[(2 * e) * 72] = (bf16_t)(vkeep[e] & 0xffffu); vt[(2 * e + 1) * 72] = (bf16_t)(vkeep[e] >> 16); }
        if (tid >= 64) {
            for (int idx = tid - 64; idx < 1024; idx += 192) { const int rr = idx >> 5, cc = 32 + (idx & 31); Tb[rr * 72 + cc] = 0; Tg[rr * 72 + cc] = 0; }
        } else {
            const int blk = tid >> 5, c = tid & 31;
            float x[32];
#pragma unroll
            for (int e = 0; e < 32; ++e) x[e] = (e == c) ? 1.f : 0.f;
            const unsigned ad_lds = (unsigned)(size_t)(Ad + blk * 1024);
#pragma unroll
            for (int ib = 0; ib < 8; ++ib) {
                const int i0 = ib * 4;
                float s0 = x[i0], s1 = x[i0 + 1], s2 = x[i0 + 2], s3 = x[i0 + 3];
#pragma unroll
                for (int mb = 0; mb <= ib; mb += 2) {
                    f32x4 a[4][2];
                    lds_read8s(ad_lds + (unsigned)((i0 * 32 + mb * 4) * 4), a);
#pragma unroll
                    for (int cb = 0; cb < 2; ++cb) {
                        const int m4 = mb + cb;
                        if (m4 < ib) {
#pragma unroll
                            for (int e = 0; e < 4; ++e) {
                                const float xx = x[m4 * 4 + e];
                                s0 -= a[0][cb][e] * xx; s1 -= a[1][cb][e] * xx; s2 -= a[2][cb][e] * xx; s3 -= a[3][cb][e] * xx;
                            }
                        } else if (m4 == ib) {
                            s1 -= a[1][cb][0] * s0;
                            s2 -= a[2][cb][0] * s0; s2 -= a[2][cb][1] * s1;
                            s3 -= a[3][cb][0] * s0; s3 -= a[3][cb][1] * s1; s3 -= a[3][cb][2] * s2;
                        }
                    }
                    __builtin_amdgcn_sched_barrier(0);
                }
                x[i0] = s0; x[i0 + 1] = s1; x[i0 + 2] = s2; x[i0 + 3] = s3;
            }
            bf16_t* dt = DT + (blk * 32 + c) * 40;
#pragma unroll
            for (int q4 = 0; q4 < 4; ++q4) {
                u32x4 o; o.x = pack2(x[8 * q4], x[8 * q4 + 1]); o.y = pack2(x[8 * q4 + 2], x[8 * q4 + 3]); o.z = pack2(x[8 * q4 + 4], x[8 * q4 + 5]); o.w = pack2(x[8 * q4 + 6], x[8 * q4 + 7]);
                *(u32x4*)(dt + q4 * 8) = o;
            }
            const int cg = blk * 32 + c;
            const float bc = sbeta[cg], bg = bc * segam[cg];
#pragma unroll
            for (int rr = 0; rr < 32; ++rr) {
                if (blk == 1) D1R[rr * 40 + c] = (bf16_t)f2bf(x[rr]);
                Tb[(blk * 32 + rr) * 72 + cg] = (bf16_t)f2bf(x[rr] * bc);
                Tg[(blk * 32 + rr) * 72 + cg] = (bf16_t)f2bf(x[rr] * bg);
            }
        }
    }
    __syncthreads();
    if (wave == 0) {
        f32x16 Pm, Qm;
#pragma unroll
        for (int e = 0; e < 16; ++e) { Pm[e] = 0.f; Qm[e] = 0.f; }
#pragma unroll
        for (int ks = 0; ks < 2; ++ks) {
            const bf16x8 a = *(const bf16x8*)(A10 + r * 40 + ks * 16 + h2 * 8);
            const bf16x8 bb = *(const bf16x8*)(DT + r * 40 + ks * 16 + h2 * 8);
            Pm = MFMA32(a, bb, Pm);
        }
#pragma unroll
        for (int sq = 0; sq < 2; ++sq) {
            u32x4 pw;
            pw.x = pack2(Pm[8 * sq + 0], Pm[8 * sq + 1]); pw.y = pack2(Pm[8 * sq + 2], Pm[8 * sq + 3]);
            pw.z = pack2(Pm[8 * sq + 4], Pm[8 * sq + 5]); pw.w = pack2(Pm[8 * sq + 6], Pm[8 * sq + 7]);
            const bf16_t* dp = D1R + r * 40 + 16 * sq + 4 * h2;
            const u32x2 lo = *(const u32x2*)dp, hi = *(const u32x2*)(dp + 8);
            u32x4 aw; aw.x = lo.x; aw.y = lo.y; aw.z = hi.x; aw.w = hi.y;
            Qm = MFMA32(__builtin_bit_cast(bf16x8, aw), __builtin_bit_cast(bf16x8, pw), Qm);
        }
        const float bc = sbeta[r], bg = bc * segam[r];
#pragma unroll
        for (int e = 0; e < 16; ++e) {
            const int il = crow(e, h2);
            Tb[(32 + il) * 72 + r] = (bf16_t)f2bf(-Qm[e] * bc);
            Tg[(32 + il) * 72 + r] = (bf16_t)f2bf(-Qm[e] * bg);
        }
    }
    __syncthreads();
    {
        const int nt = wave;
        f32x16 aU[2], aW[2];
#pragma unroll
        for (int e = 0; e < 16; ++e) { aU[0][e] = 0.f; aU[1][e] = 0.f; aW[0][e] = 0.f; aW[1][e] = 0.f; }
#pragma unroll
        for (int ks = 0; ks < 4; ++ks) {
            const bf16x8 bv = *(const bf16x8*)(vT + (nt * 32 + r) * 72 + ks * 16 + h2 * 8);
            const bf16x8 bk = *(const bf16x8*)(kT + (nt * 32 + r) * 72 + ks * 16 + h2 * 8);
#pragma unroll
            for (int mt = 0; mt < 2; ++mt) {
                const bf16x8 ab = *(const bf16x8*)(Tb + (mt * 32 + r) * 72 + ks * 16 + h2 * 8);
                const bf16x8 ag = *(const bf16x8*)(Tg + (mt * 32 + r) * 72 + ks * 16 + h2 * 8);
                aU[mt] = MFMA32(ab, bv, aU[mt]); aW[mt] = MFMA32(ag, bk, aW[mt]);
            }
        }
        bf16_t* u = (bf16_t*)(P.ws + OFF_U) + (size_t)ci * 8192;
        bf16_t* w = (bf16_t*)(P.ws + OFF_W) + (size_t)ci * 8192;
#pragma unroll
        for (int mt = 0; mt < 2; ++mt) {
            u32x4 o0, o1;
            o0.x = pack2(aU[mt][0], aU[mt][1]); o0.y = pack2(aU[mt][2], aU[mt][3]); o0.z = pack2(aU[mt][4], aU[mt][5]); o0.w = pack2(aU[mt][6], aU[mt][7]);
            o1.x = pack2(aU[mt][8], aU[mt][9]); o1.y = pack2(aU[mt][10], aU[mt][11]); o1.z = pack2(aU[mt][12], aU[mt][13]); o1.w = pack2(aU[mt][14], aU[mt][15]);
            bf16_t* d = u + (((nt * 2 + mt) * 64 + lane) * 16);
            *(u32x4*)d = o0; *(u32x4*)(d + 8) = o1;
            bf16_t* wb = w + (((mt * 8 + nt * 2 + (r >> 4)) * 64 + 32 * ((r >> 3) & 1)) * 8) + (r & 7);
#pragma unroll
            for (int e = 0; e < 16; ++e) wb[crow(e, h2) * 8] = (bf16_t)f2bf(aW[mt][e]);
        }
    }
    __syncthreads();
}

DI void fox_cumsum(const Params& P, int bh, unsigned char* smem, int tt) {
    const int tid = tt, lane = tid & 63, wave = tid >> 6;
    const int b = bh >> 3, hh = bh & 7;
    float* wsum = (float*)smem;
    const float* gates = (const float*)(P.ws + OFF_GATES);
    const float bf = P.in[9][hh];
    float v[8]; float run = 0.f;
#pragma unroll
    for (int e = 0; e < 8; ++e) {
        const float xx = gates[((size_t)b * TSEQ + tid * 8 + e) * 16 + 8 + hh] + bf;
        const float ls = fminf(xx, 0.f) - log1pf(__expf(-fabsf(xx)));
        run += ls; v[e] = run;
    }
    float sc = run;
#pragma unroll
    for (int o = 1; o < 64; o <<= 1) { const float t = shup(sc, o, lane); if (lane >= o) sc += t; }
    if (lane == 63) wsum[wave] = sc;
    __syncthreads();
    float off = sc - run;
    for (int w = 0; w < wave; ++w) off += wsum[w];
    float* cf = (float*)(P.ws + OFF_CF) + (size_t)bh * TSEQ + tid * 8;
#pragma unroll
    for (int e = 0; e < 8; ++e) cf[e] = v[e] + off;
    __syncthreads();
}

DI void gdn_scan(const Params& P, int item, unsigned char* smem, int tt) {
    const int tid = tt, lane = tid & 63, wave = tid >> 6, r = lane & 31, h2 = lane >> 5;
    const int bh = item >> 2, vs = item & 3, b = bh >> 2, hd = bh & 3;
    const int cb = bh * 32;
    bf16_t* SbT = (bf16_t*)smem;
    bf16_t* VnT = SbT + 32 * 136;
    const bool w01 = wave < 2;
    const int mt = wave & 1;
    const bf16_t* Ubase = (const bf16_t*)(P.ws + OFF_U);
    const bf16_t* Abase = (const bf16_t*)(P.ws + (w01 ? OFF_W : OFF_QD));
    const bf16_t* Kbase = (const bf16_t*)(P.ws + OFF_KDT);
    const bf16_t* QKbase = (const bf16_t*)(P.ws + OFF_QK);
    const float* glast = (const float*)(P.ws + OFF_GLAST);
    bf16_t* og = (bf16_t*)(P.ws + OFF_OG);
    f32x16 S;
#pragma unroll
    for (int e = 0; e < 16; ++e) S[e] = 0.f;
    for (int i = tid; i < 32 * 136 / 2; i += 256) ((unsigned*)SbT)[i] = 0u;
#define SCAN_LOAD_A(AF, ci_) do { const bf16_t* ap_ = Abase + (size_t)(ci_) * 8192 + (mt * 8 * 64 + lane) * 8; \
        _Pragma("unroll") for (int ks = 0; ks < 8; ++ks) AF[ks] = *(const bf16x8*)(ap_ + ks * 512); } while (0)
#define SCAN_LOAD_K(ci_) do { const bf16_t* kp_ = Kbase + (size_t)(ci_) * 8192 + (wave * 4 * 64 + lane) * 8; \
        _Pragma("unroll") for (int ks = 0; ks < 4; ++ks) Kf[ks] = *(const bf16x8*)(kp_ + ks * 512); } while (0)
#define SCAN_LOAD_X(ci_) do { if (w01) { const bf16_t* up_ = Ubase + (size_t)(ci_) * 8192 + ((vs * 2 + mt) * 64 + lane) * 16; \
            Xa = *(const u32x4*)up_; Xb = *(const u32x4*)(up_ + 8); } \
        else { const bf16_t* qp_ = QKbase + (size_t)(ci_) * 4096 + (mt * 4 * 64 + lane) * 8; \
            Xa = *(const u32x4*)qp_; Xb = *(const u32x4*)(qp_ + 512); Xc = *(const u32x4*)(qp_ + 1024); Xd = *(const u32x4*)(qp_ + 1536); } } while (0)
#define SCAN_STEP(AF, n_) do { \
        const int cn1 = cb + ((n_) + 1 < 32 ? (n_) + 1 : 31); const int cn2 = cb + ((n_) + 2 < 32 ? (n_) + 2 : 31); \
        const float gl = shlane(glreg, (n_)); \
        f32x16 acc1; \
        bf16x8 sf[8]; \
        _Pragma("unroll") for (int ks = 0; ks < 8; ++ks) sf[ks] = *(const bf16x8*)(SbT + r * 136 + ks * 16 + h2 * 8); \
        _Pragma("unroll") for (int e = 0; e < 16; ++e) acc1[e] = 0.f; \
        __builtin_amdgcn_sched_barrier(0); \
        _Pragma("unroll") for (int ks = 0; ks < 8; ++ks) acc1 = MFMA32(AF[ks], sf[ks], acc1); \
        __builtin_amdgcn_sched_barrier(0); \
        SCAN_LOAD_A(AF, cn2); \
        if (w01) { \
            u32x2 ov; \
            ov.x = pack2(bflo(Xa.x) - acc1[0], bfhi(Xa.x) - acc1[1]); ov.y = pack2(bflo(Xa.y) - acc1[2], bfhi(Xa.y) - acc1[3]); *(u32x2*)(VnT + r * 72 + mt * 32 + 0 + 4 * h2) = ov; \
            ov.x = pack2(bflo(Xa.z) - acc1[4], bfhi(Xa.z) - acc1[5]); ov.y = pack2(bflo(Xa.w) - acc1[6], bfhi(Xa.w) - acc1[7]); *(u32x2*)(VnT + r * 72 + mt * 32 + 8 + 4 * h2) = ov; \
            ov.x = pack2(bflo(Xb.x) - acc1[8], bfhi(Xb.x) - acc1[9]); ov.y = pack2(bflo(Xb.y) - acc1[10], bfhi(Xb.y) - acc1[11]); *(u32x2*)(VnT + r * 72 + mt * 32 + 16 + 4 * h2) = ov; \
            ov.x = pack2(bflo(Xb.z) - acc1[12], bfhi(Xb.z) - acc1[13]); ov.y = pack2(bflo(Xb.w) - acc1[14], bfhi(Xb.w) - acc1[15]); *(u32x2*)(VnT + r * 72 + mt * 32 + 24 + 4 * h2) = ov; \
        } \
        __syncthreads(); \
        bf16x8 Vf[4]; \
        _Pragma("unroll") for (int ks = 0; ks < 4; ++ks) Vf[ks] = *(const bf16x8*)(VnT + r * 72 + ks * 16 + h2 * 8); \
        _Pragma("unroll") for (int e = 0; e < 16; ++e) S[e] *= gl; \
        __builtin_amdgcn_sched_barrier(0); \
        _Pragma("unroll") for (int ks = 0; ks < 4; ++ks) S = MFMA32(Kf[ks], Vf[ks], S); \
        if (!w01) { \
            acc1 = MFMA32(__builtin_bit_cast(bf16x8, Xa), Vf[0], acc1); acc1 = MFMA32(__builtin_bit_cast(bf16x8, Xb), Vf[1], acc1); \
            acc1 = MFMA32(__builtin_bit_cast(bf16x8, Xc), Vf[2], acc1); acc1 = MFMA32(__builtin_bit_cast(bf16x8, Xd), Vf[3], acc1); \
        } \
        __builtin_amdgcn_sched_barrier(0); \
        SCAN_LOAD_K(cn1); \
        SCAN_LOAD_X(cn1); \
        _Pragma("unroll") for (int g = 0; g < 4; ++g) { u32x2 ov; ov.x = pack2(S[4 * g + 0], S[4 * g + 1]); ov.y = pack2(S[4 * g + 2], S[4 * g + 3]); \
            *(u32x2*)(SbT + r * 136 + wave * 32 + 8 * g + 4 * h2) = ov; } \
        if (!w01) { \
            bf16_t* op = og + ((size_t)b * TSEQ + (n_) * 64 + mt * 32) * 512 + hd * 128 + vs * 32 + r; \
            _Pragma("unroll") for (int e = 0; e < 16; ++e) op[(size_t)crow(e, h2) * 512] = (bf16_t)f2bf(acc1[e]); \
        } \
        __syncthreads(); \
    } while (0)
    const float glreg = glast[cb + (lane & 31)];
    bf16x8 Af0[8], Af1[8], Kf[4];
    u32x4 Xa, Xb, Xc, Xd;
    Xc = Xd = (u32x4){0u, 0u, 0u, 0u};
    SCAN_LOAD_A(Af0, cb); SCAN_LOAD_K(cb); SCAN_LOAD_X(cb);
    SCAN_LOAD_A(Af1, cb + 1);
    __syncthreads();
#pragma unroll 1
    for (int n = 0; n < 32; n += 2) {
        SCAN_STEP(Af0, n);
        SCAN_STEP(Af1, n + 1);
    }
#undef SCAN_LOAD_A
#undef SCAN_LOAD_K
#undef SCAN_LOAD_X
#undef SCAN_STEP
}

DI void fox_attn(const Params& P, int bh, int qb, unsigned char* smem, int tt) {
    const int tid = tt, lane = tid & 63, wave = tid >> 6, r = lane & 31, h2 = lane >> 5;
    const int b = bh >> 3, hh = bh & 7;
    constexpr int BUFB = 2 * 64 * 72 * 2 + 256;
    constexpr float L2E = 1.4426950408889634f;
    const bf16_t* fqk = (const bf16_t*)(P.ws + OFF_FQK);
    const bf16_t* vT = (const bf16_t*)(P.ws + OFF_VT) + (size_t)bh * 64 * TSEQ;
    const float* cf = (const float*)(P.ws + OFF_CF) + (size_t)bh * TSEQ;
    const int q = qb * 128 + wave * 32 + r;
    bf16x8 Qf[4];
    {
        const bf16_t* qp = fqk + ((size_t)b * TSEQ + q) * 1024 + hh * 64 + h2 * 8;
#pragma unroll
        for (int ks = 0; ks < 4; ++ks) Qf[ks] = *(const bf16x8*)(qp + ks * 16);
    }
    const float cq = cf[q] * L2E;
    float m = -1e30f, l = 0.f;
    f32x16 O[2];
#pragma unroll
    for (int e = 0; e < 16; ++e) { O[0][e] = 0.f; O[1][e] = 0.f; }
    const int ntiles = 2 * qb + 2;
    const int srow = tid >> 3, scol = (tid & 7) * 8;
    const bf16_t* kg = fqk + ((size_t)b * TSEQ + srow) * 1024 + 512 + hh * 64 + scol;
    const bf16_t* vg = vT + (size_t)srow * TSEQ + scol;
    u32x4 rk0, rk1, rv0, rv1; float rc = 0.f;
    rk0 = *(const u32x4*)kg; rk1 = *(const u32x4*)(kg + 32 * 1024);
    rv0 = *(const u32x4*)vg; rv1 = *(const u32x4*)(vg + 32 * TSEQ);
    if (tid < 64) rc = cf[tid] * L2E;
    {
        bf16_t* Ks = (bf16_t*)smem; bf16_t* VTs = Ks + 64 * 72; float* cks = (float*)(smem + 2 * 64 * 72 * 2);
        *(u32x4*)(Ks + srow * 72 + scol) = rk0; *(u32x4*)(Ks + (srow + 32) * 72 + scol) = rk1;
        *(u32x4*)(VTs + srow * 72 + scol) = rv0; *(u32x4*)(VTs + (srow + 32) * 72 + scol) = rv1;
        if (tid < 64) cks[tid] = rc;
    }
    __syncthreads();
#pragma unroll 1
    for (int kt = 0; kt < ntiles; ++kt) {
        const unsigned char* bufc = smem + (kt & 1) * BUFB;
        const bf16_t* Ks = (const bf16_t*)bufc; const bf16_t* VTs = Ks + 64 * 72; const float* cks = (const float*)(bufc + 2 * 64 * 72 * 2);
        const bool more = kt + 1 < ntiles;
        if (more) {
            const bf16_t* kg2 = kg + (size_t)(kt + 1) * 64 * 1024; const bf16_t* vg2 = vg + (kt + 1) * 64;
            rk0 = *(const u32x4*)kg2; rk1 = *(const u32x4*)(kg2 + 32 * 1024);
            rv0 = *(const u32x4*)vg2; rv1 = *(const u32x4*)(vg2 + 32 * TSEQ);
            if (tid < 64) rc = cf[(kt + 1) * 64 + tid] * L2E;
        }
        f32x16 sacc[2];
        f32x4 ckv[2][4];
        {
            bf16x8 kf[2][4];
#pragma unroll
            for (int mt = 0; mt < 2; ++mt)
#pragma unroll
                for (int ks = 0; ks < 4; ++ks) kf[mt][ks] = *(const bf16x8*)(Ks + (mt * 32 + r) * 72 + ks * 16 + h2 * 8);
#pragma unroll
            for (int mt = 0; mt < 2; ++mt)
#pragma unroll
                for (int g = 0; g < 4; ++g) ckv[mt][g] = *(const f32x4*)(cks + mt * 32 + 8 * g + 4 * h2);
#pragma unroll
            for (int e = 0; e < 16; ++e) { sacc[0][e] = 0.f; sacc[1][e] = 0.f; }
            __builtin_amdgcn_sched_barrier(0);
#pragma unroll
            for (int ks = 0; ks < 4; ++ks) { sacc[0] = MFMA32(kf[0][ks], Qf[ks], sacc[0]); sacc[1] = MFMA32(kf[1][ks], Qf[ks], sacc[1]); }
        }
        const bool diag = kt >= ntiles - 2;
        float mx = -1e30f;
        {
            const f32x2v csc = {0.125f * L2E, 0.125f * L2E};
#pragma unroll
            for (int mt = 0; mt < 2; ++mt)
#pragma unroll
                for (int g = 0; g < 4; ++g) {
                    const f32x4 ck4 = ckv[mt][g];
                    const f32x2v c01 = {ck4[0], ck4[1]}, c23 = {ck4[2], ck4[3]};
                    const f32x2v a01 = {sacc[mt][4 * g], sacc[mt][4 * g + 1]}, a23 = {sacc[mt][4 * g + 2], sacc[mt][4 * g + 3]};
                    const f32x2v s01 = a01 * csc - c01, s23 = a23 * csc - c23;
                    sacc[mt][4 * g] = s01.x; sacc[mt][4 * g + 1] = s01.y; sacc[mt][4 * g + 2] = s23.x; sacc[mt][4 * g + 3] = s23.y;
                    mx = fmaxf(fmaxf(mx, s01.x), s01.y); mx = fmaxf(fmaxf(mx, s23.x), s23.y);
                }
        }
        if (diag) {
            mx = -1e30f;
            const int qrel = q - kt * 64 - 4 * h2;
#pragma unroll
            for (int mt = 0; mt < 2; ++mt)
#pragma unroll
                for (int e = 0; e < 16; ++e) {
                    const int krel = mt * 32 + (e & 3) + 8 * (e >> 2);
                    const float sv = (krel > qrel) ? -1e30f : sacc[mt][e];
                    sacc[mt][e] = sv;
                    mx = fmaxf(mx, sv);
                }
        }
        mx = fmaxf(mx, shx(mx, 32, lane));
        if (__builtin_amdgcn_ballot_w64(mx + cq - m > 8.f) != 0ull) {
            const float mn = fmaxf(m, mx + cq);
            const float alpha = __builtin_amdgcn_exp2f(m - mn);
            m = mn;
            l *= alpha;
            const f32x2v al2 = {alpha, alpha};
#pragma unroll
            for (int dt = 0; dt < 2; ++dt)
#pragma unroll
                for (int p2 = 0; p2 < 8; ++p2) {
                    f32x2v ov = {O[dt][2 * p2], O[dt][2 * p2 + 1]};
                    ov = ov * al2;
                    O[dt][2 * p2] = ov.x; O[dt][2 * p2 + 1] = ov.y;
                }
        }
        {
            const float sh = cq - m;
            const f32x2v sh2 = {sh, sh};
            f32x2v rs2 = {0.f, 0.f};
#pragma unroll
            for (int mt = 0; mt < 2; ++mt)
#pragma unroll
                for (int p2 = 0; p2 < 8; ++p2) {
                    const f32x2v sv = {sacc[mt][2 * p2], sacc[mt][2 * p2 + 1]};
                    const f32x2v t = sv + sh2;
                    f32x2v pp; pp.x = __builtin_amdgcn_exp2f(t.x); pp.y = __builtin_amdgcn_exp2f(t.y);
                    sacc[mt][2 * p2] = pp.x; sacc[mt][2 * p2 + 1] = pp.y;
                    rs2 = rs2 + pp;
                }
            l += rs2.x + rs2.y;
        }
        {
            u32x4 vw[2][2][2];
#pragma unroll
            for (int mt = 0; mt < 2; ++mt)
#pragma unroll
                for (int s = 0; s < 2; ++s)
#pragma unroll
                    for (int dt = 0; dt < 2; ++dt) {
                        const bf16_t* vp = VTs + (dt * 32 + r) * 72 + mt * 32 + 16 * s + 4 * h2;
                        const u32x2 lo = *(const u32x2*)vp, hi = *(const u32x2*)(vp + 8);
                        vw[mt][s][dt].x = lo.x; vw[mt][s][dt].y = lo.y; vw[mt][s][dt].z = hi.x; vw[mt][s][dt].w = hi.y;
                    }
            u32x4 pw[2][2];
#pragma unroll
            for (int mt = 0; mt < 2; ++mt)
#pragma unroll
                for (int s = 0; s < 2; ++s) {
                    pw[mt][s].x = pack2(sacc[mt][8 * s + 0], sacc[mt][8 * s + 1]); pw[mt][s].y = pack2(sacc[mt][8 * s + 2], sacc[mt][8 * s + 3]);
                    pw[mt][s].z = pack2(sacc[mt][8 * s + 4], sacc[mt][8 * s + 5]); pw[mt][s].w = pack2(sacc[mt][8 * s + 6], sacc[mt][8 * s + 7]);
                }
            __builtin_amdgcn_sched_barrier(0);
#pragma unroll
            for (int mt = 0; mt < 2; ++mt)
#pragma unroll
                for (int s = 0; s < 2; ++s) {
                    const bf16x8 pf = __builtin_bit_cast(bf16x8, pw[mt][s]);
                    O[0] = MFMA32(__builtin_bit_cast(bf16x8, vw[mt][s][0]), pf, O[0]);
                    O[1] = MFMA32(__builtin_bit_cast(bf16x8, vw[mt][s][1]), pf, O[1]);
                }
        }
        if (more) {
            unsigned char* bufn = smem + ((kt + 1) & 1) * BUFB;
            bf16_t* Kn = (bf16_t*)bufn; bf16_t* VTn = Kn + 64 * 72; float* ckn = (float*)(bufn + 2 * 64 * 72 * 2);
            *(u32x4*)(Kn + srow * 72 + scol) = rk0; *(u32x4*)(Kn + (srow + 32) * 72 + scol) = rk1;
            *(u32x4*)(VTn + srow * 72 + scol) = rv0; *(u32x4*)(VTn + (srow + 32) * 72 + scol) = rv1;
            if (tid < 64) ckn[tid] = rc;
        }
        __syncthreads();
    }
    l += shx(l, 32, lane);
    const float inv = 1.f / l;
    float ss = 0.f;
#pragma unroll
    for (int e = 0; e < 16; ++e) { O[0][e] *= inv; O[1][e] *= inv; ss += O[0][e] * O[0][e] + O[1][e] * O[1][e]; }
    ss += shx(ss, 32, lane);
    const float sc = rsqrtf(ss * (1.f / 64.f) + 1e-6f);
    bf16_t* op = (bf16_t*)(P.ws + OFF_MIX) + ((size_t)b * TSEQ + q) * 1024 + 512 + hh * 64;
    const float* fg = P.in[10];
    f32x4 ggv[2][4];
#pragma unroll
    for (int dt = 0; dt < 2; ++dt)
#pragma unroll
        for (int g = 0; g < 4; ++g) ggv[dt][g] = *(const f32x4*)(fg + dt * 32 + 8 * g + 4 * h2);
#pragma unroll
    for (int dt = 0; dt < 2; ++dt)
#pragma unroll
        for (int g = 0; g < 4; ++g) {
            const int d0 = dt * 32 + 8 * g + 4 * h2;
            const f32x4 gg = ggv[dt][g];
            u32x2 o;
            o.x = pack2(O[dt][4 * g + 0] * sc * gg[0], O[dt][4 * g + 1] * sc * gg[1]); o.y = pack2(O[dt][4 * g + 2] * sc * gg[2], O[dt][4 * g + 3] * sc * gg[3]);
            *(u32x2*)(op + d0) = o;
        }
}

#define XB_TMO      128
#define XB_XCNT(j)  (256  + 64 * (j))
#define XB_XSUB(j)  (1280 + 64 * (j))
#define XB_XGEN(j)  (2304 + 64 * (j))
#define XB_TOP      3328
#define XB_TOPGEN   3392
#define XCD_BAR_WORDS 3456
#define XB_SPIN_CAP (1u << 18)
#define LAS __attribute__((address_space(3)))
DI unsigned xb_ld(unsigned* p)              { return __hip_atomic_load(p, __ATOMIC_RELAXED, __HIP_MEMORY_SCOPE_AGENT); }
DI unsigned xb_add(unsigned* p, unsigned v) { return __hip_atomic_fetch_add(p, v, __ATOMIC_RELAXED, __HIP_MEMORY_SCOPE_AGENT); }
DI unsigned xb_xcc_id() { return (unsigned)__builtin_amdgcn_s_getreg((3 << 11) | 20) & 0xFu; }
#define XB_SPIN(cond, bar) do { unsigned _sp = 0; while (cond) { __builtin_amdgcn_s_sleep(1); \
    if ((++_sp & 255u) == 0u) { if (xb_ld(&(bar)[XB_TMO])) break; if (_sp > XB_SPIN_CAP) { atomicAdd(&(bar)[XB_TMO], 1u); break; } } } } while (0)
struct XcdBarrier { unsigned* bar; unsigned x; volatile LAS unsigned* st; };
DI XcdBarrier xcd_barrier_post(unsigned* bar, volatile LAS unsigned* st, int tid0) {
    XcdBarrier b; b.bar = bar; b.x = xb_xcc_id(); b.st = st;
    if (tid0 == 0) (void)xb_add(&bar[XB_XCNT(b.x)], 1u);
    return b;
}
DI void xcd_barrier_complete(unsigned* bar, unsigned x, unsigned& nloc, unsigned& nx) {
    const unsigned G = gridDim.x * gridDim.y * gridDim.z;
    unsigned sum, cnt, mine, sp = 0u;
    for (;;) {
        sum = 0u; cnt = 0u; mine = 0u;
#pragma unroll
        for (unsigned j = 0; j < 16; ++j) { const unsigned c = xb_ld(&bar[XB_XCNT(j)]); sum += c; cnt += (c > 0u) ? 1u : 0u; mine = (j == x) ? c : mine; }
        if (sum == G) break;
        __builtin_amdgcn_s_sleep(1);
        if ((++sp & 255u) == 0u) { if (xb_ld(&bar[XB_TMO])) break; if (sp > XB_SPIN_CAP) { atomicAdd(&bar[XB_TMO], 1u); break; } }
    }
    nloc = mine > 0u ? mine : 1u; nx = cnt > 0u ? cnt : 1u;
}
DI void xcd_barrier(const XcdBarrier& b, const int wid_s) {
    asm volatile("s_waitcnt vmcnt(0)" ::: "memory");
    __syncthreads();
    if (fresh_tid(wid_s) == 0) {
        unsigned* bar = b.bar;
        __builtin_amdgcn_s_waitcnt(0);
        unsigned nloc = b.st[0], nx = b.st[1];
        if (nloc == 0u) { xcd_barrier_complete(bar, b.x, nloc, nx); b.st[0] = nloc; b.st[1] = nx; }
        const unsigned old = xb_add(&bar[XB_XSUB(b.x)], 1u);
        const unsigned gen = old / nloc;
        if (old + 1u == (gen + 1u) * nloc) {
            __builtin_amdgcn_fence(__ATOMIC_RELEASE, "agent");
            asm volatile("s_waitcnt vmcnt(0)" ::: "memory");
            const unsigned og = xb_add(&bar[XB_TOP], 1u);
            const unsigned tg = og / nx;
            if (og + 1u == (tg + 1u) * nx) xb_add(&bar[XB_TOPGEN], 1u);
            else XB_SPIN(xb_ld(&bar[XB_TOPGEN]) == tg, bar);
            __builtin_amdgcn_fence(__ATOMIC_ACQUIRE, "agent");
            xb_add(&bar[XB_XGEN(b.x)], 1u);
            asm volatile("s_waitcnt vmcnt(0)" ::: "memory");
        } else {
            XB_SPIN(xb_ld(&bar[XB_XGEN(b.x)]) == gen, bar);
            __builtin_amdgcn_fence(__ATOMIC_ACQUIRE, "agent");
            asm volatile("s_waitcnt vmcnt(0)" ::: "memory");
        }
    }
    __syncthreads();
}


template <int MODE> struct EpiLnFused {
    static constexpr bool PERM = true, AFTER_DRAIN = true;
    const float* x; const float* g_in; const float* b_in; const float* stats;
    const bf16_t* h1; const bf16_t* pg;
    float* xbuf; unsigned* cnt; const float* g; const float* b; float* outf; bf16_t* outb;
    DI void operator()(const pg8::f32x4 (&)[2][2][4][2], const pg8::Unit&, int, int, int, int) const {}
    DI void fused(pg8::f32x4 (&acc)[2][2][4][2], const pg8::Unit& u, int wr, int wc, int fr, int fq, pg8::PG8_LAS_T ldsp, int wid, int lane) const {
        float* P = (float*)(unsigned char*)ldsp;
        float* ST = P + 2048;
        const int tid = wid * 64 + lane;
        f32x4 gi[2][2], bi[2][2];
#pragma unroll
        for (int bj = 0; bj < 2; ++bj) {
            const int col = u.pn * 256 + bj * 128 + wc * 32 + 8 * fq;
            if (MODE == 0) { gi[bj][0] = *(const f32x4*)(g_in + col); gi[bj][1] = *(const f32x4*)(g_in + col + 4); bi[bj][0] = *(const f32x4*)(b_in + col); bi[bj][1] = *(const f32x4*)(b_in + col + 4); }
        }
#pragma unroll
        for (int ai = 0; ai < 2; ++ai)
#pragma unroll
            for (int m = 0; m < 4; ++m) {
                const int rt = ai * 128 + wr * 64 + m * 16 + fr, row = u.pm * 256 + rt;
                float sm = 0.f, sq = 0.f;
                float mu = 0.f, rs = 0.f;
                if (MODE == 0) { mu = stats[row * 2]; rs = stats[row * 2 + 1]; }
#pragma unroll
                for (int bj = 0; bj < 2; ++bj) {
                    const int col = u.pn * 256 + bj * 128 + wc * 32 + 8 * fq;
                    const size_t idx = (size_t)row * DM + col;
                    f32x4 v0, v1;
                    if (MODE == 0) {
                        const f32x4 x0 = *(const f32x4*)(x + idx), x1 = *(const f32x4*)(x + idx + 4);
                        v0 = ((x0 - mu) * rs * gi[bj][0] + bi[bj][0]) * ALPHA + acc[ai][bj][m][0];
                        v1 = ((x1 - mu) * rs * gi[bj][1] + bi[bj][1]) * ALPHA + acc[ai][bj][m][1];
                    } else {
                        const u32x4 w = *(const u32x4*)(pg + idx);
                        const u32x4 hw = *(const u32x4*)(h1 + idx);
                        v0 = (f32x4){bflo(hw.x), bfhi(hw.x), bflo(hw.y), bfhi(hw.y)} * ALPHA + acc[ai][bj][m][0];
                        v1 = (f32x4){bflo(hw.z), bfhi(hw.z), bflo(hw.w), bfhi(hw.w)} * ALPHA + acc[ai][bj][m][1];
                        v0[0] += bflo(w.x); v0[1] += bfhi(w.x); v0[2] += bflo(w.y); v0[3] += bfhi(w.y);
                        v1[0] += bflo(w.z); v1[1] += bfhi(w.z); v1[2] += bflo(w.w); v1[3] += bfhi(w.w);
                    }
                    acc[ai][bj][m][0] = v0; acc[ai][bj][m][1] = v1;
#pragma unroll
                    for (int e = 0; e < 4; ++e) { sm += v0[e] + v1[e]; sq += v0[e] * v0[e] + v1[e] * v1[e]; }
                }
                sm += shx(sm, 16, lane); sm += shx(sm, 32, lane);
                sq += shx(sq, 16, lane); sq += shx(sq, 32, lane);
                if (fq == 0) { P[(rt * 4 + wc) * 2] = sm; P[(rt * 4 + wc) * 2 + 1] = sq; }
            }
        __syncthreads();
        if (tid < 256) {
            const f32x4 a = *(const f32x4*)(P + tid * 8), c = *(const f32x4*)(P + tid * 8 + 4);
            float* slot = xbuf + ((size_t)(u.pm * 256 + tid) * 4 + u.pn) * 2;
            __hip_atomic_store(slot, (a[0] + a[2]) + (c[0] + c[2]), __ATOMIC_RELAXED, __HIP_MEMORY_SCOPE_AGENT);
            __hip_atomic_store(slot + 1, (a[1] + a[3]) + (c[1] + c[3]), __ATOMIC_RELAXED, __HIP_MEMORY_SCOPE_AGENT);
        }
        asm volatile("s_waitcnt vmcnt(0)" ::: "memory");
        __syncthreads();
        if (tid == 0) {
            xb_add(cnt + u.pm, 1u);
            unsigned sp = 0;
            while (xb_ld(cnt + u.pm) < 4u) { __builtin_amdgcn_s_sleep(1); if (++sp > (1u << 22)) break; }
        }
        __syncthreads();
        if (tid < 256) {
            float* slot = xbuf + (size_t)(u.pm * 256 + tid) * 8;
            float pv[8];
#pragma unroll
            for (int e = 0; e < 8; ++e) pv[e] = __hip_atomic_load(slot + e, __ATOMIC_RELAXED, __HIP_MEMORY_SCOPE_AGENT);
            const float sm = (pv[0] + pv[2]) + (pv[4] + pv[6]), sq = (pv[1] + pv[3]) + (pv[5] + pv[7]);
            const float mean = sm * (1.f / 1024.f);
            const float var = fmaxf(sq * (1.f / 1024.f) - mean * mean, 0.f);
            ST[tid * 2] = mean; ST[tid * 2 + 1] = rsqrtf(var + 1e-5f);
        }
        __syncthreads();
        f32x4 go[2][2], bo[2][2];
#pragma unroll
        for (int bj = 0; bj < 2; ++bj) {
            const int col = u.pn * 256 + bj * 128 + wc * 32 + 8 * fq;
            go[bj][0] = *(const f32x4*)(g + col); go[bj][1] = *(const f32x4*)(g + col + 4); bo[bj][0] = *(const f32x4*)(b + col); bo[bj][1] = *(const f32x4*)(b + col + 4);
        }
#pragma unroll
        for (int ai = 0; ai < 2; ++ai)
#pragma unroll
            for (int m = 0; m < 4; ++m) {
                const int rt = ai * 128 + wr * 64 + m * 16 + fr, row = u.pm * 256 + rt;
                const float mean = ST[rt * 2], rstd = ST[rt * 2 + 1];
#pragma unroll
                for (int bj = 0; bj < 2; ++bj) {
                    const int col = u.pn * 256 + bj * 128 + wc * 32 + 8 * fq;
                    const size_t idx = (size_t)row * DM + col;
                    const f32x4 o0 = (acc[ai][bj][m][0] - mean) * rstd * go[bj][0] + bo[bj][0], o1 = (acc[ai][bj][m][1] - mean) * rstd * go[bj][1] + bo[bj][1];
                    if (outf) { *(f32x4*)(outf + idx) = o0; *(f32x4*)(outf + idx + 4) = o1; }
                    if (outb) *(u32x4*)(outb + idx) = pack8(o0, o1);
                }
            }
    }
};

template <class Epi> DI void run_gemm(pg8::PG8_LAS_T lds, const bf16_t* A, const bf16_t* Bt, int N, int K, const Epi& E, const int wid_s) {
    pg8::Gemm g{A, Bt, M_TOK, N, K}; pg8::StaticOrder S; S.init(M_TOK, N, (int)gridDim.x, (int)blockIdx.x);
    pg8::gemm_phase<Epi, pg8::StaticOrder, true, true>(lds, g, S, E, wid_s);
}
__global__ void __launch_bounds__(512, 2) fwd_mega(Params P) {
    cg::grid_group grid = cg::this_grid();
    extern __shared__ __attribute__((aligned(16))) unsigned char lds[];
    pg8::PG8_LAS_T glds = (pg8::PG8_LAS_T)lds;
    volatile LAS unsigned* xb_words = (volatile LAS unsigned*)(glds + LDS_MISC);
    volatile int* s_item = (volatile int*)(lds + LDS_MISC + 16);
    const int nblk = gridDim.x, bid = blockIdx.x;
    unsigned char* ws = P.ws;

    const int wid_s = __builtin_amdgcn_readfirstlane((int)threadIdx.x >> 6);
    if (threadIdx.x < 4) xb_words[threadIdx.x] = 0u;
    __syncthreads();
    const XcdBarrier xbar = xcd_barrier_post((unsigned*)(ws + OFF_BAR), xb_words, (int)threadIdx.x);
    if (P.out == nullptr) grid.sync();

    {
    for (int base = bid * 2; base < 1984 + 4096; base += nblk * 2) {
        PHASE_IDS
        const int it = base + team;
        if (it < 960) {
            transpose_tile(P.in[4], 1024, 3600, (bf16_t*)(ws + OFF_WIN), it / 60, it % 60, 1, (float*)smem, tt);
        } else if (it < 1984) {
            const int loc = it - 960;
            transpose_tile(P.in[15], 4096, 1024, (bf16_t*)(ws + OFF_WDOWN), loc / 16, loc % 16, 0, (float*)smem, tt);
        } else {
            const int row = (it - 1984) * 4 + tw;
            ln_row(P.in[0] + (size_t)row * DM, P.in[2], P.in[3], nullptr, (bf16_t*)(ws + OFF_HB) + (size_t)row * DM, (float*)(ws + OFF_STATS) + row * 2, lane);
            { const f32x4 pv = *(const f32x4*)(P.in[1] + (size_t)row * 256 + lane * 4); u32x2 w; w.x = pack2(pv[0], pv[1]); w.y = pack2(pv[2], pv[3]);
              *(u32x2*)((bf16_t*)(ws + OFF_PB) + (size_t)row * 256 + lane * 4) = w; }
        }
    }
    }
    xcd_barrier(xbar, wid_s);

    { EpiProj E{ws}; run_gemm(glds, (const bf16_t*)(ws + OFF_HB), (const bf16_t*)(ws + OFF_WIN), NPROJ, DM, E, wid_s); }
    {
        const int nun = (M_TOK / 256) * (NPROJ / 256);
        const int maxu = (nun + nblk - 1) / nblk;
        int first_short = nun - (maxu - 1) * nblk, nshort = nblk - first_short;
        if (nshort <= 0) { first_short = 0; nshort = nblk; }
        if (bid >= first_short) {
            for (int base = (bid - first_short) * 2; base < 1600; base += nshort * 2) {
                PHASE_IDS
                const int j = base + team;
                const float* W; int K, N, loc, nnt; bf16_t* Wt;
                if (j < 256) { W = P.in[11]; K = 1024; N = 1024; Wt = (bf16_t*)(ws + OFF_WOUT); loc = j; nnt = 16; }
                else if (j < 1280) { W = P.in[14]; K = 1024; N = 4096; Wt = (bf16_t*)(ws + OFF_WUP); loc = j - 256; nnt = 64; }
                else if (j < 1536) { W = P.in[17]; K = 1024; N = 1024; Wt = (bf16_t*)(ws + OFF_WG); loc = j - 1280; nnt = 16; }
                else { W = P.in[16]; K = 256; N = 1024; Wt = (bf16_t*)(ws + OFF_WPLE); loc = j - 1536; nnt = 16; }
                transpose_tile(W, K, N, Wt, loc / nnt, loc % nnt, 0, (float*)smem, tt);
            }
        }
    }
    xcd_barrier(xbar, wid_s);

    for (int rep = 0; rep < NREP(2); ++rep)
    {
    for (int base = bid * 2; base < 1024 + 64; base += nblk * 2) {
        PHASE_IDS
        const int it = base + team;
        if (it < 1024) prep_chunk(P, it, smem, tt); else fox_cumsum(P, it - 1024, smem, tt);
    }
    }
    xcd_barrier(xbar, wid_s);

    for (int rep = 0; rep < NREP(3); ++rep)
    {
    bool first = true;
    for (;;) {
        PHASE_IDS
        int pr;
        if (first) { first = false; pr = bid; }
        else {
            __syncthreads();
            if (tid == 0) *s_item = nblk + atomicAdd((int*)(ws + OFF_CTR) + rep, 1);
            __syncthreads();
            pr = *s_item;
        }
        if (pr >= 64 + 512) break;
        if (pr < 64) gdn_scan(P, pr * 2 + team, smem, tt);
        else { const int fj = pr - 64; fox_attn(P, (fj & 31) * 2 + team, 15 - (fj >> 5), smem, tt); }
    }
    }
    xcd_barrier(xbar, wid_s);

    { PHASE_IDS
    for (int it = bid; it < M_TOK / 8; it += nblk) {
        const int row = it * 8 + wave8;
        bf16_t* mix = (bf16_t*)(ws + OFF_MIX) + (size_t)row * DM;
        {
            const int col = lane * 8;
            const u32x4 ov = *(const u32x4*)((const bf16_t*)(ws + OFF_OG) + (size_t)row * 512 + col);
            const u32x4 zv = *(const u32x4*)((const bf16_t*)(ws + OFF_Z) + (size_t)row * 512 + col);
            float o[8] = {bflo(ov.x), bfhi(ov.x), bflo(ov.y), bfhi(ov.y), bflo(ov.z), bfhi(ov.z), bflo(ov.w), bfhi(ov.w)};
            float z[8] = {bflo(zv.x), bfhi(zv.x), bflo(zv.y), bfhi(zv.y), bflo(zv.z), bfhi(zv.z), bflo(zv.w), bfhi(zv.w)};
            float ss = 0.f;
#pragma unroll
            for (int e = 0; e < 8; ++e) ss += o[e] * o[e];
            ss += shx(ss, 1, lane); ss += shx(ss, 2, lane); ss += shx(ss, 4, lane); ss += shx(ss, 8, lane);
            const float sc = rsqrtf(ss * (1.f / 128.f) + 1e-6f);
            const float* gg = P.in[8] + (col & 127);
            float v[8];
#pragma unroll
            for (int e = 0; e < 8; ++e) v[e] = o[e] * sc * gg[e] * siluf(z[e]);
            u32x4 w; w.x = pack2(v[0], v[1]); w.y = pack2(v[2], v[3]); w.z = pack2(v[4], v[5]); w.w = pack2(v[6], v[7]);
            *(u32x4*)(mix + col) = w;
        }
    }
    }
    xcd_barrier(xbar, wid_s);

    { EpiLnFused<0> E{P.in[0], P.in[2], P.in[3], (const float*)(ws + OFF_STATS), nullptr, nullptr, (float*)(ws + OFF_XBUF), (unsigned*)(ws + OFF_PCNT), P.in[12], P.in[13], nullptr, (bf16_t*)(ws + OFF_H1B)};
      run_gemm(glds, (const bf16_t*)(ws + OFF_MIX), (const bf16_t*)(ws + OFF_WOUT), DM, DM, E, wid_s); }
    xcd_barrier(xbar, wid_s);

    { EpiUp E{(bf16_t*)(ws + OFF_FFB)}; run_gemm(glds, (const bf16_t*)(ws + OFF_H1B), (const bf16_t*)(ws + OFF_WUP), 4096, DM, E, wid_s); }
    { EpiGate E{(bf16_t*)(ws + OFF_PG), P.in[18]}; run_gemm(glds, (const bf16_t*)(ws + OFF_H1B), (const bf16_t*)(ws + OFF_WG), DM, DM, E, wid_s); }
    { EpiPle E{(bf16_t*)(ws + OFF_PG)}; run_gemm(glds, (const bf16_t*)(ws + OFF_PB), (const bf16_t*)(ws + OFF_WPLE), DM, 256, E, wid_s); }
    xcd_barrier(xbar, wid_s);

    { EpiLnFused<1> E{nullptr, nullptr, nullptr, nullptr, (const bf16_t*)(ws + OFF_H1B), (const bf16_t*)(ws + OFF_PG), (float*)(ws + OFF_XBUF) + (size_t)M_TOK * 8, (unsigned*)(ws + OFF_PCNT) + 64, P.in[19], P.in[20], P.out, nullptr};
      run_gemm(glds, (const bf16_t*)(ws + OFF_FFB), (const bf16_t*)(ws + OFF_WDOWN), DM, 4096, E, wid_s); }
}

extern "C" void kernel_launch(void* const* d_in, const int* in_sizes, int n_in, void* d_out, int out_size, void* d_ws, size_t ws_size, hipStream_t stream) {
    static int grid_blocks = 0;
    if (!grid_blocks) {
        int dev = 0, cus = 0, per_cu = 0;
        (void)hipGetDevice(&dev);
        (void)hipDeviceGetAttribute(&cus, hipDeviceAttributeMultiprocessorCount, dev);
        if (hipFuncSetAttribute((const void*)fwd_mega, hipFuncAttributeMaxDynamicSharedMemorySize, LDS_BYTES) != hipSuccess) fprintf(stderr, "kernel_launch: hipFuncSetAttribute failed\n");
        (void)hipOccupancyMaxActiveBlocksPerMultiprocessor(&per_cu, (const void*)fwd_mega, 512, LDS_BYTES);
        if (per_cu < 1) fprintf(stderr, "kernel_launch: occupancy query reports %d blocks per CU\n", per_cu);
        (void)hipGetLastError();
        grid_blocks = cus;
        if (ws_size < 232 * MBy) fprintf(stderr, "kernel_launch: workspace too small (%zu)\n", ws_size);
    }
    Params p{};
    for (int i = 0; i < 21; ++i) p.in[i] = (const float*)d_in[i];
    p.out = (float*)d_out; p.ws = (unsigned char*)d_ws;
    (void)hipMemsetAsync((unsigned char*)d_ws + OFF_BAR, 0, 16384, stream);
    void* args[] = {&p};
    hipError_t e = hipLaunchCooperativeKernel((void*)fwd_mega, dim3(grid_blocks), dim3(512), args, LDS_BYTES, stream);
    if (e != hipSuccess) fprintf(stderr, "cooperative launch failed: %s (grid %d)\n", hipGetErrorString(e), grid_blocks);
}
```

```cpp
#include <hip/hip_runtime.h>
#include <hip/hip_cooperative_groups.h>
#include <cstdio>
namespace cg = cooperative_groups;

typedef unsigned short bf16_t;
typedef short bf16x8 __attribute__((ext_vector_type(8)));
typedef short s16x4 __attribute__((ext_vector_type(4)));
typedef float f32x16 __attribute__((ext_vector_type(16)));
typedef float f32x4 __attribute__((ext_vector_type(4)));
typedef unsigned u32x4 __attribute__((ext_vector_type(4)));
typedef unsigned u32x2 __attribute__((ext_vector_type(2)));
typedef float f32x2v __attribute__((ext_vector_type(2)));

#define DI __device__ __forceinline__
#define MFMA32(a, b, c) __builtin_amdgcn_mfma_f32_32x32x16_bf16((a), (b), (c), 0, 0, 0)

constexpr int M_TOK = 16384, DM = 1024, TSEQ = 2048;
constexpr int NPROJ = 3840;
constexpr size_t MBy = 1u << 20;
constexpr size_t OFF_WIN = 0, OFF_WOUT = 8 * MBy, OFF_WUP = 10 * MBy, OFF_WDOWN = 18 * MBy, OFF_WG = 26 * MBy, OFF_WPLE = 28 * MBy;
constexpr size_t OFF_STATS = 28 * MBy + 512 * 1024, OFF_GLAST = 28 * MBy + 640 * 1024, OFF_BAR = 29 * MBy + 512 * 1024, OFF_CTR = OFF_BAR + 14336, OFF_CF = 28 * MBy + 768 * 1024;
constexpr size_t OFF_XBUF = 31 * MBy, OFF_PCNT = OFF_BAR + 14848;
constexpr size_t OFF_GATES = 30 * MBy, OFF_GQKV = 32 * MBy, OFF_Z = 80 * MBy, OFF_FQK = 96 * MBy, OFF_VT = 128 * MBy, OFF_HB = 144 * MBy;
constexpr size_t OFF_U = 144 * MBy, OFF_W = 160 * MBy, OFF_QD = 176 * MBy, OFF_KDT = 192 * MBy, OFF_QK = 208 * MBy;
constexpr size_t OFF_OG = 32 * MBy, OFF_MIX = 216 * MBy;
constexpr size_t OFF_H1B = 32 * MBy, OFF_PB = 248 * MBy, OFF_FFB = 72 * MBy, OFF_PG = 200 * MBy;
constexpr float ALPHA = 1.189207115002721f;
constexpr int TEAM_LDS = 76800, LDS_MISC = 153600, LDS_BYTES = 153600 + 256;
#ifndef REP_MASK
#define REP_MASK 0
#endif
#define NREP(k) (1 + ((REP_MASK >> (k)) & 1))

struct Params { const float* in[21]; float* out; unsigned char* ws; };

DI float bf2f(unsigned b) { return __uint_as_float(b << 16); }
typedef float f32x2_t __attribute__((ext_vector_type(2))); typedef __bf16 bf16x2_t __attribute__((ext_vector_type(2)));
DI unsigned pack2(float lo, float hi) { f32x2_t v = {lo, hi}; bf16x2_t b = __builtin_convertvector(v, bf16x2_t); return __builtin_bit_cast(unsigned, b); }
DI unsigned f2bf(float x) { return pack2(x, 0.f) & 0xffffu; }
DI float bflo(unsigned w) { return __uint_as_float(w << 16); }
DI float bfhi(unsigned w) { return __uint_as_float(w & 0xffff0000u); }
DI int crow(int e, int h) { return (e & 3) + 8 * (e >> 2) + 4 * h; }
DI float shx(float v, int mask, int lane) { return __int_as_float(__builtin_amdgcn_ds_bpermute((lane ^ mask) << 2, __float_as_int(v))); }
DI float shup(float v, int o, int lane) { return __int_as_float(__builtin_amdgcn_ds_bpermute(((lane - o) & 63) << 2, __float_as_int(v))); }
DI float shlane(float v, int src) { return __int_as_float(__builtin_amdgcn_readlane(__float_as_int(v), src)); }
DI float wave_sum(float v, int lane) { for (int o = 32; o > 0; o >>= 1) v += shx(v, o, lane); return v; }
DI float siluf(float x) { return x * __builtin_amdgcn_rcpf(1.f + __expf(-x)); }
DI float sigmoidf_(float x) { return __builtin_amdgcn_rcpf(1.f + __expf(-x)); }
DI int fresh_tid(int wid_s) { int l; asm volatile("v_mbcnt_lo_u32_b32 %0, -1, 0\n\tv_mbcnt_hi_u32_b32 %0, -1, %0" : "=v"(l)); return wid_s * 64 + l; }
#define PHASE_IDS const int tid = fresh_tid(wid_s), lane = tid & 63, wave8 = tid >> 6, team = tid >> 8, tt = tid & 255, tw = tt >> 6; unsigned char* smem = lds + team * TEAM_LDS; (void)lane; (void)wave8; (void)tt; (void)tw; (void)smem;

DI void ln_row(const float* src, const float* __restrict__ g, const float* __restrict__ b, float* dstf, bf16_t* dstb, float* stats, int lane) {
    f32x4 v[4];
#pragma unroll
    for (int i = 0; i < 4; ++i) v[i] = *(const f32x4*)(src + i * 256 + lane * 4);
    float s = 0.f;
#pragma unroll
    for (int i = 0; i < 4; ++i) s += (v[i][0] + v[i][1]) + (v[i][2] + v[i][3]);
    s = wave_sum(s, lane);
    const float mu = s * (1.f / 1024.f);
    float q = 0.f;
#pragma unroll
    for (int i = 0; i < 4; ++i) { f32x4 d = v[i] - mu; q += (d[0] * d[0] + d[1] * d[1]) + (d[2] * d[2] + d[3] * d[3]); }
    q = wave_sum(q, lane);
    const float rstd = rsqrtf(q * (1.f / 1024.f) + 1e-5f);
    f32x4 gv[4], bv[4];
#pragma unroll
    for (int i = 0; i < 4; ++i) { gv[i] = *(const f32x4*)(g + i * 256 + lane * 4); bv[i] = *(const f32x4*)(b + i * 256 + lane * 4); }
#pragma unroll
    for (int i = 0; i < 4; ++i) {
        const f32x4 gg = gv[i], bb = bv[i];
        const f32x4 o = (v[i] - mu) * rstd * gg + bb;
        if (dstf) *(f32x4*)(dstf + i * 256 + lane * 4) = o;
        if (dstb) { u32x2 w; w.x = pack2(o[0], o[1]); w.y = pack2(o[2], o[3]); *(u32x2*)(dstb + i * 256 + lane * 4) = w; }
    }
    if (stats && lane == 0) { stats[0] = mu; stats[1] = rstd; }
}

DI void transpose_tile(const float* __restrict__ W, int K, int N, bf16_t* __restrict__ Wt, int kt, int nt, int mode, float* tile, int tt) {
    const int tid = tt;
    const int k0 = kt * 64, n0 = nt * 64;
    {
        const int c = tid & 63, n = n0 + c;
        int sc = n;
        if (mode == 1) { sc = (n < 2048) ? n : (n < 3584) ? n + 8 : (n < 3592) ? 2048 + (n - 3584) : (n < 3600) ? n : -1; }
        const int scc = sc >= 0 ? sc : 0;
        const float mk = sc >= 0 ? 1.f : 0.f;
        float wv[16];
#pragma unroll
        for (int i = 0; i < 16; ++i) wv[i] = W[(size_t)(k0 + (tid >> 6) + 4 * i) * N + scc];
#pragma unroll
        for (int i = 0; i < 16; ++i) tile[((tid >> 6) + 4 * i) * 65 + c] = wv[i] * mk;
    }
    __syncthreads();
    {
        const int n = tid >> 2, ks = (tid & 3) * 16;
        u32x4 o0, o1;
        o0.x = pack2(tile[(ks + 0) * 65 + n], tile[(ks + 1) * 65 + n]); o0.y = pack2(tile[(ks + 2) * 65 + n], tile[(ks + 3) * 65 + n]);
        o0.z = pack2(tile[(ks + 4) * 65 + n], tile[(ks + 5) * 65 + n]); o0.w = pack2(tile[(ks + 6) * 65 + n], tile[(ks + 7) * 65 + n]);
        o1.x = pack2(tile[(ks + 8) * 65 + n], tile[(ks + 9) * 65 + n]); o1.y = pack2(tile[(ks + 10) * 65 + n], tile[(ks + 11) * 65 + n]);
        o1.z = pack2(tile[(ks + 12) * 65 + n], tile[(ks + 13) * 65 + n]); o1.w = pack2(tile[(ks + 14) * 65 + n], tile[(ks + 15) * 65 + n]);
        bf16_t* dst = Wt + (size_t)(n0 + n) * K + k0 + ks;
        *(u32x4*)dst = o0; *(u32x4*)(dst + 8) = o1;
    }
    __syncthreads();
}

namespace pg8 {
#define PG8_LAS __attribute__((address_space(3)))
typedef PG8_LAS unsigned char* PG8_LAS_T;
typedef unsigned short bf16_t;
typedef short bf16x8 __attribute__((ext_vector_type(8)));
typedef float f32x4 __attribute__((ext_vector_type(4)));
typedef unsigned u32x4 __attribute__((ext_vector_type(4)));
constexpr int BM = 256, BK = 64, HALF = 128, HTB = HALF * BK * 2  , STAGE_BYTES = 8 * HTB, NXCD = 8, WGM = 8;

__host__ __device__ __forceinline__ int lds_byte(int r, int c) { const int st = (r >> 4) * 2 + (c >> 5), rr = r & 15, cc = c & 31, ob = rr * 64 + cc * 2; return st * 1024 + (ob ^ (((ob >> 9) & 1) << 5)); }
__host__ __device__ __forceinline__ void stage_rc(int b, int& R, int& C) { const int st = b / 1024, sb = b % 1024, swz = sb ^ (((sb >> 9) & 1) << 5); R = (st >> 1) * 16 + swz / 64; C = (st & 1) * 32 + (swz % 64) / 2; }
__host__ __device__ __forceinline__ int perm32(int rho) { const int n = rho >> 4, i = rho & 15; return 8 * (i >> 2) + 4 * n + (i & 3); }

struct Unit { int pm, pn; };
struct Gemm { const bf16_t* A; const bf16_t* Bt; int M, N, K; };

struct StaticOrder {
    int nM, nN, nwg, G, c;
    __host__ __device__ void init(int M, int N, int G_, int c_) { nM = M / BM; nN = N / BM; nwg = nM * nN; G = G_; c = c_; }
    __host__ __device__ bool next(int i, Unit& u) const {
        const long L = (long)i * G + c; if (L >= nwg) return false;
        int wgid = (int)L; { const int q = nwg / NXCD, r = nwg % NXCD, xcd = wgid % NXCD, off = wgid / NXCD; wgid = (xcd < r ? xcd * (q + 1) : r * (q + 1) + (xcd - r) * q) + off; }
        const int nig = WGM * nN, gid = wgid / nig, fm = gid * WGM, gsz = (nM - fm) < WGM ? (nM - fm) : WGM;
        u.pm = fm + ((wgid % nig) % gsz); u.pn = (wgid % nig) / gsz; return true;
    }
    __device__ __forceinline__ void a_ready(const Unit&) const {}
    __device__ __forceinline__ void done(const Unit&) const {}
};
template <class Epi, class Sched, bool ALIGN_EPI = false, bool SP2 = false>
__device__ __forceinline__ void gemm_phase(PG8_LAS unsigned char* lds, const Gemm g, const Sched& S, const Epi& E, const int wid_s) {
    const int tid = fresh_tid(wid_s), wid = wid_s, lane = tid & 63, wr = wid >> 2, wc = wid & 3, fr = lane & 15, fq = lane >> 4;
    const int K = g.K, nt = K / BK;
    unsigned voffA[2], voffB[2];
#pragma unroll
    for (int i = 0; i < 2; ++i) { int R, C; stage_rc(tid * 16 + i * 8192, R, C); const int Rb = Epi::PERM ? ((R & ~31) + perm32(R & 31)) : R;
        voffA[i] = (unsigned)(R * K + C) * 2u; voffB[i] = (unsigned)(Rb * K + C) * 2u; }
    const size_t kstep = (size_t)(BK * 2);
    const size_t hstep = (size_t)HALF * K * 2;
    const size_t tstep = 2 * hstep;
    const unsigned ldsw = (unsigned)wid * 1024u;
    const int aoff = lds_byte(wr * 64 + fr, fq * 8), boff = lds_byte(wc * 32 + fr, fq * 8);
#define PG8_SA(b, h) (((b) * 2 + (h)) * HTB)
#define PG8_SB(b, h) ((4 + (b) * 2 + (h)) * HTB)
#define PG8_STAGE(bufoff, gbase, voff) do { _Pragma("unroll") for (int _i = 0; _i < 2; ++_i) \
        __builtin_amdgcn_global_load_lds((const unsigned*)((const char*)(gbase) + (voff)[_i]), (PG8_LAS unsigned*)(lds + (bufoff) + ldsw + _i * 8192), 16, 0, 0); } while (0)
#define PG8_LDA(dst, b, h) do { _Pragma("unroll") for (int m = 0; m < 4; ++m) _Pragma("unroll") for (int k = 0; k < 2; ++k) dst[m][k] = *(const PG8_LAS bf16x8*)(lds + PG8_SA(b, h) + aoff + m * 2048 + k * 1024); } while (0)
#define PG8_LDB(dst, b, h) do { _Pragma("unroll") for (int n = 0; n < 2; ++n) _Pragma("unroll") for (int k = 0; k < 2; ++k) dst[n][k] = *(const PG8_LAS bf16x8*)(lds + PG8_SB(b, h) + boff + n * 2048 + k * 1024); } while (0)
#define PG8_MMA(ai, bj, At, Bt) do { __builtin_amdgcn_s_setprio(1); _Pragma("unroll") for (int m = 0; m < 4; ++m) _Pragma("unroll") for (int n = 0; n < 2; ++n) _Pragma("unroll") for (int k = 0; k < 2; ++k) \
        acc[ai][bj][m][n] = __builtin_amdgcn_mfma_f32_16x16x32_bf16(Bt[n][k], At[m][k], acc[ai][bj][m][n], 0, 0, 0); __builtin_amdgcn_s_setprio(0); } while (0)
#define PG8_WAIT_V(n) asm volatile("s_waitcnt vmcnt(" #n ")" ::: "memory")
#define PG8_WAIT_L(n) asm volatile("s_waitcnt lgkmcnt(" #n ")" ::: "memory")
#define PG8_BAR __builtin_amdgcn_s_barrier()
#define PG8_SCHED __builtin_amdgcn_sched_barrier(0)
    Unit cur, nxt; int ui = 0;
    if (!S.next(0, cur)) return;
    f32x4 acc[2][2][4][2];
#pragma unroll
    for (int a = 0; a < 2; ++a)
#pragma unroll
        for (int b = 0; b < 2; ++b)
#pragma unroll
            for (int m = 0; m < 4; ++m)
#pragma unroll
                for (int n = 0; n < 2; ++n) acc[a][b][m][n] = (f32x4){0.f, 0.f, 0.f, 0.f};
    bf16x8 At[4][2], B0[2][2], B1[2][2];
    const char* cA = (const char*)g.A + (size_t)cur.pm * tstep; const char* cB = (const char*)g.Bt + (size_t)cur.pn * tstep;
    S.a_ready(cur);
    if constexpr (SP2) {
        PG8_STAGE(PG8_SB(0, 0), cB, voffB); PG8_STAGE(PG8_SB(0, 1), cB + hstep, voffB); PG8_STAGE(PG8_SA(0, 0), cA, voffA); PG8_STAGE(PG8_SA(0, 1), cA + hstep, voffA);
        if (wr == 1) PG8_BAR;
        PG8_WAIT_V(2); PG8_BAR;
        PG8_STAGE(PG8_SB(1, 0), cB + kstep, voffB); PG8_STAGE(PG8_SA(1, 0), cA + kstep, voffA); PG8_STAGE(PG8_SB(1, 1), cB + hstep + kstep, voffB);
        PG8_WAIT_V(6); PG8_BAR;
    } else {
        PG8_STAGE(PG8_SB(0, 0), cB, voffB); PG8_STAGE(PG8_SA(0, 0), cA, voffA); PG8_STAGE(PG8_SB(0, 1), cB + hstep, voffB); PG8_STAGE(PG8_SA(0, 1), cA + hstep, voffA);
        if (wr == 1) PG8_BAR;
        PG8_WAIT_V(4); PG8_BAR;
        PG8_STAGE(PG8_SB(1, 0), cB + kstep, voffB); PG8_STAGE(PG8_SA(1, 0), cA + kstep, voffA); PG8_STAGE(PG8_SB(1, 1), cB + hstep + kstep, voffB);
        PG8_WAIT_V(6); PG8_BAR;
    }
    for (;;) {
        const bool has_next = S.next(ui + 1, nxt);
        const char* nA = has_next ? (const char*)g.A + (size_t)nxt.pm * tstep : cA; const char* nB = has_next ? (const char*)g.Bt + (size_t)nxt.pn * tstep : cB;
        for (int t = 0; t < nt; t += 2) {
            const bool last = (t == nt - 2);
            const char* a1 = cA + (size_t)(t + 1) * kstep;
            const char* a2 = last ? nA : cA + (size_t)(t + 2) * kstep; const char* b2 = last ? nB : cB + (size_t)(t + 2) * kstep;
            const char* a3 = a2 + kstep; const char* b3 = b2 + kstep;
            if (last && has_next) S.a_ready(nxt);
            if constexpr (SP2) {
            PG8_LDB(B0, 0, 0); PG8_LDB(B1, 0, 1); PG8_SCHED; PG8_LDA(At, 0, 0); PG8_STAGE(PG8_SA(1, 1), a1 + hstep, voffA);
            PG8_WAIT_V(8); PG8_WAIT_L(0); PG8_BAR; PG8_MMA(0, 0, At, B0); PG8_MMA(0, 1, At, B1); PG8_BAR; PG8_SCHED;
            PG8_LDA(At, 0, 1); PG8_STAGE(PG8_SB(0, 0), b2, voffB); PG8_STAGE(PG8_SB(0, 1), b2 + hstep, voffB); PG8_STAGE(PG8_SA(0, 0), a2, voffA);
            PG8_WAIT_V(8); PG8_WAIT_L(0); PG8_BAR; PG8_MMA(1, 0, At, B0); PG8_MMA(1, 1, At, B1); PG8_BAR; PG8_SCHED;
            PG8_LDB(B0, 1, 0); PG8_LDB(B1, 1, 1); PG8_SCHED; PG8_LDA(At, 1, 0); PG8_STAGE(PG8_SA(0, 1), a2 + hstep, voffA);
            PG8_WAIT_V(8); PG8_WAIT_L(0); PG8_BAR; PG8_MMA(0, 0, At, B0); PG8_MMA(0, 1, At, B1); PG8_BAR; PG8_SCHED;
            PG8_LDA(At, 1, 1); PG8_STAGE(PG8_SB(1, 0), b3, voffB); PG8_STAGE(PG8_SB(1, 1), b3 + hstep, voffB); PG8_STAGE(PG8_SA(1, 0), a3, voffA);
            PG8_WAIT_V(8); PG8_WAIT_L(0); PG8_BAR; PG8_MMA(1, 0, At, B0); PG8_MMA(1, 1, At, B1); PG8_BAR; PG8_SCHED;
            } else {
            PG8_LDB(B0, 0, 0); PG8_SCHED; PG8_LDA(At, 0, 0); PG8_STAGE(PG8_SA(1, 1), a1 + hstep, voffA);
            PG8_WAIT_L(8); PG8_BAR; PG8_WAIT_L(0); PG8_MMA(0, 0, At, B0); PG8_BAR; PG8_SCHED;
            PG8_LDB(B1, 0, 1); PG8_STAGE(PG8_SB(0, 0), b2, voffB);
            PG8_BAR; PG8_WAIT_L(0); PG8_MMA(0, 1, At, B1); PG8_BAR;
            PG8_LDA(At, 0, 1); PG8_STAGE(PG8_SA(0, 0), a2, voffA);
            PG8_BAR; PG8_WAIT_L(0); PG8_MMA(1, 0, At, B0); PG8_BAR; PG8_SCHED;
            PG8_STAGE(PG8_SB(0, 1), b2 + hstep, voffB);
            PG8_WAIT_V(6); PG8_BAR; PG8_MMA(1, 1, At, B1); PG8_BAR;
            PG8_LDB(B0, 1, 0); PG8_SCHED; PG8_LDA(At, 1, 0); PG8_STAGE(PG8_SA(0, 1), a2 + hstep, voffA);
            PG8_WAIT_L(8); PG8_BAR; PG8_WAIT_L(0); PG8_MMA(0, 0, At, B0); PG8_BAR; PG8_SCHED;
            PG8_LDB(B1, 1, 1); PG8_STAGE(PG8_SB(1, 0), b3, voffB);
            PG8_BAR; PG8_WAIT_L(0); PG8_MMA(0, 1, At, B1); PG8_BAR;
            PG8_LDA(At, 1, 1); PG8_STAGE(PG8_SA(1, 0), a3, voffA);
            PG8_BAR; PG8_WAIT_L(0); PG8_MMA(1, 0, At, B0); PG8_BAR; PG8_SCHED;
            PG8_STAGE(PG8_SB(1, 1), b3 + hstep, voffB);
            PG8_WAIT_V(6); PG8_BAR; PG8_MMA(1, 1, At, B1); PG8_BAR;
            }
        }
        if constexpr (ALIGN_EPI) { if (wr == 0) PG8_BAR; }
        if constexpr (!Epi::AFTER_DRAIN) { E(acc, cur, wr, wc, fr, fq); S.done(cur); }
        if (!has_next) break;
#pragma unroll
        for (int a = 0; a < 2; ++a)
#pragma unroll
            for (int b = 0; b < 2; ++b)
#pragma unroll
                for (int m = 0; m < 4; ++m)
#pragma unroll
                    for (int n = 0; n < 2; ++n) acc[a][b][m][n] = (f32x4){0.f, 0.f, 0.f, 0.f};
        cur = nxt; cA = nA; cB = nB; ++ui;
        if constexpr (ALIGN_EPI) { if (wr == 1) PG8_BAR; }
    }
    PG8_WAIT_V(0);
    if constexpr (!ALIGN_EPI) { if (wr == 0) PG8_BAR; }
    PG8_BAR;
    if constexpr (Epi::AFTER_DRAIN) { E.fused(acc, cur, wr, wc, fr, fq, lds, wid, lane); S.done(cur); }
#undef PG8_SA
#undef PG8_SB
#undef PG8_STAGE
#undef PG8_LDA
#undef PG8_LDB
#undef PG8_MMA
#undef PG8_WAIT_V
#undef PG8_WAIT_L
#undef PG8_BAR
#undef PG8_SCHED
}
}

template <class F> DI void epi_rows(const pg8::f32x4 (&acc)[2][2][4][2], const pg8::Unit& u, int wr, int wc, int fr, int fq, F f) {
#pragma unroll
    for (int ai = 0; ai < 2; ++ai)
#pragma unroll
        for (int m = 0; m < 4; ++m) {
            const int row = u.pm * 256 + ai * 128 + wr * 64 + m * 16 + fr;
#pragma unroll
            for (int bj = 0; bj < 2; ++bj) f(row, u.pn * 256 + bj * 128 + wc * 32 + 8 * fq, acc[ai][bj][m][0], acc[ai][bj][m][1]);
        }
}
DI u32x4 pack8(const f32x4& a, const f32x4& b) { u32x4 w; w.x = pack2(a[0], a[1]); w.y = pack2(a[2], a[3]); w.z = pack2(b[0], b[1]); w.w = pack2(b[2], b[3]); return w; }
struct EpiProj {
    static constexpr bool PERM = true, AFTER_DRAIN = false;
    unsigned char* ws;
    DI void operator()(const pg8::f32x4 (&acc)[2][2][4][2], const pg8::Unit& u, int wr, int wc, int fr, int fq) const {
        const int pn = u.pn;
        if (pn < 12) {
            bf16_t* dst; int ld, cofs;
            if (pn < 6) { dst = (bf16_t*)(ws + OFF_GQKV); ld = 1536; cofs = 0; }
            else if (pn < 8) { dst = (bf16_t*)(ws + OFF_Z); ld = 512; cofs = 1536; }
            else { dst = (bf16_t*)(ws + OFF_FQK); ld = 1024; cofs = 2048; }
            epi_rows(acc, u, wr, wc, fr, fq, [&](int row, int col, const f32x4& a, const f32x4& b) { *(u32x4*)(dst + (size_t)row * ld + (col - cofs)) = pack8(a, b); });
        } else if (pn < 14) {
            bf16_t* vT = (bf16_t*)(ws + OFF_VT);
            epi_rows(acc, u, wr, wc, fr, fq, [&](int row, int col, const f32x4& a, const f32x4& b) {
                const int c = col - 3072, hh = c >> 6, d0 = c & 63, bb = row >> 11, t = row & 2047;
                bf16_t* p = vT + ((size_t)(bb * 8 + hh) * 64 + d0) * TSEQ + t;
#pragma unroll
                for (int e = 0; e < 4; ++e) { p[(size_t)e * TSEQ] = (bf16_t)f2bf(a[e]); p[(size_t)(e + 4) * TSEQ] = (bf16_t)f2bf(b[e]); }
            });
        } else {
            float* gates = (float*)(ws + OFF_GATES);
            epi_rows(acc, u, wr, wc, fr, fq, [&](int row, int col, const f32x4& a, const f32x4& b) {
                const int c = col - 3584;
                if (c < 16) { *(f32x4*)(gates + (size_t)row * 16 + c) = a; *(f32x4*)(gates + (size_t)row * 16 + c + 4) = b; }
            });
        }
    }
};
struct EpiOutProj {
    static constexpr bool PERM = true, AFTER_DRAIN = false;
    const float* x; const float* g; const float* b; const float* stats; float* out;
    DI void operator()(const pg8::f32x4 (&acc)[2][2][4][2], const pg8::Unit& u, int wr, int wc, int fr, int fq) const {
        epi_rows(acc, u, wr, wc, fr, fq, [&](int row, int col, const f32x4& a0, const f32x4& a1) {
            const float mu = stats[row * 2], rs = stats[row * 2 + 1];
            const size_t idx = (size_t)row * DM + col;
            const f32x4 x0 = *(const f32x4*)(x + idx), x1 = *(const f32x4*)(x + idx + 4);
            const f32x4 g0 = *(const f32x4*)(g + col), g1 = *(const f32x4*)(g + col + 4), b0 = *(const f32x4*)(b + col), b1 = *(const f32x4*)(b + col + 4);
            *(f32x4*)(out + idx) = ((x0 - mu) * rs * g0 + b0) * ALPHA + a0;
            *(f32x4*)(out + idx + 4) = ((x1 - mu) * rs * g1 + b1) * ALPHA + a1;
        });
    }
};
struct EpiUp {
    static constexpr bool PERM = true, AFTER_DRAIN = false;
    bf16_t* ffb;
    DI void operator()(const pg8::f32x4 (&acc)[2][2][4][2], const pg8::Unit& u, int wr, int wc, int fr, int fq) const {
        epi_rows(acc, u, wr, wc, fr, fq, [&](int row, int col, const f32x4& a, const f32x4& b) {
            f32x4 ra, rb;
#pragma unroll
            for (int e = 0; e < 4; ++e) { const float va = fmaxf(a[e], 0.f), vb = fmaxf(b[e], 0.f); ra[e] = va * va; rb[e] = vb * vb; }
            *(u32x4*)(ffb + (size_t)row * 4096 + col) = pack8(ra, rb);
        });
    }
};
struct EpiGate {
    static constexpr bool PERM = true, AFTER_DRAIN = false;
    bf16_t* pg; const float* bias;
    DI void operator()(const pg8::f32x4 (&acc)[2][2][4][2], const pg8::Unit& u, int wr, int wc, int fr, int fq) const {
        f32x4 bv[2][2];
#pragma unroll
        for (int bj = 0; bj < 2; ++bj) { const int c0 = u.pn * 256 + bj * 128 + wc * 32 + 8 * fq; bv[bj][0] = *(const f32x4*)(bias + c0); bv[bj][1] = *(const f32x4*)(bias + c0 + 4); }
        epi_rows(acc, u, wr, wc, fr, fq, [&](int row, int col, const f32x4& a, const f32x4& b) {
            const int bj = (col >> 7) & 1;
            const f32x4 b0 = bv[bj][0], b1 = bv[bj][1];
            f32x4 ra, rb;
#pragma unroll
            for (int e = 0; e < 4; ++e) { ra[e] = sigmoidf_(a[e] + b0[e]); rb[e] = sigmoidf_(b[e] + b1[e]); }
            *(u32x4*)(pg + (size_t)row * DM + col) = pack8(ra, rb);
        });
    }
};
struct EpiPle {
    static constexpr bool PERM = true, AFTER_DRAIN = false;
    bf16_t* pg;
    DI void operator()(const pg8::f32x4 (&acc)[2][2][4][2], const pg8::Unit& u, int wr, int wc, int fr, int fq) const {
        epi_rows(acc, u, wr, wc, fr, fq, [&](int row, int col, const f32x4& a, const f32x4& b) {
            u32x4* p = (u32x4*)(pg + (size_t)row * DM + col);
            const u32x4 w = *p;
            f32x4 ra, rb;
            ra[0] = a[0] * bflo(w.x); ra[1] = a[1] * bfhi(w.x); ra[2] = a[2] * bflo(w.y); ra[3] = a[3] * bfhi(w.y);
            rb[0] = b[0] * bflo(w.z); rb[1] = b[1] * bfhi(w.z); rb[2] = b[2] * bflo(w.w); rb[3] = b[3] * bfhi(w.w);
            *p = pack8(ra, rb);
        });
    }
};
struct EpiDown {
    static constexpr bool PERM = true, AFTER_DRAIN = false;
    const bf16_t* pg; float* out;
    DI void operator()(const pg8::f32x4 (&acc)[2][2][4][2], const pg8::Unit& u, int wr, int wc, int fr, int fq) const {
        epi_rows(acc, u, wr, wc, fr, fq, [&](int row, int col, const f32x4& a, const f32x4& b) {
            const size_t idx = (size_t)row * DM + col;
            const u32x4 w = *(const u32x4*)(pg + idx);
            f32x4 o0 = *(const f32x4*)(out + idx), o1 = *(const f32x4*)(out + idx + 4);
            o0 = o0 * ALPHA + a; o1 = o1 * ALPHA + b;
            o0[0] += bflo(w.x); o0[1] += bfhi(w.x); o0[2] += bflo(w.y); o0[3] += bfhi(w.y);
            o1[0] += bflo(w.z); o1[1] += bfhi(w.z); o1[2] += bflo(w.w); o1[3] += bfhi(w.w);
            *(f32x4*)(out + idx) = o0; *(f32x4*)(out + idx + 4) = o1;
        });
    }
};
DI void lds_read8(unsigned addr, f32x4 (&a)[4][2]) {
    asm volatile(
        "ds_read_b128 %0, %8\n\tds_read_b128 %1, %8 offset:16\n\t"
        "ds_read_b128 %2, %8 offset:256\n\tds_read_b128 %3, %8 offset:272\n\t"
        "ds_read_b128 %4, %8 offset:512\n\tds_read_b128 %5, %8 offset:528\n\t"
        "ds_read_b128 %6, %8 offset:768\n\tds_read_b128 %7, %8 offset:784\n\t"
        "s_waitcnt lgkmcnt(0)"
        : "=&v"(a[0][0]), "=&v"(a[0][1]), "=&v"(a[1][0]), "=&v"(a[1][1]), "=&v"(a[2][0]), "=&v"(a[2][1]), "=&v"(a[3][0]), "=&v"(a[3][1])
        : "v"(addr) : "memory");
}
DI void lds_read8s(unsigned addr, f32x4 (&a)[4][2]) {
    asm volatile(
        "ds_read_b128 %0, %8\n\tds_read_b128 %1, %8 offset:16\n\t"
        "ds_read_b128 %2, %8 offset:128\n\tds_read_b128 %3, %8 offset:144\n\t"
        "ds_read_b128 %4, %8 offset:256\n\tds_read_b128 %5, %8 offset:272\n\t"
        "ds_read_b128 %6, %8 offset:384\n\tds_read_b128 %7, %8 offset:400\n\t"
        "s_waitcnt lgkmcnt(0)"
        : "=&v"(a[0][0]), "=&v"(a[0][1]), "=&v"(a[1][0]), "=&v"(a[1][1]), "=&v"(a[2][0]), "=&v"(a[2][1]), "=&v"(a[3][0]), "=&v"(a[3][1])
        : "v"(addr) : "memory");
}
DI void prep_chunk(const Params& P, int ci, unsigned char* smem, int tt) {
    const int tid = tt, lane = tid & 63, wave = tid >> 6, r = lane & 31, h2 = lane >> 5;
    const int b = ci >> 7, hd = (ci >> 5) & 3, n = ci & 31, t0 = n * 64;
    const size_t rowbase = (size_t)b * TSEQ + t0;
    bf16_t* kbf = (bf16_t*)smem;
    bf16_t* qbf = kbf + 64 * 136;
    bf16_t* vT  = (bf16_t*)smem;
    bf16_t* Tb  = (bf16_t*)(smem + 18432);
    bf16_t* Tg  = (bf16_t*)(smem + 27648);
    bf16_t* kT  = (bf16_t*)(smem + 36864);
    float*  Ad  = (float*)(smem + 55296);
    bf16_t* A10 = (bf16_t*)(smem + 63488);
    bf16_t* DT  = (bf16_t*)(smem + 66048);
    float* sbeta = (float*)(smem + 71168);
    float* sgam = sbeta + 64; float* segam = sgam + 64; float* sdk = segam + 64;
    bf16_t* D1R = (bf16_t*)(smem + 72192);
    const bf16_t* gq = (const bf16_t*)(P.ws + OFF_GQKV);
    const float* gates = (const float*)(P.ws + OFF_GATES);
    const float* cw = P.in[5];
    if (tid < 64) {
        const float* gt = gates + (rowbase + tid) * 16;
        const float be = sigmoidf_(gt[hd]);
        const float a = gt[4 + hd] + P.in[7][hd];
        const float sp = fmaxf(a, 0.f) + log1pf(__expf(-fabsf(a)));
        float lg = -__expf(P.in[6][hd]) * sp;
#pragma unroll
        for (int o = 1; o < 64; o <<= 1) { const float t = shup(lg, o, lane); if (lane >= o) lg += t; }
        const float gl = shlane(lg, 63);
        sbeta[tid] = be; sgam[tid] = lg; segam[tid] = __expf(lg); sdk[tid] = __expf(gl - lg);
    }
    {
        float* wl = Ad;
        for (int idx = tid; idx < 384; idx += 256) {
            const int wh = idx >> 7, rem = idx & 127, j = rem >> 5, c4 = (rem & 31) * 4;
            const int cbw = (wh == 0 ? 512 : wh == 1 ? 0 : 1024) + hd * 128;
            *(f32x4*)(wl + (wh * 4 + j) * 128 + c4) = *(const f32x4*)(cw + j * 1536 + cbw + c4);
        }
    }
    __syncthreads();
    unsigned vkeep[16];
#pragma unroll
    for (int e = 0; e < 16; ++e) vkeep[e] = 0u;
    {
        const int i = tid >> 2, seg = tid & 3;
        const float* wl = Ad;
#pragma unroll 1
        for (int which = 0; which < 3; ++which) {
            const int colbase = (which == 0 ? 512 : which == 1 ? 0 : 1024) + hd * 128 + seg * 32;
            u32x4 xr[4][4];
#pragma unroll
            for (int j = 0; j < 4; ++j) {
                const int t = t0 + i - 3 + j;
                const int tc = t < 0 ? 0 : t;
                const bf16_t* xp = gq + ((size_t)b * TSEQ + tc) * 1536 + colbase;
#pragma unroll
                for (int sub = 0; sub < 4; ++sub) xr[j][sub] = *(const u32x4*)(xp + sub * 8);
            }
            float val[32];
#pragma unroll
            for (int sub = 0; sub < 4; ++sub) {
                float a8[8];
#pragma unroll
                for (int e = 0; e < 8; ++e) a8[e] = 0.f;
#pragma unroll
                for (int j = 0; j < 4; ++j) {
                    const float mk = (t0 + i - 3 + j) < 0 ? 0.f : 1.f;
                    const u32x4 xv = xr[j][sub];
                    f32x4 w0 = *(const f32x4*)(wl + (which * 4 + j) * 128 + seg * 32 + sub * 8), w1 = *(const f32x4*)(wl + (which * 4 + j) * 128 + seg * 32 + sub * 8 + 4);
                    w0 = w0 * mk; w1 = w1 * mk;
                    a8[0] += w0[0] * bflo(xv.x); a8[1] += w0[1] * bfhi(xv.x); a8[2] += w0[2] * bflo(xv.y); a8[3] += w0[3] * bfhi(xv.y);
                    a8[4] += w1[0] * bflo(xv.z); a8[5] += w1[1] * bfhi(xv.z); a8[6] += w1[2] * bflo(xv.w); a8[7] += w1[3] * bfhi(xv.w);
                }
#pragma unroll
                for (int e = 0; e < 8; ++e) val[sub * 8 + e] = siluf(a8[e]);
            }
            float ss = 0.f;
#pragma unroll
            for (int e = 0; e < 32; ++e) ss += val[e] * val[e];
            ss += shx(ss, 1, lane); ss += shx(ss, 2, lane);
            const float sc = (which == 2) ? 1.f : rsqrtf(ss + 1e-6f) * (which == 1 ? 0.08838834764831845f : 1.f);
            unsigned pk[16];
#pragma unroll
            for (int e = 0; e < 16; ++e) pk[e] = pack2(val[2 * e] * sc, val[2 * e + 1] * sc);
            if (which == 2) {
#pragma unroll
                for (int e = 0; e < 16; ++e) vkeep[e] = pk[e];
            } else {
                bf16_t* dst = (which == 0 ? kbf : qbf) + i * 136 + seg * 32;
#pragma unroll
                for (int sub = 0; sub < 4; ++sub) { u32x4 o; o.x = pk[4 * sub]; o.y = pk[4 * sub + 1]; o.z = pk[4 * sub + 2]; o.w = pk[4 * sub + 3]; *(u32x4*)(dst + sub * 8) = o; }
                if (which == 0) {
                    bf16_t* kt = kT + (seg * 32) * 72 + i;
#pragma unroll
                    for (int e = 0; e < 16; ++e) { kt[(2 * e) * 72] = (bf16_t)(pk[e] & 0xffffu); kt[(2 * e + 1) * 72] = (bf16_t)(pk[e] >> 16); }
                }
            }
        }
    }
    __syncthreads();
    {
        const int mi = wave >> 1, ni = wave & 1;
        f32x16 aK, aQ;
#pragma unroll
        for (int e = 0; e < 16; ++e) { aK[e] = 0.f; aQ[e] = 0.f; }
#pragma unroll
        for (int ks = 0; ks < 8; ++ks) {
            const bf16x8 ak = *(const bf16x8*)(kbf + (mi * 32 + r) * 136 + ks * 16 + h2 * 8);
            const bf16x8 bk = *(const bf16x8*)(kbf + (ni * 32 + r) * 136 + ks * 16 + h2 * 8);
            const bf16x8 aq = *(const bf16x8*)(qbf + (mi * 32 + r) * 136 + ks * 16 + h2 * 8);
            aK = MFMA32(ak, bk, aK); aQ = MFMA32(aq, bk, aQ);
        }
        const int j = ni * 32 + r;
        const float gj = sgam[j];
        bf16_t* qkout = (bf16_t*)(P.ws + OFF_QK) + (size_t)ci * 4096;
#pragma unroll
        for (int e = 0; e < 16; ++e) {
            const int il = crow(e, h2), i = mi * 32 + il;
            const float dec = (i >= j) ? __expf(sgam[i] - gj) : 0.f;
            const float aij = (i > j) ? aK[e] * sbeta[i] * dec : 0.f;
            if (mi == ni) Ad[(mi * 32 + il) * 32 + r] = aij;
            else if (mi == 1) A10[il * 40 + r] = (bf16_t)f2bf(aij);
            qkout[(((i >> 5) * 4 + (j >> 4)) * 64 + (i & 31) + 32 * ((j >> 3) & 1)) * 8 + (j & 7)] = (bf16_t)f2bf((i >= j) ? aQ[e] * dec : 0.f);
        }
    }
    {
        const int i = tid >> 2, seg = tid & 3;
        const float eg = segam[i];
        bf16_t* qd = (bf16_t*)(P.ws + OFF_QD) + (size_t)ci * 8192;
#pragma unroll
        for (int sub = 0; sub < 4; ++sub) {
            const u32x4 v = *(const u32x4*)(qbf + i * 136 + seg * 32 + sub * 8);
            u32x4 o;
            o.x = pack2(bflo(v.x) * eg, bfhi(v.x) * eg); o.y = pack2(bflo(v.y) * eg, bfhi(v.y) * eg);
            o.z = pack2(bflo(v.z) * eg, bfhi(v.z) * eg); o.w = pack2(bflo(v.w) * eg, bfhi(v.w) * eg);
            *(u32x4*)(qd + ((((i >> 5) * 8 + seg * 2 + (sub >> 1)) * 64 + (i & 31) + 32 * (sub & 1)) * 8)) = o;
        }
        const int kidx = tid >> 1, cs = (tid & 1) * 32;
        bf16_t* kd = (bf16_t*)(P.ws + OFF_KDT) + (size_t)ci * 8192;
#pragma unroll
        for (int sub = 0; sub < 4; ++sub) {
            const u32x4 v = *(const u32x4*)(kT + kidx * 72 + cs + sub * 8);
            const f32x4 d0 = *(const f32x4*)(sdk + cs + sub * 8), d1 = *(const f32x4*)(sdk + cs + sub * 8 + 4);
            u32x4 o;
            o.x = pack2(bflo(v.x) * d0[0], bfhi(v.x) * d0[1]); o.y = pack2(bflo(v.y) * d0[2], bfhi(v.y) * d0[3]);
            o.z = pack2(bflo(v.z) * d1[0], bfhi(v.z) * d1[1]); o.w = pack2(bflo(v.w) * d1[2], bfhi(v.w) * d1[3]);
            *(u32x4*)(kd + ((((kidx >> 5) * 4 + ((cs + sub * 8) >> 4)) * 64 + (kidx & 31) + 32 * (sub & 1)) * 8)) = o;
        }
        if (tid == 0) ((float*)(P.ws + OFF_GLAST))[ci] = segam[63];
    }
    __syncthreads();
    {
        const int i = tid >> 2, seg = tid & 3;
        bf16_t* vt = vT + (seg * 32) * 72 + i;
#pragma unroll
        for (int e = 0; e < 16; ++e) { vt[(2 * e) * 72] = (bf16_t)(vkeep[e] & 0xffffu); vt[(2 * e + 1) * 72] = (bf16_t)(vkeep[e] >> 16); }
        if (tid >= 64) {
            for (int idx = tid - 64; idx < 1024; idx += 192) { const int rr = idx >> 5, cc = 32 + (idx & 31); Tb[rr * 72 + cc] = 0; Tg[rr * 72 + cc] = 0; }
        } else {
            const int blk = tid >> 5, c = tid & 31;
            float x[32];
#pragma unroll
            for (int e = 0; e < 32; ++e) x[e] = (e == c) ? 1.f : 0.f;
            const unsigned ad_lds = (unsigned)(size_t)(Ad + blk * 1024);
#pragma unroll
            for (int ib = 0; ib < 8; ++ib) {
                const int i0 = ib * 4;
                float s0 = x[i0], s1 = x[i0 + 1], s2 = x[i0 + 2], s3 = x[i0 + 3];
#pragma unroll
                for (int mb = 0; mb <= ib; mb += 2) {
                    f32x4 a[4][2];
                    lds_read8s(ad_lds + (unsigned)((i0 * 32 + mb * 4) * 4), a);
#pragma unroll
                    for (int cb = 0; cb < 2; ++cb) {
                        const int m4 = mb + cb;
                        if (m4 < ib) {
#pragma unroll
                            for (int e = 0; e < 4; ++e) {
                                const float xx = x[m4 * 4 + e];
                                s0 -= a[0][cb][e] * xx; s1 -= a[1][cb][e] * xx; s2 -= a[2][cb][e] * xx; s3 -= a[3][cb][e] * xx;
                            }
                        } else if (m4 == ib) {
                            s1 -= a[1][cb][0] * s0;
                            s2 -= a[2][cb][0] * s0; s2 -= a[2][cb][1] * s1;
                            s3 -= a[3][cb][0] * s0; s3 -= a[3][cb][1] * s1; s3 -= a[3][cb][2] * s2;
                        }
                    }
                    __builtin_amdgcn_sched_barrier(0);
                }
                x[i0] = s0; x[i0 + 1] = s1; x[i0 + 2] = s2; x[i0 + 3] = s3;
            }
            bf16_t* dt = DT + (blk * 32 + c) * 40;
#pragma unroll
            for (int q4 = 0; q4 < 4; ++q4) {
                u32x4 o; o.x = pack2(x[8 * q4], x[8 * q4 + 1]); o.y = pack2(x[8 * q4 + 2], x[8 * q4 + 3]); o.z = pack2(x[8 * q4 + 4], x[8 * q4 + 5]); o.w = pack2(x[8 * q4 + 6], x[8 * q4 + 7]);
                *(u32x4*)(dt + q4 * 8) = o;
            }
            const int cg = blk * 32 + c;
            const float bc = sbeta[cg], bg = bc * segam[cg];
#pragma unroll
            for (int rr = 0; rr < 32; ++rr) {
                if (blk == 1) D1R[rr * 40 + c] = (bf16_t)f2bf(x[rr]);
                Tb[(blk * 32 + rr) * 72 + cg] = (bf16_t)f2bf(x[rr] * bc);
                Tg[(blk * 32 + rr) * 72 + cg] = (bf16_t)f2bf(x[rr] * bg);
            }
        }
    }
    __syncthreads();
    if (wave == 0) {
        f32x16 Pm, Qm;
#pragma unroll
        for (int e = 0; e < 16; ++e) { Pm[e] = 0.f; Qm[e] = 0.f; }
#pragma unroll
        for (int ks = 0; ks < 2; ++ks) {
            const bf16x8 a = *(const bf16x8*)(A10 + r * 40 + ks * 16 + h2 * 8);
            const bf16x8 bb = *(const bf16x8*)(DT + r * 40 + ks * 16 + h2 * 8);
            Pm = MFMA32(a, bb, Pm);
        }
#pragma unroll
        for (int sq = 0; sq < 2; ++sq) {
            u32x4 pw;
            pw.x = pack2(Pm[8 * sq + 0], Pm[8 * sq + 1]); pw.y = pack2(Pm[8 * sq + 2], Pm[8 * sq + 3]);
            pw.z = pack2(Pm[8 * sq + 4], Pm[8 * sq + 5]); pw.w = pack2(Pm[8 * sq + 6], Pm[8 * sq + 7]);
            const bf16_t* dp = D1R + r * 40 + 16 * sq + 4 * h2;
            const u32x2 lo = *(const u32x2*)dp, hi = *(const u32x2*)(dp + 8);
            u32x4 aw; aw.x = lo.x; aw.y = lo.y; aw.z = hi.x; aw.w = hi.y;
            Qm = MFMA32(__builtin_bit_cast(bf16x8, aw), __builtin_bit_cast(bf16x8, pw), Qm);
        }
        const float bc = sbeta[r], bg = bc * segam[r];
#pragma unroll
        for (int e = 0; e < 16; ++e) {
            const int il = crow(e, h2);
            Tb[(32 + il) * 72 + r] = (bf16_t)f2bf(-Qm[e] * bc);
            Tg[(32 + il) * 72 + r] = (bf16_t)f2bf(-Qm[e] * bg);
        }
    }
    __syncthreads();
    {
        const int nt = wave;
        f32x16 aU[2], aW[2];
#pragma unroll
        for (int e = 0; e < 16; ++e) { aU[0][e] = 0.f; aU[1][e] = 0.f; aW[0][e] = 0.f; aW[1][e] = 0.f; }
#pragma unroll
        for (int ks = 0; ks < 4; ++ks) {
            const bf16x8 bv = *(const bf16x8*)(vT + (nt * 32 + r) * 72 + ks * 16 + h2 * 8);
            const bf16x8 bk = *(const bf16x8*)(kT + (nt * 32 + r) * 72 + ks * 16 + h2 * 8);
#pragma unroll
            for (int mt = 0; mt < 2; ++mt) {
                const bf16x8 ab = *(const bf16x8*)(Tb + (mt * 32 + r) * 72 + ks * 16 + h2 * 8);
                const bf16x8 ag = *(const bf16x8*)(Tg + (mt * 32 + r) * 72 + ks * 16 + h2 * 8);
                aU[mt] = MFMA32(ab, bv, aU[mt]); aW[mt] = MFMA32(ag, bk, aW[mt]);
            }
        }
        bf16_t* u = (bf16_t*)(P.ws + OFF_U) + (size_t)ci * 8192;
        bf16_t* w = (bf16_t*)(P.ws + OFF_W) + (size_t)ci * 8192;
#pragma unroll
        for (int mt = 0; mt < 2; ++mt) {
            u32x4 o0, o1;
            o0.x = pack2(aU[mt][0], aU[mt][1]); o0.y = pack2(aU[mt][2], aU[mt][3]); o0.z = pack2(aU[mt][4], aU[mt][5]); o0.w = pack2(aU[mt][6], aU[mt][7]);
            o1.x = pack2(aU[mt][8], aU[mt][9]); o1.y = pack2(aU[mt][10], aU[mt][11]); o1.z = pack2(aU[mt][12], aU[mt][13]); o1.w = pack2(aU[mt][14], aU[mt][15]);
            bf16_t* d = u + (((nt * 2 + mt) * 64 + lane) * 16);
            *(u32x4*)d = o0; *(u32x4*)(d + 8) = o1;
            bf16_t* wb = w + (((mt * 8 + nt * 2 + (r >> 4)) * 64 + 32 * ((r >> 3) & 1)) * 8) + (r & 7);
#pragma unroll
            for (int e = 0; e < 16; ++e) wb[crow(e, h2) * 8] = (bf16_t)f2bf(aW[mt][e]);
        }
    }
    __syncthreads();
}

DI void fox_cumsum(const Params& P, int bh, unsigned char* smem, int tt) {
    const int tid = tt, lane = tid & 63, wave = tid >> 6;
    const int b = bh >> 3, hh = bh & 7;
    float* wsum = (float*)smem;
    const float* gates = (const float*)(P.ws + OFF_GATES);
    const float bf = P.in[9][hh];
    float v[8]; float run = 0.f;
#pragma unroll
    for (int e = 0; e < 8; ++e) {
        const float xx = gates[((size_t)b * TSEQ + tid * 8 + e) * 16 + 8 + hh] + bf;
        const float ls = fminf(xx, 0.f) - log1pf(__expf(-fabsf(xx)));
        run += ls; v[e] = run;
    }
    float sc = run;
#pragma unroll
    for (int o = 1; o < 64; o <<= 1) { const float t = shup(sc, o, lane); if (lane >= o) sc += t; }
    if (lane == 63) wsum[wave] = sc;
    __syncthreads();
    float off = sc - run;
    for (int w = 0; w < wave; ++w) off += wsum[w];
    float* cf = (float*)(P.ws + OFF_CF) + (size_t)bh * TSEQ + tid * 8;
#pragma unroll
    for (int e = 0; e < 8; ++e) cf[e] = v[e] + off;
    __syncthreads();
}

DI void gdn_scan(const Params& P, int item, unsigned char* smem, int tt) {
    const int tid = tt, lane = tid & 63, wave = tid >> 6, r = lane & 31, h2 = lane >> 5;
    const int bh = item >> 2, vs = item & 3, b = bh >> 2, hd = bh & 3;
    const int cb = bh * 32;
    bf16_t* SbT = (bf16_t*)smem;
    bf16_t* VnT = SbT + 32 * 136;
    const bool w01 = wave < 2;
    const int mt = wave & 1;
    const bf16_t* Ubase = (const bf16_t*)(P.ws + OFF_U);
    const bf16_t* Abase = (const bf16_t*)(P.ws + (w01 ? OFF_W : OFF_QD));
    const bf16_t* Kbase = (const bf16_t*)(P.ws + OFF_KDT);
    const bf16_t* QKbase = (const bf16_t*)(P.ws + OFF_QK);
    const float* glast = (const float*)(P.ws + OFF_GLAST);
    bf16_t* og = (bf16_t*)(P.ws + OFF_OG);
    f32x16 S;
#pragma unroll
    for (int e = 0; e < 16; ++e) S[e] = 0.f;
    for (int i = tid; i < 32 * 136 / 2; i += 256) ((unsigned*)SbT)[i] = 0u;
#define SCAN_LOAD_A(AF, ci_) do { const bf16_t* ap_ = Abase + (size_t)(ci_) * 8192 + (mt * 8 * 64 + lane) * 8; \
        _Pragma("unroll") for (int ks = 0; ks < 8; ++ks) AF[ks] = *(const bf16x8*)(ap_ + ks * 512); } while (0)
#define SCAN_LOAD_K(ci_) do { const bf16_t* kp_ = Kbase + (size_t)(ci_) * 8192 + (wave * 4 * 64 + lane) * 8; \
        _Pragma("unroll") for (int ks = 0; ks < 4; ++ks) Kf[ks] = *(const bf16x8*)(kp_ + ks * 512); } while (0)
#define SCAN_LOAD_X(ci_) do { if (w01) { const bf16_t* up_ = Ubase + (size_t)(ci_) * 8192 + ((vs * 2 + mt) * 64 + lane) * 16; \
            Xa = *(const u32x4*)up_; Xb = *(const u32x4*)(up_ + 8); } \
        else { const bf16_t* qp_ = QKbase + (size_t)(ci_) * 4096 + (mt * 4 * 64 + lane) * 8; \
            Xa = *(const u32x4*)qp_; Xb = *(const u32x4*)(qp_ + 512); Xc = *(const u32x4*)(qp_ + 1024); Xd = *(const u32x4*)(qp_ + 1536); } } while (0)
#define SCAN_STEP(AF, n_) do { \
        const int cn1 = cb + ((n_) + 1 < 32 ? (n_) + 1 : 31); const int cn2 = cb + ((n_) + 2 < 32 ? (n_) + 2 : 31); \
        const float gl = shlane(glreg, (n_)); \
        f32x16 acc1; \
        bf16x8 sf[8]; \
        _Pragma("unroll") for (int ks = 0; ks < 8; ++ks) sf[ks] = *(const bf16x8*)(SbT + r * 136 + ks * 16 + h2 * 8); \
        _Pragma("unroll") for (int e = 0; e < 16; ++e) acc1[e] = 0.f; \
        __builtin_amdgcn_sched_barrier(0); \
        _Pragma("unroll") for (int ks = 0; ks < 8; ++ks) acc1 = MFMA32(AF[ks], sf[ks], acc1); \
        __builtin_amdgcn_sched_barrier(0); \
        SCAN_LOAD_A(AF, cn2); \
        if (w01) { \
            u32x2 ov; \
            ov.x = pack2(bflo(Xa.x) - acc1[0], bfhi(Xa.x) - acc1[1]); ov.y = pack2(bflo(Xa.y) - acc1[2], bfhi(Xa.y) - acc1[3]); *(u32x2*)(VnT + r * 72 + mt * 32 + 0 + 4 * h2) = ov; \
            ov.x = pack2(bflo(Xa.z) - acc1[4], bfhi(Xa.z) - acc1[5]); ov.y = pack2(bflo(Xa.w) - acc1[6], bfhi(Xa.w) - acc1[7]); *(u32x2*)(VnT + r * 72 + mt * 32 + 8 + 4 * h2) = ov; \
            ov.x = pack2(bflo(Xb.x) - acc1[8], bfhi(Xb.x) - acc1[9]); ov.y = pack2(bflo(Xb.y) - acc1[10], bfhi(Xb.y) - acc1[11]); *(u32x2*)(VnT + r * 72 + mt * 32 + 16 + 4 * h2) = ov; \
            ov.x = pack2(bflo(Xb.z) - acc1[12], bfhi(Xb.z) - acc1[13]); ov.y = pack2(bflo(Xb.w) - acc1[14], bfhi(Xb.w) - acc1[15]); *(u32x2*)(VnT + r * 72 + mt * 32 + 24 + 4 * h2) = ov; \
        } \
        __syncthreads(); \
        bf16x8 Vf[4]; \
        _Pragma("unroll") for (int ks = 0; ks < 4; ++ks) Vf[ks] = *(const bf16x8*)(VnT + r * 72 + ks * 16 + h2 * 8); \
        _Pragma("unroll") for (int e = 0; e < 16; ++e) S[e] *= gl; \
        __builtin_amdgcn_sched_barrier(0); \
        _Pragma("unroll") for (int ks = 0; ks < 4; ++ks) S = MFMA32(Kf[ks], Vf[ks], S); \
        if (!w01) { \
            acc1 = MFMA32(__builtin_bit_cast(bf16x8, Xa), Vf[0], acc1); acc1 = MFMA32(__builtin_bit_cast(bf16x8, Xb), Vf[1], acc1); \
            acc1 = MFMA32(__builtin_bit_cast(bf16x8, Xc), Vf[2], acc1); acc1 = MFMA32(__builtin_bit_cast(bf16x8, Xd), Vf[3], acc1); \
        } \
        __builtin_amdgcn_sched_barrier(0); \
        SCAN_LOAD_K(cn1); \
        SCAN_LOAD_X(cn1); \
        _Pragma("unroll") for (int g = 0; g < 4; ++g) { u32x2 ov; ov.x = pack2(S[4 * g + 0], S[4 * g + 1]); ov.y = pack2(S[4 * g + 2], S[4 * g + 3]); \
            *(u32x2*)(SbT + r * 136 + wave * 32 + 8 * g + 4 * h2) = ov; } \
        if (!w01) { \
            bf16_t* op = og + ((size_t)b * TSEQ + (n_) * 64 + mt * 32) * 512 + hd * 128 + vs * 32 + r; \
            _Pragma("unroll") for (int e = 0; e < 16; ++e) op[(size_t)crow(e, h2) * 512] = (bf16_t)f2bf(acc1[e]); \
        } \
        __syncthreads(); \
    } while (0)
    const float glreg = glast[cb + (lane & 31)];
    bf16x8 Af0[8], Af1[8], Kf[4];
    u32x4 Xa, Xb, Xc, Xd;
    Xc = Xd = (u32x4){0u, 0u, 0u, 0u};
    SCAN_LOAD_A(Af0, cb); SCAN_LOAD_K(cb); SCAN_LOAD_X(cb);
    SCAN_LOAD_A(Af1, cb + 1);
    __syncthreads();
#pragma unroll 1
    for (int n = 0; n < 32; n += 2) {
        SCAN_STEP(Af0, n);
        SCAN_STEP(Af1, n + 1);
    }
#undef SCAN_LOAD_A
#undef SCAN_LOAD_K
#undef SCAN_LOAD_X
#undef SCAN_STEP
}

DI void fox_attn(const Params& P, int bh, int qb, unsigned char* smem, int tt) {
    const int tid = tt, lane = tid & 63, wave = tid >> 6, r = lane & 31, h2 = lane >> 5;
    const int b = bh >> 3, hh = bh & 7;
    constexpr int BUFB = 2 * 64 * 72 * 2 + 256;
    constexpr float L2E = 1.4426950408889634f;
    const bf16_t* fqk = (const bf16_t*)(P.ws + OFF_FQK);
    const bf16_t* vT = (const bf16_t*)(P.ws + OFF_VT) + (size_t)bh * 64 * TSEQ;
    const float* cf = (const float*)(P.ws + OFF_CF) + (size_t)bh * TSEQ;
    const int q = qb * 128 + wave * 32 + r;
    bf16x8 Qf[4];
    {
        const bf16_t* qp = fqk + ((size_t)b * TSEQ + q) * 1024 + hh * 64 + h2 * 8;
#pragma unroll
        for (int ks = 0; ks < 4; ++ks) Qf[ks] = *(const bf16x8*)(qp + ks * 16);
    }
    const float cq = cf[q] * L2E;
    float m = -1e30f, l = 0.f;
    f32x16 O[2];
#pragma unroll
    for (int e = 0; e < 16; ++e) { O[0][e] = 0.f; O[1][e] = 0.f; }
    const int ntiles = 2 * qb + 2;
    const int srow = tid >> 3, scol = (tid & 7) * 8;
    const bf16_t* kg = fqk + ((size_t)b * TSEQ + srow) * 1024 + 512 + hh * 64 + scol;
    const bf16_t* vg = vT + (size_t)srow * TSEQ + scol;
    u32x4 rk0, rk1, rv0, rv1; float rc = 0.f;
    rk0 = *(const u32x4*)kg; rk1 = *(const u32x4*)(kg + 32 * 1024);
    rv0 = *(const u32x4*)vg; rv1 = *(const u32x4*)(vg + 32 * TSEQ);
    if (tid < 64) rc = cf[tid] * L2E;
    {
        bf16_t* Ks = (bf16_t*)smem; bf16_t* VTs = Ks + 64 * 72; float* cks = (float*)(smem + 2 * 64 * 72 * 2);
        *(u32x4*)(Ks + srow * 72 + scol) = rk0; *(u32x4*)(Ks + (srow + 32) * 72 + scol) = rk1;
        *(u32x4*)(VTs + srow * 72 + scol) = rv0; *(u32x4*)(VTs + (srow + 32) * 72 + scol) = rv1;
        if (tid < 64) cks[tid] = rc;
    }
    __syncthreads();
#pragma unroll 1
    for (int kt = 0; kt < ntiles; ++kt) {
        const unsigned char* bufc = smem + (kt & 1) * BUFB;
        const bf16_t* Ks = (const bf16_t*)bufc; const bf16_t* VTs = Ks + 64 * 72; const float* cks = (const float*)(bufc + 2 * 64 * 72 * 2);
        const bool more = kt + 1 < ntiles;
        if (more) {
            const bf16_t* kg2 = kg + (size_t)(kt + 1) * 64 * 1024; const bf16_t* vg2 = vg + (kt + 1) * 64;
            rk0 = *(const u32x4*)kg2; rk1 = *(const u32x4*)(kg2 + 32 * 1024);
            rv0 = *(const u32x4*)vg2; rv1 = *(const u32x4*)(vg2 + 32 * TSEQ);
            if (tid < 64) rc = cf[(kt + 1) * 64 + tid] * L2E;
        }
        f32x16 sacc[2];
        f32x4 ckv[2][4];
        {
            bf16x8 kf[2][4];
#pragma unroll
            for (int mt = 0; mt < 2; ++mt)
#pragma unroll
                for (int ks = 0; ks < 4; ++ks) kf[mt][ks] = *(const bf16x8*)(Ks + (mt * 32 + r) * 72 + ks * 16 + h2 * 8);
#pragma unroll
            for (int mt = 0; mt < 2; ++mt)
#pragma unroll
                for (int g = 0; g < 4; ++g) ckv[mt][g] = *(const f32x4*)(cks + mt * 32 + 8 * g + 4 * h2);
#pragma unroll
            for (int e = 0; e < 16; ++e) { sacc[0][e] = 0.f; sacc[1][e] = 0.f; }
            __builtin_amdgcn_sched_barrier(0);
#pragma unroll
            for (int ks = 0; ks < 4; ++ks) { sacc[0] = MFMA32(kf[0][ks], Qf[ks], sacc[0]); sacc[1] = MFMA32(kf[1][ks], Qf[ks], sacc[1]); }
        }
        const bool diag = kt >= ntiles - 2;
        float mx = -1e30f;
        {
            const f32x2v csc = {0.125f * L2E, 0.125f * L2E};
#pragma unroll
            for (int mt = 0; mt < 2; ++mt)
#pragma unroll
                for (int g = 0; g < 4; ++g) {
                    const f32x4 ck4 = ckv[mt][g];
                    const f32x2v c01 = {ck4[0], ck4[1]}, c23 = {ck4[2], ck4[3]};
                    const f32x2v a01 = {sacc[mt][4 * g], sacc[mt][4 * g + 1]}, a23 = {sacc[mt][4 * g + 2], sacc[mt][4 * g + 3]};
                    const f32x2v s01 = a01 * csc - c01, s23 = a23 * csc - c23;
                    sacc[mt][4 * g] = s01.x; sacc[mt][4 * g + 1] = s01.y; sacc[mt][4 * g + 2] = s23.x; sacc[mt][4 * g + 3] = s23.y;
                    mx = fmaxf(fmaxf(mx, s01.x), s01.y); mx = fmaxf(fmaxf(mx, s23.x), s23.y);
                }
        }
        if (diag) {
            mx = -1e30f;
            const int qrel = q - kt * 64 - 4 * h2;
#pragma unroll
            for (int mt = 0; mt < 2; ++mt)
#pragma unroll
                for (int e = 0; e < 16; ++e) {
                    const int krel = mt * 32 + (e & 3) + 8 * (e >> 2);
                    const float sv = (krel > qrel) ? -1e30f : sacc[mt][e];
                    sacc[mt][e] = sv;
                    mx = fmaxf(mx, sv);
                }
        }
        mx = fmaxf(mx, shx(mx, 32, lane));
        if (__builtin_amdgcn_ballot_w64(mx + cq - m > 30.f) != 0ull) {
            const float mn = fmaxf(m, mx + cq);
            const float alpha = __builtin_amdgcn_exp2f(m - mn);
            m = mn;
            l *= alpha;
            const f32x2v al2 = {alpha, alpha};
#pragma unroll
            for (int dt = 0; dt < 2; ++dt)
#pragma unroll
                for (int p2 = 0; p2 < 8; ++p2) {
                    f32x2v ov = {O[dt][2 * p2], O[dt][2 * p2 + 1]};
                    ov = ov * al2;
                    O[dt][2 * p2] = ov.x; O[dt][2 * p2 + 1] = ov.y;
                }
        }
        {
            const float sh = cq - m;
            const f32x2v sh2 = {sh, sh};
            f32x2v rs2 = {0.f, 0.f};
#pragma unroll
            for (int mt = 0; mt < 2; ++mt)
#pragma unroll
                for (int p2 = 0; p2 < 8; ++p2) {
                    const f32x2v sv = {sacc[mt][2 * p2], sacc[mt][2 * p2 + 1]};
                    const f32x2v t = sv + sh2;
                    f32x2v pp; pp.x = __builtin_amdgcn_exp2f(t.x); pp.y = __builtin_amdgcn_exp2f(t.y);
                    sacc[mt][2 * p2] = pp.x; sacc[mt][2 * p2 + 1] = pp.y;
                    rs2 = rs2 + pp;
                }
            l += rs2.x + rs2.y;
        }
        {
            u32x4 vw[2][2][2];
#pragma unroll
            for (int mt = 0; mt < 2; ++mt)
#pragma unroll
                for (int s = 0; s < 2; ++s)
#pragma unroll
                    for (int dt = 0; dt < 2; ++dt) {
                        const bf16_t* vp = VTs + (dt * 32 + r) * 72 + mt * 32 + 16 * s + 4 * h2;
                        const u32x2 lo = *(const u32x2*)vp, hi = *(const u32x2*)(vp + 8);
                        vw[mt][s][dt].x = lo.x; vw[mt][s][dt].y = lo.y; vw[mt][s][dt].z = hi.x; vw[mt][s][dt].w = hi.y;
                    }
            u32x4 pw[2][2];
#pragma unroll
            for (int mt = 0; mt < 2; ++mt)
#pragma unroll
                for (int s = 0; s < 2; ++s) {
                    pw[mt][s].x = pack2(sacc[mt][8 * s + 0], sacc[mt][8 * s + 1]); pw[mt][s].y = pack2(sacc[mt][8 * s + 2], sacc[mt][8 * s + 3]);
                    pw[mt][s].z = pack2(sacc[mt][8 * s + 4], sacc[mt][8 * s + 5]); pw[mt][s].w = pack2(sacc[mt][8 * s + 6], sacc[mt][8 * s + 7]);
                }
            __builtin_amdgcn_sched_barrier(0);
#pragma unroll
            for (int mt = 0; mt < 2; ++mt)
#pragma unroll
                for (int s = 0; s < 2; ++s) {
                    const bf16x8 pf = __builtin_bit_cast(bf16x8, pw[mt][s]);
                    O[0] = MFMA32(__builtin_bit_cast(bf16x8, vw[mt][s][0]), pf, O[0]);
                    O[1] = MFMA32(__builtin_bit_cast(bf16x8, vw[mt][s][1]), pf, O[1]);
                }
        }
        if (more) {
            unsigned char* bufn = smem + ((kt + 1) & 1) * BUFB;
            bf16_t* Kn = (bf16_t*)bufn; bf16_t* VTn = Kn + 64 * 72; float* ckn = (float*)(bufn + 2 * 64 * 72 * 2);
            *(u32x4*)(Kn + srow * 72 + scol) = rk0; *(u32x4*)(Kn + (srow + 32) * 72 + scol) = rk1;
            *(u32x4*)(VTn + srow * 72 + scol) = rv0; *(u32x4*)(VTn + (srow + 32) * 72 + scol) = rv1;
            if (tid < 64) ckn[tid] = rc;
        }
        __syncthreads();
    }
    l += shx(l, 32, lane);
    const float inv = 1.f / l;
    float ss = 0.f;
#pragma unroll
    for (int e = 0; e < 16; ++e) { O[0][e] *= inv; O[1][e] *= inv; ss += O[0][e] * O[0][e] + O[1][e] * O[1][e]; }
    ss += shx(ss, 32, lane);
    const float sc = rsqrtf(ss * (1.f / 64.f) + 1e-6f);
    bf16_t* op = (bf16_t*)(P.ws + OFF_MIX) + ((size_t)b * TSEQ + q) * 1024 + 512 + hh * 64;
    const float* fg = P.in[10];
    f32x4 ggv[2][4];
#pragma unroll
    for (int dt = 0; dt < 2; ++dt)
#pragma unroll
        for (int g = 0; g < 4; ++g) ggv[dt][g] = *(const f32x4*)(fg + dt * 32 + 8 * g + 4 * h2);
#pragma unroll
    for (int dt = 0; dt < 2; ++dt)
#pragma unroll
        for (int g = 0; g < 4; ++g) {
            const int d0 = dt * 32 + 8 * g + 4 * h2;
            const f32x4 gg = ggv[dt][g];
            u32x2 o;
            o.x = pack2(O[dt][4 * g + 0] * sc * gg[0], O[dt][4 * g + 1] * sc * gg[1]); o.y = pack2(O[dt][4 * g + 2] * sc * gg[2], O[dt][4 * g + 3] * sc * gg[3]);
            *(u32x2*)(op + d0) = o;
        }
}

#define XB_TMO      128
#define XB_XCNT(j)  (256  + 64 * (j))
#define XB_XSUB(j)  (1280 + 64 * (j))
#define XB_XGEN(j)  (2304 + 64 * (j))
#define XB_TOP      3328
#define XB_TOPGEN   3392
#define XCD_BAR_WORDS 3456
#define XB_SPIN_CAP (1u << 18)
#define LAS __attribute__((address_space(3)))
DI unsigned xb_ld(unsigned* p)              { return __hip_atomic_load(p, __ATOMIC_RELAXED, __HIP_MEMORY_SCOPE_AGENT); }
DI unsigned xb_add(unsigned* p, unsigned v) { return __hip_atomic_fetch_add(p, v, __ATOMIC_RELAXED, __HIP_MEMORY_SCOPE_AGENT); }
DI unsigned xb_xcc_id() { return (unsigned)__builtin_amdgcn_s_getreg((3 << 11) | 20) & 0xFu; }
#define XB_SPIN(cond, bar) do { unsigned _sp = 0; while (cond) { __builtin_amdgcn_s_sleep(1); \
    if ((++_sp & 255u) == 0u) { if (xb_ld(&(bar)[XB_TMO])) break; if (_sp > XB_SPIN_CAP) { atomicAdd(&(bar)[XB_TMO], 1u); break; } } } } while (0)
struct XcdBarrier { unsigned* bar; unsigned x; volatile LAS unsigned* st; };
DI XcdBarrier xcd_barrier_post(unsigned* bar, volatile LAS unsigned* st, int tid0) {
    XcdBarrier b; b.bar = bar; b.x = xb_xcc_id(); b.st = st;
    if (tid0 == 0) (void)xb_add(&bar[XB_XCNT(b.x)], 1u);
    return b;
}
DI void xcd_barrier_complete(unsigned* bar, unsigned x, unsigned& nloc, unsigned& nx) {
    const unsigned G = gridDim.x * gridDim.y * gridDim.z;
    unsigned sum, cnt, mine, sp = 0u;
    for (;;) {
        sum = 0u; cnt = 0u; mine = 0u;
#pragma unroll
        for (unsigned j = 0; j < 16; ++j) { const unsigned c = xb_ld(&bar[XB_XCNT(j)]); sum += c; cnt += (c > 0u) ? 1u : 0u; mine = (j == x) ? c : mine; }
        if (sum == G) break;
        __builtin_amdgcn_s_sleep(1);
        if ((++sp & 255u) == 0u) { if (xb_ld(&bar[XB_TMO])) break; if (sp > XB_SPIN_CAP) { atomicAdd(&bar[XB_TMO], 1u); break; } }
    }
    nloc = mine > 0u ? mine : 1u; nx = cnt > 0u ? cnt : 1u;
}
DI void xcd_barrier(const XcdBarrier& b, const int wid_s) {
    asm volatile("s_waitcnt vmcnt(0)" ::: "memory");
    __syncthreads();
    if (fresh_tid(wid_s) == 0) {
        unsigned* bar = b.bar;
        __builtin_amdgcn_s_waitcnt(0);
        unsigned nloc = b.st[0], nx = b.st[1];
        if (nloc == 0u) { xcd_barrier_complete(bar, b.x, nloc, nx); b.st[0] = nloc; b.st[1] = nx; }
        const unsigned old = xb_add(&bar[XB_XSUB(b.x)], 1u);
        const unsigned gen = old / nloc;
        if (old + 1u == (gen + 1u) * nloc) {
            __builtin_amdgcn_fence(__ATOMIC_RELEASE, "agent");
            asm volatile("s_waitcnt vmcnt(0)" ::: "memory");
            const unsigned og = xb_add(&bar[XB_TOP], 1u);
            const unsigned tg = og / nx;
            if (og + 1u == (tg + 1u) * nx) xb_add(&bar[XB_TOPGEN], 1u);
            else XB_SPIN(xb_ld(&bar[XB_TOPGEN]) == tg, bar);
            __builtin_amdgcn_fence(__ATOMIC_ACQUIRE, "agent");
            xb_add(&bar[XB_XGEN(b.x)], 1u);
            asm volatile("s_waitcnt vmcnt(0)" ::: "memory");
        } else {
            XB_SPIN(xb_ld(&bar[XB_XGEN(b.x)]) == gen, bar);
            __builtin_amdgcn_fence(__ATOMIC_ACQUIRE, "agent");
            asm volatile("s_waitcnt vmcnt(0)" ::: "memory");
        }
    }
    __syncthreads();
}


template <int MODE> struct EpiLnFused {
    static constexpr bool PERM = true, AFTER_DRAIN = true;
    const float* x; const float* g_in; const float* b_in; const float* stats;
    const bf16_t* h1; const bf16_t* pg;
    float* xbuf; unsigned* cnt; const float* g; const float* b; float* outf; bf16_t* outb;
    DI void operator()(const pg8::f32x4 (&)[2][2][4][2], const pg8::Unit&, int, int, int, int) const {}
    DI void fused(pg8::f32x4 (&acc)[2][2][4][2], const pg8::Unit& u, int wr, int wc, int fr, int fq, pg8::PG8_LAS_T ldsp, int wid, int lane) const {
        float* P = (float*)(unsigned char*)ldsp;
        float* ST = P + 2048;
        const int tid = wid * 64 + lane;
        f32x4 gi[2][2], bi[2][2];
#pragma unroll
        for (int bj = 0; bj < 2; ++bj) {
            const int col = u.pn * 256 + bj * 128 + wc * 32 + 8 * fq;
            if (MODE == 0) { gi[bj][0] = *(const f32x4*)(g_in + col); gi[bj][1] = *(const f32x4*)(g_in + col + 4); bi[bj][0] = *(const f32x4*)(b_in + col); bi[bj][1] = *(const f32x4*)(b_in + col + 4); }
        }
#pragma unroll
        for (int ai = 0; ai < 2; ++ai)
#pragma unroll
            for (int m = 0; m < 4; ++m) {
                const int rt = ai * 128 + wr * 64 + m * 16 + fr, row = u.pm * 256 + rt;
                float sm = 0.f, sq = 0.f;
                float mu = 0.f, rs = 0.f;
                if (MODE == 0) { mu = stats[row * 2]; rs = stats[row * 2 + 1]; }
#pragma unroll
                for (int bj = 0; bj < 2; ++bj) {
                    const int col = u.pn * 256 + bj * 128 + wc * 32 + 8 * fq;
                    const size_t idx = (size_t)row * DM + col;
                    f32x4 v0, v1;
                    if (MODE == 0) {
                        const f32x4 x0 = *(const f32x4*)(x + idx), x1 = *(const f32x4*)(x + idx + 4);
                        v0 = ((x0 - mu) * rs * gi[bj][0] + bi[bj][0]) * ALPHA + acc[ai][bj][m][0];
                        v1 = ((x1 - mu) * rs * gi[bj][1] + bi[bj][1]) * ALPHA + acc[ai][bj][m][1];
                    } else {
                        const u32x4 w = *(const u32x4*)(pg + idx);
                        const u32x4 hw = *(const u32x4*)(h1 + idx);
                        v0 = (f32x4){bflo(hw.x), bfhi(hw.x), bflo(hw.y), bfhi(hw.y)} * ALPHA + acc[ai][bj][m][0];
                        v1 = (f32x4){bflo(hw.z), bfhi(hw.z), bflo(hw.w), bfhi(hw.w)} * ALPHA + acc[ai][bj][m][1];
                        v0[0] += bflo(w.x); v0[1] += bfhi(w.x); v0[2] += bflo(w.y); v0[3] += bfhi(w.y);
                        v1[0] += bflo(w.z); v1[1] += bfhi(w.z); v1[2] += bflo(w.w); v1[3] += bfhi(w.w);
                    }
                    acc[ai][bj][m][0] = v0; acc[ai][bj][m][1] = v1;
#pragma unroll
                    for (int e = 0; e < 4; ++e) { sm += v0[e] + v1[e]; sq += v0[e] * v0[e] + v1[e] * v1[e]; }
                }
                sm += shx(sm, 16, lane); sm += shx(sm, 32, lane);
                sq += shx(sq, 16, lane); sq += shx(sq, 32, lane);
                if (fq == 0) { P[(rt * 4 + wc) * 2] = sm; P[(rt * 4 + wc) * 2 + 1] = sq; }
            }
        __syncthreads();
        if (tid < 256) {
            const f32x4 a = *(const f32x4*)(P + tid * 8), c = *(const f32x4*)(P + tid * 8 + 4);
            float* slot = xbuf + ((size_t)(u.pm * 256 + tid) * 4 + u.pn) * 2;
            __hip_atomic_store(slot, (a[0] + a[2]) + (c[0] + c[2]), __ATOMIC_RELAXED, __HIP_MEMORY_SCOPE_AGENT);
            __hip_atomic_store(slot + 1, (a[1] + a[3]) + (c[1] + c[3]), __ATOMIC_RELAXED, __HIP_MEMORY_SCOPE_AGENT);
        }
        asm volatile("s_waitcnt vmcnt(0)" ::: "memory");
        __syncthreads();
        if (tid == 0) {
            xb_add(cnt + u.pm, 1u);
            unsigned sp = 0;
            while (xb_ld(cnt + u.pm) < 4u) { __builtin_amdgcn_s_sleep(1); if (++sp > (1u << 22)) break; }
        }
        __syncthreads();
        if (tid < 256) {
            float* slot = xbuf + (size_t)(u.pm * 256 + tid) * 8;
            float pv[8];
#pragma unroll
            for (int e = 0; e < 8; ++e) pv[e] = __hip_atomic_load(slot + e, __ATOMIC_RELAXED, __HIP_MEMORY_SCOPE_AGENT);
            const float sm = (pv[0] + pv[2]) + (pv[4] + pv[6]), sq = (pv[1] + pv[3]) + (pv[5] + pv[7]);
            const float mean = sm * (1.f / 1024.f);
            const float var = fmaxf(sq * (1.f / 1024.f) - mean * mean, 0.f);
            ST[tid * 2] = mean; ST[tid * 2 + 1] = rsqrtf(var + 1e-5f);
        }
        __syncthreads();
        f32x4 go[2][2], bo[2][2];
#pragma unroll
        for (int bj = 0; bj < 2; ++bj) {
            const int col = u.pn * 256 + bj * 128 + wc * 32 + 8 * fq;
            go[bj][0] = *(const f32x4*)(g + col); go[bj][1] = *(const f32x4*)(g + col + 4); bo[bj][0] = *(const f32x4*)(b + col); bo[bj][1] = *(const f32x4*)(b + col + 4);
        }
#pragma unroll
        for (int ai = 0; ai < 2; ++ai)
#pragma unroll
            for (int m = 0; m < 4; ++m) {
                const int rt = ai * 128 + wr * 64 + m * 16 + fr, row = u.pm * 256 + rt;
                const float mean = ST[rt * 2], rstd = ST[rt * 2 + 1];
#pragma unroll
                for (int bj = 0; bj < 2; ++bj) {
                    const int col = u.pn * 256 + bj * 128 + wc * 32 + 8 * fq;
                    const size_t idx = (size_t)row * DM + col;
                    const f32x4 o0 = (acc[ai][bj][m][0] - mean) * rstd * go[bj][0] + bo[bj][0], o1 = (acc[ai][bj][m][1] - mean) * rstd * go[bj][1] + bo[bj][1];
                    if (outf) { *(f32x4*)(outf + idx) = o0; *(f32x4*)(outf + idx + 4) = o1; }
                    if (outb) *(u32x4*)(outb + idx) = pack8(o0, o1);
                }
            }
    }
};

template <class Epi> DI void run_gemm(pg8::PG8_LAS_T lds, const bf16_t* A, const bf16_t* Bt, int N, int K, const Epi& E, const int wid_s) {
    pg8::Gemm g{A, Bt, M_TOK, N, K}; pg8::StaticOrder S; S.init(M_TOK, N, (int)gridDim.x, (int)blockIdx.x);
    pg8::gemm_phase<Epi, pg8::StaticOrder, true, true>(lds, g, S, E, wid_s);
}
__global__ void __launch_bounds__(512, 2) fwd_mega(Params P) {
    cg::grid_group grid = cg::this_grid();
    extern __shared__ __attribute__((aligned(16))) unsigned char lds[];
    pg8::PG8_LAS_T glds = (pg8::PG8_LAS_T)lds;
    volatile LAS unsigned* xb_words = (volatile LAS unsigned*)(glds + LDS_MISC);
    volatile int* s_item = (volatile int*)(lds + LDS_MISC + 16);
    const int nblk = gridDim.x, bid = blockIdx.x;
    unsigned char* ws = P.ws;

    const int wid_s = __builtin_amdgcn_readfirstlane((int)threadIdx.x >> 6);
    if (threadIdx.x < 4) xb_words[threadIdx.x] = 0u;
    __syncthreads();
    const XcdBarrier xbar = xcd_barrier_post((unsigned*)(ws + OFF_BAR), xb_words, (int)threadIdx.x);
    if (P.out == nullptr) grid.sync();

    {
    for (int base = bid * 2; base < 1984 + 4096; base += nblk * 2) {
        PHASE_IDS
        const int it = base + team;
        if (it < 960) {
            transpose_tile(P.in[4], 1024, 3600, (bf16_t*)(ws + OFF_WIN), it / 60, it % 60, 1, (float*)smem, tt);
        } else if (it < 1984) {
            const int loc = it - 960;
            transpose_tile(P.in[15], 4096, 1024, (bf16_t*)(ws + OFF_WDOWN), loc / 16, loc % 16, 0, (float*)smem, tt);
        } else {
            const int row = (it - 1984) * 4 + tw;
            ln_row(P.in[0] + (size_t)row * DM, P.in[2], P.in[3], nullptr, (bf16_t*)(ws + OFF_HB) + (size_t)row * DM, (float*)(ws + OFF_STATS) + row * 2, lane);
            { const f32x4 pv = *(const f32x4*)(P.in[1] + (size_t)row * 256 + lane * 4); u32x2 w; w.x = pack2(pv[0], pv[1]); w.y = pack2(pv[2], pv[3]);
              *(u32x2*)((bf16_t*)(ws + OFF_PB) + (size_t)row * 256 + lane * 4) = w; }
        }
    }
    }
    xcd_barrier(xbar, wid_s);

    { EpiProj E{ws}; run_gemm(glds, (const bf16_t*)(ws + OFF_HB), (const bf16_t*)(ws + OFF_WIN), NPROJ, DM, E, wid_s); }
    {
        const int nun = (M_TOK / 256) * (NPROJ / 256);
        const int maxu = (nun + nblk - 1) / nblk;
        int first_short = nun - (maxu - 1) * nblk, nshort = nblk - first_short;
        if (nshort <= 0) { first_short = 0; nshort = nblk; }
        if (bid >= first_short) {
            for (int base = (bid - first_short) * 2; base < 1600; base += nshort * 2) {
                PHASE_IDS
                const int j = base + team;
                const float* W; int K, N, loc, nnt; bf16_t* Wt;
                if (j < 256) { W = P.in[11]; K = 1024; N = 1024; Wt = (bf16_t*)(ws + OFF_WOUT); loc = j; nnt = 16; }
                else if (j < 1280) { W = P.in[14]; K = 1024; N = 4096; Wt = (bf16_t*)(ws + OFF_WUP); loc = j - 256; nnt = 64; }
                else if (j < 1536) { W = P.in[17]; K = 1024; N = 1024; Wt = (bf16_t*)(ws + OFF_WG); loc = j - 1280; nnt = 16; }
                else { W = P.in[16]; K = 256; N = 1024; Wt = (bf16_t*)(ws + OFF_WPLE); loc = j - 1536; nnt = 16; }
                transpose_tile(W, K, N, Wt, loc / nnt, loc % nnt, 0, (float*)smem, tt);
            }
        }
    }
    xcd_barrier(xbar, wid_s);

    for (int rep = 0; rep < NREP(2); ++rep)
    {
    for (int base = bid * 2; base < 1024 + 64; base += nblk * 2) {
        PHASE_IDS
        const int it = base + team;
        if (it < 1024) prep_chunk(P, it, smem, tt); else fox_cumsum(P, it - 1024, smem, tt);
    }
    }
    xcd_barrier(xbar, wid_s);

    for (int rep = 0; rep < NREP(3); ++rep)
    {
    bool first = true;
    for (;;) {
        PHASE_IDS
        int pr;
        if (first) { first = false; pr = bid; }
        else {
            __syncthreads();
            if (tid == 0) *s_item = nblk + atomicAdd((int*)(ws + OFF_CTR) + rep, 1);
            __syncthreads();
            pr = *s_item;
        }
        if (pr >= 64 + 512) break;
        if (pr < 64) gdn_scan(P, pr * 2 + team, smem, tt);
        else { const int fj = pr - 64; fox_attn(P, (fj & 31) * 2 + team, 15 - (fj >> 5), smem, tt); }
    }
    }
    xcd_barrier(xbar, wid_s);

    { PHASE_IDS
    for (int it = bid; it < M_TOK / 8; it += nblk) {
        const int row = it * 8 + wave8;
        bf16_t* mix = (bf16_t*)(ws + OFF_MIX) + (size_t)row * DM;
        {
            const int col = lane * 8;
            const u32x4 ov = *(const u32x4*)((const bf16_t*)(ws + OFF_OG) + (size_t)row * 512 + col);
            const u32x4 zv = *(const u32x4*)((const bf16_t*)(ws + OFF_Z) + (size_t)row * 512 + col);
            float o[8] = {bflo(ov.x), bfhi(ov.x), bflo(ov.y), bfhi(ov.y), bflo(ov.z), bfhi(ov.z), bflo(ov.w), bfhi(ov.w)};
            float z[8] = {bflo(zv.x), bfhi(zv.x), bflo(zv.y), bfhi(zv.y), bflo(zv.z), bfhi(zv.z), bflo(zv.w), bfhi(zv.w)};
            float ss = 0.f;
#pragma unroll
            for (int e = 0; e < 8; ++e) ss += o[e] * o[e];
            ss += shx(ss, 1, lane); ss += shx(ss, 2, lane); ss += shx(ss, 4, lane); ss += shx(ss, 8, lane);
            const float sc = rsqrtf(ss * (1.f / 128.f) + 1e-6f);
            const float* gg = P.in[8] + (col & 127);
            float v[8];
#pragma unroll
            for (int e = 0; e < 8; ++e) v[e] = o[e] * sc * gg[e] * siluf(z[e]);
            u32x4 w; w.x = pack2(v[0], v[1]); w.y = pack2(v[2], v[3]); w.z = pack2(v[4], v[5]); w.w = pack2(v[6], v[7]);
            *(u32x4*)(mix + col) = w;
        }
    }
    }
    xcd_barrier(xbar, wid_s);

    { EpiLnFused<0> E{P.in[0], P.in[2], P.in[3], (const float*)(ws + OFF_STATS), nullptr, nullptr, (float*)(ws + OFF_XBUF), (unsigned*)(ws + OFF_PCNT), P.in[12], P.in[13], nullptr, (bf16_t*)(ws + OFF_H1B)};
      run_gemm(glds, (const bf16_t*)(ws + OFF_MIX), (const bf16_t*)(ws + OFF_WOUT), DM, DM, E, wid_s); }
    xcd_barrier(xbar, wid_s);

    { EpiUp E{(bf16_t*)(ws + OFF_FFB)}; run_gemm(glds, (const bf16_t*)(ws + OFF_H1B), (const bf16_t*)(ws + OFF_WUP), 4096, DM, E, wid_s); }
    { EpiGate E{(bf16_t*)(ws + OFF_PG), P.in[18]}; run_gemm(glds, (const bf16_t*)(ws + OFF_H1B), (const bf16_t*)(ws + OFF_WG), DM, DM, E, wid_s); }
    { EpiPle E{(bf16_t*)(ws + OFF_PG)}; run_gemm(glds, (const bf16_t*)(ws + OFF_PB), (const bf16_t*)(ws + OFF_WPLE), DM, 256, E, wid_s); }
    xcd_barrier(xbar, wid_s);

    { EpiLnFused<1> E{nullptr, nullptr, nullptr, nullptr, (const bf16_t*)(ws + OFF_H1B), (const bf16_t*)(ws + OFF_PG), (float*)(ws + OFF_XBUF) + (size_t)M_TOK * 8, (unsigned*)(ws + OFF_PCNT) + 64, P.in[19], P.in[20], P.out, nullptr};
      run_gemm(glds, (const bf16_t*)(ws + OFF_FFB), (const bf16_t*)(ws + OFF_WDOWN), DM, 4096, E, wid_s); }
}

extern "C" void kernel_launch(void* const* d_in, const int* in_sizes, int n_in, void* d_out, int out_size, void* d_ws, size_t ws_size, hipStream_t stream) {
    static int grid_blocks = 0;
    if (!grid_blocks) {
        int dev = 0, cus = 0, per_cu = 0;
        (void)hipGetDevice(&dev);
        (void)hipDeviceGetAttribute(&cus, hipDeviceAttributeMultiprocessorCount, dev);
        if (hipFuncSetAttribute((const void*)fwd_mega, hipFuncAttributeMaxDynamicSharedMemorySize, LDS_BYTES) != hipSuccess) fprintf(stderr, "kernel_launch: hipFuncSetAttribute failed\n");
        (void)hipOccupancyMaxActiveBlocksPerMultiprocessor(&per_cu, (const void*)fwd_mega, 512, LDS_BYTES);
        if (per_cu < 1) fprintf(stderr, "kernel_launch: occupancy query reports %d blocks per CU\n", per_cu);
        (void)hipGetLastError();
        grid_blocks = cus;
        if (ws_size < 232 * MBy) fprintf(stderr, "kernel_launch: workspace too small (%zu)\n", ws_size);
    }
    Params p{};
    for (int i = 0; i < 21; ++i) p.in[i] = (const float*)d_in[i];
    p.out = (float*)d_out; p.ws = (unsigned char*)d_ws;
    (void)hipMemsetAsync((unsigned char*)d_ws + OFF_BAR, 0, 16384, stream);
    void* args[] = {&p};
    hipError_t e = hipLaunchCooperativeKernel((void*)fwd_mega, dim3(grid_blocks), dim3(512), args, LDS_BYTES, stream);
    if (e != hipSuccess) fprintf(stderr, "cooperative launch failed: %s (grid %d)\n", hipGetErrorString(e), grid_blocks);
}
```

```cpp
#include <hip/hip_runtime.h>
#include <hip/hip_cooperative_groups.h>
#include <cstdio>
namespace cg = cooperative_groups;

typedef unsigned short bf16_t;
typedef short bf16x8 __attribute__((ext_vector_type(8)));
typedef short s16x4 __attribute__((ext_vector_type(4)));
typedef float f32x16 __attribute__((ext_vector_type(16)));
typedef float f32x4 __attribute__((ext_vector_type(4)));
typedef unsigned u32x4 __attribute__((ext_vector_type(4)));
typedef unsigned u32x2 __attribute__((ext_vector_type(2)));
typedef float f32x2v __attribute__((ext_vector_type(2)));

#define DI __device__ __forceinline__
#define MFMA32(a, b, c) __builtin_amdgcn_mfma_f32_32x32x16_bf16((a), (b), (c), 0, 0, 0)

constexpr int M_TOK = 16384, DM = 1024, TSEQ = 2048;
constexpr int NPROJ = 3840;
constexpr size_t MBy = 1u << 20;
constexpr size_t OFF_WIN = 0, OFF_WOUT = 8 * MBy, OFF_WUP = 10 * MBy, OFF_WDOWN = 18 * MBy, OFF_WG = 26 * MBy, OFF_WPLE = 28 * MBy;
constexpr size_t OFF_STATS = 28 * MBy + 512 * 1024, OFF_GLAST = 28 * MBy + 640 * 1024, OFF_BAR = 29 * MBy + 512 * 1024, OFF_CTR = OFF_BAR + 14336, OFF_CF = 28 * MBy + 768 * 1024;
constexpr size_t OFF_XBUF = 31 * MBy, OFF_PCNT = OFF_BAR + 14848;
constexpr size_t OFF_GATES = 30 * MBy, OFF_GQKV = 32 * MBy, OFF_Z = 80 * MBy, OFF_FQK = 96 * MBy, OFF_VT = 128 * MBy, OFF_HB = 144 * MBy;
constexpr size_t OFF_U = 144 * MBy, OFF_W = 160 * MBy, OFF_QD = 176 * MBy, OFF_KDT = 192 * MBy, OFF_QK = 208 * MBy;
constexpr size_t OFF_OG = 32 * MBy, OFF_MIX = 216 * MBy;
constexpr size_t OFF_H1B = 32 * MBy, OFF_PB = 248 * MBy, OFF_FFB = 72 * MBy, OFF_PG = 200 * MBy;
constexpr float ALPHA = 1.189207115002721f;
constexpr int TEAM_LDS = 76800, LDS_MISC = 153600, LDS_BYTES = 153600 + 256;
#ifndef REP_MASK
#define REP_MASK 0
#endif
#define NREP(k) (1 + ((REP_MASK >> (k)) & 1))

struct Params { const float* in[21]; float* out; unsigned char* ws; };

DI float bf2f(unsigned b) { return __uint_as_float(b << 16); }
typedef float f32x2_t __attribute__((ext_vector_type(2))); typedef __bf16 bf16x2_t __attribute__((ext_vector_type(2)));
DI unsigned pack2(float lo, float hi) { f32x2_t v = {lo, hi}; bf16x2_t b = __builtin_convertvector(v, bf16x2_t); return __builtin_bit_cast(unsigned, b); }
DI unsigned f2bf(float x) { return pack2(x, 0.f) & 0xffffu; }
DI float bflo(unsigned w) { return __uint_as_float(w << 16); }
DI float bfhi(unsigned w) { return __uint_as_float(w & 0xffff0000u); }
DI int crow(int e, int h) { return (e & 3) + 8 * (e >> 2) + 4 * h; }
DI float shx(float v, int mask, int lane) { return __int_as_float(__builtin_amdgcn_ds_bpermute((lane ^ mask) << 2, __float_as_int(v))); }
DI float shup(float v, int o, int lane) { return __int_as_float(__builtin_amdgcn_ds_bpermute(((lane - o) & 63) << 2, __float_as_int(v))); }
DI float shlane(float v, int src) { return __int_as_float(__builtin_amdgcn_readlane(__float_as_int(v), src)); }
DI float wave_sum(float v, int lane) { for (int o = 32; o > 0; o >>= 1) v += shx(v, o, lane); return v; }
DI float siluf(float x) { return x * __builtin_amdgcn_rcpf(1.f + __expf(-x)); }
DI float sigmoidf_(float x) { return __builtin_amdgcn_rcpf(1.f + __expf(-x)); }
DI int fresh_tid(int wid_s) { int l; asm volatile("v_mbcnt_lo_u32_b32 %0, -1, 0\n\tv_mbcnt_hi_u32_b32 %0, -1, %0" : "=v"(l)); return wid_s * 64 + l; }
#define PHASE_IDS const int tid = fresh_tid(wid_s), lane = tid & 63, wave8 = tid >> 6, team = tid >> 8, tt = tid & 255, tw = tt >> 6; unsigned char* smem = lds + team * TEAM_LDS; (void)lane; (void)wave8; (void)tt; (void)tw; (void)smem;

DI void ln_row(const float* src, const float* __restrict__ g, const float* __restrict__ b, float* dstf, bf16_t* dstb, float* stats, int lane) {
    f32x4 v[4];
#pragma unroll
    for (int i = 0; i < 4; ++i) v[i] = *(const f32x4*)(src + i * 256 + lane * 4);
    float s = 0.f;
#pragma unroll
    for (int i = 0; i < 4; ++i) s += (v[i][0] + v[i][1]) + (v[i][2] + v[i][3]);
    s = wave_sum(s, lane);
    const float mu = s * (1.f / 1024.f);
    float q = 0.f;
#pragma unroll
    for (int i = 0; i < 4; ++i) { f32x4 d = v[i] - mu; q += (d[0] * d[0] + d[1] * d[1]) + (d[2] * d[2] + d[3] * d[3]); }
    q = wave_sum(q, lane);
    const float rstd = rsqrtf(q * (1.f / 1024.f) + 1e-5f);
    f32x4 gv[4], bv[4];
#pragma unroll
    for (int i = 0; i < 4; ++i) { gv[i] = *(const f32x4*)(g + i * 256 + lane * 4); bv[i] = *(const f32x4*)(b + i * 256 + lane * 4); }
#pragma unroll
    for (int i = 0; i < 4; ++i) {
        const f32x4 gg = gv[i], bb = bv[i];
        const f32x4 o = (v[i] - mu) * rstd * gg + bb;
        if (dstf) *(f32x4*)(dstf + i * 256 + lane * 4) = o;
        if (dstb) { u32x2 w; w.x = pack2(o[0], o[1]); w.y = pack2(o[2], o[3]); *(u32x2*)(dstb + i * 256 + lane * 4) = w; }
    }
    if (stats && lane == 0) { stats[0] = mu; stats[1] = rstd; }
}

DI void transpose_tile(const float* __restrict__ W, int K, int N, bf16_t* __restrict__ Wt, int kt, int nt, int mode, float* tile, int tt) {
    const int tid = tt;
    const int k0 = kt * 64, n0 = nt * 64;
    {
        const int c = tid & 63, n = n0 + c;
        int sc = n;
        if (mode == 1) { sc = (n < 2048) ? n : (n < 3584) ? n + 8 : (n < 3592) ? 2048 + (n - 3584) : (n < 3600) ? n : -1; }
        const int scc = sc >= 0 ? sc : 0;
        const float mk = sc >= 0 ? 1.f : 0.f;
        float wv[16];
#pragma unroll
        for (int i = 0; i < 16; ++i) wv[i] = W[(size_t)(k0 + (tid >> 6) + 4 * i) * N + scc];
#pragma unroll
        for (int i = 0; i < 16; ++i) tile[((tid >> 6) + 4 * i) * 65 + c] = wv[i] * mk;
    }
    __syncthreads();
    {
        const int n = tid >> 2, ks = (tid & 3) * 16;
        u32x4 o0, o1;
        o0.x = pack2(tile[(ks + 0) * 65 + n], tile[(ks + 1) * 65 + n]); o0.y = pack2(tile[(ks + 2) * 65 + n], tile[(ks + 3) * 65 + n]);
        o0.z = pack2(tile[(ks + 4) * 65 + n], tile[(ks + 5) * 65 + n]); o0.w = pack2(tile[(ks + 6) * 65 + n], tile[(ks + 7) * 65 + n]);
        o1.x = pack2(tile[(ks + 8) * 65 + n], tile[(ks + 9) * 65 + n]); o1.y = pack2(tile[(ks + 10) * 65 + n], tile[(ks + 11) * 65 + n]);
        o1.z = pack2(tile[(ks + 12) * 65 + n], tile[(ks + 13) * 65 + n]); o1.w = pack2(tile[(ks + 14) * 65 + n], tile[(ks + 15) * 65 + n]);
        bf16_t* dst = Wt + (size_t)(n0 + n) * K + k0 + ks;
        *(u32x4*)dst = o0; *(u32x4*)(dst + 8) = o1;
    }
    __syncthreads();
}

namespace pg8 {
#define PG8_LAS __attribute__((address_space(3)))
typedef PG8_LAS unsigned char* PG8_LAS_T;
typedef unsigned short bf16_t;
typedef short bf16x8 __attribute__((ext_vector_type(8)));
typedef float f32x4 __attribute__((ext_vector_type(4)));
typedef unsigned u32x4 __attribute__((ext_vector_type(4)));
constexpr int BM = 256, BK = 64, HALF = 128, HTB = HALF * BK * 2  , STAGE_BYTES = 8 * HTB, NXCD = 8, WGM = 8;

__host__ __device__ __forceinline__ int lds_byte(int r, int c) { const int st = (r >> 4) * 2 + (c >> 5), rr = r & 15, cc = c & 31, ob = rr * 64 + cc * 2; return st * 1024 + (ob ^ (((ob >> 9) & 1) << 5)); }
__host__ __device__ __forceinline__ void stage_rc(int b, int& R, int& C) { const int st = b / 1024, sb = b % 1024, swz = sb ^ (((sb >> 9) & 1) << 5); R = (st >> 1) * 16 + swz / 64; C = (st & 1) * 32 + (swz % 64) / 2; }
__host__ __device__ __forceinline__ int perm32(int rho) { const int n = rho >> 4, i = rho & 15; return 8 * (i >> 2) + 4 * n + (i & 3); }

struct Unit { int pm, pn; };
struct Gemm { const bf16_t* A; const bf16_t* Bt; int M, N, K; };

struct StaticOrder {
    int nM, nN, nwg, G, c;
    __host__ __device__ void init(int M, int N, int G_, int c_) { nM = M / BM; nN = N / BM; nwg = nM * nN; G = G_; c = c_; }
    __host__ __device__ bool next(int i, Unit& u) const {
        const long L = (long)i * G + c; if (L >= nwg) return false;
        int wgid = (int)L; { const int q = nwg / NXCD, r = nwg % NXCD, xcd = wgid % NXCD, off = wgid / NXCD; wgid = (xcd < r ? xcd * (q + 1) : r * (q + 1) + (xcd - r) * q) + off; }
        const int nig = WGM * nN, gid = wgid / nig, fm = gid * WGM, gsz = (nM - fm) < WGM ? (nM - fm) : WGM;
        u.pm = fm + ((wgid % nig) % gsz); u.pn = (wgid % nig) / gsz; return true;
    }
    __device__ __forceinline__ void a_ready(const Unit&) const {}
    __device__ __forceinline__ void done(const Unit&) const {}
};
template <class Epi, class Sched, bool ALIGN_EPI = false, bool SP2 = false>
__device__ __forceinline__ void gemm_phase(PG8_LAS unsigned char* lds, const Gemm g, const Sched& S, const Epi& E, const int wid_s) {
    const int tid = fresh_tid(wid_s), wid = wid_s, lane = tid & 63, wr = wid >> 2, wc = wid & 3, fr = lane & 15, fq = lane >> 4;
    const int K = g.K, nt = K / BK;
    unsigned voffA[2], voffB[2];
#pragma unroll
    for (int i = 0; i < 2; ++i) { int R, C; stage_rc(tid * 16 + i * 8192, R, C); const int Rb = Epi::PERM ? ((R & ~31) + perm32(R & 31)) : R;
        voffA[i] = (unsigned)(R * K + C) * 2u; voffB[i] = (unsigned)(Rb * K + C) * 2u; }
    const size_t kstep = (size_t)(BK * 2);
    const size_t hstep = (size_t)HALF * K * 2;
    const size_t tstep = 2 * hstep;
    const unsigned ldsw = (unsigned)wid * 1024u;
    const int aoff = lds_byte(wr * 64 + fr, fq * 8), boff = lds_byte(wc * 32 + fr, fq * 8);
#define PG8_SA(b, h) (((b) * 2 + (h)) * HTB)
#define PG8_SB(b, h) ((4 + (b) * 2 + (h)) * HTB)
#define PG8_STAGE(bufoff, gbase, voff) do { _Pragma("unroll") for (int _i = 0; _i < 2; ++_i) \
        __builtin_amdgcn_global_load_lds((const unsigned*)((const char*)(gbase) + (voff)[_i]), (PG8_LAS unsigned*)(lds + (bufoff) + ldsw + _i * 8192), 16, 0, 0); } while (0)
#define PG8_LDA(dst, b, h) do { _Pragma("unroll") for (int m = 0; m < 4; ++m) _Pragma("unroll") for (int k = 0; k < 2; ++k) dst[m][k] = *(const PG8_LAS bf16x8*)(lds + PG8_SA(b, h) + aoff + m * 2048 + k * 1024); } while (0)
#define PG8_LDB(dst, b, h) do { _Pragma("unroll") for (int n = 0; n < 2; ++n) _Pragma("unroll") for (int k = 0; k < 2; ++k) dst[n][k] = *(const PG8_LAS bf16x8*)(lds + PG8_SB(b, h) + boff + n * 2048 + k * 1024); } while (0)
#define PG8_MMA(ai, bj, At, Bt) do { __builtin_amdgcn_s_setprio(1); _Pragma("unroll") for (int m = 0; m < 4; ++m) _Pragma("unroll") for (int n = 0; n < 2; ++n) _Pragma("unroll") for (int k = 0; k < 2; ++k) \
        acc[ai][bj][m][n] = __builtin_amdgcn_mfma_f32_16x16x32_bf16(Bt[n][k], At[m][k], acc[ai][bj][m][n], 0, 0, 0); __builtin_amdgcn_s_setprio(0); } while (0)
#define PG8_WAIT_V(n) asm volatile("s_waitcnt vmcnt(" #n ")" ::: "memory")
#define PG8_WAIT_L(n) asm volatile("s_waitcnt lgkmcnt(" #n ")" ::: "memory")
#define PG8_BAR __builtin_amdgcn_s_barrier()
#define PG8_SCHED __builtin_amdgcn_sched_barrier(0)
    Unit cur, nxt; int ui = 0;
    if (!S.next(0, cur)) return;
    f32x4 acc[2][2][4][2];
#pragma unroll
    for (int a = 0; a < 2; ++a)
#pragma unroll
        for (int b = 0; b < 2; ++b)
#pragma unroll
            for (int m = 0; m < 4; ++m)
#pragma unroll
                for (int n = 0; n < 2; ++n) acc[a][b][m][n] = (f32x4){0.f, 0.f, 0.f, 0.f};
    bf16x8 At[4][2], B0[2][2], B1[2][2];
    const char* cA = (const char*)g.A + (size_t)cur.pm * tstep; const char* cB = (const char*)g.Bt + (size_t)cur.pn * tstep;
    S.a_ready(cur);
    if constexpr (SP2) {
        PG8_STAGE(PG8_SB(0, 0), cB, voffB); PG8_STAGE(PG8_SB(0, 1), cB + hstep, voffB); PG8_STAGE(PG8_SA(0, 0), cA, voffA); PG8_STAGE(PG8_SA(0, 1), cA + hstep, voffA);
        if (wr == 1) PG8_BAR;
        PG8_WAIT_V(2); PG8_BAR;
        PG8_STAGE(PG8_SB(1, 0), cB + kstep, voffB); PG8_STAGE(PG8_SA(1, 0), cA + kstep, voffA); PG8_STAGE(PG8_SB(1, 1), cB + hstep + kstep, voffB);
        PG8_WAIT_V(6); PG8_BAR;
    } else {
        PG8_STAGE(PG8_SB(0, 0), cB, voffB); PG8_STAGE(PG8_SA(0, 0), cA, voffA); PG8_STAGE(PG8_SB(0, 1), cB + hstep, voffB); PG8_STAGE(PG8_SA(0, 1), cA + hstep, voffA);
        if (wr == 1) PG8_BAR;
        PG8_WAIT_V(4); PG8_BAR;
        PG8_STAGE(PG8_SB(1, 0), cB + kstep, voffB); PG8_STAGE(PG8_SA(1, 0), cA + kstep, voffA); PG8_STAGE(PG8_SB(1, 1), cB + hstep + kstep, voffB);
        PG8_WAIT_V(6); PG8_BAR;
    }
    for (;;) {
        const bool has_next = S.next(ui + 1, nxt);
        const char* nA = has_next ? (const char*)g.A + (size_t)nxt.pm * tstep : cA; const char* nB = has_next ? (const char*)g.Bt + (size_t)nxt.pn * tstep : cB;
        for (int t = 0; t < nt; t += 2) {
            const bool last = (t == nt - 2);
            const char* a1 = cA + (size_t)(t + 1) * kstep;
            const char* a2 = last ? nA : cA + (size_t)(t + 2) * kstep; const char* b2 = last ? nB : cB + (size_t)(t + 2) * kstep;
            const char* a3 = a2 + kstep; const char* b3 = b2 + kstep;
            if (last && has_next) S.a_ready(nxt);
            if constexpr (SP2) {
            PG8_LDB(B0, 0, 0); PG8_LDB(B1, 0, 1); PG8_SCHED; PG8_LDA(At, 0, 0); PG8_STAGE(PG8_SA(1, 1), a1 + hstep, voffA);
            PG8_WAIT_V(8); PG8_WAIT_L(0); PG8_BAR; PG8_MMA(0, 0, At, B0); PG8_MMA(0, 1, At, B1); PG8_BAR; PG8_SCHED;
            PG8_LDA(At, 0, 1); PG8_STAGE(PG8_SB(0, 0), b2, voffB); PG8_STAGE(PG8_SB(0, 1), b2 + hstep, voffB); PG8_STAGE(PG8_SA(0, 0), a2, voffA);
            PG8_WAIT_V(8); PG8_WAIT_L(0); PG8_BAR; PG8_MMA(1, 0, At, B0); PG8_MMA(1, 1, At, B1); PG8_BAR; PG8_SCHED;
            PG8_LDB(B0, 1, 0); PG8_LDB(B1, 1, 1); PG8_SCHED; PG8_LDA(At, 1, 0); PG8_STAGE(PG8_SA(0, 1), a2 + hstep, voffA);
            PG8_WAIT_V(8); PG8_WAIT_L(0); PG8_BAR; PG8_MMA(0, 0, At, B0); PG8_MMA(0, 1, At, B1); PG8_BAR; PG8_SCHED;
            PG8_LDA(At, 1, 1); PG8_STAGE(PG8_SB(1, 0), b3, voffB); PG8_STAGE(PG8_SB(1, 1), b3 + hstep, voffB); PG8_STAGE(PG8_SA(1, 0), a3, voffA);
            PG8_WAIT_V(8); PG8_WAIT_L(0); PG8_BAR; PG8_MMA(1, 0, At, B0); PG8_MMA(1, 1, At, B1); PG8_BAR; PG8_SCHED;
            } else {
            PG8_LDB(B0, 0, 0); PG8_SCHED; PG8_LDA(At, 0, 0); PG8_STAGE(PG8_SA(1, 1), a1 + hstep, voffA);
            PG8_WAIT_L(8); PG8_BAR; PG8_WAIT_L(0); PG8_MMA(0, 0, At, B0); PG8_BAR; PG8_SCHED;
            PG8_LDB(B1, 0, 1); PG8_STAGE(PG8_SB(0, 0), b2, voffB);
            PG8_BAR; PG8_WAIT_L(0); PG8_MMA(0, 1, At, B1); PG8_BAR;
            PG8_LDA(At, 0, 1); PG8_STAGE(PG8_SA(0, 0), a2, voffA);
            PG8_BAR; PG8_WAIT_L(0); PG8_MMA(1, 0, At, B0); PG8_BAR; PG8_SCHED;
            PG8_STAGE(PG8_SB(0, 1), b2 + hstep, voffB);
            PG8_WAIT_V(6); PG8_BAR; PG8_MMA(1, 1, At, B1); PG8_BAR;
            PG8_LDB(B0, 1, 0); PG8_SCHED; PG8_LDA(At, 1, 0); PG8_STAGE(PG8_SA(0, 1), a2 + hstep, voffA);
            PG8_WAIT_L(8); PG8_BAR; PG8_WAIT_L(0); PG8_MMA(0, 0, At, B0); PG8_BAR; PG8_SCHED;
            PG8_LDB(B1, 1, 1); PG8_STAGE(PG8_SB(1, 0), b3, voffB);
            PG8_BAR; PG8_WAIT_L(0); PG8_MMA(0, 1, At, B1); PG8_BAR;
            PG8_LDA(At, 1, 1); PG8_STAGE(PG8_SA(1, 0), a3, voffA);
            PG8_BAR; PG8_WAIT_L(0); PG8_MMA(1, 0, At, B0); PG8_BAR; PG8_SCHED;
            PG8_STAGE(PG8_SB(1, 1), b3 + hstep, voffB);
            PG8_WAIT_V(6); PG8_BAR; PG8_MMA(1, 1, At, B1); PG8_BAR;
            }
        }
        if constexpr (ALIGN_EPI) { if (wr == 0) PG8_BAR; }
        if constexpr (!Epi::AFTER_DRAIN) { E(acc, cur, wr, wc, fr, fq); S.done(cur); }
        if (!has_next) break;
#pragma unroll
        for (int a = 0; a < 2; ++a)
#pragma unroll
            for (int b = 0; b < 2; ++b)
#pragma unroll
                for (int m = 0; m < 4; ++m)
#pragma unroll
                    for (int n = 0; n < 2; ++n) acc[a][b][m][n] = (f32x4){0.f, 0.f, 0.f, 0.f};
        cur = nxt; cA = nA; cB = nB; ++ui;
        if constexpr (ALIGN_EPI) { if (wr == 1) PG8_BAR; }
    }
    PG8_WAIT_V(0);
    if constexpr (!ALIGN_EPI) { if (wr == 0) PG8_BAR; }
    PG8_BAR;
    if constexpr (Epi::AFTER_DRAIN) { E.fused(acc, cur, wr, wc, fr, fq, lds, wid, lane); S.done(cur); }
#undef PG8_SA
#undef PG8_SB
#undef PG8_STAGE
#undef PG8_LDA
#undef PG8_LDB
#undef PG8_MMA
#undef PG8_WAIT_V
#undef PG8_WAIT_L
#undef PG8_BAR
#undef PG8_SCHED
}
}

template <class F> DI void epi_rows(const pg8::f32x4 (&acc)[2][2][4][2], const pg8::Unit& u, int wr, int wc, int fr, int fq, F f) {
#pragma unroll
    for (int ai = 0; ai < 2; ++ai)
#pragma unroll
        for (int m = 0; m < 4; ++m) {
            const int row = u.pm * 256 + ai * 128 + wr * 64 + m * 16 + fr;
#pragma unroll
            for (int bj = 0; bj < 2; ++bj) f(row, u.pn * 256 + bj * 128 + wc * 32 + 8 * fq, acc[ai][bj][m][0], acc[ai][bj][m][1]);
        }
}
DI u32x4 pack8(const f32x4& a, const f32x4& b) { u32x4 w; w.x = pack2(a[0], a[1]); w.y = pack2(a[2], a[3]); w.z = pack2(b[0], b[1]); w.w = pack2(b[2], b[3]); return w; }
struct EpiProj {
    static constexpr bool PERM = true, AFTER_DRAIN = false;
    unsigned char* ws;
    DI void operator()(const pg8::f32x4 (&acc)[2][2][4][2], const pg8::Unit& u, int wr, int wc, int fr, int fq) const {
        const int pn = u.pn;
        if (pn < 12) {
            bf16_t* dst; int ld, cofs;
            if (pn < 6) { dst = (bf16_t*)(ws + OFF_GQKV); ld = 1536; cofs = 0; }
            else if (pn < 8) { dst = (bf16_t*)(ws + OFF_Z); ld = 512; cofs = 1536; }
            else { dst = (bf16_t*)(ws + OFF_FQK); ld = 1024; cofs = 2048; }
            epi_rows(acc, u, wr, wc, fr, fq, [&](int row, int col, const f32x4& a, const f32x4& b) { *(u32x4*)(dst + (size_t)row * ld + (col - cofs)) = pack8(a, b); });
        } else if (pn < 14) {
            bf16_t* vT = (bf16_t*)(ws + OFF_VT);
            epi_rows(acc, u, wr, wc, fr, fq, [&](int row, int col, const f32x4& a, const f32x4& b) {
                const int c = col - 3072, hh = c >> 6, d0 = c & 63, bb = row >> 11, t = row & 2047;
                bf16_t* p = vT + ((size_t)(bb * 8 + hh) * 64 + d0) * TSEQ + t;
#pragma unroll
                for (int e = 0; e < 4; ++e) { p[(size_t)e * TSEQ] = (bf16_t)f2bf(a[e]); p[(size_t)(e + 4) * TSEQ] = (bf16_t)f2bf(b[e]); }
            });
        } else {
            float* gates = (float*)(ws + OFF_GATES);
            epi_rows(acc, u, wr, wc, fr, fq, [&](int row, int col, const f32x4& a, const f32x4& b) {
                const int c = col - 3584;
                if (c < 16) { *(f32x4*)(gates + (size_t)row * 16 + c) = a; *(f32x4*)(gates + (size_t)row * 16 + c + 4) = b; }
            });
        }
    }
};
struct EpiOutProj {
    static constexpr bool PERM = true, AFTER_DRAIN = false;
    const float* x; const float* g; const float* b; const float* stats; float* out;
    DI void operator()(const pg8::f32x4 (&acc)[2][2][4][2], const pg8::Unit& u, int wr, int wc, int fr, int fq) const {
        epi_rows(acc, u, wr, wc, fr, fq, [&](int row, int col, const f32x4& a0, const f32x4& a1) {
            const float mu = stats[row * 2], rs = stats[row * 2 + 1];
            const size_t idx = (size_t)row * DM + col;
            const f32x4 x0 = *(const f32x4*)(x + idx), x1 = *(const f32x4*)(x + idx + 4);
            const f32x4 g0 = *(const f32x4*)(g + col), g1 = *(const f32x4*)(g + col + 4), b0 = *(const f32x4*)(b + col), b1 = *(const f32x4*)(b + col + 4);
            *(f32x4*)(out + idx) = ((x0 - mu) * rs * g0 + b0) * ALPHA + a0;
            *(f32x4*)(out + idx + 4) = ((x1 - mu) * rs * g1 + b1) * ALPHA + a1;
        });
    }
};
struct EpiUp {
    static constexpr bool PERM = true, AFTER_DRAIN = false;
    bf16_t* ffb;
    DI void operator()(const pg8::f32x4 (&acc)[2][2][4][2], const pg8::Unit& u, int wr, int wc, int fr, int fq) const {
        epi_rows(acc, u, wr, wc, fr, fq, [&](int row, int col, const f32x4& a, const f32x4& b) {
            f32x4 ra, rb;
#pragma unroll
            for (int e = 0; e < 4; ++e) { const float va = fmaxf(a[e], 0.f), vb = fmaxf(b[e], 0.f); ra[e] = va * va; rb[e] = vb * vb; }
            *(u32x4*)(ffb + (size_t)row * 4096 + col) = pack8(ra, rb);
        });
    }
};
struct EpiGate {
    static constexpr bool PERM = true, AFTER_DRAIN = false;
    bf16_t* pg; const float* bias;
    DI void operator()(const pg8::f32x4 (&acc)[2][2][4][2], const pg8::Unit& u, int wr, int wc, int fr, int fq) const {
        f32x4 bv[2][2];
#pragma unroll
        for (int bj = 0; bj < 2; ++bj) { const int c0 = u.pn * 256 + bj * 128 + wc * 32 + 8 * fq; bv[bj][0] = *(const f32x4*)(bias + c0); bv[bj][1] = *(const f32x4*)(bias + c0 + 4); }
        epi_rows(acc, u, wr, wc, fr, fq, [&](int row, int col, const f32x4& a, const f32x4& b) {
            const int bj = (col >> 7) & 1;
            const f32x4 b0 = bv[bj][0], b1 = bv[bj][1];
            f32x4 ra, rb;
#pragma unroll
            for (int e = 0; e < 4; ++e) { ra[e] = sigmoidf_(a[e] + b0[e]); rb[e] = sigmoidf_(b[e] + b1[e]); }
            *(u32x4*)(pg + (size_t)row * DM + col) = pack8(ra, rb);
        });
    }
};
struct EpiPle {
    static constexpr bool PERM = true, AFTER_DRAIN = false;
    bf16_t* pg;
    DI void operator()(const pg8::f32x4 (&acc)[2][2][4][2], const pg8::Unit& u, int wr, int wc, int fr, int fq) const {
        epi_rows(acc, u, wr, wc, fr, fq, [&](int row, int col, const f32x4& a, const f32x4& b) {
            u32x4* p = (u32x4*)(pg + (size_t)row * DM + col);
            const u32x4 w = *p;
            f32x4 ra, rb;
            ra[0] = a[0] * bflo(w.x); ra[1] = a[1] * bfhi(w.x); ra[2] = a[2] * bflo(w.y); ra[3] = a[3] * bfhi(w.y);
            rb[0] = b[0] * bflo(w.z); rb[1] = b[1] * bfhi(w.z); rb[2] = b[2] * bflo(w.w); rb[3] = b[3] * bfhi(w.w);
            *p = pack8(ra, rb);
        });
    }
};
struct EpiDown {
    static constexpr bool PERM = true, AFTER_DRAIN = false;
    const bf16_t* pg; float* out;
    DI void operator()(const pg8::f32x4 (&acc)[2][2][4][2], const pg8::Unit& u, int wr, int wc, int fr, int fq) const {
        epi_rows(acc, u, wr, wc, fr, fq, [&](int row, int col, const f32x4& a, const f32x4& b) {
            const size_t idx = (size_t)row * DM + col;
            const u32x4 w = *(const u32x4*)(pg + idx);
            f32x4 o0 = *(const f32x4*)(out + idx), o1 = *(const f32x4*)(out + idx + 4);
            o0 = o0 * ALPHA + a; o1 = o1 * ALPHA + b;
            o0[0] += bflo(w.x); o0[1] += bfhi(w.x); o0[2] += bflo(w.y); o0[3] += bfhi(w.y);
            o1[0] += bflo(w.z); o1[1] += bfhi(w.z); o1[2] += bflo(w.w); o1[3] += bfhi(w.w);
            *(f32x4*)(out + idx) = o0; *(f32x4*)(out + idx + 4) = o1;
        });
    }
};
DI void lds_read8(unsigned addr, f32x4 (&a)[4][2]) {
    asm volatile(
        "ds_read_b128 %0, %8\n\tds_read_b128 %1, %8 offset:16\n\t"
        "ds_read_b128 %2, %8 offset:256\n\tds_read_b128 %3, %8 offset:272\n\t"
        "ds_read_b128 %4, %8 offset:512\n\tds_read_b128 %5, %8 offset:528\n\t"
        "ds_read_b128 %6, %8 offset:768\n\tds_read_b128 %7, %8 offset:784\n\t"
        "s_waitcnt lgkmcnt(0)"
        : "=&v"(a[0][0]), "=&v"(a[0][1]), "=&v"(a[1][0]), "=&v"(a[1][1]), "=&v"(a[2][0]), "=&v"(a[2][1]), "=&v"(a[3][0]), "=&v"(a[3][1])
        : "v"(addr) : "memory");
}
DI void lds_read8s(unsigned addr, f32x4 (&a)[4][2]) {
    asm volatile(
        "ds_read_b128 %0, %8\n\tds_read_b128 %1, %8 offset:16\n\t"
        "ds_read_b128 %2, %8 offset:128\n\tds_read_b128 %3, %8 offset:144\n\t"
        "ds_read_b128 %4, %8 offset:256\n\tds_read_b128 %5, %8 offset:272\n\t"
        "ds_read_b128 %6, %8 offset:384\n\tds_read_b128 %7, %8 offset:400\n\t"
        "s_waitcnt lgkmcnt(0)"
        : "=&v"(a[0][0]), "=&v"(a[0][1]), "=&v"(a[1][0]), "=&v"(a[1][1]), "=&v"(a[2][0]), "=&v"(a[2][1]), "=&v"(a[3][0]), "=&v"(a[3][1])
        : "v"(addr) : "memory");
}
DI void prep_chunk(const Params& P, int ci, unsigned char* smem, int tt) {
    const int tid = tt, lane = tid & 63, wave = tid >> 6, r = lane & 31, h2 = lane >> 5;
    const int b = ci >> 7, hd = (ci >> 5) & 3, n = ci & 31, t0 = n * 64;
    const size_t rowbase = (size_t)b * TSEQ + t0;
    bf16_t* kbf = (bf16_t*)smem;
    bf16_t* qbf = kbf + 64 * 136;
    bf16_t* vT  = (bf16_t*)smem;
    bf16_t* Tb  = (bf16_t*)(smem + 18432);
    bf16_t* Tg  = (bf16_t*)(smem + 27648);
    bf16_t* kT  = (bf16_t*)(smem + 36864);
    float*  Ad  = (float*)(smem + 55296);
    bf16_t* A10 = (bf16_t*)(smem + 63488);
    bf16_t* DT  = (bf16_t*)(smem + 66048);
    float* sbeta = (float*)(smem + 71168);
    float* sgam = sbeta + 64; float* segam = sgam + 64; float* sdk = segam + 64;
    bf16_t* D1R = (bf16_t*)(smem + 72192);
    const bf16_t* gq = (const bf16_t*)(P.ws + OFF_GQKV);
    const float* gates = (const float*)(P.ws + OFF_GATES);
    const float* cw = P.in[5];
    if (tid < 64) {
        const float* gt = gates + (rowbase + tid) * 16;
        const float be = sigmoidf_(gt[hd]);
        const float a = gt[4 + hd] + P.in[7][hd];
        const float sp = fmaxf(a, 0.f) + log1pf(__expf(-fabsf(a)));
        float lg = -__expf(P.in[6][hd]) * sp;
#pragma unroll
        for (int o = 1; o < 64; o <<= 1) { const float t = shup(lg, o, lane); if (lane >= o) lg += t; }
        const float gl = shlane(lg, 63);
        sbeta[tid] = be; sgam[tid] = lg; segam[tid] = __expf(lg); sdk[tid] = __expf(gl - lg);
    }
    {
        float* wl = Ad;
        for (int idx = tid; idx < 384; idx += 256) {
            const int wh = idx >> 7, rem = idx & 127, j = rem >> 5, c4 = (rem & 31) * 4;
            const int cbw = (wh == 0 ? 512 : wh == 1 ? 0 : 1024) + hd * 128;
            *(f32x4*)(wl + (wh * 4 + j) * 128 + c4) = *(const f32x4*)(cw + j * 1536 + cbw + c4);
        }
    }
    __syncthreads();
    unsigned vkeep[16];
#pragma unroll
    for (int e = 0; e < 16; ++e) vkeep[e] = 0u;
    {
        const int i = tid >> 2, seg = tid & 3;
        const float* wl = Ad;
#pragma unroll 1
        for (int which = 0; which < 3; ++which) {
            const int colbase = (which == 0 ? 512 : which == 1 ? 0 : 1024) + hd * 128 + seg * 32;
            u32x4 xr[4][4];
#pragma unroll
            for (int j = 0; j < 4; ++j) {
                const int t = t0 + i - 3 + j;
                const int tc = t < 0 ? 0 : t;
                const bf16_t* xp = gq + ((size_t)b * TSEQ + tc) * 1536 + colbase;
#pragma unroll
                for (int sub = 0; sub < 4; ++sub) xr[j][sub] = *(const u32x4*)(xp + sub * 8);
            }
            float val[32];
#pragma unroll
            for (int sub = 0; sub < 4; ++sub) {
                float a8[8];
#pragma unroll
                for (int e = 0; e < 8; ++e) a8[e] = 0.f;
#pragma unroll
                for (int j = 0; j < 4; ++j) {
                    const float mk = (t0 + i - 3 + j) < 0 ? 0.f : 1.f;
                    const u32x4 xv = xr[j][sub];
                    f32x4 w0 = *(const f32x4*)(wl + (which * 4 + j) * 128 + seg * 32 + sub * 8), w1 = *(const f32x4*)(wl + (which * 4 + j) * 128 + seg * 32 + sub * 8 + 4);
                    w0 = w0 * mk; w1 = w1 * mk;
                    a8[0] += w0[0] * bflo(xv.x); a8[1] += w0[1] * bfhi(xv.x); a8[2] += w0[2] * bflo(xv.y); a8[3] += w0[3] * bfhi(xv.y);
                    a8[4] += w1[0] * bflo(xv.z); a8[5] += w1[1] * bfhi(xv.z); a8[6] += w1[2] * bflo(xv.w); a8[7] += w1[3] * bfhi(xv.w);
                }
#pragma unroll
                for (int e = 0; e < 8; ++e) val[sub * 8 + e] = siluf(a8[e]);
            }
            float ss = 0.f;
#pragma unroll
            for (int e = 0; e < 32; ++e) ss += val[e] * val[e];
            ss += shx(ss, 1, lane); ss += shx(ss, 2, lane);
            const float sc = (which == 2) ? 1.f : rsqrtf(ss + 1e-6f) * (which == 1 ? 0.08838834764831845f : 1.f);
            unsigned pk[16];
#pragma unroll
            for (int e = 0; e < 16; ++e) pk[e] = pack2(val[2 * e] * sc, val[2 * e + 1] * sc);
            if (which == 2) {
#pragma unroll
                for (int e = 0; e < 16; ++e) vkeep[e] = pk[e];
            } else {
                bf16_t* dst = (which == 0 ? kbf : qbf) + i * 136 + seg * 32;
#pragma unroll
                for (int sub = 0; sub < 4; ++sub) { u32x4 o; o.x = pk[4 * sub]; o.y = pk[4 * sub + 1]; o.z = pk[4 * sub + 2]; o.w = pk[4 * sub + 3]; *(u32x4*)(dst + sub * 8) = o; }
                if (which == 0) {
                    bf16_t* kt = kT + (seg * 32) * 72 + i;
#pragma unroll
                    for (int e = 0; e < 16; ++e) { kt[(2 * e) * 72] = (bf16_t)(pk[e] & 0xffffu); kt[(2 * e + 1) * 72] = (bf16_t)(pk[e] >> 16); }
                }
            }
        }
    }
    __syncthreads();
    {
        const int mi = wave >> 1, ni = wave & 1;
        f32x16 aK, aQ;
#pragma unroll
        for (int e = 0; e < 16; ++e) { aK[e] = 0.f; aQ[e] = 0.f; }
#pragma unroll
        for (int ks = 0; ks < 8; ++ks) {
            const bf16x8 ak = *(const bf16x8*)(kbf + (mi * 32 + r) * 136 + ks * 16 + h2 * 8);
            const bf16x8 bk = *(const bf16x8*)(kbf + (ni * 32 + r) * 136 + ks * 16 + h2 * 8);
            const bf16x8 aq = *(const bf16x8*)(qbf + (mi * 32 + r) * 136 + ks * 16 + h2 * 8);
            aK = MFMA32(ak, bk, aK); aQ = MFMA32(aq, bk, aQ);
        }
        const int j = ni * 32 + r;
        const float gj = sgam[j];
        bf16_t* qkout = (bf16_t*)(P.ws + OFF_QK) + (size_t)ci * 4096;
#pragma unroll
        for (int e = 0; e < 16; ++e) {
            const int il = crow(e, h2), i = mi * 32 + il;
            const float dec = (i >= j) ? __expf(sgam[i] - gj) : 0.f;
            const float aij = (i > j) ? aK[e] * sbeta[i] * dec : 0.f;
            if (mi == ni) Ad[(mi * 32 + il) * 32 + r] = aij;
            else if (mi == 1) A10[il * 40 + r] = (bf16_t)f2bf(aij);
            qkout[(((i >> 5) * 4 + (j >> 4)) * 64 + (i & 31) + 32 * ((j >> 3) & 1)) * 8 + (j & 7)] = (bf16_t)f2bf((i >= j) ? aQ[e] * dec : 0.f);
        }
    }
    {
        const int i = tid >> 2, seg = tid & 3;
        const float eg = segam[i];
        bf16_t* qd = (bf16_t*)(P.ws + OFF_QD) + (size_t)ci * 8192;
#pragma unroll
        for (int sub = 0; sub < 4; ++sub) {
            const u32x4 v = *(const u32x4*)(qbf + i * 136 + seg * 32 + sub * 8);
            u32x4 o;
            o.x = pack2(bflo(v.x) * eg, bfhi(v.x) * eg); o.y = pack2(bflo(v.y) * eg, bfhi(v.y) * eg);
            o.z = pack2(bflo(v.z) * eg, bfhi(v.z) * eg); o.w = pack2(bflo(v.w) * eg, bfhi(v.w) * eg);
            *(u32x4*)(qd + ((((i >> 5) * 8 + seg * 2 + (sub >> 1)) * 64 + (i & 31) + 32 * (sub & 1)) * 8)) = o;
        }
        const int kidx = tid >> 1, cs = (tid & 1) * 32;
        bf16_t* kd = (bf16_t*)(P.ws + OFF_KDT) + (size_t)ci * 8192;
#pragma unroll
        for (int sub = 0; sub < 4; ++sub) {
            const u32x4 v = *(const u32x4*)(kT + kidx * 72 + cs + sub * 8);
            const f32x4 d0 = *(const f32x4*)(sdk + cs + sub * 8), d1 = *(const f32x4*)(sdk + cs + sub * 8 + 4);
            u32x4 o;
            o.x = pack2(bflo(v.x) * d0[0], bfhi(v.x) * d0[1]); o.y = pack2(bflo(v.y) * d0[2], bfhi(v.y) * d0[3]);
            o.z = pack2(bflo(v.z) * d1[0], bfhi(v.z) * d1[1]); o.w = pack2(bflo(v.w) * d1[2], bfhi(v.w) * d1[3]);
            *(u32x4*)(kd + ((((kidx >> 5) * 4 + ((cs + sub * 8) >> 4)) * 64 + (kidx & 31) + 32 * (sub & 1)) * 8)) = o;
        }
        if (tid == 0) ((float*)(P.ws + OFF_GLAST))[ci] = segam[63];
    }
    __syncthreads();
    {
        const int i = tid >> 2, seg = tid & 3;
        bf16_t* vt = vT + (seg * 32) * 72 + i;
#pragma unroll
        for (int e = 0; e < 16; ++e) { vt[(2 * e) * 72] = (bf16_t)(vkeep[e] & 0xffffu); vt[(2 * e + 1) * 72] = (bf16_t)(vkeep[e] >> 16); }
        if (tid >= 64) {
            for (int idx = tid - 64; idx < 1024; idx += 192) { const int rr = idx >> 5, cc = 32 + (idx & 31); Tb[rr * 72 + cc] = 0; Tg[rr * 72 + cc] = 0; }
        } else {
            const int blk = tid >> 5, c = tid & 31;
            float x[32];
#pragma unroll
            for (int e = 0; e < 32; ++e) x[e] = (e == c) ? 1.f : 0.f;
            const unsigned ad_lds = (unsigned)(size_t)(Ad + blk * 1024);
#pragma unroll
            for (int ib = 0; ib < 8; ++ib) {
                const int i0 = ib * 4;
                float s0 = x[i0], s1 = x[i0 + 1], s2 = x[i0 + 2], s3 = x[i0 + 3];
#pragma unroll
                for (int mb = 0; mb <= ib; mb += 2) {
                    f32x4 a[4][2];
                    lds_read8s(ad_lds + (unsigned)((i0 * 32 + mb * 4) * 4), a);
#pragma unroll
                    for (int cb = 0; cb < 2; ++cb) {
                        const int m4 = mb + cb;
                        if (m4 < ib) {
#pragma unroll
                            for (int e = 0; e < 4; ++e) {
                                const float xx = x[m4 * 4 + e];
                                s0 -= a[0][cb][e] * xx; s1 -= a[1][cb][e] * xx; s2 -= a[2][cb][e] * xx; s3 -= a[3][cb][e] * xx;
                            }
                        } else if (m4 == ib) {
                            s1 -= a[1][cb][0] * s0;
                            s2 -= a[2][cb][0] * s0; s2 -= a[2][cb][1] * s1;
                            s3 -= a[3][cb][0] * s0; s3 -= a[3][cb][1] * s1; s3 -= a[3][cb][2] * s2;
                        }
                    }
                    __builtin_amdgcn_sched_barrier(0);
                }
                x[i0] = s0; x[i0 + 1] = s1; x[i0 + 2] = s2; x[i0 + 3] = s3;
            }
            bf16_t* dt = DT + (blk * 32 + c) * 40;
#pragma unroll
            for (int q4 = 0; q4 < 4; ++q4) {
                u32x4 o; o.x = pack2(x[8 * q4], x[8 * q4 + 1]); o.y = pack2(x[8 * q4 + 2], x[8 * q4 + 3]); o.z = pack2(x[8 * q4 + 4], x[8 * q4 + 5]); o.w = pack2(x[8 * q4 + 6], x[8 * q4 + 7]);
                *(u32x4*)(dt + q4 * 8) = o;
            }
            const int cg = blk * 32 + c;
            const float bc = sbeta[cg], bg = bc * segam[cg];
#pragma unroll
            for (int rr = 0; rr < 32; ++rr) {
                if (blk == 1) D1R[rr * 40 + c] = (bf16_t)f2bf(x[rr]);
                Tb[(blk * 32 + rr) * 72 + cg] = (bf16_t)f2bf(x[rr] * bc);
                Tg[(blk * 32 + rr) * 72 + cg] = (bf16_t)f2bf(x[rr] * bg);
            }
        }
    }
    __syncthreads();
    if (wave == 0) {
        f32x16 Pm, Qm;
#pragma unroll
        for (int e = 0; e < 16; ++e) { Pm[e] = 0.f; Qm[e] = 0.f; }
#pragma unroll
        for (int ks = 0; ks < 2; ++ks) {
            const bf16x8 a = *(const bf16x8*)(A10 + r * 40 + ks * 16 + h2 * 8);
            const bf16x8 bb = *(const bf16x8*)(DT + r * 40 + ks * 16 + h2 * 8);
            Pm = MFMA32(a, bb, Pm);
        }
#pragma unroll
        for (int sq = 0; sq < 2; ++sq) {
            u32x4 pw;
            pw.x = pack2(Pm[8 * sq + 0], Pm[8 * sq + 1]); pw.y = pack2(Pm[8 * sq + 2], Pm[8 * sq + 3]);
            pw.z = pack2(Pm[8 * sq + 4], Pm[8 * sq + 5]); pw.w = pack2(Pm[8 * sq + 6], Pm[8 * sq + 7]);
            const bf16_t* dp = D1R + r * 40 + 16 * sq + 4 * h2;
            const u32x2 lo = *(const u32x2*)dp, hi = *(const u32x2*)(dp + 8);
            u32x4 aw; aw.x = lo.x; aw.y = lo.y; aw.z = hi.x; aw.w = hi.y;
            Qm = MFMA32(__builtin_bit_cast(bf16x8, aw), __builtin_bit_cast(bf16x8, pw), Qm);
        }
        const float bc = sbeta[r], bg = bc * segam[r];
#pragma unroll
        for (int e = 0; e < 16; ++e) {
            const int il = crow(e, h2);
            Tb[(32 + il) * 72 + r] = (bf16_t)f2bf(-Qm[e] * bc);
            Tg[(32 + il) * 72 + r] = (bf16_t)f2bf(-Qm[e] * bg);
        }
    }
    __syncthreads();
    {
        const int nt = wave;
        f32x16 aU[2], aW[2];
#pragma unroll
        for (int e = 0; e < 16; ++e) { aU[0][e] = 0.f; aU[1][e] = 0.f; aW[0][e] = 0.f; aW[1][e] = 0.f; }
#pragma unroll
        for (int ks = 0; ks < 4; ++ks) {
            const bf16x8 bv = *(const bf16x8*)(vT + (nt * 32 + r) * 72 + ks * 16 + h2 * 8);
            const bf16x8 bk = *(const bf16x8*)(kT + (nt * 32 + r) * 72 + ks * 16 + h2 * 8);
#pragma unroll
            for (int mt = 0; mt < 2; ++mt) {
                const bf16x8 ab = *(const bf16x8*)(Tb + (mt * 32 + r) * 72 + ks * 16 + h2 * 8);
                const bf16x8 ag = *(const bf16x8*)(Tg + (mt * 32 + r) * 72 + ks * 16 + h2 * 8);
                aU[mt] = MFMA32(ab, bv, aU[mt]); aW[mt] = MFMA32(ag, bk, aW[mt]);
            }
        }
        bf16_t* u = (bf16_t*)(P.ws + OFF_U) + (size_t)ci * 8192;
        bf16_t* w = (bf16_t*)(P.ws + OFF_W) + (size_t)ci * 8192;
#pragma unroll
        for (int mt = 0; mt < 2; ++mt) {
            u32x4 o0, o1;
            o0.x = pack2(aU[mt][0], aU[mt][1]); o0.y = pack2(aU[mt][2], aU[mt][3]); o0.z = pack2(aU[mt][4], aU[mt][5]); o0.w = pack2(aU[mt][6], aU[mt][7]);
            o1.x = pack2(aU[mt][8], aU[mt][9]); o1.y = pack2(aU[mt][10], aU[mt][11]); o1.z = pack2(aU[mt][12], aU[mt][13]); o1.w = pack2(aU[mt][14], aU[mt][15]);
            bf16_t* d = u + (((nt * 2 + mt) * 64 + lane) * 16);
            *(u32x4*)d = o0; *(u32x4*)(d + 8) = o1;
            bf16_t* wb = w + (((mt * 8 + nt * 2 + (r >> 4)) * 64 + 32 * ((r >> 3) & 1)) * 8) + (r & 7);
#pragma unroll
            for (int e = 0; e < 16; ++e) wb[crow(e, h2) * 8] = (bf16_t)f2bf(aW[mt][e]);
        }
    }
    __syncthreads();
}

DI void fox_cumsum(const Params& P, int bh, unsigned char* smem, int tt) {
    const int tid = tt, lane = tid & 63, wave = tid >> 6;
    const int b = bh >> 3, hh = bh & 7;
    float* wsum = (float*)smem;
    const float* gates = (const float*)(P.ws + OFF_GATES);
    const float bf = P.in[9][hh];
    float v[8]; float run = 0.f;
#pragma unroll
    for (int e = 0; e < 8; ++e) {
        const float xx = gates[((size_t)b * TSEQ + tid * 8 + e) * 16 + 8 + hh] + bf;
        const float ls = fminf(xx, 0.f) - log1pf(__expf(-fabsf(xx)));
        run += ls; v[e] = run;
    }
    float sc = run;
#pragma unroll
    for (int o = 1; o < 64; o <<= 1) { const float t = shup(sc, o, lane); if (lane >= o) sc += t; }
    if (lane == 63) wsum[wave] = sc;
    __syncthreads();
    float off = sc - run;
    for (int w = 0; w < wave; ++w) off += wsum[w];
    float* cf = (float*)(P.ws + OFF_CF) + (size_t)bh * TSEQ + tid * 8;
#pragma unroll
    for (int e = 0; e < 8; ++e) cf[e] = v[e] + off;
    __syncthreads();
}

DI void gdn_scan(const Params& P, int item, unsigned char* smem, int tt) {
    const int tid = tt, lane = tid & 63, wave = tid >> 6, r = lane & 31, h2 = lane >> 5;
    const int bh = item >> 2, vs = item & 3, b = bh >> 2, hd = bh & 3;
    const int cb = bh * 32;
    bf16_t* SbT = (bf16_t*)smem;
    bf16_t* VnT = SbT + 32 * 136;
    const bool w01 = wave < 2;
    const int mt = wave & 1;
    const bf16_t* Ubase = (const bf16_t*)(P.ws + OFF_U);
    const bf16_t* Abase = (const bf16_t*)(P.ws + (w01 ? OFF_W : OFF_QD));
    const bf16_t* Kbase = (const bf16_t*)(P.ws + OFF_KDT);
    const bf16_t* QKbase = (const bf16_t*)(P.ws + OFF_QK);
    const float* glast = (const float*)(P.ws + OFF_GLAST);
    bf16_t* og = (bf16_t*)(P.ws + OFF_OG);
    f32x16 S;
#pragma unroll
    for (int e = 0; e < 16; ++e) S[e] = 0.f;
    for (int i = tid; i < 32 * 136 / 2; i += 256) ((unsigned*)SbT)[i] = 0u;
#define SCAN_LOAD_A(AF, ci_) do { const bf16_t* ap_ = Abase + (size_t)(ci_) * 8192 + (mt * 8 * 64 + lane) * 8; \
        _Pragma("unroll") for (int ks = 0; ks < 8; ++ks) AF[ks] = *(const bf16x8*)(ap_ + ks * 512); } while (0)
#define SCAN_LOAD_K(ci_) do { const bf16_t* kp_ = Kbase + (size_t)(ci_) * 8192 + (wave * 4 * 64 + lane) * 8; \
        _Pragma("unroll") for (int ks = 0; ks < 4; ++ks) Kf[ks] = *(const bf16x8*)(kp_ + ks * 512); } while (0)
#define SCAN_LOAD_X(ci_) do { if (w01) { const bf16_t* up_ = Ubase + (size_t)(ci_) * 8192 + ((vs * 2 + mt) * 64 + lane) * 16; \
            Xa = *(const u32x4*)up_; Xb = *(const u32x4*)(up_ + 8); } \
        else { const bf16_t* qp_ = QKbase + (size_t)(ci_) * 4096 + (mt * 4 * 64 + lane) * 8; \
            Xa = *(const u32x4*)qp_; Xb = *(const u32x4*)(qp_ + 512); Xc = *(const u32x4*)(qp_ + 1024); Xd = *(const u32x4*)(qp_ + 1536); } } while (0)
#define SCAN_STEP(AF, n_) do { \
        const int cn1 = cb + ((n_) + 1 < 32 ? (n_) + 1 : 31); const int cn2 = cb + ((n_) + 2 < 32 ? (n_) + 2 : 31); \
        const float gl = shlane(glreg, (n_)); \
        f32x16 acc1; \
        bf16x8 sf[8]; \
        _Pragma("unroll") for (int ks = 0; ks < 8; ++ks) sf[ks] = *(const bf16x8*)(SbT + r * 136 + ks * 16 + h2 * 8); \
        _Pragma("unroll") for (int e = 0; e < 16; ++e) acc1[e] = 0.f; \
        __builtin_amdgcn_sched_barrier(0); \
        _Pragma("unroll") for (int ks = 0; ks < 8; ++ks) acc1 = MFMA32(AF[ks], sf[ks], acc1); \
        __builtin_amdgcn_sched_barrier(0); \
        SCAN_LOAD_A(AF, cn2); \
        if (w01) { \
            u32x2 ov; \
            ov.x = pack2(bflo(Xa.x) - acc1[0], bfhi(Xa.x) - acc1[1]); ov.y = pack2(bflo(Xa.y) - acc1[2], bfhi(Xa.y) - acc1[3]); *(u32x2*)(VnT + r * 72 + mt * 32 + 0 + 4 * h2) = ov; \
            ov.x = pack2(bflo(Xa.z) - acc1[4], bfhi(Xa.z) - acc1[5]); ov.y = pack2(bflo(Xa.w) - acc1[6], bfhi(Xa.w) - acc1[7]); *(u32x2*)(VnT + r * 72 + mt * 32 + 8 + 4 * h2) = ov; \
            ov.x = pack2(bflo(Xb.x) - acc1[8], bfhi(Xb.x) - acc1[9]); ov.y = pack2(bflo(Xb.y) - acc1[10], bfhi(Xb.y) - acc1[11]); *(u32x2*)(VnT + r * 72 + mt * 32 + 16 + 4 * h2) = ov; \
            ov.x = pack2(bflo(Xb.z) - acc1[12], bfhi(Xb.z) - acc1[13]); ov.y = pack2(bflo(Xb.w) - acc1[14], bfhi(Xb.w) - acc1[15]); *(u32x2*)(VnT + r * 72 + mt * 32 + 24 + 4 * h2) = ov; \
        } \
        __syncthreads(); \
        bf16x8 Vf[4]; \
        _Pragma("unroll") for (int ks = 0; ks < 4; ++ks) Vf[ks] = *(const bf16x8*)(VnT + r * 72 + ks * 16 + h2 * 8); \
        _Pragma("unroll") for (int e = 0; e < 16; ++e) S[e] *= gl; \
        __builtin_amdgcn_sched_barrier(0); \
        _Pragma("unroll") for (int ks = 0; ks < 4; ++ks) S = MFMA32(Kf[ks], Vf[ks], S); \
        if (!w01) { \
            acc1 = MFMA32(__builtin_bit_cast(bf16x8, Xa), Vf[0], acc1); acc1 = MFMA32(__builtin_bit_cast(bf16x8, Xb), Vf[1], acc1); \
            acc1 = MFMA32(__builtin_bit_cast(bf16x8, Xc), Vf[2], acc1); acc1 = MFMA32(__builtin_bit_cast(bf16x8, Xd), Vf[3], acc1); \
        } \
        __builtin_amdgcn_sched_barrier(0); \
        SCAN_LOAD_K(cn1); \
        SCAN_LOAD_X(cn1); \
        _Pragma("unroll") for (int g = 0; g < 4; ++g) { u32x2 ov; ov.x = pack2(S[4 * g + 0], S[4 * g + 1]); ov.y = pack2(S[4 * g + 2], S[4 * g + 3]); \
            *(u32x2*)(SbT + r * 136 + wave * 32 + 8 * g + 4 * h2) = ov; } \
        if (!w01) { \
            bf16_t* op = og + ((size_t)b * TSEQ + (n_) * 64 + mt * 32) * 512 + hd * 128 + vs * 32 + r; \
            _Pragma("unroll") for (int e = 0; e < 16; ++e) op[(size_t)crow(e, h2) * 512] = (bf16_t)f2bf(acc1[e]); \
        } \
        __syncthreads(); \
    } while (0)
    const float glreg = glast[cb + (lane & 31)];
    bf16x8 Af0[8], Af1[8], Kf[4];
    u32x4 Xa, Xb, Xc, Xd;
    Xc = Xd = (u32x4){0u, 0u, 0u, 0u};
    SCAN_LOAD_A(Af0, cb); SCAN_LOAD_K(cb); SCAN_LOAD_X(cb);
    SCAN_LOAD_A(Af1, cb + 1);
    __syncthreads();
#pragma unroll 1
    for (int n = 0; n < 32; n += 2) {
        SCAN_STEP(Af0, n);
        SCAN_STEP(Af1, n + 1);
    }
#undef SCAN_LOAD_A
#undef SCAN_LOAD_K
#undef SCAN_LOAD_X
#undef SCAN_STEP
}

DI void fox_attn(const Params& P, int bh, int qb, unsigned char* smem, int tt) {
    const int tid = tt, lane = tid & 63, wave = tid >> 6, r = lane & 31, h2 = lane >> 5;
    const int b = bh >> 3, hh = bh & 7;
    constexpr int BUFB = 2 * 64 * 72 * 2 + 256;
    constexpr float L2E = 1.4426950408889634f;
    const bf16_t* fqk = (const bf16_t*)(P.ws + OFF_FQK);
    const bf16_t* vT = (const bf16_t*)(P.ws + OFF_VT) + (size_t)bh * 64 * TSEQ;
    const float* cf = (const float*)(P.ws + OFF_CF) + (size_t)bh * TSEQ;
    const int q = qb * 128 + wave * 32 + r;
    bf16x8 Qf[4];
    {
        const bf16_t* qp = fqk + ((size_t)b * TSEQ + q) * 1024 + hh * 64 + h2 * 8;
#pragma unroll
        for (int ks = 0; ks < 4; ++ks) Qf[ks] = *(const bf16x8*)(qp + ks * 16);
    }
    const float cq = cf[q] * L2E;
    float m = -1e30f, l = 0.f;
    f32x16 O[2];
#pragma unroll
    for (int e = 0; e < 16; ++e) { O[0][e] = 0.f; O[1][e] = 0.f; }
    const int ntiles = 2 * qb + 2;
    const int srow = tid >> 3, scol = (tid & 7) * 8;
    const bf16_t* kg = fqk + ((size_t)b * TSEQ + srow) * 1024 + 512 + hh * 64 + scol;
    const bf16_t* vg = vT + (size_t)srow * TSEQ + scol;
    u32x4 rk0, rk1, rv0, rv1; float rc = 0.f;
    rk0 = *(const u32x4*)kg; rk1 = *(const u32x4*)(kg + 32 * 1024);
    rv0 = *(const u32x4*)vg; rv1 = *(const u32x4*)(vg + 32 * TSEQ);
    if (tid < 64) rc = cf[tid] * L2E;
    {
        bf16_t* Ks = (bf16_t*)smem; bf16_t* VTs = Ks + 64 * 72; float* cks = (float*)(smem + 2 * 64 * 72 * 2);
        *(u32x4*)(Ks + srow * 72 + scol) = rk0; *(u32x4*)(Ks + (srow + 32) * 72 + scol) = rk1;
        *(u32x4*)(VTs + srow * 72 + scol) = rv0; *(u32x4*)(VTs + (srow + 32) * 72 + scol) = rv1;
        if (tid < 64) cks[tid] = rc;
    }
    __syncthreads();
#pragma unroll 1
    for (int kt = 0; kt < ntiles; ++kt) {
        const unsigned char* bufc = smem + (kt & 1) * BUFB;
        const bf16_t* Ks = (const bf16_t*)bufc; const bf16_t* VTs = Ks + 64 * 72; const float* cks = (const float*)(bufc + 2 * 64 * 72 * 2);
        const bool more = kt + 1 < ntiles;
        if (more) {
            const bf16_t* kg2 = kg + (size_t)(kt + 1) * 64 * 1024; const bf16_t* vg2 = vg + (kt + 1) * 64;
            rk0 = *(const u32x4*)kg2; rk1 = *(const u32x4*)(kg2 + 32 * 1024);
            rv0 = *(const u32x4*)vg2; rv1 = *(const u32x4*)(vg2 + 32 * TSEQ);
            if (tid < 64) rc = cf[(kt + 1) * 64 + tid] * L2E;
        }
        f32x16 sacc[2];
        f32x4 ckv[2][4];
        {
            bf16x8 kf[2][4];
#pragma unroll
            for (int mt = 0; mt < 2; ++mt)
#pragma unroll
                for (int ks = 0; ks < 4; ++ks) kf[mt][ks] = *(const bf16x8*)(Ks + (mt * 32 + r) * 72 + ks * 16 + h2 * 8);
#pragma unroll
            for (int mt = 0; mt < 2; ++mt)
#pragma unroll
                for (int g = 0; g < 4; ++g) ckv[mt][g] = *(const f32x4*)(cks + mt * 32 + 8 * g + 4 * h2);
#pragma unroll
            for (int e = 0; e < 16; ++e) { sacc[0][e] = 0.f; sacc[1][e] = 0.f; }
            __builtin_amdgcn_sched_barrier(0);
#pragma unroll
            for (int ks = 0; ks < 4; ++ks) { sacc[0] = MFMA32(kf[0][ks], Qf[ks], sacc[0]); sacc[1] = MFMA32(kf[1][ks], Qf[ks], sacc[1]); }
        }
        const bool diag = kt >= ntiles - 2;
        float mx = -1e30f;
        {
            const f32x2v csc = {0.125f * L2E, 0.125f * L2E};
#pragma unroll
            for (int mt = 0; mt < 2; ++mt)
#pragma unroll
                for (int g = 0; g < 4; ++g) {
                    const f32x4 ck4 = ckv[mt][g];
                    const f32x2v c01 = {ck4[0], ck4[1]}, c23 = {ck4[2], ck4[3]};
                    const f32x2v a01 = {sacc[mt][4 * g], sacc[mt][4 * g + 1]}, a23 = {sacc[mt][4 * g + 2], sacc[mt][4 * g + 3]};
                    const f32x2v s01 = a01 * csc - c01, s23 = a23 * csc - c23;
                    sacc[mt][4 * g] = s01.x; sacc[mt][4 * g + 1] = s01.y; sacc[mt][4 * g + 2] = s23.x; sacc[mt][4 * g + 3] = s23.y;
                    mx = fmaxf(fmaxf(mx, s01.x), s01.y); mx = fmaxf(fmaxf(mx, s23.x), s23.y);
                }
        }
        if (diag) {
            mx = -1e30f;
            const int qrel = q - kt * 64 - 4 * h2;
#pragma unroll
            for (int mt = 0; mt < 2; ++mt)
#pragma unroll
                for (int e = 0; e < 16; ++e) {
                    const int krel = mt * 32 + (e & 3) + 8 * (e >> 2);
                    const float sv = (krel > qrel) ? -1e30f : sacc[mt][e];
                    sacc[mt][e] = sv;
                    mx = fmaxf(mx, sv);
                }
        }
        if (__builtin_amdgcn_ballot_w64(mx + cq - m > 30.f) != 0ull) {
            mx = fmaxf(mx, shx(mx, 32, lane));
            const float mn = fmaxf(m, mx + cq);
            const float alpha = __builtin_amdgcn_exp2f(m - mn);
            m = mn;
            l *= alpha;
            const f32x2v al2 = {alpha, alpha};
#pragma unroll
            for (int dt = 0; dt < 2; ++dt)
#pragma unroll
                for (int p2 = 0; p2 < 8; ++p2) {
                    f32x2v ov = {O[dt][2 * p2], O[dt][2 * p2 + 1]};
                    ov = ov * al2;
                    O[dt][2 * p2] = ov.x; O[dt][2 * p2 + 1] = ov.y;
                }
        }
        {
            const float sh = cq - m;
            const f32x2v sh2 = {sh, sh};
            f32x2v rs2 = {0.f, 0.f};
#pragma unroll
            for (int mt = 0; mt < 2; ++mt)
#pragma unroll
                for (int p2 = 0; p2 < 8; ++p2) {
                    const f32x2v sv = {sacc[mt][2 * p2], sacc[mt][2 * p2 + 1]};
                    const f32x2v t = sv + sh2;
                    f32x2v pp; pp.x = __builtin_amdgcn_exp2f(t.x); pp.y = __builtin_amdgcn_exp2f(t.y);
                    sacc[mt][2 * p2] = pp.x; sacc[mt][2 * p2 + 1] = pp.y;
                    rs2 = rs2 + pp;
                }
            l += rs2.x + rs2.y;
        }
        {
            u32x4 vw[2][2][2];
#pragma unroll
            for (int mt = 0; mt < 2; ++mt)
#pragma unroll
                for (int s = 0; s < 2; ++s)
#pragma unroll
                    for (int dt = 0; dt < 2; ++dt) {
                        const bf16_t* vp = VTs + (dt * 32 + r) * 72 + mt * 32 + 16 * s + 4 * h2;
                        const u32x2 lo = *(const u32x2*)vp, hi = *(const u32x2*)(vp + 8);
                        vw[mt][s][dt].x = lo.x; vw[mt][s][dt].y = lo.y; vw[mt][s][dt].z = hi.x; vw[mt][s][dt].w = hi.y;
                    }
            u32x4 pw[2][2];
#pragma unroll
            for (int mt = 0; mt < 2; ++mt)
#pragma unroll
                for (int s = 0; s < 2; ++s) {
                    pw[mt][s].x = pack2(sacc[mt][8 * s + 0], sacc[mt][8 * s + 1]); pw[mt][s].y = pack2(sacc[mt][8 * s + 2], sacc[mt][8 * s + 3]);
                    pw[mt][s].z = pack2(sacc[mt][8 * s + 4], sacc[mt][8 * s + 5]); pw[mt][s].w = pack2(sacc[mt][8 * s + 6], sacc[mt][8 * s + 7]);
                }
            __builtin_amdgcn_sched_barrier(0);
#pragma unroll
            for (int mt = 0; mt < 2; ++mt)
#pragma unroll
                for (int s = 0; s < 2; ++s) {
                    const bf16x8 pf = __builtin_bit_cast(bf16x8, pw[mt][s]);
                    O[0] = MFMA32(__builtin_bit_cast(bf16x8, vw[mt][s][0]), pf, O[0]);
                    O[1] = MFMA32(__builtin_bit_cast(bf16x8, vw[mt][s][1]), pf, O[1]);
                }
        }
        if (more) {
            unsigned char* bufn = smem + ((kt + 1) & 1) * BUFB;
            bf16_t* Kn = (bf16_t*)bufn; bf16_t* VTn = Kn + 64 * 72; float* ckn = (float*)(bufn + 2 * 64 * 72 * 2);
            *(u32x4*)(Kn + srow * 72 + scol) = rk0; *(u32x4*)(Kn + (srow + 32) * 72 + scol) = rk1;
            *(u32x4*)(VTn + srow * 72 + scol) = rv0; *(u32x4*)(VTn + (srow + 32) * 72 + scol) = rv1;
            if (tid < 64) ckn[tid] = rc;
        }
        __syncthreads();
    }
    l += shx(l, 32, lane);
    const float inv = 1.f / l;
    float ss = 0.f;
#pragma unroll
    for (int e = 0; e < 16; ++e) { O[0][e] *= inv; O[1][e] *= inv; ss += O[0][e] * O[0][e] + O[1][e] * O[1][e]; }
    ss += shx(ss, 32, lane);
    const float sc = rsqrtf(ss * (1.f / 64.f) + 1e-6f);
    bf16_t* op = (bf16_t*)(P.ws + OFF_MIX) + ((size_t)b * TSEQ + q) * 1024 + 512 + hh * 64;
    const float* fg = P.in[10];
    f32x4 ggv[2][4];
#pragma unroll
    for (int dt = 0; dt < 2; ++dt)
#pragma unroll
        for (int g = 0; g < 4; ++g) ggv[dt][g] = *(const f32x4*)(fg + dt * 32 + 8 * g + 4 * h2);
#pragma unroll
    for (int dt = 0; dt < 2; ++dt)
#pragma unroll
        for (int g = 0; g < 4; ++g) {
            const int d0 = dt * 32 + 8 * g + 4 * h2;
            const f32x4 gg = ggv[dt][g];
            u32x2 o;
            o.x = pack2(O[dt][4 * g + 0] * sc * gg[0], O[dt][4 * g + 1] * sc * gg[1]); o.y = pack2(O[dt][4 * g + 2] * sc * gg[2], O[dt][4 * g + 3] * sc * gg[3]);
            *(u32x2*)(op + d0) = o;
        }
}

#define XB_TMO      128
#define XB_XCNT(j)  (256  + 64 * (j))
#define XB_XSUB(j)  (1280 + 64 * (j))
#define XB_XGEN(j)  (2304 + 64 * (j))
#define XB_TOP      3328
#define XB_TOPGEN   3392
#define XCD_BAR_WORDS 3456
#define XB_SPIN_CAP (1u << 18)
#define LAS __attribute__((address_space(3)))
DI unsigned xb_ld(unsigned* p)              { return __hip_atomic_load(p, __ATOMIC_RELAXED, __HIP_MEMORY_SCOPE_AGENT); }
DI unsigned xb_add(unsigned* p, unsigned v) { return __hip_atomic_fetch_add(p, v, __ATOMIC_RELAXED, __HIP_MEMORY_SCOPE_AGENT); }
DI unsigned xb_xcc_id() { return (unsigned)__builtin_amdgcn_s_getreg((3 << 11) | 20) & 0xFu; }
#define XB_SPIN(cond, bar) do { unsigned _sp = 0; while (cond) { __builtin_amdgcn_s_sleep(1); \
    if ((++_sp & 255u) == 0u) { if (xb_ld(&(bar)[XB_TMO])) break; if (_sp > XB_SPIN_CAP) { atomicAdd(&(bar)[XB_TMO], 1u); break; } } } } while (0)
struct XcdBarrier { unsigned* bar; unsigned x; volatile LAS unsigned* st; };
DI XcdBarrier xcd_barrier_post(unsigned* bar, volatile LAS unsigned* st, int tid0) {
    XcdBarrier b; b.bar = bar; b.x = xb_xcc_id(); b.st = st;
    if (tid0 == 0) (void)xb_add(&bar[XB_XCNT(b.x)], 1u);
    return b;
}
DI void xcd_barrier_complete(unsigned* bar, unsigned x, unsigned& nloc, unsigned& nx) {
    const unsigned G = gridDim.x * gridDim.y * gridDim.z;
    unsigned sum, cnt, mine, sp = 0u;
    for (;;) {
        sum = 0u; cnt = 0u; mine = 0u;
#pragma unroll
        for (unsigned j = 0; j < 16; ++j) { const unsigned c = xb_ld(&bar[XB_XCNT(j)]); sum += c; cnt += (c > 0u) ? 1u : 0u; mine = (j == x) ? c : mine; }
        if (sum == G) break;
        __builtin_amdgcn_s_sleep(1);
        if ((++sp & 255u) == 0u) { if (xb_ld(&bar[XB_TMO])) break; if (sp > XB_SPIN_CAP) { atomicAdd(&bar[XB_TMO], 1u); break; } }
    }
    nloc = mine > 0u ? mine : 1u; nx = cnt > 0u ? cnt : 1u;
}
DI void xcd_barrier(const XcdBarrier& b, const int wid_s) {
    asm volatile("s_waitcnt vmcnt(0)" ::: "memory");
    __syncthreads();
    if (fresh_tid(wid_s) == 0) {
        unsigned* bar = b.bar;
        __builtin_amdgcn_s_waitcnt(0);
        unsigned nloc = b.st[0], nx = b.st[1];
        if (nloc == 0u) { xcd_barrier_complete(bar, b.x, nloc, nx); b.st[0] = nloc; b.st[1] = nx; }
        const unsigned old = xb_add(&bar[XB_XSUB(b.x)], 1u);
        const unsigned gen = old / nloc;
        if (old + 1u == (gen + 1u) * nloc) {
            __builtin_amdgcn_fence(__ATOMIC_RELEASE, "agent");
            asm volatile("s_waitcnt vmcnt(0)" ::: "memory");
            const unsigned og = xb_add(&bar[XB_TOP], 1u);
            const unsigned tg = og / nx;
            if (og + 1u == (tg + 1u) * nx) xb_add(&bar[XB_TOPGEN], 1u);
            else XB_SPIN(xb_ld(&bar[XB_TOPGEN]) == tg, bar);
            __builtin_amdgcn_fence(__ATOMIC_ACQUIRE, "agent");
            xb_add(&bar[XB_XGEN(b.x)], 1u);
            asm volatile("s_waitcnt vmcnt(0)" ::: "memory");
        } else {
            XB_SPIN(xb_ld(&bar[XB_XGEN(b.x)]) == gen, bar);
            __builtin_amdgcn_fence(__ATOMIC_ACQUIRE, "agent");
            asm volatile("s_waitcnt vmcnt(0)" ::: "memory");
        }
    }
    __syncthreads();
}


template <int MODE> struct EpiLnFused {
    static constexpr bool PERM = true, AFTER_DRAIN = true;
    const float* x; const float* g_in; const float* b_in; const float* stats;
    const bf16_t* h1; const bf16_t* pg;
    float* xbuf; unsigned* cnt; const float* g; const float* b; float* outf; bf16_t* outb;
    DI void operator()(const pg8::f32x4 (&)[2][2][4][2], const pg8::Unit&, int, int, int, int) const {}
    DI void fused(pg8::f32x4 (&acc)[2][2][4][2], const pg8::Unit& u, int wr, int wc, int fr, int fq, pg8::PG8_LAS_T ldsp, int wid, int lane) const {
        float* P = (float*)(unsigned char*)ldsp;
        float* ST = P + 2048;
        const int tid = wid * 64 + lane;
        f32x4 gi[2][2], bi[2][2];
#pragma unroll
        for (int bj = 0; bj < 2; ++bj) {
            const int col = u.pn * 256 + bj * 128 + wc * 32 + 8 * fq;
            if (MODE == 0) { gi[bj][0] = *(const f32x4*)(g_in + col); gi[bj][1] = *(const f32x4*)(g_in + col + 4); bi[bj][0] = *(const f32x4*)(b_in + col); bi[bj][1] = *(const f32x4*)(b_in + col + 4); }
        }
#pragma unroll
        for (int ai = 0; ai < 2; ++ai)
#pragma unroll
            for (int m = 0; m < 4; ++m) {
                const int rt = ai * 128 + wr * 64 + m * 16 + fr, row = u.pm * 256 + rt;
                float sm = 0.f, sq = 0.f;
                float mu = 0.f, rs = 0.f;
                if (MODE == 0) { mu = stats[row * 2]; rs = stats[row * 2 + 1]; }
#pragma unroll
                for (int bj = 0; bj < 2; ++bj) {
                    const int col = u.pn * 256 + bj * 128 + wc * 32 + 8 * fq;
                    const size_t idx = (size_t)row * DM + col;
                    f32x4 v0, v1;
                    if (MODE == 0) {
                        const f32x4 x0 = *(const f32x4*)(x + idx), x1 = *(const f32x4*)(x + idx + 4);
                        v0 = ((x0 - mu) * rs * gi[bj][0] + bi[bj][0]) * ALPHA + acc[ai][bj][m][0];
                        v1 = ((x1 - mu) * rs * gi[bj][1] + bi[bj][1]) * ALPHA + acc[ai][bj][m][1];
                    } else {
                        const u32x4 w = *(const u32x4*)(pg + idx);
                        const u32x4 hw = *(const u32x4*)(h1 + idx);
                        v0 = (f32x4){bflo(hw.x), bfhi(hw.x), bflo(hw.y), bfhi(hw.y)} * ALPHA + acc[ai][bj][m][0];
                        v1 = (f32x4){bflo(hw.z), bfhi(hw.z), bflo(hw.w), bfhi(hw.w)} * ALPHA + acc[ai][bj][m][1];
                        v0[0] += bflo(w.x); v0[1] += bfhi(w.x); v0[2] += bflo(w.y); v0[3] += bfhi(w.y);
                        v1[0] += bflo(w.z); v1[1] += bfhi(w.z); v1[2] += bflo(w.w); v1[3] += bfhi(w.w);
                    }
                    acc[ai][bj][m][0] = v0; acc[ai][bj][m][1] = v1;
#pragma unroll
                    for (int e = 0; e < 4; ++e) { sm += v0[e] + v1[e]; sq += v0[e] * v0[e] + v1[e] * v1[e]; }
                }
                sm += shx(sm, 16, lane); sm += shx(sm, 32, lane);
                sq += shx(sq, 16, lane); sq += shx(sq, 32, lane);
                if (fq == 0) { P[(rt * 4 + wc) * 2] = sm; P[(rt * 4 + wc) * 2 + 1] = sq; }
            }
        __syncthreads();
        if (tid < 256) {
            const f32x4 a = *(const f32x4*)(P + tid * 8), c = *(const f32x4*)(P + tid * 8 + 4);
            float* slot = xbuf + ((size_t)(u.pm * 256 + tid) * 4 + u.pn) * 2;
            __hip_atomic_store(slot, (a[0] + a[2]) + (c[0] + c[2]), __ATOMIC_RELAXED, __HIP_MEMORY_SCOPE_AGENT);
            __hip_atomic_store(slot + 1, (a[1] + a[3]) + (c[1] + c[3]), __ATOMIC_RELAXED, __HIP_MEMORY_SCOPE_AGENT);
        }
        asm volatile("s_waitcnt vmcnt(0)" ::: "memory");
        __syncthreads();
        if (tid == 0) {
            xb_add(cnt + u.pm, 1u);
            unsigned sp = 0;
            while (xb_ld(cnt + u.pm) < 4u) { __builtin_amdgcn_s_sleep(1); if (++sp > (1u << 22)) break; }
        }
        __syncthreads();
        if (tid < 256) {
            float* slot = xbuf + (size_t)(u.pm * 256 + tid) * 8;
            float pv[8];
#pragma unroll
            for (int e = 0; e < 8; ++e) pv[e] = __hip_atomic_load(slot + e, __ATOMIC_RELAXED, __HIP_MEMORY_SCOPE_AGENT);
            const float sm = (pv[0] + pv[2]) + (pv[4] + pv[6]), sq = (pv[1] + pv[3]) + (pv[5] + pv[7]);
            const float mean = sm * (1.f / 1024.f);
            const float var = fmaxf(sq * (1.f / 1024.f) - mean * mean, 0.f);
            ST[tid * 2] = mean; ST[tid * 2 + 1] = rsqrtf(var + 1e-5f);
        }
        __syncthreads();
        f32x4 go[2][2], bo[2][2];
#pragma unroll
        for (int bj = 0; bj < 2; ++bj) {
            const int col = u.pn * 256 + bj * 128 + wc * 32 + 8 * fq;
            go[bj][0] = *(const f32x4*)(g + col); go[bj][1] = *(const f32x4*)(g + col + 4); bo[bj][0] = *(const f32x4*)(b + col); bo[bj][1] = *(const f32x4*)(b + col + 4);
        }
#pragma unroll
        for (int ai = 0; ai < 2; ++ai)
#pragma unroll
            for (int m = 0; m < 4; ++m) {
                const int rt = ai * 128 + wr * 64 + m * 16 + fr, row = u.pm * 256 + rt;
                const float mean = ST[rt * 2], rstd = ST[rt * 2 + 1];
#pragma unroll
                for (int bj = 0; bj < 2; ++bj) {
                    const int col = u.pn * 256 + bj * 128 + wc * 32 + 8 * fq;
                    const size_t idx = (size_t)row * DM + col;
                    const f32x4 o0 = (acc[ai][bj][m][0] - mean) * rstd * go[bj][0] + bo[bj][0], o1 = (acc[ai][bj][m][1] - mean) * rstd * go[bj][1] + bo[bj][1];
                    if (outf) { *(f32x4*)(outf + idx) = o0; *(f32x4*)(outf + idx + 4) = o1; }
                    if (outb) *(u32x4*)(outb + idx) = pack8(o0, o1);
                }
            }
    }
};

template <class Epi> DI void run_gemm(pg8::PG8_LAS_T lds, const bf16_t* A, const bf16_t* Bt, int N, int K, const Epi& E, const int wid_s) {
    pg8::Gemm g{A, Bt, M_TOK, N, K}; pg8::StaticOrder S; S.init(M_TOK, N, (int)gridDim.x, (int)blockIdx.x);
    pg8::gemm_phase<Epi, pg8::StaticOrder, true, true>(lds, g, S, E, wid_s);
}
__global__ void __launch_bounds__(512, 2) fwd_mega(Params P) {
    cg::grid_group grid = cg::this_grid();
    extern __shared__ __attribute__((aligned(16))) unsigned char lds[];
    pg8::PG8_LAS_T glds = (pg8::PG8_LAS_T)lds;
    volatile LAS unsigned* xb_words = (volatile LAS unsigned*)(glds + LDS_MISC);
    volatile int* s_item = (volatile int*)(lds + LDS_MISC + 16);
    const int nblk = gridDim.x, bid = blockIdx.x;
    unsigned char* ws = P.ws;

    const int wid_s = __builtin_amdgcn_readfirstlane((int)threadIdx.x >> 6);
    if (threadIdx.x < 4) xb_words[threadIdx.x] = 0u;
    __syncthreads();
    const XcdBarrier xbar = xcd_barrier_post((unsigned*)(ws + OFF_BAR), xb_words, (int)threadIdx.x);
    if (P.out == nullptr) grid.sync();

    {
    for (int base = bid * 2; base < 1984 + 4096; base += nblk * 2) {
        PHASE_IDS
        const int it = base + team;
        if (it < 960) {
            transpose_tile(P.in[4], 1024, 3600, (bf16_t*)(ws + OFF_WIN), it / 60, it % 60, 1, (float*)smem, tt);
        } else if (it < 1984) {
            const int loc = it - 960;
            transpose_tile(P.in[15], 4096, 1024, (bf16_t*)(ws + OFF_WDOWN), loc / 16, loc % 16, 0, (float*)smem, tt);
        } else {
            const int row = (it - 1984) * 4 + tw;
            ln_row(P.in[0] + (size_t)row * DM, P.in[2], P.in[3], nullptr, (bf16_t*)(ws + OFF_HB) + (size_t)row * DM, (float*)(ws + OFF_STATS) + row * 2, lane);
            { const f32x4 pv = *(const f32x4*)(P.in[1] + (size_t)row * 256 + lane * 4); u32x2 w; w.x = pack2(pv[0], pv[1]); w.y = pack2(pv[2], pv[3]);
              *(u32x2*)((bf16_t*)(ws + OFF_PB) + (size_t)row * 256 + lane * 4) = w; }
        }
    }
    }
    xcd_barrier(xbar, wid_s);

    { EpiProj E{ws}; run_gemm(glds, (const bf16_t*)(ws + OFF_HB), (const bf16_t*)(ws + OFF_WIN), NPROJ, DM, E, wid_s); }
    {
        const int nun = (M_TOK / 256) * (NPROJ / 256);
        const int maxu = (nun + nblk - 1) / nblk;
        int first_short = nun - (maxu - 1) * nblk, nshort = nblk - first_short;
        if (nshort <= 0) { first_short = 0; nshort = nblk; }
        if (bid >= first_short) {
            for (int base = (bid - first_short) * 2; base < 1600; base += nshort * 2) {
                PHASE_IDS
                const int j = base + team;
                const float* W; int K, N, loc, nnt; bf16_t* Wt;
                if (j < 256) { W = P.in[11]; K = 1024; N = 1024; Wt = (bf16_t*)(ws + OFF_WOUT); loc = j; nnt = 16; }
                else if (j < 1280) { W = P.in[14]; K = 1024; N = 4096; Wt = (bf16_t*)(ws + OFF_WUP); loc = j - 256; nnt = 64; }
                else if (j < 1536) { W = P.in[17]; K = 1024; N = 1024; Wt = (bf16_t*)(ws + OFF_WG); loc = j - 1280; nnt = 16; }
                else { W = P.in[16]; K = 256; N = 1024; Wt = (bf16_t*)(ws + OFF_WPLE); loc = j - 1536; nnt = 16; }
                transpose_tile(W, K, N, Wt, loc / nnt, loc % nnt, 0, (float*)smem, tt);
            }
        }
    }
    xcd_barrier(xbar, wid_s);

    for (int rep = 0; rep < NREP(2); ++rep)
    {
    for (int base = bid * 2; base < 1024 + 64; base += nblk * 2) {
        PHASE_IDS
        const int it = base + team;
        if (it < 1024) prep_chunk(P, it, smem, tt); else fox_cumsum(P, it - 1024, smem, tt);
    }
    }
    xcd_barrier(xbar, wid_s);

    for (int rep = 0; rep < NREP(3); ++rep)
    {
    bool first = true;
    for (;;) {
        PHASE_IDS
        int pr;
        if (first) { first = false; pr = bid; }
        else {
            __syncthreads();
            if (tid == 0) *s_item = nblk + atomicAdd((int*)(ws + OFF_CTR) + rep, 1);
            __syncthreads();
            pr = *s_item;
        }
        if (pr >= 64 + 512) break;
        if (pr < 64) gdn_scan(P, pr * 2 + team, smem, tt);
        else { const int fj = pr - 64; fox_attn(P, (fj & 31) * 2 + team, 15 - (fj >> 5), smem, tt); }
    }
    }
    xcd_barrier(xbar, wid_s);

    { PHASE_IDS
    for (int it = bid; it < M_TOK / 8; it += nblk) {
        const int row = it * 8 + wave8;
        bf16_t* mix = (bf16_t*)(ws + OFF_MIX) + (size_t)row * DM;
        {
            const int col = lane * 8;
            const u32x4 ov = *(const u32x4*)((const bf16_t*)(ws + OFF_OG) + (size_t)row * 512 + col);
            const u32x4 zv = *(const u32x4*)((const bf16_t*)(ws + OFF_Z) + (size_t)row * 512 + col);
            float o[8] = {bflo(ov.x), bfhi(ov.x), bflo(ov.y), bfhi(ov.y), bflo(ov.z), bfhi(ov.z), bflo(ov.w), bfhi(ov.w)};
            float z[8] = {bflo(zv.x), bfhi(zv.x), bflo(zv.y), bfhi(zv.y), bflo(zv.z), bfhi(zv.z), bflo(zv.w), bfhi(zv.w)};
            float ss = 0.f;
#pragma unroll
            for (int e = 0; e < 8; ++e) ss += o[e] * o[e];
            ss += shx(ss, 1, lane); ss += shx(ss, 2, lane); ss += shx(ss, 4, lane); ss += shx(ss, 8, lane);
            const float sc = rsqrtf(ss * (1.f / 128.f) + 1e-6f);
            const float* gg = P.in[8] + (col & 127);
            float v[8];
#pragma unroll
            for (int e = 0; e < 8; ++e) v[e] = o[e] * sc * gg[e] * siluf(z[e]);
            u32x4 w; w.x = pack2(v[0], v[1]); w.y = pack2(v[2], v[3]); w.z = pack2(v[4], v[5]); w.w = pack2(v[6], v[7]);
            *(u32x4*)(mix + col) = w;
        }
    }
    }
    xcd_barrier(xbar, wid_s);

    { EpiLnFused<0> E{P.in[0], P.in[2], P.in[3], (const float*)(ws + OFF_STATS), nullptr, nullptr, (float*)(ws + OFF_XBUF), (unsigned*)(ws + OFF_PCNT), P.in[12], P.in[13], nullptr, (bf16_t*)(ws + OFF_H1B)};
      run_gemm(glds, (const bf16_t*)(ws + OFF_MIX), (const bf16_t*)(ws + OFF_WOUT), DM, DM, E, wid_s); }
    xcd_barrier(xbar, wid_s);

    { EpiUp E{(bf16_t*)(ws + OFF_FFB)}; run_gemm(glds, (const bf16_t*)(ws + OFF_H1B), (const bf16_t*)(ws + OFF_WUP), 4096, DM, E, wid_s); }
    { EpiGate E{(bf16_t*)(ws + OFF_PG), P.in[18]}; run_gemm(glds, (const bf16_t*)(ws + OFF_H1B), (const bf16_t*)(ws + OFF_WG), DM, DM, E, wid_s); }
    { EpiPle E{(bf16_t*)(ws + OFF_PG)}; run_gemm(glds, (const bf16_t*)(ws + OFF_PB), (const bf16_t*)(ws + OFF_WPLE), DM, 256, E, wid_s); }
    xcd_barrier(xbar, wid_s);

    { EpiLnFused<1> E{nullptr, nullptr, nullptr, nullptr, (const bf16_t*)(ws + OFF_H1B), (const bf16_t*)(ws + OFF_PG), (float*)(ws + OFF_XBUF) + (size_t)M_TOK * 8, (unsigned*)(ws + OFF_PCNT) + 64, P.in[19], P.in[20], P.out, nullptr};
      run_gemm(glds, (const bf16_t*)(ws + OFF_FFB), (const bf16_t*)(ws + OFF_WDOWN), DM, 4096, E, wid_s); }
}

extern "C" void kernel_launch(void* const* d_in, const int* in_sizes, int n_in, void* d_out, int out_size, void* d_ws, size_t ws_size, hipStream_t stream) {
    static int grid_blocks = 0;
    if (!grid_blocks) {
        int dev = 0, cus = 0, per_cu = 0;
        (void)hipGetDevice(&dev);
        (void)hipDeviceGetAttribute(&cus, hipDeviceAttributeMultiprocessorCount, dev);
        if (hipFuncSetAttribute((const void*)fwd_mega, hipFuncAttributeMaxDynamicSharedMemorySize, LDS_BYTES) != hipSuccess) fprintf(stderr, "kernel_launch: hipFuncSetAttribute failed\n");
        (void)hipOccupancyMaxActiveBlocksPerMultiprocessor(&per_cu, (const void*)fwd_mega, 512, LDS_BYTES);
        if (per_cu < 1) fprintf(stderr, "kernel_launch: occupancy query reports %d blocks per CU\n", per_cu);
        (void)hipGetLastError();
        grid_blocks = cus;
        if (ws_size < 232 * MBy) fprintf(stderr, "kernel_launch: workspace too small (%zu)\n", ws_size);
    }
    Params p{};
    for (int i = 0; i < 21; ++i) p.in[i] = (const float*)d_in[i];
    p.out = (float*)d_out; p.ws = (unsigned char*)d_ws;
    (void)hipMemsetAsync((unsigned char*)d_ws + OFF_BAR, 0, 16384, stream);
    void* args[] = {&p};
    hipError_t e = hipLaunchCooperativeKernel((void*)fwd_mega, dim3(grid_blocks), dim3(512), args, LDS_BYTES, stream);
    if (e != hipSuccess) fprintf(stderr, "cooperative launch failed: %s (grid %d)\n", hipGetErrorString(e), grid_blocks);
}
```

```cpp
#include <hip/hip_runtime.h>
#include <hip/hip_cooperative_groups.h>
#include <cstdio>
namespace cg = cooperative_groups;

typedef unsigned short bf16_t;
typedef short bf16x8 __attribute__((ext_vector_type(8)));
typedef short s16x4 __attribute__((ext_vector_type(4)));
typedef float f32x16 __attribute__((ext_vector_type(16)));
typedef float f32x4 __attribute__((ext_vector_type(4)));
typedef unsigned u32x4 __attribute__((ext_vector_type(4)));
typedef unsigned u32x2 __attribute__((ext_vector_type(2)));
typedef float f32x2v __attribute__((ext_vector_type(2)));

#define DI __device__ __forceinline__
#define MFMA32(a, b, c) __builtin_amdgcn_mfma_f32_32x32x16_bf16((a), (b), (c), 0, 0, 0)

constexpr int M_TOK = 16384, DM = 1024, TSEQ = 2048;
constexpr int NPROJ = 3840;
constexpr size_t MBy = 1u << 20;
constexpr size_t OFF_WIN = 0, OFF_WOUT = 8 * MBy, OFF_WUP = 10 * MBy, OFF_WDOWN = 18 * MBy, OFF_WG = 26 * MBy, OFF_WPLE = 28 * MBy;
constexpr size_t OFF_STATS = 28 * MBy + 512 * 1024, OFF_GLAST = 28 * MBy + 640 * 1024, OFF_BAR = 29 * MBy + 512 * 1024, OFF_CTR = OFF_BAR + 14336, OFF_CF = 28 * MBy + 768 * 1024;
constexpr size_t OFF_XBUF = 31 * MBy, OFF_PCNT = OFF_BAR + 14848;
constexpr size_t OFF_GATES = 30 * MBy, OFF_GQKV = 32 * MBy, OFF_Z = 80 * MBy, OFF_FQK = 96 * MBy, OFF_VT = 128 * MBy, OFF_HB = 144 * MBy;
constexpr size_t OFF_U = 144 * MBy, OFF_W = 160 * MBy, OFF_QD = 176 * MBy, OFF_KDT = 192 * MBy, OFF_QK = 208 * MBy;
constexpr size_t OFF_OG = 32 * MBy, OFF_MIX = 216 * MBy;
constexpr size_t OFF_H1B = 32 * MBy, OFF_PB = 248 * MBy, OFF_FFB = 72 * MBy, OFF_PG = 200 * MBy;
constexpr float ALPHA = 1.189207115002721f;
constexpr int TEAM_LDS = 76800, LDS_MISC = 153600, LDS_BYTES = 153600 + 256;
#ifndef REP_MASK
#define REP_MASK 0
#endif
#define NREP(k) (1 + ((REP_MASK >> (k)) & 1))

struct Params { const float* in[21]; float* out; unsigned char* ws; };

DI float bf2f(unsigned b) { return __uint_as_float(b << 16); }
typedef float f32x2_t __attribute__((ext_vector_type(2))); typedef __bf16 bf16x2_t __attribute__((ext_vector_type(2)));
DI unsigned pack2(float lo, float hi) { f32x2_t v = {lo, hi}; bf16x2_t b = __builtin_convertvector(v, bf16x2_t); return __builtin_bit_cast(unsigned, b); }
DI unsigned f2bf(float x) { return pack2(x, 0.f) & 0xffffu; }
DI float bflo(unsigned w) { return __uint_as_float(w << 16); }
DI float bfhi(unsigned w) { return __uint_as_float(w & 0xffff0000u); }
DI int crow(int e, int h) { return (e & 3) + 8 * (e >> 2) + 4 * h; }
DI float shx(float v, int mask, int lane) { return __int_as_float(__builtin_amdgcn_ds_bpermute((lane ^ mask) << 2, __float_as_int(v))); }
DI float shup(float v, int o, int lane) { return __int_as_float(__builtin_amdgcn_ds_bpermute(((lane - o) & 63) << 2, __float_as_int(v))); }
DI float shlane(float v, int src) { return __int_as_float(__builtin_amdgcn_readlane(__float_as_int(v), src)); }
DI float wave_sum(float v, int lane) { for (int o = 32; o > 0; o >>= 1) v += shx(v, o, lane); return v; }
DI float siluf(float x) { return x * __builtin_amdgcn_rcpf(1.f + __expf(-x)); }
DI float sigmoidf_(float x) { return __builtin_amdgcn_rcpf(1.f + __expf(-x)); }
DI int fresh_tid(int wid_s) { int l; asm volatile("v_mbcnt_lo_u32_b32 %0, -1, 0\n\tv_mbcnt_hi_u32_b32 %0, -1, %0" : "=v"(l)); return wid_s * 64 + l; }
#define PHASE_IDS const int tid = fresh_tid(wid_s), lane = tid & 63, wave8 = tid >> 6, team = tid >> 8, tt = tid & 255, tw = tt >> 6; unsigned char* smem = lds + team * TEAM_LDS; (void)lane; (void)wave8; (void)tt; (void)tw; (void)smem;

DI void ln_row(const float* src, const float* __restrict__ g, const float* __restrict__ b, float* dstf, bf16_t* dstb, float* stats, int lane) {
    f32x4 v[4];
#pragma unroll
    for (int i = 0; i < 4; ++i) v[i] = *(const f32x4*)(src + i * 256 + lane * 4);
    float s = 0.f;
#pragma unroll
    for (int i = 0; i < 4; ++i) s += (v[i][0] + v[i][1]) + (v[i][2] + v[i][3]);
    s = wave_sum(s, lane);
    const float mu = s * (1.f / 1024.f);
    float q = 0.f;
#pragma unroll
    for (int i = 0; i < 4; ++i) { f32x4 d = v[i] - mu; q += (d[0] * d[0] + d[1] * d[1]) + (d[2] * d[2] + d[3] * d[3]); }
    q = wave_sum(q, lane);
    const float rstd = rsqrtf(q * (1.f / 1024.f) + 1e-5f);
    f32x4 gv[4], bv[4];
#pragma unroll
    for (int i = 0; i < 4; ++i) { gv[i] = *(const f32x4*)(g + i * 256 + lane * 4); bv[i] = *(const f32x4*)(b + i * 256 + lane * 4); }
#pragma unroll
    for (int i = 0; i < 4; ++i) {
        const f32x4 gg = gv[i], bb = bv[i];
        const f32x4 o = (v[i] - mu) * rstd * gg + bb;
        if (dstf) *(f32x4*)(dstf + i * 256 + lane * 4) = o;
        if (dstb) { u32x2 w; w.x = pack2(o[0], o[1]); w.y = pack2(o[2], o[3]); *(u32x2*)(dstb + i * 256 + lane * 4) = w; }
    }
    if (stats && lane == 0) { stats[0] = mu; stats[1] = rstd; }
}

DI void transpose_tile(const float* __restrict__ W, int K, int N, bf16_t* __restrict__ Wt, int kt, int nt, int mode, float* tile, int tt) {
    const int tid = tt;
    const int k0 = kt * 64, n0 = nt * 64;
    {
        const int c = tid & 63, n = n0 + c;
        int sc = n;
        if (mode == 1) { sc = (n < 2048) ? n : (n < 3584) ? n + 8 : (n < 3592) ? 2048 + (n - 3584) : (n < 3600) ? n : -1; }
        const int scc = sc >= 0 ? sc : 0;
        const float mk = sc >= 0 ? 1.f : 0.f;
        float wv[16];
#pragma unroll
        for (int i = 0; i < 16; ++i) wv[i] = W[(size_t)(k0 + (tid >> 6) + 4 * i) * N + scc];
#pragma unroll
        for (int i = 0; i < 16; ++i) tile[((tid >> 6) + 4 * i) * 65 + c] = wv[i] * mk;
    }
    __syncthreads();
    {
        const int n = tid >> 2, ks = (tid & 3) * 16;
        u32x4 o0, o1;
        o0.x = pack2(tile[(ks + 0) * 65 + n], tile[(ks + 1) * 65 + n]); o0.y = pack2(tile[(ks + 2) * 65 + n], tile[(ks + 3) * 65 + n]);
        o0.z = pack2(tile[(ks + 4) * 65 + n], tile[(ks + 5) * 65 + n]); o0.w = pack2(tile[(ks + 6) * 65 + n], tile[(ks + 7) * 65 + n]);
        o1.x = pack2(tile[(ks + 8) * 65 + n], tile[(ks + 9) * 65 + n]); o1.y = pack2(tile[(ks + 10) * 65 + n], tile[(ks + 11) * 65 + n]);
        o1.z = pack2(tile[(ks + 12) * 65 + n], tile[(ks + 13) * 65 + n]); o1.w = pack2(tile[(ks + 14) * 65 + n], tile[(ks + 15) * 65 + n]);
        bf16_t* dst = Wt + (size_t)(n0 + n) * K + k0 + ks;
        *(u32x4*)dst = o0; *(u32x4*)(dst + 8) = o1;
    }
    __syncthreads();
}

namespace pg8 {
#define PG8_LAS __attribute__((address_space(3)))
typedef PG8_LAS unsigned char* PG8_LAS_T;
typedef unsigned short bf16_t;
typedef short bf16x8 __attribute__((ext_vector_type(8)));
typedef float f32x4 __attribute__((ext_vector_type(4)));
typedef unsigned u32x4 __attribute__((ext_vector_type(4)));
constexpr int BM = 256, BK = 64, HALF = 128, HTB = HALF * BK * 2  , STAGE_BYTES = 8 * HTB, NXCD = 8, WGM = 4;

__host__ __device__ __forceinline__ int lds_byte(int r, int c) { const int st = (r >> 4) * 2 + (c >> 5), rr = r & 15, cc = c & 31, ob = rr * 64 + cc * 2; return st * 1024 + (ob ^ (((ob >> 9) & 1) << 5)); }
__host__ __device__ __forceinline__ void stage_rc(int b, int& R, int& C) { const int st = b / 1024, sb = b % 1024, swz = sb ^ (((sb >> 9) & 1) << 5); R = (st >> 1) * 16 + swz / 64; C = (st & 1) * 32 + (swz % 64) / 2; }
__host__ __device__ __forceinline__ int perm32(int rho) { const int n = rho >> 4, i = rho & 15; return 8 * (i >> 2) + 4 * n + (i & 3); }

struct Unit { int pm, pn; };
struct Gemm { const bf16_t* A; const bf16_t* Bt; int M, N, K; };

struct StaticOrder {
    int nM, nN, nwg, G, c;
    __host__ __device__ void init(int M, int N, int G_, int c_) { nM = M / BM; nN = N / BM; nwg = nM * nN; G = G_; c = c_; }
    __host__ __device__ bool next(int i, Unit& u) const {
        const long L = (long)i * G + c; if (L >= nwg) return false;
        int wgid = (int)L; { const int q = nwg / NXCD, r = nwg % NXCD, xcd = wgid % NXCD, off = wgid / NXCD; wgid = (xcd < r ? xcd * (q + 1) : r * (q + 1) + (xcd - r) * q) + off; }
        const int nig = WGM * nN, gid = wgid / nig, fm = gid * WGM, gsz = (nM - fm) < WGM ? (nM - fm) : WGM;
        u.pm = fm + ((wgid % nig) % gsz); u.pn = (wgid % nig) / gsz; return true;
    }
    __device__ __forceinline__ void a_ready(const Unit&) const {}
    __device__ __forceinline__ void done(const Unit&) const {}
};
template <class Epi, class Sched, bool ALIGN_EPI = false, bool SP2 = false>
__device__ __forceinline__ void gemm_phase(PG8_LAS unsigned char* lds, const Gemm g, const Sched& S, const Epi& E, const int wid_s) {
    const int tid = fresh_tid(wid_s), wid = wid_s, lane = tid & 63, wr = wid >> 2, wc = wid & 3, fr = lane & 15, fq = lane >> 4;
    const int K = g.K, nt = K / BK;
    unsigned voffA[2], voffB[2];
#pragma unroll
    for (int i = 0; i < 2; ++i) { int R, C; stage_rc(tid * 16 + i * 8192, R, C); const int Rb = Epi::PERM ? ((R & ~31) + perm32(R & 31)) : R;
        voffA[i] = (unsigned)(R * K + C) * 2u; voffB[i] = (unsigned)(Rb * K + C) * 2u; }
    const size_t kstep = (size_t)(BK * 2);
    const size_t hstep = (size_t)HALF * K * 2;
    const size_t tstep = 2 * hstep;
    const unsigned ldsw = (unsigned)wid * 1024u;
    const int aoff = lds_byte(wr * 64 + fr, fq * 8), boff = lds_byte(wc * 32 + fr, fq * 8);
#define PG8_SA(b, h) (((b) * 2 + (h)) * HTB)
#define PG8_SB(b, h) ((4 + (b) * 2 + (h)) * HTB)
#define PG8_STAGE(bufoff, gbase, voff) do { _Pragma("unroll") for (int _i = 0; _i < 2; ++_i) \
        __builtin_amdgcn_global_load_lds((const unsigned*)((const char*)(gbase) + (voff)[_i]), (PG8_LAS unsigned*)(lds + (bufoff) + ldsw + _i * 8192), 16, 0, 0); } while (0)
#define PG8_LDA(dst, b, h) do { _Pragma("unroll") for (int m = 0; m < 4; ++m) _Pragma("unroll") for (int k = 0; k < 2; ++k) dst[m][k] = *(const PG8_LAS bf16x8*)(lds + PG8_SA(b, h) + aoff + m * 2048 + k * 1024); } while (0)
#define PG8_LDB(dst, b, h) do { _Pragma("unroll") for (int n = 0; n < 2; ++n) _Pragma("unroll") for (int k = 0; k < 2; ++k) dst[n][k] = *(const PG8_LAS bf16x8*)(lds + PG8_SB(b, h) + boff + n * 2048 + k * 1024); } while (0)
#define PG8_MMA(ai, bj, At, Bt) do { __builtin_amdgcn_s_setprio(1); _Pragma("unroll") for (int m = 0; m < 4; ++m) _Pragma("unroll") for (int n = 0; n < 2; ++n) _Pragma("unroll") for (int k = 0; k < 2; ++k) \
        acc[ai][bj][m][n] = __builtin_amdgcn_mfma_f32_16x16x32_bf16(Bt[n][k], At[m][k], acc[ai][bj][m][n], 0, 0, 0); __builtin_amdgcn_s_setprio(0); } while (0)
#define PG8_WAIT_V(n) asm volatile("s_waitcnt vmcnt(" #n ")" ::: "memory")
#define PG8_WAIT_L(n) asm volatile("s_waitcnt lgkmcnt(" #n ")" ::: "memory")
#define PG8_BAR __builtin_amdgcn_s_barrier()
#define PG8_SCHED __builtin_amdgcn_sched_barrier(0)
    Unit cur, nxt; int ui = 0;
    if (!S.next(0, cur)) return;
    f32x4 acc[2][2][4][2];
#pragma unroll
    for (int a = 0; a < 2; ++a)
#pragma unroll
        for (int b = 0; b < 2; ++b)
#pragma unroll
            for (int m = 0; m < 4; ++m)
#pragma unroll
                for (int n = 0; n < 2; ++n) acc[a][b][m][n] = (f32x4){0.f, 0.f, 0.f, 0.f};
    bf16x8 At[4][2], B0[2][2], B1[2][2];
    const char* cA = (const char*)g.A + (size_t)cur.pm * tstep; const char* cB = (const char*)g.Bt + (size_t)cur.pn * tstep;
    S.a_ready(cur);
    if constexpr (SP2) {
        PG8_STAGE(PG8_SB(0, 0), cB, voffB); PG8_STAGE(PG8_SB(0, 1), cB + hstep, voffB); PG8_STAGE(PG8_SA(0, 0), cA, voffA); PG8_STAGE(PG8_SA(0, 1), cA + hstep, voffA);
        if (wr == 1) PG8_BAR;
        PG8_WAIT_V(2); PG8_BAR;
        PG8_STAGE(PG8_SB(1, 0), cB + kstep, voffB); PG8_STAGE(PG8_SA(1, 0), cA + kstep, voffA); PG8_STAGE(PG8_SB(1, 1), cB + hstep + kstep, voffB);
        PG8_WAIT_V(6); PG8_BAR;
    } else {
        PG8_STAGE(PG8_SB(0, 0), cB, voffB); PG8_STAGE(PG8_SA(0, 0), cA, voffA); PG8_STAGE(PG8_SB(0, 1), cB + hstep, voffB); PG8_STAGE(PG8_SA(0, 1), cA + hstep, voffA);
        if (wr == 1) PG8_BAR;
        PG8_WAIT_V(4); PG8_BAR;
        PG8_STAGE(PG8_SB(1, 0), cB + kstep, voffB); PG8_STAGE(PG8_SA(1, 0), cA + kstep, voffA); PG8_STAGE(PG8_SB(1, 1), cB + hstep + kstep, voffB);
        PG8_WAIT_V(6); PG8_BAR;
    }
    for (;;) {
        const bool has_next = S.next(ui + 1, nxt);
        const char* nA = has_next ? (const char*)g.A + (size_t)nxt.pm * tstep : cA; const char* nB = has_next ? (const char*)g.Bt + (size_t)nxt.pn * tstep : cB;
        for (int t = 0; t < nt; t += 2) {
            const bool last = (t == nt - 2);
            const char* a1 = cA + (size_t)(t + 1) * kstep;
            const char* a2 = last ? nA : cA + (size_t)(t + 2) * kstep; const char* b2 = last ? nB : cB + (size_t)(t + 2) * kstep;
            const char* a3 = a2 + kstep; const char* b3 = b2 + kstep;
            if (last && has_next) S.a_ready(nxt);
            if constexpr (SP2) {
            PG8_LDB(B0, 0, 0); PG8_LDB(B1, 0, 1); PG8_SCHED; PG8_LDA(At, 0, 0); PG8_STAGE(PG8_SA(1, 1), a1 + hstep, voffA);
            PG8_WAIT_V(8); PG8_WAIT_L(0); PG8_BAR; PG8_MMA(0, 0, At, B0); PG8_MMA(0, 1, At, B1); PG8_BAR; PG8_SCHED;
            PG8_LDA(At, 0, 1); PG8_STAGE(PG8_SB(0, 0), b2, voffB); PG8_STAGE(PG8_SB(0, 1), b2 + hstep, voffB); PG8_STAGE(PG8_SA(0, 0), a2, voffA);
            PG8_WAIT_V(8); PG8_WAIT_L(0); PG8_BAR; PG8_MMA(1, 0, At, B0); PG8_MMA(1, 1, At, B1); PG8_BAR; PG8_SCHED;
            PG8_LDB(B0, 1, 0); PG8_LDB(B1, 1, 1); PG8_SCHED; PG8_LDA(At, 1, 0); PG8_STAGE(PG8_SA(0, 1), a2 + hstep, voffA);
            PG8_WAIT_V(8); PG8_WAIT_L(0); PG8_BAR; PG8_MMA(0, 0, At, B0); PG8_MMA(0, 1, At, B1); PG8_BAR; PG8_SCHED;
            PG8_LDA(At, 1, 1); PG8_STAGE(PG8_SB(1, 0), b3, voffB); PG8_STAGE(PG8_SB(1, 1), b3 + hstep, voffB); PG8_STAGE(PG8_SA(1, 0), a3, voffA);
            PG8_WAIT_V(8); PG8_WAIT_L(0); PG8_BAR; PG8_MMA(1, 0, At, B0); PG8_MMA(1, 1, At, B1); PG8_BAR; PG8_SCHED;
            } else {
            PG8_LDB(B0, 0, 0); PG8_SCHED; PG8_LDA(At, 0, 0); PG8_STAGE(PG8_SA(1, 1), a1 + hstep, voffA);
            PG8_WAIT_L(8); PG8_BAR; PG8_WAIT_L(0); PG8_MMA(0, 0, At, B0); PG8_BAR; PG8_SCHED;
            PG8_LDB(B1, 0, 1); PG8_STAGE(PG8_SB(0, 0), b2, voffB);
            PG8_BAR; PG8_WAIT_L(0); PG8_MMA(0, 1, At, B1); PG8_BAR;
            PG8_LDA(At, 0, 1); PG8_STAGE(PG8_SA(0, 0), a2, voffA);
            PG8_BAR; PG8_WAIT_L(0); PG8_MMA(1, 0, At, B0); PG8_BAR; PG8_SCHED;
            PG8_STAGE(PG8_SB(0, 1), b2 + hstep, voffB);
            PG8_WAIT_V(6); PG8_BAR; PG8_MMA(1, 1, At, B1); PG8_BAR;
            PG8_LDB(B0, 1, 0); PG8_SCHED; PG8_LDA(At, 1, 0); PG8_STAGE(PG8_SA(0, 1), a2 + hstep, voffA);
            PG8_WAIT_L(8); PG8_BAR; PG8_WAIT_L(0); PG8_MMA(0, 0, At, B0); PG8_BAR; PG8_SCHED;
            PG8_LDB(B1, 1, 1); PG8_STAGE(PG8_SB(1, 0), b3, voffB);
            PG8_BAR; PG8_WAIT_L(0); PG8_MMA(0, 1, At, B1); PG8_BAR;
            PG8_LDA(At, 1, 1); PG8_STAGE(PG8_SA(1, 0), a3, voffA);
            PG8_BAR; PG8_WAIT_L(0); PG8_MMA(1, 0, At, B0); PG8_BAR; PG8_SCHED;
            PG8_STAGE(PG8_SB(1, 1), b3 + hstep, voffB);
            PG8_WAIT_V(6); PG8_BAR; PG8_MMA(1, 1, At, B1); PG8_BAR;
            }
        }
        if constexpr (ALIGN_EPI) { if (wr == 0) PG8_BAR; }
        if constexpr (!Epi::AFTER_DRAIN) { E(acc, cur, wr, wc, fr, fq); S.done(cur); }
        if (!has_next) break;
#pragma unroll
        for (int a = 0; a < 2; ++a)
#pragma unroll
            for (int b = 0; b < 2; ++b)
#pragma unroll
                for (int m = 0; m < 4; ++m)
#pragma unroll
                    for (int n = 0; n < 2; ++n) acc[a][b][m][n] = (f32x4){0.f, 0.f, 0.f, 0.f};
        cur = nxt; cA = nA; cB = nB; ++ui;
        if constexpr (ALIGN_EPI) { if (wr == 1) PG8_BAR; }
    }
    PG8_WAIT_V(0);
    if constexpr (!ALIGN_EPI) { if (wr == 0) PG8_BAR; }
    PG8_BAR;
    if constexpr (Epi::AFTER_DRAIN) { E.fused(acc, cur, wr, wc, fr, fq, lds, wid, lane); S.done(cur); }
#undef PG8_SA
#undef PG8_SB
#undef PG8_STAGE
#undef PG8_LDA
#undef PG8_LDB
#undef PG8_MMA
#undef PG8_WAIT_V
#undef PG8_WAIT_L
#undef PG8_BAR
#undef PG8_SCHED
}
}

template <class F> DI void epi_rows(const pg8::f32x4 (&acc)[2][2][4][2], const pg8::Unit& u, int wr, int wc, int fr, int fq, F f) {
#pragma unroll
    for (int ai = 0; ai < 2; ++ai)
#pragma unroll
        for (int m = 0; m < 4; ++m) {
            const int row = u.pm * 256 + ai * 128 + wr * 64 + m * 16 + fr;
#pragma unroll
            for (int bj = 0; bj < 2; ++bj) f(row, u.pn * 256 + bj * 128 + wc * 32 + 8 * fq, acc[ai][bj][m][0], acc[ai][bj][m][1]);
        }
}
DI u32x4 pack8(const f32x4& a, const f32x4& b) { u32x4 w; w.x = pack2(a[0], a[1]); w.y = pack2(a[2], a[3]); w.z = pack2(b[0], b[1]); w.w = pack2(b[2], b[3]); return w; }
struct EpiProj {
    static constexpr bool PERM = true, AFTER_DRAIN = false;
    unsigned char* ws;
    DI void operator()(const pg8::f32x4 (&acc)[2][2][4][2], const pg8::Unit& u, int wr, int wc, int fr, int fq) const {
        const int pn = u.pn;
        if (pn < 12) {
            bf16_t* dst; int ld, cofs;
            if (pn < 6) { dst = (bf16_t*)(ws + OFF_GQKV); ld = 1536; cofs = 0; }
            else if (pn < 8) { dst = (bf16_t*)(ws + OFF_Z); ld = 512; cofs = 1536; }
            else { dst = (bf16_t*)(ws + OFF_FQK); ld = 1024; cofs = 2048; }
            epi_rows(acc, u, wr, wc, fr, fq, [&](int row, int col, const f32x4& a, const f32x4& b) { *(u32x4*)(dst + (size_t)row * ld + (col - cofs)) = pack8(a, b); });
        } else if (pn < 14) {
            bf16_t* vT = (bf16_t*)(ws + OFF_VT);
            epi_rows(acc, u, wr, wc, fr, fq, [&](int row, int col, const f32x4& a, const f32x4& b) {
                const int c = col - 3072, hh = c >> 6, d0 = c & 63, bb = row >> 11, t = row & 2047;
                bf16_t* p = vT + ((size_t)(bb * 8 + hh) * 64 + d0) * TSEQ + t;
#pragma unroll
                for (int e = 0; e < 4; ++e) { p[(size_t)e * TSEQ] = (bf16_t)f2bf(a[e]); p[(size_t)(e + 4) * TSEQ] = (bf16_t)f2bf(b[e]); }
            });
        } else {
            float* gates = (float*)(ws + OFF_GATES);
            epi_rows(acc, u, wr, wc, fr, fq, [&](int row, int col, const f32x4& a, const f32x4& b) {
                const int c = col - 3584;
                if (c < 16) { *(f32x4*)(gates + (size_t)row * 16 + c) = a; *(f32x4*)(gates + (size_t)row * 16 + c + 4) = b; }
            });
        }
    }
};
struct EpiOutProj {
    static constexpr bool PERM = true, AFTER_DRAIN = false;
    const float* x; const float* g; const float* b; const float* stats; float* out;
    DI void operator()(const pg8::f32x4 (&acc)[2][2][4][2], const pg8::Unit& u, int wr, int wc, int fr, int fq) const {
        epi_rows(acc, u, wr, wc, fr, fq, [&](int row, int col, const f32x4& a0, const f32x4& a1) {
            const float mu = stats[row * 2], rs = stats[row * 2 + 1];
            const size_t idx = (size_t)row * DM + col;
            const f32x4 x0 = *(const f32x4*)(x + idx), x1 = *(const f32x4*)(x + idx + 4);
            const f32x4 g0 = *(const f32x4*)(g + col), g1 = *(const f32x4*)(g + col + 4), b0 = *(const f32x4*)(b + col), b1 = *(const f32x4*)(b + col + 4);
            *(f32x4*)(out + idx) = ((x0 - mu) * rs * g0 + b0) * ALPHA + a0;
            *(f32x4*)(out + idx + 4) = ((x1 - mu) * rs * g1 + b1) * ALPHA + a1;
        });
    }
};
struct EpiUp {
    static constexpr bool PERM = true, AFTER_DRAIN = false;
    bf16_t* ffb;
    DI void operator()(const pg8::f32x4 (&acc)[2][2][4][2], const pg8::Unit& u, int wr, int wc, int fr, int fq) const {
        epi_rows(acc, u, wr, wc, fr, fq, [&](int row, int col, const f32x4& a, const f32x4& b) {
            f32x4 ra, rb;
#pragma unroll
            for (int e = 0; e < 4; ++e) { const float va = fmaxf(a[e], 0.f), vb = fmaxf(b[e], 0.f); ra[e] = va * va; rb[e] = vb * vb; }
            *(u32x4*)(ffb + (size_t)row * 4096 + col) = pack8(ra, rb);
        });
    }
};
struct EpiGate {
    static constexpr bool PERM = true, AFTER_DRAIN = false;
    bf16_t* pg; const float* bias;
    DI void operator()(const pg8::f32x4 (&acc)[2][2][4][2], const pg8::Unit& u, int wr, int wc, int fr, int fq) const {
        f32x4 bv[2][2];
#pragma unroll
        for (int bj = 0; bj < 2; ++bj) { const int c0 = u.pn * 256 + bj * 128 + wc * 32 + 8 * fq; bv[bj][0] = *(const f32x4*)(bias + c0); bv[bj][1] = *(const f32x4*)(bias + c0 + 4); }
        epi_rows(acc, u, wr, wc, fr, fq, [&](int row, int col, const f32x4& a, const f32x4& b) {
            const int bj = (col >> 7) & 1;
            const f32x4 b0 = bv[bj][0], b1 = bv[bj][1];
            f32x4 ra, rb;
#pragma unroll
            for (int e = 0; e < 4; ++e) { ra[e] = sigmoidf_(a[e] + b0[e]); rb[e] = sigmoidf_(b[e] + b1[e]); }
            *(u32x4*)(pg + (size_t)row * DM + col) = pack8(ra, rb);
        });
    }
};
struct EpiPle {
    static constexpr bool PERM = true, AFTER_DRAIN = false;
    bf16_t* pg;
    DI void operator()(const pg8::f32x4 (&acc)[2][2][4][2], const pg8::Unit& u, int wr, int wc, int fr, int fq) const {
        epi_rows(acc, u, wr, wc, fr, fq, [&](int row, int col, const f32x4& a, const f32x4& b) {
            u32x4* p = (u32x4*)(pg + (size_t)row * DM + col);
            const u32x4 w = *p;
            f32x4 ra, rb;
            ra[0] = a[0] * bflo(w.x); ra[1] = a[1] * bfhi(w.x); ra[2] = a[2] * bflo(w.y); ra[3] = a[3] * bfhi(w.y);
            rb[0] = b[0] * bflo(w.z); rb[1] = b[1] * bfhi(w.z); rb[2] = b[2] * bflo(w.w); rb[3] = b[3] * bfhi(w.w);
            *p = pack8(ra, rb);
        });
    }
};
struct EpiDown {
    static constexpr bool PERM = true, AFTER_DRAIN = false;
    const bf16_t* pg; float* out;
    DI void operator()(const pg8::f32x4 (&acc)[2][2][4][2], const pg8::Unit& u, int wr, int wc, int fr, int fq) const {
        epi_rows(acc, u, wr, wc, fr, fq, [&](int row, int col, const f32x4& a, const f32x4& b) {
            const size_t idx = (size_t)row * DM + col;
            const u32x4 w = *(const u32x4*)(pg + idx);
            f32x4 o0 = *(const f32x4*)(out + idx), o1 = *(const f32x4*)(out + idx + 4);
            o0 = o0 * ALPHA + a; o1 = o1 * ALPHA + b;
            o0[0] += bflo(w.x); o0[1] += bfhi(w.x); o0[2] += bflo(w.y); o0[3] += bfhi(w.y);
            o1[0] += bflo(w.z); o1[1] += bfhi(w.z); o1[2] += bflo(w.w); o1[3] += bfhi(w.w);
            *(f32x4*)(out + idx) = o0; *(f32x4*)(out + idx + 4) = o1;
        });
    }
};
DI void lds_read8(unsigned addr, f32x4 (&a)[4][2]) {
    asm volatile(
        "ds_read_b128 %0, %8\n\tds_read_b128 %1, %8 offset:16\n\t"
        "ds_read_b128 %2, %8 offset:256\n\tds_read_b128 %3, %8 offset:272\n\t"
        "ds_read_b128 %4, %8 offset:512\n\tds_read_b128 %5, %8 offset:528\n\t"
        "ds_read_b128 %6, %8 offset:768\n\tds_read_b128 %7, %8 offset:784\n\t"
        "s_waitcnt lgkmcnt(0)"
        : "=&v"(a[0][0]), "=&v"(a[0][1]), "=&v"(a[1][0]), "=&v"(a[1][1]), "=&v"(a[2][0]), "=&v"(a[2][1]), "=&v"(a[3][0]), "=&v"(a[3][1])
        : "v"(addr) : "memory");
}
DI void lds_read8s(unsigned addr, f32x4 (&a)[4][2]) {
    asm volatile(
        "ds_read_b128 %0, %8\n\tds_read_b128 %1, %8 offset:16\n\t"
        "ds_read_b128 %2, %8 offset:128\n\tds_read_b128 %3, %8 offset:144\n\t"
        "ds_read_b128 %4, %8 offset:256\n\tds_read_b128 %5, %8 offset:272\n\t"
        "ds_read_b128 %6, %8 offset:384\n\tds_read_b128 %7, %8 offset:400\n\t"
        "s_waitcnt lgkmcnt(0)"
        : "=&v"(a[0][0]), "=&v"(a[0][1]), "=&v"(a[1][0]), "=&v"(a[1][1]), "=&v"(a[2][0]), "=&v"(a[2][1]), "=&v"(a[3][0]), "=&v"(a[3][1])
        : "v"(addr) : "memory");
}
DI void prep_chunk(const Params& P, int ci, unsigned char* smem, int tt) {
    const int tid = tt, lane = tid & 63, wave = tid >> 6, r = lane & 31, h2 = lane >> 5;
    const int b = ci >> 7, hd = (ci >> 5) & 3, n = ci & 31, t0 = n * 64;
    const size_t rowbase = (size_t)b * TSEQ + t0;
    bf16_t* kbf = (bf16_t*)smem;
    bf16_t* qbf = kbf + 64 * 136;
    bf16_t* vT  = (bf16_t*)smem;
    bf16_t* Tb  = (bf16_t*)(smem + 18432);
    bf16_t* Tg  = (bf16_t*)(smem + 27648);
    bf16_t* kT  = (bf16_t*)(smem + 36864);
    float*  Ad  = (float*)(smem + 55296);
    bf16_t* A10 = (bf16_t*)(smem + 63488);
    bf16_t* DT  = (bf16_t*)(smem + 66048);
    float* sbeta = (float*)(smem + 71168);
    float* sgam = sbeta + 64; float* segam = sgam + 64; float* sdk = segam + 64;
    bf16_t* D1R = (bf16_t*)(smem + 72192);
    const bf16_t* gq = (const bf16_t*)(P.ws + OFF_GQKV);
    const float* gates = (const float*)(P.ws + OFF_GATES);
    const float* cw = P.in[5];
    if (tid < 64) {
        const float* gt = gates + (rowbase + tid) * 16;
        const float be = sigmoidf_(gt[hd]);
        const float a = gt[4 + hd] + P.in[7][hd];
        const float sp = fmaxf(a, 0.f) + log1pf(__expf(-fabsf(a)));
        float lg = -__expf(P.in[6][hd]) * sp;
#pragma unroll
        for (int o = 1; o < 64; o <<= 1) { const float t = shup(lg, o, lane); if (lane >= o) lg += t; }
        const float gl = shlane(lg, 63);
        sbeta[tid] = be; sgam[tid] = lg; segam[tid] = __expf(lg); sdk[tid] = __expf(gl - lg);
    }
    {
        float* wl = Ad;
        for (int idx = tid; idx < 384; idx += 256) {
            const int wh = idx >> 7, rem = idx & 127, j = rem >> 5, c4 = (rem & 31) * 4;
            const int cbw = (wh == 0 ? 512 : wh == 1 ? 0 : 1024) + hd * 128;
            *(f32x4*)(wl + (wh * 4 + j) * 128 + c4) = *(const f32x4*)(cw + j * 1536 + cbw + c4);
        }
    }
    __syncthreads();
    unsigned vkeep[16];
#pragma unroll
    for (int e = 0; e < 16; ++e) vkeep[e] = 0u;
    {
        const int i = tid >> 2, seg = tid & 3;
        const float* wl = Ad;
#pragma unroll 1
        for (int which = 0; which < 3; ++which) {
            const int colbase = (which == 0 ? 512 : which == 1 ? 0 : 1024) + hd * 128 + seg * 32;
            u32x4 xr[4][4];
#pragma unroll
            for (int j = 0; j < 4; ++j) {
                const int t = t0 + i - 3 + j;
                const int tc = t < 0 ? 0 : t;
                const bf16_t* xp = gq + ((size_t)b * TSEQ + tc) * 1536 + colbase;
#pragma unroll
                for (int sub = 0; sub < 4; ++sub) xr[j][sub] = *(const u32x4*)(xp + sub * 8);
            }
            float val[32];
#pragma unroll
            for (int sub = 0; sub < 4; ++sub) {
                float a8[8];
#pragma unroll
                for (int e = 0; e < 8; ++e) a8[e] = 0.f;
#pragma unroll
                for (int j = 0; j < 4; ++j) {
                    const float mk = (t0 + i - 3 + j) < 0 ? 0.f : 1.f;
                    const u32x4 xv = xr[j][sub];
                    f32x4 w0 = *(const f32x4*)(wl + (which * 4 + j) * 128 + seg * 32 + sub * 8), w1 = *(const f32x4*)(wl + (which * 4 + j) * 128 + seg * 32 + sub * 8 + 4);
                    w0 = w0 * mk; w1 = w1 * mk;
                    a8[0] += w0[0] * bflo(xv.x); a8[1] += w0[1] * bfhi(xv.x); a8[2] += w0[2] * bflo(xv.y); a8[3] += w0[3] * bfhi(xv.y);
                    a8[4] += w1[0] * bflo(xv.z); a8[5] += w1[1] * bfhi(xv.z); a8[6] += w1[2] * bflo(xv.w); a8[7] += w1[3] * bfhi(xv.w);
                }
#pragma unroll
                for (int e = 0; e < 8; ++e) val[sub * 8 + e] = siluf(a8[e]);
            }
            float ss = 0.f;
#pragma unroll
            for (int e = 0; e < 32; ++e) ss += val[e] * val[e];
            ss += shx(ss, 1, lane); ss += shx(ss, 2, lane);
            const float sc = (which == 2) ? 1.f : rsqrtf(ss + 1e-6f) * (which == 1 ? 0.08838834764831845f : 1.f);
            unsigned pk[16];
#pragma unroll
            for (int e = 0; e < 16; ++e) pk[e] = pack2(val[2 * e] * sc, val[2 * e + 1] * sc);
            if (which == 2) {
#pragma unroll
                for (int e = 0; e < 16; ++e) vkeep[e] = pk[e];
            } else {
                bf16_t* dst = (which == 0 ? kbf : qbf) + i * 136 + seg * 32;
#pragma unroll
                for (int sub = 0; sub < 4; ++sub) { u32x4 o; o.x = pk[4 * sub]; o.y = pk[4 * sub + 1]; o.z = pk[4 * sub + 2]; o.w = pk[4 * sub + 3]; *(u32x4*)(dst + sub * 8) = o; }
                if (which == 0) {
                    bf16_t* kt = kT + (seg * 32) * 72 + i;
#pragma unroll
                    for (int e = 0; e < 16; ++e) { kt[(2 * e) * 72] = (bf16_t)(pk[e] & 0xffffu); kt[(2 * e + 1) * 72] = (bf16_t)(pk[e] >> 16); }
                }
            }
        }
    }
    __syncthreads();
    {
        const int mi = wave >> 1, ni = wave & 1;
        f32x16 aK, aQ;
#pragma unroll
        for (int e = 0; e < 16; ++e) { aK[e] = 0.f; aQ[e] = 0.f; }
#pragma unroll
        for (int ks = 0; ks < 8; ++ks) {
            const bf16x8 ak = *(const bf16x8*)(kbf + (mi * 32 + r) * 136 + ks * 16 + h2 * 8);
            const bf16x8 bk = *(const bf16x8*)(kbf + (ni * 32 + r) * 136 + ks * 16 + h2 * 8);
            const bf16x8 aq = *(const bf16x8*)(qbf + (mi * 32 + r) * 136 + ks * 16 + h2 * 8);
            aK = MFMA32(ak, bk, aK); aQ = MFMA32(aq, bk, aQ);
        }
        const int j = ni * 32 + r;
        const float gj = sgam[j];
        bf16_t* qkout = (bf16_t*)(P.ws + OFF_QK) + (size_t)ci * 4096;
#pragma unroll
        for (int e = 0; e < 16; ++e) {
            const int il = crow(e, h2), i = mi * 32 + il;
            const float dec = (i >= j) ? __expf(sgam[i] - gj) : 0.f;
            const float aij = (i > j) ? aK[e] * sbeta[i] * dec : 0.f;
            if (mi == ni) Ad[(mi * 32 + il) * 32 + r] = aij;
            else if (mi == 1) A10[il * 40 + r] = (bf16_t)f2bf(aij);
            qkout[(((i >> 5) * 4 + (j >> 4)) * 64 + (i & 31) + 32 * ((j >> 3) & 1)) * 8 + (j & 7)] = (bf16_t)f2bf((i >= j) ? aQ[e] * dec : 0.f);
        }
    }
    {
        const int i = tid >> 2, seg = tid & 3;
        const float eg = segam[i];
        bf16_t* qd = (bf16_t*)(P.ws + OFF_QD) + (size_t)ci * 8192;
#pragma unroll
        for (int sub = 0; sub < 4; ++sub) {
            const u32x4 v = *(const u32x4*)(qbf + i * 136 + seg * 32 + sub * 8);
            u32x4 o;
            o.x = pack2(bflo(v.x) * eg, bfhi(v.x) * eg); o.y = pack2(bflo(v.y) * eg, bfhi(v.y) * eg);
            o.z = pack2(bflo(v.z) * eg, bfhi(v.z) * eg); o.w = pack2(bflo(v.w) * eg, bfhi(v.w) * eg);
            *(u32x4*)(qd + ((((i >> 5) * 8 + seg * 2 + (sub >> 1)) * 64 + (i & 31) + 32 * (sub & 1)) * 8)) = o;
        }
        const int kidx = tid >> 1, cs = (tid & 1) * 32;
        bf16_t* kd = (bf16_t*)(P.ws + OFF_KDT) + (size_t)ci * 8192;
#pragma unroll
        for (int sub = 0; sub < 4; ++sub) {
            const u32x4 v = *(const u32x4*)(kT + kidx * 72 + cs + sub * 8);
            const f32x4 d0 = *(const f32x4*)(sdk + cs + sub * 8), d1 = *(const f32x4*)(sdk + cs + sub * 8 + 4);
            u32x4 o;
            o.x = pack2(bflo(v.x) * d0[0], bfhi(v.x) * d0[1]); o.y = pack2(bflo(v.y) * d0[2], bfhi(v.y) * d0[3]);
            o.z = pack2(bflo(v.z) * d1[0], bfhi(v.z) * d1[1]); o.w = pack2(bflo(v.w) * d1[2], bfhi(v.w) * d1[3]);
            *(u32x4*)(kd + ((((kidx >> 5) * 4 + ((cs + sub * 8) >> 4)) * 64 + (kidx & 31) + 32 * (sub & 1)) * 8)) = o;
        }
        if (tid == 0) ((float*)(P.ws + OFF_GLAST))[ci] = segam[63];
    }
    __syncthreads();
    {
        const int i = tid >> 2, seg = tid & 3;
        bf16_t* vt = vT + (seg * 32) * 72 + i;
#pragma unroll
        for (int e = 0; e < 16; ++e) { vt[(2 * e) * 72] = (bf16_t)(vkeep[e] & 0xffffu); vt[(2 * e + 1) * 72] = (bf16_t)(vkeep[e] >> 16); }
        if (tid >= 64) {
            for (int idx = tid - 64; idx < 1024; idx += 192) { const int rr = idx >> 5, cc = 32 + (idx & 31); Tb[rr * 72 + cc] = 0; Tg[rr * 72 + cc] = 0; }
        } else {
            const int blk = tid >> 5, c = tid & 31;
            float x[32];
#pragma unroll
            for (int e = 0; e < 32; ++e) x[e] = (e == c) ? 1.f : 0.f;
            const unsigned ad_lds = (unsigned)(size_t)(Ad + blk * 1024);
#pragma unroll
            for (int ib = 0; ib < 8; ++ib) {
                const int i0 = ib * 4;
                float s0 = x[i0], s1 = x[i0 + 1], s2 = x[i0 + 2], s3 = x[i0 + 3];
#pragma unroll
                for (int mb = 0; mb <= ib; mb += 2) {
                    f32x4 a[4][2];
                    lds_read8s(ad_lds + (unsigned)((i0 * 32 + mb * 4) * 4), a);
#pragma unroll
                    for (int cb = 0; cb < 2; ++cb) {
                        const int m4 = mb + cb;
                        if (m4 < ib) {
#pragma unroll
                            for (int e = 0; e < 4; ++e) {
                                const float xx = x[m4 * 4 + e];
                                s0 -= a[0][cb][e] * xx; s1 -= a[1][cb][e] * xx; s2 -= a[2][cb][e] * xx; s3 -= a[3][cb][e] * xx;
                            }
                        } else if (m4 == ib) {
                            s1 -= a[1][cb][0] * s0;
                            s2 -= a[2][cb][0] * s0; s2 -= a[2][cb][1] * s1;
                            s3 -= a[3][cb][0] * s0; s3 -= a[3][cb][1] * s1; s3 -= a[3][cb][2] * s2;
                        }
                    }
                    __builtin_amdgcn_sched_barrier(0);
                }
                x[i0] = s0; x[i0 + 1] = s1; x[i0 + 2] = s2; x[i0 + 3] = s3;
            }
            bf16_t* dt = DT + (blk * 32 + c) * 40;
#pragma unroll
            for (int q4 = 0; q4 < 4; ++q4) {
                u32x4 o; o.x = pack2(x[8 * q4], x[8 * q4 + 1]); o.y = pack2(x[8 * q4 + 2], x[8 * q4 + 3]); o.z = pack2(x[8 * q4 + 4], x[8 * q4 + 5]); o.w = pack2(x[8 * q4 + 6], x[8 * q4 + 7]);
                *(u32x4*)(dt + q4 * 8) = o;
            }
            const int cg = blk * 32 + c;
            const float bc = sbeta[cg], bg = bc * segam[cg];
#pragma unroll
            for (int rr = 0; rr < 32; ++rr) {
                if (blk == 1) D1R[rr * 40 + c] = (bf16_t)f2bf(x[rr]);
                Tb[(blk * 32 + rr) * 72 + cg] = (bf16_t)f2bf(x[rr] * bc);
                Tg[(blk * 32 + rr) * 72 + cg] = (bf16_t)f2bf(x[rr] * bg);
            }
        }
    }
    __syncthreads();
    if (wave == 0) {
        f32x16 Pm, Qm;
#pragma unroll
        for (int e = 0; e < 16; ++e) { Pm[e] = 0.f; Qm[e] = 0.f; }
#pragma unroll
        for (int ks = 0; ks < 2; ++ks) {
            const bf16x8 a = *(const bf16x8*)(A10 + r * 40 + ks * 16 + h2 * 8);
            const bf16x8 bb = *(const bf16x8*)(DT + r * 40 + ks * 16 + h2 * 8);
            Pm = MFMA32(a, bb, Pm);
        }
#pragma unroll
        for (int sq = 0; sq < 2; ++sq) {
            u32x4 pw;
            pw.x = pack2(Pm[8 * sq + 0], Pm[8 * sq + 1]); pw.y = pack2(Pm[8 * sq + 2], Pm[8 * sq + 3]);
            pw.z = pack2(Pm[8 * sq + 4], Pm[8 * sq + 5]); pw.w = pack2(Pm[8 * sq + 6], Pm[8 * sq + 7]);
            const bf16_t* dp = D1R + r * 40 + 16 * sq + 4 * h2;
            const u32x2 lo = *(const u32x2*)dp, hi = *(const u32x2*)(dp + 8);
            u32x4 aw; aw.x = lo.x; aw.y = lo.y; aw.z = hi.x; aw.w = hi.y;
            Qm = MFMA32(__builtin_bit_cast(bf16x8, aw), __builtin_bit_cast(bf16x8, pw), Qm);
        }
        const float bc = sbeta[r], bg = bc * segam[r];
#pragma unroll
        for (int e = 0; e < 16; ++e) {
            const int il = crow(e, h2);
            Tb[(32 + il) * 72 + r] = (bf16_t)f2bf(-Qm[e] * bc);
            Tg[(32 + il) * 72 + r] = (bf16_t)f2bf(-Qm[e] * bg);
        }
    }
    __syncthreads();
    {
        const int nt = wave;
        f32x16 aU[2], aW[2];
#pragma unroll
        for (int e = 0; e < 16; ++e) { aU[0][e] = 0.f; aU[1][e] = 0.f; aW[0][e] = 0.f; aW[1][e] = 0.f; }
#pragma unroll
        for (int ks = 0; ks < 4; ++ks) {
            const bf16x8 bv = *(const bf16x8*)(vT + (nt * 32 + r) * 72 + ks * 16 + h2 * 8);
            const bf16x8 bk = *(const bf16x8*)(kT + (nt * 32 + r) * 72 + ks * 16 + h2 * 8);
#pragma unroll
            for (int mt = 0; mt < 2; ++mt) {
                const bf16x8 ab = *(const bf16x8*)(Tb + (mt * 32 + r) * 72 + ks * 16 + h2 * 8);
                const bf16x8 ag = *(const bf16x8*)(Tg + (mt * 32 + r) * 72 + ks * 16 + h2 * 8);
                aU[mt] = MFMA32(ab, bv, aU[mt]); aW[mt] = MFMA32(ag, bk, aW[mt]);
            }
        }
        bf16_t* u = (bf16_t*)(P.ws + OFF_U) + (size_t)ci * 8192;
        bf16_t* w = (bf16_t*)(P.ws + OFF_W) + (size_t)ci * 8192;
#pragma unroll
        for (int mt = 0; mt < 2; ++mt) {
            u32x4 o0, o1;
            o0.x = pack2(aU[mt][0], aU[mt][1]); o0.y = pack2(aU[mt][2], aU[mt][3]); o0.z = pack2(aU[mt][4], aU[mt][5]); o0.w = pack2(aU[mt][6], aU[mt][7]);
            o1.x = pack2(aU[mt][8], aU[mt][9]); o1.y = pack2(aU[mt][10], aU[mt][11]); o1.z = pack2(aU[mt][12], aU[mt][13]); o1.w = pack2(aU[mt][14], aU[mt][15]);
            bf16_t* d = u + (((nt * 2 + mt) * 64 + lane) * 16);
            *(u32x4*)d = o0; *(u32x4*)(d + 8) = o1;
            bf16_t* wb = w + (((mt * 8 + nt * 2 + (r >> 4)) * 64 + 32 * ((r >> 3) & 1)) * 8) + (r & 7);
#pragma unroll
            for (int e = 0; e < 16; ++e) wb[crow(e, h2) * 8] = (bf16_t)f2bf(aW[mt][e]);
        }
    }
    __syncthreads();
}

DI void fox_cumsum(const Params& P, int bh, unsigned char* smem, int tt) {
    const int tid = tt, lane = tid & 63, wave = tid >> 6;
    const int b = bh >> 3, hh = bh & 7;
    float* wsum = (float*)smem;
    const float* gates = (const float*)(P.ws + OFF_GATES);
    const float bf = P.in[9][hh];
    float v[8]; float run = 0.f;
#pragma unroll
    for (int e = 0; e < 8; ++e) {
        const float xx = gates[((size_t)b * TSEQ + tid * 8 + e) * 16 + 8 + hh] + bf;
        const float ls = fminf(xx, 0.f) - log1pf(__expf(-fabsf(xx)));
        run += ls; v[e] = run;
    }
    float sc = run;
#pragma unroll
    for (int o = 1; o < 64; o <<= 1) { const float t = shup(sc, o, lane); if (lane >= o) sc += t; }
    if (lane == 63) wsum[wave] = sc;
    __syncthreads();
    float off = sc - run;
    for (int w = 0; w < wave; ++w) off += wsum[w];
    float* cf = (float*)(P.ws + OFF_CF) + (size_t)bh * TSEQ + tid * 8;
#pragma unroll
    for (int e = 0; e < 8; ++e) cf[e] = v[e] + off;
    __syncthreads();
}

DI void gdn_scan(const Params& P, int item, unsigned char* smem, int tt) {
    const int tid = tt, lane = tid & 63, wave = tid >> 6, r = lane & 31, h2 = lane >> 5;
    const int bh = item >> 2, vs = item & 3, b = bh >> 2, hd = bh & 3;
    const int cb = bh * 32;
    bf16_t* SbT = (bf16_t*)smem;
    bf16_t* VnT = SbT + 32 * 136;
    const bool w01 = wave < 2;
    const int mt = wave & 1;
    const bf16_t* Ubase = (const bf16_t*)(P.ws + OFF_U);
    const bf16_t* Abase = (const bf16_t*)(P.ws + (w01 ? OFF_W : OFF_QD));
    const bf16_t* Kbase = (const bf16_t*)(P.ws + OFF_KDT);
    const bf16_t* QKbase = (const bf16_t*)(P.ws + OFF_QK);
    const float* glast = (const float*)(P.ws + OFF_GLAST);
    bf16_t* og = (bf16_t*)(P.ws + OFF_OG);
    f32x16 S;
#pragma unroll
    for (int e = 0; e < 16; ++e) S[e] = 0.f;
    for (int i = tid; i < 32 * 136 / 2; i += 256) ((unsigned*)SbT)[i] = 0u;
#define SCAN_LOAD_A(AF, ci_) do { const bf16_t* ap_ = Abase + (size_t)(ci_) * 8192 + (mt * 8 * 64 + lane) * 8; \
        _Pragma("unroll") for (int ks = 0; ks < 8; ++ks) AF[ks] = *(const bf16x8*)(ap_ + ks * 512); } while (0)
#define SCAN_LOAD_K(ci_) do { const bf16_t* kp_ = Kbase + (size_t)(ci_) * 8192 + (wave * 4 * 64 + lane) * 8; \
        _Pragma("unroll") for (int ks = 0; ks < 4; ++ks) Kf[ks] = *(const bf16x8*)(kp_ + ks * 512); } while (0)
#define SCAN_LOAD_X(ci_) do { if (w01) { const bf16_t* up_ = Ubase + (size_t)(ci_) * 8192 + ((vs * 2 + mt) * 64 + lane) * 16; \
            Xa = *(const u32x4*)up_; Xb = *(const u32x4*)(up_ + 8); } \
        else { const bf16_t* qp_ = QKbase + (size_t)(ci_) * 4096 + (mt * 4 * 64 + lane) * 8; \
            Xa = *(const u32x4*)qp_; Xb = *(const u32x4*)(qp_ + 512); Xc = *(const u32x4*)(qp_ + 1024); Xd = *(const u32x4*)(qp_ + 1536); } } while (0)
#define SCAN_STEP(AF, n_) do { \
        const int cn1 = cb + ((n_) + 1 < 32 ? (n_) + 1 : 31); const int cn2 = cb + ((n_) + 2 < 32 ? (n_) + 2 : 31); \
        const float gl = shlane(glreg, (n_)); \
        f32x16 acc1; \
        bf16x8 sf[8]; \
        _Pragma("unroll") for (int ks = 0; ks < 8; ++ks) sf[ks] = *(const bf16x8*)(SbT + r * 136 + ks * 16 + h2 * 8); \
        _Pragma("unroll") for (int e = 0; e < 16; ++e) acc1[e] = 0.f; \
        __builtin_amdgcn_sched_barrier(0); \
        _Pragma("unroll") for (int ks = 0; ks < 8; ++ks) acc1 = MFMA32(AF[ks], sf[ks], acc1); \
        __builtin_amdgcn_sched_barrier(0); \
        SCAN_LOAD_A(AF, cn2); \
        if (w01) { \
            u32x2 ov; \
            ov.x = pack2(bflo(Xa.x) - acc1[0], bfhi(Xa.x) - acc1[1]); ov.y = pack2(bflo(Xa.y) - acc1[2], bfhi(Xa.y) - acc1[3]); *(u32x2*)(VnT + r * 72 + mt * 32 + 0 + 4 * h2) = ov; \
            ov.x = pack2(bflo(Xa.z) - acc1[4], bfhi(Xa.z) - acc1[5]); ov.y = pack2(bflo(Xa.w) - acc1[6], bfhi(Xa.w) - acc1[7]); *(u32x2*)(VnT + r * 72 + mt * 32 + 8 + 4 * h2) = ov; \
            ov.x = pack2(bflo(Xb.x) - acc1[8], bfhi(Xb.x) - acc1[9]); ov.y = pack2(bflo(Xb.y) - acc1[10], bfhi(Xb.y) - acc1[11]); *(u32x2*)(VnT + r * 72 + mt * 32 + 16 + 4 * h2) = ov; \
            ov.x = pack2(bflo(Xb.z) - acc1[12], bfhi(Xb.z) - acc1[13]); ov.y = pack2(bflo(Xb.w) - acc1[14], bfhi(Xb.w) - acc1[15]); *(u32x2*)(VnT + r * 72 + mt * 32 + 24 + 4 * h2) = ov; \
        } \
        __syncthreads(); \
        bf16x8 Vf[4]; \
        _Pragma("unroll") for (int ks = 0; ks < 4; ++ks) Vf[ks] = *(const bf16x8*)(VnT + r * 72 + ks * 16 + h2 * 8); \
        _Pragma("unroll") for (int e = 0; e < 16; ++e) S[e] *= gl; \
        __builtin_amdgcn_sched_barrier(0); \
        _Pragma("unroll") for (int ks = 0; ks < 4; ++ks) S = MFMA32(Kf[ks], Vf[ks], S); \
        if (!w01) { \
            acc1 = MFMA32(__builtin_bit_cast(bf16x8, Xa), Vf[0], acc1); acc1 = MFMA32(__builtin_bit_cast(bf16x8, Xb), Vf[1], acc1); \
            acc1 = MFMA32(__builtin_bit_cast(bf16x8, Xc), Vf[2], acc1); acc1 = MFMA32(__builtin_bit_cast(bf16x8, Xd), Vf[3], acc1); \
        } \
        __builtin_amdgcn_sched_barrier(0); \
        SCAN_LOAD_K(cn1); \
        SCAN_LOAD_X(cn1); \
        _Pragma("unroll") for (int g = 0; g < 4; ++g) { u32x2 ov; ov.x = pack2(S[4 * g + 0], S[4 * g + 1]); ov.y = pack2(S[4 * g + 2], S[4 * g + 3]); \
            *(u32x2*)(SbT + r * 136 + wave * 32 + 8 * g + 4 * h2) = ov; } \
        if (!w01) { \
            bf16_t* op = og + ((size_t)b * TSEQ + (n_) * 64 + mt * 32) * 512 + hd * 128 + vs * 32 + r; \
            _Pragma("unroll") for (int e = 0; e < 16; ++e) op[(size_t)crow(e, h2) * 512] = (bf16_t)f2bf(acc1[e]); \
        } \
        __syncthreads(); \
    } while (0)
    const float glreg = glast[cb + (lane & 31)];
    bf16x8 Af0[8], Af1[8], Kf[4];
    u32x4 Xa, Xb, Xc, Xd;
    Xc = Xd = (u32x4){0u, 0u, 0u, 0u};
    SCAN_LOAD_A(Af0, cb); SCAN_LOAD_K(cb); SCAN_LOAD_X(cb);
    SCAN_LOAD_A(Af1, cb + 1);
    __syncthreads();
#pragma unroll 1
    for (int n = 0; n < 32; n += 2) {
        SCAN_STEP(Af0, n);
        SCAN_STEP(Af1, n + 1);
    }
#undef SCAN_LOAD_A
#undef SCAN_LOAD_K
#undef SCAN_LOAD_X
#undef SCAN_STEP
}

DI void fox_attn(const Params& P, int bh, int qb, unsigned char* smem, int tt) {
    const int tid = tt, lane = tid & 63, wave = tid >> 6, r = lane & 31, h2 = lane >> 5;
    const int b = bh >> 3, hh = bh & 7;
    constexpr int BUFB = 2 * 64 * 72 * 2 + 256;
    constexpr float L2E = 1.4426950408889634f;
    const bf16_t* fqk = (const bf16_t*)(P.ws + OFF_FQK);
    const bf16_t* vT = (const bf16_t*)(P.ws + OFF_VT) + (size_t)bh * 64 * TSEQ;
    const float* cf = (const float*)(P.ws + OFF_CF) + (size_t)bh * TSEQ;
    const int q = qb * 128 + wave * 32 + r;
    bf16x8 Qf[4];
    {
        const bf16_t* qp = fqk + ((size_t)b * TSEQ + q) * 1024 + hh * 64 + h2 * 8;
#pragma unroll
        for (int ks = 0; ks < 4; ++ks) Qf[ks] = *(const bf16x8*)(qp + ks * 16);
    }
    const float cq = cf[q] * L2E;
    float m = -1e30f, l = 0.f;
    f32x16 O[2];
#pragma unroll
    for (int e = 0; e < 16; ++e) { O[0][e] = 0.f; O[1][e] = 0.f; }
    const int ntiles = 2 * qb + 2;
    const int srow = tid >> 3, scol = (tid & 7) * 8;
    const bf16_t* kg = fqk + ((size_t)b * TSEQ + srow) * 1024 + 512 + hh * 64 + scol;
    const bf16_t* vg = vT + (size_t)srow * TSEQ + scol;
    u32x4 rk0, rk1, rv0, rv1; float rc = 0.f;
    rk0 = *(const u32x4*)kg; rk1 = *(const u32x4*)(kg + 32 * 1024);
    rv0 = *(const u32x4*)vg; rv1 = *(const u32x4*)(vg + 32 * TSEQ);
    if (tid < 64) rc = cf[tid] * L2E;
    {
        bf16_t* Ks = (bf16_t*)smem; bf16_t* VTs = Ks + 64 * 72; float* cks = (float*)(smem + 2 * 64 * 72 * 2);
        *(u32x4*)(Ks + srow * 72 + scol) = rk0; *(u32x4*)(Ks + (srow + 32) * 72 + scol) = rk1;
        *(u32x4*)(VTs + srow * 72 + scol) = rv0; *(u32x4*)(VTs + (srow + 32) * 72 + scol) = rv1;
        if (tid < 64) cks[tid] = rc;
    }
    __syncthreads();
#pragma unroll 1
    for (int kt = 0; kt < ntiles; ++kt) {
        const unsigned char* bufc = smem + (kt & 1) * BUFB;
        const bf16_t* Ks = (const bf16_t*)bufc; const bf16_t* VTs = Ks + 64 * 72; const float* cks = (const float*)(bufc + 2 * 64 * 72 * 2);
        const bool more = kt + 1 < ntiles;
        if (more) {
            const bf16_t* kg2 = kg + (size_t)(kt + 1) * 64 * 1024; const bf16_t* vg2 = vg + (kt + 1) * 64;
            rk0 = *(const u32x4*)kg2; rk1 = *(const u32x4*)(kg2 + 32 * 1024);
            rv0 = *(const u32x4*)vg2; rv1 = *(const u32x4*)(vg2 + 32 * TSEQ);
            if (tid < 64) rc = cf[(kt + 1) * 64 + tid] * L2E;
        }
        f32x16 sacc[2];
        f32x4 ckv[2][4];
        {
            bf16x8 kf[2][4];
#pragma unroll
            for (int mt = 0; mt < 2; ++mt)
#pragma unroll
                for (int ks = 0; ks < 4; ++ks) kf[mt][ks] = *(const bf16x8*)(Ks + (mt * 32 + r) * 72 + ks * 16 + h2 * 8);
#pragma unroll
            for (int mt = 0; mt < 2; ++mt)
#pragma unroll
                for (int g = 0; g < 4; ++g) ckv[mt][g] = *(const f32x4*)(cks + mt * 32 + 8 * g + 4 * h2);
#pragma unroll
            for (int e = 0; e < 16; ++e) { sacc[0][e] = 0.f; sacc[1][e] = 0.f; }
            __builtin_amdgcn_sched_barrier(0);
#pragma unroll
            for (int ks = 0; ks < 4; ++ks) { sacc[0] = MFMA32(kf[0][ks], Qf[ks], sacc[0]); sacc[1] = MFMA32(kf[1][ks], Qf[ks], sacc[1]); }
        }
        const bool diag = kt >= ntiles - 2;
        float mx = -1e30f;
        {
            const f32x2v csc = {0.125f * L2E, 0.125f * L2E};
#pragma unroll
            for (int mt = 0; mt < 2; ++mt)
#pragma unroll
                for (int g = 0; g < 4; ++g) {
                    const f32x4 ck4 = ckv[mt][g];
                    const f32x2v c01 = {ck4[0], ck4[1]}, c23 = {ck4[2], ck4[3]};
                    const f32x2v a01 = {sacc[mt][4 * g], sacc[mt][4 * g + 1]}, a23 = {sacc[mt][4 * g + 2], sacc[mt][4 * g + 3]};
                    const f32x2v s01 = a01 * csc - c01, s23 = a23 * csc - c23;
                    sacc[mt][4 * g] = s01.x; sacc[mt][4 * g + 1] = s01.y; sacc[mt][4 * g + 2] = s23.x; sacc[mt][4 * g + 3] = s23.y;
                    mx = fmaxf(fmaxf(mx, s01.x), s01.y); mx = fmaxf(fmaxf(mx, s23.x), s23.y);
                }
        }
        if (diag) {
            mx = -1e30f;
            const int qrel = q - kt * 64 - 4 * h2;
#pragma unroll
            for (int mt = 0; mt < 2; ++mt)
#pragma unroll
                for (int e = 0; e < 16; ++e) {
                    const int krel = mt * 32 + (e & 3) + 8 * (e >> 2);
                    const float sv = (krel > qrel) ? -1e30f : sacc[mt][e];
                    sacc[mt][e] = sv;
                    mx = fmaxf(mx, sv);
                }
        }
        if (__builtin_amdgcn_ballot_w64(mx + cq - m > 30.f) != 0ull) {
            mx = fmaxf(mx, shx(mx, 32, lane));
            const float mn = fmaxf(m, mx + cq);
            const float alpha = __builtin_amdgcn_exp2f(m - mn);
            m = mn;
            l *= alpha;
            const f32x2v al2 = {alpha, alpha};
#pragma unroll
            for (int dt = 0; dt < 2; ++dt)
#pragma unroll
                for (int p2 = 0; p2 < 8; ++p2) {
                    f32x2v ov = {O[dt][2 * p2], O[dt][2 * p2 + 1]};
                    ov = ov * al2;
                    O[dt][2 * p2] = ov.x; O[dt][2 * p2 + 1] = ov.y;
                }
        }
        {
            const float sh = cq - m;
            const f32x2v sh2 = {sh, sh};
            f32x2v rs2 = {0.f, 0.f};
#pragma unroll
            for (int mt = 0; mt < 2; ++mt)
#pragma unroll
                for (int p2 = 0; p2 < 8; ++p2) {
                    const f32x2v sv = {sacc[mt][2 * p2], sacc[mt][2 * p2 + 1]};
                    const f32x2v t = sv + sh2;
                    f32x2v pp; pp.x = __builtin_amdgcn_exp2f(t.x); pp.y = __builtin_amdgcn_exp2f(t.y);
                    sacc[mt][2 * p2] = pp.x; sacc[mt][2 * p2 + 1] = pp.y;
                    rs2 = rs2 + pp;
                }
            l += rs2.x + rs2.y;
        }
        {
            u32x4 vw[2][2][2];
#pragma unroll
            for (int mt = 0; mt < 2; ++mt)
#pragma unroll
                for (int s = 0; s < 2; ++s)
#pragma unroll
                    for (int dt = 0; dt < 2; ++dt) {
                        const bf16_t* vp = VTs + (dt * 32 + r) * 72 + mt * 32 + 16 * s + 4 * h2;
                        const u32x2 lo = *(const u32x2*)vp, hi = *(const u32x2*)(vp + 8);
                        vw[mt][s][dt].x = lo.x; vw[mt][s][dt].y = lo.y; vw[mt][s][dt].z = hi.x; vw[mt][s][dt].w = hi.y;
                    }
            u32x4 pw[2][2];
#pragma unroll
            for (int mt = 0; mt < 2; ++mt)
#pragma unroll
                for (int s = 0; s < 2; ++s) {
                    pw[mt][s].x = pack2(sacc[mt][8 * s + 0], sacc[mt][8 * s + 1]); pw[mt][s].y = pack2(sacc[mt][8 * s + 2], sacc[mt][8 * s + 3]);
                    pw[mt][s].z = pack2(sacc[mt][8 * s + 4], sacc[mt][8 * s + 5]); pw[mt][s].w = pack2(sacc[mt][8 * s + 6], sacc[mt][8 * s + 7]);
                }
            __builtin_amdgcn_sched_barrier(0);
#pragma unroll
            for (int mt = 0; mt < 2; ++mt)
#pragma unroll
                for (int s = 0; s < 2; ++s) {
                    const bf16x8 pf = __builtin_bit_cast(bf16x8, pw[mt][s]);
                    O[0] = MFMA32(__builtin_bit_cast(bf16x8, vw[mt][s][0]), pf, O[0]);
                    O[1] = MFMA32(__builtin_bit_cast(bf16x8, vw[mt][s][1]), pf, O[1]);
                }
        }
        if (more) {
            unsigned char* bufn = smem + ((kt + 1) & 1) * BUFB;
            bf16_t* Kn = (bf16_t*)bufn; bf16_t* VTn = Kn + 64 * 72; float* ckn = (float*)(bufn + 2 * 64 * 72 * 2);
            *(u32x4*)(Kn + srow * 72 + scol) = rk0; *(u32x4*)(Kn + (srow + 32) * 72 + scol) = rk1;
            *(u32x4*)(VTn + srow * 72 + scol) = rv0; *(u32x4*)(VTn + (srow + 32) * 72 + scol) = rv1;
            if (tid < 64) ckn[tid] = rc;
        }
        __syncthreads();
    }
    l += shx(l, 32, lane);
    const float inv = 1.f / l;
    float ss = 0.f;
#pragma unroll
    for (int e = 0; e < 16; ++e) { O[0][e] *= inv; O[1][e] *= inv; ss += O[0][e] * O[0][e] + O[1][e] * O[1][e]; }
    ss += shx(ss, 32, lane);
    const float sc = rsqrtf(ss * (1.f / 64.f) + 1e-6f);
    bf16_t* op = (bf16_t*)(P.ws + OFF_MIX) + ((size_t)b * TSEQ + q) * 1024 + 512 + hh * 64;
    const float* fg = P.in[10];
    f32x4 ggv[2][4];
#pragma unroll
    for (int dt = 0; dt < 2; ++dt)
#pragma unroll
        for (int g = 0; g < 4; ++g) ggv[dt][g] = *(const f32x4*)(fg + dt * 32 + 8 * g + 4 * h2);
#pragma unroll
    for (int dt = 0; dt < 2; ++dt)
#pragma unroll
        for (int g = 0; g < 4; ++g) {
            const int d0 = dt * 32 + 8 * g + 4 * h2;
            const f32x4 gg = ggv[dt][g];
            u32x2 o;
            o.x = pack2(O[dt][4 * g + 0] * sc * gg[0], O[dt][4 * g + 1] * sc * gg[1]); o.y = pack2(O[dt][4 * g + 2] * sc * gg[2], O[dt][4 * g + 3] * sc * gg[3]);
            *(u32x2*)(op + d0) = o;
        }
}

#define XB_TMO      128
#define XB_XCNT(j)  (256  + 64 * (j))
#define XB_XSUB(j)  (1280 + 64 * (j))
#define XB_XGEN(j)  (2304 + 64 * (j))
#define XB_TOP      3328
#define XB_TOPGEN   3392
#define XCD_BAR_WORDS 3456
#define XB_SPIN_CAP (1u << 18)
#define LAS __attribute__((address_space(3)))
DI unsigned xb_ld(unsigned* p)              { return __hip_atomic_load(p, __ATOMIC_RELAXED, __HIP_MEMORY_SCOPE_AGENT); }
DI unsigned xb_add(unsigned* p, unsigned v) { return __hip_atomic_fetch_add(p, v, __ATOMIC_RELAXED, __HIP_MEMORY_SCOPE_AGENT); }
DI unsigned xb_xcc_id() { return (unsigned)__builtin_amdgcn_s_getreg((3 << 11) | 20) & 0xFu; }
#define XB_SPIN(cond, bar) do { unsigned _sp = 0; while (cond) { __builtin_amdgcn_s_sleep(1); \
    if ((++_sp & 255u) == 0u) { if (xb_ld(&(bar)[XB_TMO])) break; if (_sp > XB_SPIN_CAP) { atomicAdd(&(bar)[XB_TMO], 1u); break; } } } } while (0)
struct XcdBarrier { unsigned* bar; unsigned x; volatile LAS unsigned* st; };
DI XcdBarrier xcd_barrier_post(unsigned* bar, volatile LAS unsigned* st, int tid0) {
    XcdBarrier b; b.bar = bar; b.x = xb_xcc_id(); b.st = st;
    if (tid0 == 0) (void)xb_add(&bar[XB_XCNT(b.x)], 1u);
    return b;
}
DI void xcd_barrier_complete(unsigned* bar, unsigned x, unsigned& nloc, unsigned& nx) {
    const unsigned G = gridDim.x * gridDim.y * gridDim.z;
    unsigned sum, cnt, mine, sp = 0u;
    for (;;) {
        sum = 0u; cnt = 0u; mine = 0u;
#pragma unroll
        for (unsigned j = 0; j < 16; ++j) { const unsigned c = xb_ld(&bar[XB_XCNT(j)]); sum += c; cnt += (c > 0u) ? 1u : 0u; mine = (j == x) ? c : mine; }
        if (sum == G) break;
        __builtin_amdgcn_s_sleep(1);
        if ((++sp & 255u) == 0u) { if (xb_ld(&bar[XB_TMO])) break; if (sp > XB_SPIN_CAP) { atomicAdd(&bar[XB_TMO], 1u); break; } }
    }
    nloc = mine > 0u ? mine : 1u; nx = cnt > 0u ? cnt : 1u;
}
DI void xcd_barrier(const XcdBarrier& b, const int wid_s) {
    asm volatile("s_waitcnt vmcnt(0)" ::: "memory");
    __syncthreads();
    if (fresh_tid(wid_s) == 0) {
        unsigned* bar = b.bar;
        __builtin_amdgcn_s_waitcnt(0);
        unsigned nloc = b.st[0], nx = b.st[1];
        if (nloc == 0u) { xcd_barrier_complete(bar, b.x, nloc, nx); b.st[0] = nloc; b.st[1] = nx; }
        const unsigned old = xb_add(&bar[XB_XSUB(b.x)], 1u);
        const unsigned gen = old / nloc;
        if (old + 1u == (gen + 1u) * nloc) {
            __builtin_amdgcn_fence(__ATOMIC_RELEASE, "agent");
            asm volatile("s_waitcnt vmcnt(0)" ::: "memory");
            const unsigned og = xb_add(&bar[XB_TOP], 1u);
            const unsigned tg = og / nx;
            if (og + 1u == (tg + 1u) * nx) xb_add(&bar[XB_TOPGEN], 1u);
            else XB_SPIN(xb_ld(&bar[XB_TOPGEN]) == tg, bar);
            __builtin_amdgcn_fence(__ATOMIC_ACQUIRE, "agent");
            xb_add(&bar[XB_XGEN(b.x)], 1u);
            asm volatile("s_waitcnt vmcnt(0)" ::: "memory");
        } else {
            XB_SPIN(xb_ld(&bar[XB_XGEN(b.x)]) == gen, bar);
            __builtin_amdgcn_fence(__ATOMIC_ACQUIRE, "agent");
            asm volatile("s_waitcnt vmcnt(0)" ::: "memory");
        }
    }
    __syncthreads();
}


template <int MODE> struct EpiLnFused {
    static constexpr bool PERM = true, AFTER_DRAIN = true;
    const float* x; const float* g_in; const float* b_in; const float* stats;
    const bf16_t* h1; const bf16_t* pg;
    float* xbuf; unsigned* cnt; const float* g; const float* b; float* outf; bf16_t* outb;
    DI void operator()(const pg8::f32x4 (&)[2][2][4][2], const pg8::Unit&, int, int, int, int) const {}
    DI void fused(pg8::f32x4 (&acc)[2][2][4][2], const pg8::Unit& u, int wr, int wc, int fr, int fq, pg8::PG8_LAS_T ldsp, int wid, int lane) const {
        float* P = (float*)(unsigned char*)ldsp;
        float* ST = P + 2048;
        const int tid = wid * 64 + lane;
        f32x4 gi[2][2], bi[2][2];
#pragma unroll
        for (int bj = 0; bj < 2; ++bj) {
            const int col = u.pn * 256 + bj * 128 + wc * 32 + 8 * fq;
            if (MODE == 0) { gi[bj][0] = *(const f32x4*)(g_in + col); gi[bj][1] = *(const f32x4*)(g_in + col + 4); bi[bj][0] = *(const f32x4*)(b_in + col); bi[bj][1] = *(const f32x4*)(b_in + col + 4); }
        }
#pragma unroll
        for (int ai = 0; ai < 2; ++ai)
#pragma unroll
            for (int m = 0; m < 4; ++m) {
                const int rt = ai * 128 + wr * 64 + m * 16 + fr, row = u.pm * 256 + rt;
                float sm = 0.f, sq = 0.f;
                float mu = 0.f, rs = 0.f;
                if (MODE == 0) { mu = stats[row * 2]; rs = stats[row * 2 + 1]; }
#pragma unroll
                for (int bj = 0; bj < 2; ++bj) {
                    const int col = u.pn * 256 + bj * 128 + wc * 32 + 8 * fq;
                    const size_t idx = (size_t)row * DM + col;
                    f32x4 v0, v1;
                    if (MODE == 0) {
                        const f32x4 x0 = *(const f32x4*)(x + idx), x1 = *(const f32x4*)(x + idx + 4);
                        v0 = ((x0 - mu) * rs * gi[bj][0] + bi[bj][0]) * ALPHA + acc[ai][bj][m][0];
                        v1 = ((x1 - mu) * rs * gi[bj][1] + bi[bj][1]) * ALPHA + acc[ai][bj][m][1];
                    } else {
                        const u32x4 w = *(const u32x4*)(pg + idx);
                        const u32x4 hw = *(const u32x4*)(h1 + idx);
                        v0 = (f32x4){bflo(hw.x), bfhi(hw.x), bflo(hw.y), bfhi(hw.y)} * ALPHA + acc[ai][bj][m][0];
                        v1 = (f32x4){bflo(hw.z), bfhi(hw.z), bflo(hw.w), bfhi(hw.w)} * ALPHA + acc[ai][bj][m][1];
                        v0[0] += bflo(w.x); v0[1] += bfhi(w.x); v0[2] += bflo(w.y); v0[3] += bfhi(w.y);
                        v1[0] += bflo(w.z); v1[1] += bfhi(w.z); v1[2] += bflo(w.w); v1[3] += bfhi(w.w);
                    }
                    acc[ai][bj][m][0] = v0; acc[ai][bj][m][1] = v1;
#pragma unroll
                    for (int e = 0; e < 4; ++e) { sm += v0[e] + v1[e]; sq += v0[e] * v0[e] + v1[e] * v1[e]; }
                }
                sm += shx(sm, 16, lane); sm += shx(sm, 32, lane);
                sq += shx(sq, 16, lane); sq += shx(sq, 32, lane);
                if (fq == 0) { P[(rt * 4 + wc) * 2] = sm; P[(rt * 4 + wc) * 2 + 1] = sq; }
            }
        __syncthreads();
        if (tid < 256) {
            const f32x4 a = *(const f32x4*)(P + tid * 8), c = *(const f32x4*)(P + tid * 8 + 4);
            float* slot = xbuf + ((size_t)(u.pm * 256 + tid) * 4 + u.pn) * 2;
            __hip_atomic_store(slot, (a[0] + a[2]) + (c[0] + c[2]), __ATOMIC_RELAXED, __HIP_MEMORY_SCOPE_AGENT);
            __hip_atomic_store(slot + 1, (a[1] + a[3]) + (c[1] + c[3]), __ATOMIC_RELAXED, __HIP_MEMORY_SCOPE_AGENT);
        }
        asm volatile("s_waitcnt vmcnt(0)" ::: "memory");
        __syncthreads();
        if (tid == 0) {
            xb_add(cnt + u.pm, 1u);
            unsigned sp = 0;
            while (xb_ld(cnt + u.pm) < 4u) { __builtin_amdgcn_s_sleep(1); if (++sp > (1u << 22)) break; }
        }
        __syncthreads();
        if (tid < 256) {
            float* slot = xbuf + (size_t)(u.pm * 256 + tid) * 8;
            float pv[8];
#pragma unroll
            for (int e = 0; e < 8; ++e) pv[e] = __hip_atomic_load(slot + e, __ATOMIC_RELAXED, __HIP_MEMORY_SCOPE_AGENT);
            const float sm = (pv[0] + pv[2]) + (pv[4] + pv[6]), sq = (pv[1] + pv[3]) + (pv[5] + pv[7]);
            const float mean = sm * (1.f / 1024.f);
            const float var = fmaxf(sq * (1.f / 1024.f) - mean * mean, 0.f);
            ST[tid * 2] = mean; ST[tid * 2 + 1] = rsqrtf(var + 1e-5f);
        }
        __syncthreads();
        f32x4 go[2][2], bo[2][2];
#pragma unroll
        for (int bj = 0; bj < 2; ++bj) {
            const int col = u.pn * 256 + bj * 128 + wc * 32 + 8 * fq;
            go[bj][0] = *(const f32x4*)(g + col); go[bj][1] = *(const f32x4*)(g + col + 4); bo[bj][0] = *(const f32x4*)(b + col); bo[bj][1] = *(const f32x4*)(b + col + 4);
        }
#pragma unroll
        for (int ai = 0; ai < 2; ++ai)
#pragma unroll
            for (int m = 0; m < 4; ++m) {
                const int rt = ai * 128 + wr * 64 + m * 16 + fr, row = u.pm * 256 + rt;
                const float mean = ST[rt * 2], rstd = ST[rt * 2 + 1];
#pragma unroll
                for (int bj = 0; bj < 2; ++bj) {
                    const int col = u.pn * 256 + bj * 128 + wc * 32 + 8 * fq;
                    const size_t idx = (size_t)row * DM + col;
                    const f32x4 o0 = (acc[ai][bj][m][0] - mean) * rstd * go[bj][0] + bo[bj][0], o1 = (acc[ai][bj][m][1] - mean) * rstd * go[bj][1] + bo[bj][1];
                    if (outf) { *(f32x4*)(outf + idx) = o0; *(f32x4*)(outf + idx + 4) = o1; }
                    if (outb) *(u32x4*)(outb + idx) = pack8(o0, o1);
                }
            }
    }
};

template <class Epi> DI void run_gemm(pg8::PG8_LAS_T lds, const bf16_t* A, const bf16_t* Bt, int N, int K, const Epi& E, const int wid_s) {
    pg8::Gemm g{A, Bt, M_TOK, N, K}; pg8::StaticOrder S; S.init(M_TOK, N, (int)gridDim.x, (int)blockIdx.x);
    pg8::gemm_phase<Epi, pg8::StaticOrder, true, true>(lds, g, S, E, wid_s);
}
__global__ void __launch_bounds__(512, 2) fwd_mega(Params P) {
    cg::grid_group grid = cg::this_grid();
    extern __shared__ __attribute__((aligned(16))) unsigned char lds[];
    pg8::PG8_LAS_T glds = (pg8::PG8_LAS_T)lds;
    volatile LAS unsigned* xb_words = (volatile LAS unsigned*)(glds + LDS_MISC);
    volatile int* s_item = (volatile int*)(lds + LDS_MISC + 16);
    const int nblk = gridDim.x, bid = blockIdx.x;
    unsigned char* ws = P.ws;

    const int wid_s = __builtin_amdgcn_readfirstlane((int)threadIdx.x >> 6);
    if (threadIdx.x < 4) xb_words[threadIdx.x] = 0u;
    __syncthreads();
    const XcdBarrier xbar = xcd_barrier_post((unsigned*)(ws + OFF_BAR), xb_words, (int)threadIdx.x);
    if (P.out == nullptr) grid.sync();

    {
    for (int base = bid * 2; base < 1984 + 4096; base += nblk * 2) {
        PHASE_IDS
        const int it = base + team;
        if (it < 960) {
            transpose_tile(P.in[4], 1024, 3600, (bf16_t*)(ws + OFF_WIN), it / 60, it % 60, 1, (float*)smem, tt);
        } else if (it < 1984) {
            const int loc = it - 960;
            transpose_tile(P.in[15], 4096, 1024, (bf16_t*)(ws + OFF_WDOWN), loc / 16, loc % 16, 0, (float*)smem, tt);
        } else {
            const int row = (it - 1984) * 4 + tw;
            ln_row(P.in[0] + (size_t)row * DM, P.in[2], P.in[3], nullptr, (bf16_t*)(ws + OFF_HB) + (size_t)row * DM, (float*)(ws + OFF_STATS) + row * 2, lane);
            { const f32x4 pv = *(const f32x4*)(P.in[1] + (size_t)row * 256 + lane * 4); u32x2 w; w.x = pack2(pv[0], pv[1]); w.y = pack2(pv[2], pv[3]);
              *(u32x2*)((bf16_t*)(ws + OFF_PB) + (size_t)row * 256 + lane * 4) = w; }
        }
    }
    }
    xcd_barrier(xbar, wid_s);

    { EpiProj E{ws}; run_gemm(glds, (const bf16_t*)(ws + OFF_HB), (const bf16_t*)(ws + OFF_WIN), NPROJ, DM, E, wid_s); }
    {
        const int nun = (M_TOK / 256) * (NPROJ / 256);
        const int maxu = (nun + nblk - 1) / nblk;
        int first_short = nun - (maxu - 1) * nblk, nshort = nblk - first_short;
        if (nshort <= 0) { first_short = 0; nshort = nblk; }
        if (bid >= first_short) {
            for (int base = (bid - first_short) * 2; base < 1600; base += nshort * 2) {
                PHASE_IDS
                const int j = base + team;
                const float* W; int K, N, loc, nnt; bf16_t* Wt;
                if (j < 256) { W = P.in[11]; K = 1024; N = 1024; Wt = (bf16_t*)(ws + OFF_WOUT); loc = j; nnt = 16; }
                else if (j < 1280) { W = P.in[14]; K = 1024; N = 4096; Wt = (bf16_t*)(ws + OFF_WUP); loc = j - 256; nnt = 64; }
                else if (j < 1536) { W = P.in[17]; K = 1024; N = 1024; Wt = (bf16_t*)(ws + OFF_WG); loc = j - 1280; nnt = 16; }
                else { W = P.in[16]; K = 256; N = 1024; Wt = (bf16_t*)(ws + OFF_WPLE); loc = j - 1536; nnt = 16; }
                transpose_tile(W, K, N, Wt, loc / nnt, loc % nnt, 0, (float*)smem, tt);
            }
        }
    }
    xcd_barrier(xbar, wid_s);

    for (int rep = 0; rep < NREP(2); ++rep)
    {
    for (int base = bid * 2; base < 1024 + 64; base += nblk * 2) {
        PHASE_IDS
        const int it = base + team;
        if (it < 1024) prep_chunk(P, it, smem, tt); else fox_cumsum(P, it - 1024, smem, tt);
    }
    }
    xcd_barrier(xbar, wid_s);

    for (int rep = 0; rep < NREP(3); ++rep)
    {
    bool first = true;
    for (;;) {
        PHASE_IDS
        int pr;
        if (first) { first = false; pr = bid; }
        else {
            __syncthreads();
            if (tid == 0) *s_item = nblk + atomicAdd((int*)(ws + OFF_CTR) + rep, 1);
            __syncthreads();
            pr = *s_item;
        }
        if (pr >= 64 + 512) break;
        if (pr < 64) gdn_scan(P, pr * 2 + team, smem, tt);
        else { const int fj = pr - 64; fox_attn(P, (fj & 31) * 2 + team, 15 - (fj >> 5), smem, tt); }
    }
    }
    xcd_barrier(xbar, wid_s);

    { PHASE_IDS
    for (int it = bid; it < M_TOK / 8; it += nblk) {
        const int row = it * 8 + wave8;
        bf16_t* mix = (bf16_t*)(ws + OFF_MIX) + (size_t)row * DM;
        {
            const int col = lane * 8;
            const u32x4 ov = *(const u32x4*)((const bf16_t*)(ws + OFF_OG) + (size_t)row * 512 + col);
            const u32x4 zv = *(const u32x4*)((const bf16_t*)(ws + OFF_Z) + (size_t)row * 512 + col);
            float o[8] = {bflo(ov.x), bfhi(ov.x), bflo(ov.y), bfhi(ov.y), bflo(ov.z), bfhi(ov.z), bflo(ov.w), bfhi(ov.w)};
            float z[8] = {bflo(zv.x), bfhi(zv.x), bflo(zv.y), bfhi(zv.y), bflo(zv.z), bfhi(zv.z), bflo(zv.w), bfhi(zv.w)};
            float ss = 0.f;
#pragma unroll
            for (int e = 0; e < 8; ++e) ss += o[e] * o[e];
            ss += shx(ss, 1, lane); ss += shx(ss, 2, lane); ss += shx(ss, 4, lane); ss += shx(ss, 8, lane);
            const float sc = rsqrtf(ss * (1.f / 128.f) + 1e-6f);
            const float* gg = P.in[8] + (col & 127);
            float v[8];
#pragma unroll
            for (int e = 0; e < 8; ++e) v[e] = o[e] * sc * gg[e] * siluf(z[e]);
            u32x4 w; w.x = pack2(v[0], v[1]); w.y = pack2(v[2], v[3]); w.z = pack2(v[4], v[5]); w.w = pack2(v[6], v[7]);
            *(u32x4*)(mix + col) = w;
        }
    }
    }
    xcd_barrier(xbar, wid_s);

    { EpiLnFused<0> E{P.in[0], P.in[2], P.in[3], (const float*)(ws + OFF_STATS), nullptr, nullptr, (float*)(ws + OFF_XBUF), (unsigned*)(ws + OFF_PCNT), P.in[12], P.in[13], nullptr, (bf16_t*)(ws + OFF_H1B)};
      run_gemm(glds, (const bf16_t*)(ws + OFF_MIX), (const bf16_t*)(ws + OFF_WOUT), DM, DM, E, wid_s); }
    xcd_barrier(xbar, wid_s);

    { EpiUp E{(bf16_t*)(ws + OFF_FFB)}; run_gemm(glds, (const bf16_t*)(ws + OFF_H1B), (const bf16_t*)(ws + OFF_WUP), 4096, DM, E, wid_s); }
    { EpiGate E{(bf16_t*)(ws + OFF_PG), P.in[18]}; run_gemm(glds, (const bf16_t*)(ws + OFF_H1B), (const bf16_t*)(ws + OFF_WG), DM, DM, E, wid_s); }
    { EpiPle E{(bf16_t*)(ws + OFF_PG)}; run_gemm(glds, (const bf16_t*)(ws + OFF_PB), (const bf16_t*)(ws + OFF_WPLE), DM, 256, E, wid_s); }
    xcd_barrier(xbar, wid_s);

    { EpiLnFused<1> E{nullptr, nullptr, nullptr, nullptr, (const bf16_t*)(ws + OFF_H1B), (const bf16_t*)(ws + OFF_PG), (float*)(ws + OFF_XBUF) + (size_t)M_TOK * 8, (unsigned*)(ws + OFF_PCNT) + 64, P.in[19], P.in[20], P.out, nullptr};
      run_gemm(glds, (const bf16_t*)(ws + OFF_FFB), (const bf16_t*)(ws + OFF_WDOWN), DM, 4096, E, wid_s); }
}

extern "C" void kernel_launch(void* const* d_in, const int* in_sizes, int n_in, void* d_out, int out_size, void* d_ws, size_t ws_size, hipStream_t stream) {
    static int grid_blocks = 0;
    if (!grid_blocks) {
        int dev = 0, cus = 0, per_cu = 0;
        (void)hipGetDevice(&dev);
        (void)hipDeviceGetAttribute(&cus, hipDeviceAttributeMultiprocessorCount, dev);
        if (hipFuncSetAttribute((const void*)fwd_mega, hipFuncAttributeMaxDynamicSharedMemorySize, LDS_BYTES) != hipSuccess) fprintf(stderr, "kernel_launch: hipFuncSetAttribute failed\n");
        (void)hipOccupancyMaxActiveBlocksPerMultiprocessor(&per_cu, (const void*)fwd_mega, 512, LDS_BYTES);
        if (per_cu < 1) fprintf(stderr, "kernel_launch: occupancy query reports %d blocks per CU\n", per_cu);
        (void)hipGetLastError();
        grid_blocks = cus;
        if (ws_size < 232 * MBy) fprintf(stderr, "kernel_launch: workspace too small (%zu)\n", ws_size);
    }
    Params p{};
    for (int i = 0; i < 21; ++i) p.in[i] = (const float*)d_in[i];
    p.out = (float*)d_out; p.ws = (unsigned char*)d_ws;
    (void)hipMemsetAsync((unsigned char*)d_ws + OFF_BAR, 0, 16384, stream);
    void* args[] = {&p};
    hipError_t e = hipLaunchCooperativeKernel((void*)fwd_mega, dim3(grid_blocks), dim3(512), args, LDS_BYTES, stream);
    if (e != hipSuccess) fprintf(stderr, "cooperative launch failed: %s (grid %d)\n", hipGetErrorString(e), grid_blocks);
}
```
